# Optimizing an MI355X kernel written in HIP

```python
import math
import numpy as np
import jax
import jax.numpy as jnp
from jax import lax

D_MODEL = 1024
BATCH = 8
SEQ = 4096
DEPTH = 4

CHUNK = 64
BRANCH_WIDTH = D_MODEL // 2
N_BRANCH = 3
M_HEADS = 4
M_HEAD_DIM = BRANCH_WIDTH // M_HEADS
M_CONV = 4
S5_GROUP = 16
S5_GROUPS = BRANCH_WIDTH // S5_GROUP
S5_STATE = 64
A_HEADS = 8
A_HEAD_DIM = BRANCH_WIDTH // A_HEADS
Q_BLOCK = 128
N_GROUPS = 4
EXPERTS_PER_GROUP = 8
N_EXPERTS = N_GROUPS * EXPERTS_PER_GROUP
EXPERT_HIDDEN = D_MODEL // 2
TOP_K = 2
MOE_BLOCK = 256
LN_EPS = 1e-5
ALPHA = (2 * DEPTH) ** 0.25
BETA = (8 * DEPTH) ** -0.25
IN_SIZES = (2 * BRANCH_WIDTH, BRANCH_WIDTH, BRANCH_WIDTH, M_HEADS, M_HEADS,
            BRANCH_WIDTH, 3 * BRANCH_WIDTH, A_HEADS, N_BRANCH * D_MODEL)
IN_TOTAL = 8 * BRANCH_WIDTH + 2 * M_HEADS + A_HEADS + N_BRANCH * D_MODEL

kernel_name = 'hybrid_mlstm_s5_fox_hmoe_encoder'


def _in_starts():
    return [int(s) for s in np.cumsum((0,) + IN_SIZES)]


def layer_norm(x, g, b):
    xf = x.astype(jnp.float32)
    mu = jnp.mean(xf, axis=-1, keepdims=True)
    var = jnp.mean(jnp.square(xf - mu), axis=-1, keepdims=True)
    return ((xf - mu) * lax.rsqrt(var + LN_EPS)).astype(x.dtype) * g + b


def head_norm(h, w, n_heads):
    bsz, seq, width = h.shape
    hf = h.reshape(bsz, seq, n_heads, width // n_heads).astype(jnp.float32)
    mu = jnp.mean(hf, axis=-1, keepdims=True)
    var = jnp.mean(jnp.square(hf - mu), axis=-1, keepdims=True)
    out = ((hf - mu) * lax.rsqrt(var + LN_EPS)).reshape(bsz, seq, width)
    return out.astype(h.dtype) * w


def causal_depthwise_conv(u, w, b):
    k = w.shape[0]
    out = lax.conv_general_dilated(
        u, w[:, None, :].astype(u.dtype), window_strides=(1,), padding=[(k - 1, 0)],
        dimension_numbers=('NWC', 'WIO', 'NWC'), feature_group_count=u.shape[-1])
    return out + b


def _to_chunks(t):
    bsz, seq, heads = t.shape[:3]
    t = t.reshape((bsz, seq // CHUNK, CHUNK, heads) + t.shape[3:])
    return jnp.moveaxis(t, (1, 3), (0, 2))


def mlstm_chunkwise(q, k, v, i_pre, f_pre):
    bsz, seq, heads, dh = q.shape
    f32 = jnp.float32
    qc = _to_chunks(q.astype(f32))
    kc = _to_chunks(k.astype(f32) * dh ** -0.5)
    vc = _to_chunks(v.astype(f32))
    ic = _to_chunks(i_pre.astype(f32))
    lfc = _to_chunks(jax.nn.log_sigmoid(f_pre.astype(f32)))
    causal = jnp.tril(jnp.ones((CHUNK, CHUNK), dtype=bool))

    def step(carry, inp):
        c_st, n_st, m_st = carry
        q_, k_, v_, i_, lf = inp
        b = jnp.cumsum(lf, axis=-1)
        d_log = jnp.where(causal, b[..., :, None] - b[..., None, :] + i_[..., None, :], -jnp.inf)
        g_log = b + m_st[..., None]
        m_t = jnp.maximum(jnp.max(d_log, axis=-1), g_log)
        w_intra = jnp.exp(d_log - m_t[..., None])
        w_state = jnp.exp(g_log - m_t)
        s = jnp.einsum('bhtd,bhsd->bhts', q_, k_) * w_intra
        num = (jnp.einsum('bhts,bhsd->bhtd', s, v_)
               + w_state[..., None] * jnp.einsum('bhtk,bhkv->bhtv', q_, c_st))
        den = jnp.sum(s, axis=-1) + w_state * jnp.einsum('bhtk,bhk->bht', q_, n_st)
        h = num / jnp.maximum(jnp.abs(den), jnp.exp(-m_t))[..., None]
        b_last = b[..., -1]
        a_log = b_last[..., None] - b + i_
        m_new = jnp.maximum(b_last + m_st, jnp.max(a_log, axis=-1))
        kw = k_ * jnp.exp(a_log - m_new[..., None])[..., None]
        decay = jnp.exp(b_last + m_st - m_new)
        c_new = decay[..., None, None] * c_st + jnp.einsum('bhsk,bhsv->bhkv', kw, v_)
        n_new = decay[..., None] * n_st + jnp.sum(kw, axis=2)
        return (c_new, n_new, m_new), h

    init = (jnp.zeros((bsz, heads, dh, dh), f32), jnp.zeros((bsz, heads, dh), f32),
            jnp.zeros((bsz, heads), f32))
    _, h = lax.scan(step, init, (qc, kc, vc, ic, lfc))
    h = jnp.moveaxis(h, (0, 2), (1, 3)).reshape(bsz, seq, heads * dh)
    return h.astype(q.dtype)


def s5_grouped(u, lam_re, lam_im, log_dt, b_re, b_im, c_re, c_im, d):
    f32 = jnp.float32
    bsz, seq, _ = u.shape
    ug = u.astype(f32).reshape(bsz, seq, S5_GROUPS, S5_GROUP)
    lr, li = lam_re.astype(f32), lam_im.astype(f32)
    dt = jnp.exp(log_dt.astype(f32))[:, None]
    mag = jnp.exp(lr * dt)
    abar_re, abar_im = mag * jnp.cos(li * dt), mag * jnp.sin(li * dt)
    den = lr * lr + li * li
    nr, ni = abar_re - 1.0, abar_im
    zr = (nr * lr + ni * li) / den
    zi = (ni * lr - nr * li) / den
    br, bi = b_re.astype(f32), b_im.astype(f32)
    bbar_re = zr[..., None] * br - zi[..., None] * bi
    bbar_im = zr[..., None] * bi + zi[..., None] * br
    xr = jnp.einsum('gpc,bsgc->bsgp', bbar_re, ug)
    xi = jnp.einsum('gpc,bsgc->bsgp', bbar_im, ug)
    a_re = jnp.broadcast_to(abar_re, (1, seq) + abar_re.shape)
    a_im = jnp.broadcast_to(abar_im, (1, seq) + abar_im.shape)

    def combine(e1, e2):
        a1r, a1i, b1r, b1i = e1
        a2r, a2i, b2r, b2i = e2
        return (a1r * a2r - a1i * a2i, a1r * a2i + a1i * a2r,
                a2r * b1r - a2i * b1i + b2r, a2r * b1i + a2i * b1r + b2i)

    _, _, hr, hi = lax.associative_scan(combine, (a_re, a_im, xr, xi), axis=1)
    y = (jnp.einsum('gcp,bsgp->bsgc', c_re.astype(f32), hr)
         - jnp.einsum('gcp,bsgp->bsgc', c_im.astype(f32), hi)
         + d.astype(f32) * ug)
    return y.reshape(bsz, seq, S5_GROUPS * S5_GROUP).astype(u.dtype)


def forgetting_attention(q, k, v, f_pre):
    bsz, seq, heads, dh = q.shape
    n_blk = seq // Q_BLOCK
    f_cum = jnp.cumsum(jax.nn.log_sigmoid(f_pre.astype(jnp.float32)), axis=1)
    f_cum = jnp.transpose(f_cum, (0, 2, 1))
    q_blk = jnp.moveaxis(q.reshape(bsz, n_blk, Q_BLOCK, heads, dh), 1, 0)
    f_blk = jnp.moveaxis(f_cum.reshape(bsz, heads, n_blk, Q_BLOCK), 2, 0)
    k_pos = jnp.arange(seq)
    scale = dh ** -0.5

    def one_block(args):
        qb, fb, bi = args
        q_pos = bi * Q_BLOCK + jnp.arange(Q_BLOCK)
        s = jnp.einsum('bqhd,bkhd->bhqk', qb, k).astype(jnp.float32) * scale
        s = s + fb[..., :, None] - f_cum[..., None, :]
        s = jnp.where(k_pos[None, :] <= q_pos[:, None], s, -jnp.inf)
        p = jax.nn.softmax(s, axis=-1).astype(v.dtype)
        return jnp.einsum('bhqk,bkhd->bqhd', p, v)

    out = lax.map(one_block, (q_blk, f_blk, jnp.arange(n_blk)))
    return jnp.moveaxis(out, 0, 1).reshape(bsz, seq, heads * dh)


def hier_moe(x, w_rg, b_rg, w_re, b_re, w_gate, w_up, w_down):
    bsz, seq, d = x.shape
    n_tok = bsz * seq
    xf = x.reshape(n_tok, d)
    lg = (xf @ w_rg).astype(jnp.float32) + b_rg.astype(jnp.float32)
    grp = jnp.argmax(lg, axis=-1)
    gate_g = jnp.take_along_axis(jax.nn.softmax(lg, axis=-1), grp[:, None], axis=-1)[:, 0]
    le = ((xf @ w_re).astype(jnp.float32) + b_re.astype(jnp.float32)).reshape(
        n_tok, N_GROUPS, EXPERTS_PER_GROUP)
    le = jnp.take_along_axis(le, grp[:, None, None], axis=1)[:, 0]
    top_l, top_i = lax.top_k(le, TOP_K)
    weights = gate_g[:, None] * jax.nn.softmax(top_l, axis=-1)
    expert = grp[:, None] * EXPERTS_PER_GROUP + top_i

    n_asg = n_tok * TOP_K
    flat_e = expert.reshape(n_asg)
    flat_t = jnp.repeat(jnp.arange(n_tok, dtype=jnp.int32), TOP_K)
    flat_w = weights.reshape(n_asg)
    order = jnp.argsort(flat_e)
    se = flat_e[order]
    counts = jnp.zeros((N_EXPERTS,), jnp.int32).at[flat_e].add(1)
    starts = jnp.cumsum(counts) - counts
    pcounts = (counts + MOE_BLOCK - 1) // MOE_BLOCK * MOE_BLOCK
    pends = jnp.cumsum(pcounts)
    pstarts = pends - pcounts
    dest = pstarts[se] + jnp.arange(n_asg, dtype=jnp.int32) - starts[se]
    n_blk = -(-n_asg // MOE_BLOCK) + N_EXPERTS
    buf_tok = jnp.full((n_blk * MOE_BLOCK,), n_tok, jnp.int32).at[dest].set(flat_t[order])
    buf_w = jnp.zeros((n_blk * MOE_BLOCK,), jnp.float32).at[dest].set(flat_w[order])
    blk_e = jnp.minimum(jnp.searchsorted(pends, jnp.arange(n_blk) * MOE_BLOCK, side='right'),
                        N_EXPERTS - 1)
    x_pad = jnp.concatenate([xf, jnp.zeros((1, d), xf.dtype)], axis=0)
    xb = x_pad[buf_tok].reshape(n_blk, MOE_BLOCK, d)

    def expert_block(args):
        xe, e = args
        h = jax.nn.silu(xe @ w_gate[e]) * (xe @ w_up[e])
        return h @ w_down[e]

    yb = lax.map(expert_block, (xb, blk_e)).reshape(n_blk * MOE_BLOCK, d)
    y = jax.ops.segment_sum(yb * buf_w[:, None].astype(yb.dtype), buf_tok,
                            num_segments=n_tok + 1)[:n_tok]
    return y.reshape(bsz, seq, d)


def setup_inputs(seed: int = 0) -> dict:
    key = jax.random.key(seed)
    ks = list(jax.random.split(key, 32))
    f32 = jnp.float32
    L, D, W = DEPTH, D_MODEL, BRANCH_WIDTH
    G, P, C = S5_GROUPS, S5_STATE, S5_GROUP
    E, F = N_EXPERTS, EXPERT_HIDDEN

    def nrm(i, shape, std):
        return jax.random.normal(ks[i], shape, f32) * std

    st = _in_starts()
    b_in = nrm(2, (L, IN_TOTAL), 0.02)
    b_in = b_in.at[:, st[4]:st[4] + M_HEADS].add(jnp.linspace(3.0, 6.0, M_HEADS, dtype=f32))
    b_in = b_in.at[:, st[7]:st[7] + A_HEADS].add(jnp.linspace(1.0, 5.0, A_HEADS, dtype=f32))
    return {
        'x': nrm(0, (BATCH, SEQ, D), 1.0),
        'w_in': nrm(1, (L, D, IN_TOTAL), D ** -0.5),
        'b_in': b_in,
        'm_conv_w': nrm(3, (L, M_CONV, 2 * W), M_CONV ** -0.5),
        'm_conv_b': nrm(4, (L, 2 * W), 0.02),
        'm_norm_w': 1.0 + nrm(5, (L, W), 0.02),
        's5_lam_re': -0.5 + nrm(6, (L, G, P), 0.01),
        's5_lam_im': math.pi * jnp.arange(P, dtype=f32) + nrm(7, (L, G, P), 0.01),
        's5_log_dt': jax.random.uniform(ks[8], (L, G), f32, math.log(1e-3), math.log(1e-1)),
        's5_b_re': nrm(9, (L, G, P, C), (2 * C) ** -0.5),
        's5_b_im': nrm(10, (L, G, P, C), (2 * C) ** -0.5),
        's5_c_re': nrm(11, (L, G, C, P), (2 * P) ** -0.5),
        's5_c_im': nrm(12, (L, G, C, P), (2 * P) ** -0.5),
        's5_d': nrm(13, (L, G, C), 1.0),
        's5_w_glu': nrm(14, (L, W, W), W ** -0.5),
        's5_b_glu': nrm(15, (L, W), 0.02),
        'w_branch': nrm(16, (L, N_BRANCH, W, D), W ** -0.5),
        'w_out': nrm(17, (L, D, D), BETA * D ** -0.5),
        'ln1_g': 1.0 + nrm(18, (L, D), 0.02),
        'ln1_b': nrm(19, (L, D), 0.02),
        'w_route_group': nrm(20, (L, D, N_GROUPS), D ** -0.5),
        'b_route_group': nrm(21, (L, N_GROUPS), 0.01),
        'w_route_expert': nrm(22, (L, D, N_EXPERTS), D ** -0.5),
        'b_route_expert': nrm(23, (L, N_EXPERTS), 0.01),
        'moe_w_gate': nrm(24, (L, E, D, F), D ** -0.5),
        'moe_w_up': nrm(25, (L, E, D, F), D ** -0.5),
        'moe_w_down': nrm(26, (L, E, F, D), BETA * F ** -0.5),
        'ln2_g': 1.0 + nrm(27, (L, D), 0.02),
        'ln2_b': nrm(28, (L, D), 0.02),
    }


def reference(x, w_in, b_in, m_conv_w, m_conv_b, m_norm_w, s5_lam_re, s5_lam_im, s5_log_dt,
              s5_b_re, s5_b_im, s5_c_re, s5_c_im, s5_d, s5_w_glu, s5_b_glu, w_branch, w_out,
              ln1_g, ln1_b, w_route_group, b_route_group, w_route_expert, b_route_expert,
              moe_w_gate, moe_w_up, moe_w_down, ln2_g, ln2_b):
    bsz, seq, d = x.shape
    cuts = _in_starts()[1:-1]
    m_shape = (bsz, seq, M_HEADS, M_HEAD_DIM)
    a_shape = (bsz, seq, A_HEADS, A_HEAD_DIM)
    for l in range(DEPTH):
        proj = x @ w_in[l] + b_in[l]
        m_qk, m_v, m_o, m_i, m_f, s_u, a_qkv, a_f, gate_pre = jnp.split(proj, cuts, axis=-1)

        m_qk = jax.nn.silu(causal_depthwise_conv(m_qk, m_conv_w[l], m_conv_b[l]))
        m_q, m_k = jnp.split(m_qk, 2, axis=-1)
        h_m = mlstm_chunkwise(m_q.reshape(m_shape), m_k.reshape(m_shape), m_v.reshape(m_shape),
                              m_i, m_f)
        y_m = jax.nn.sigmoid(m_o) * head_norm(h_m, m_norm_w[l], M_HEADS)

        y_s = jax.nn.gelu(s5_grouped(s_u, s5_lam_re[l], s5_lam_im[l], s5_log_dt[l], s5_b_re[l],
                                     s5_b_im[l], s5_c_re[l], s5_c_im[l], s5_d[l]))
        y_s = y_s * jax.nn.sigmoid(y_s @ s5_w_glu[l] + s5_b_glu[l])

        a_q, a_k, a_v = jnp.split(a_qkv, 3, axis=-1)
        y_a = forgetting_attention(a_q.reshape(a_shape), a_k.reshape(a_shape),
                                   a_v.reshape(a_shape), a_f)

        gates = jax.nn.sigmoid(gate_pre).reshape(bsz, seq, N_BRANCH, d)
        mixed = (gates[:, :, 0] * (y_m @ w_branch[l, 0])
                 + gates[:, :, 1] * (y_s @ w_branch[l, 1])
                 + gates[:, :, 2] * (y_a @ w_branch[l, 2]))
        x = layer_norm(ALPHA * x + mixed @ w_out[l], ln1_g[l], ln1_b[l])

        moe_out = hier_moe(x, w_route_group[l], b_route_group[l], w_route_expert[l],
                           b_route_expert[l], moe_w_gate[l], moe_w_up[l], moe_w_down[l])
        x = layer_norm(ALPHA * x + moe_out, ln2_g[l], ln2_b[l])
    return x
```

```cpp
#include <hip/hip_runtime.h>
#include <hip/hip_bf16.h>
#include <cstdio>
#include <cstdint>
#include <cmath>

#ifndef MK_ONE_LAUNCH
#define MK_ONE_LAUNCH 1
#endif

namespace pg8 {
#define PG8_LAS __attribute__((address_space(3)))
typedef unsigned short bf16_t;
typedef short bf16x8 __attribute__((ext_vector_type(8)));
typedef float f32x4 __attribute__((ext_vector_type(4)));
typedef float f32x2 __attribute__((ext_vector_type(2)));
typedef unsigned u32x4 __attribute__((ext_vector_type(4)));
typedef unsigned u32x2 __attribute__((ext_vector_type(2)));
constexpr int BM = 256, BK = 64, HALF = 128, HTB = HALF * BK * 2  , STAGE_BYTES = 8 * HTB, NXCD = 8, WGM = 8;

__host__ __device__ __forceinline__ int lds_byte(int r, int c) { const int st = (r >> 4) * 2 + (c >> 5), rr = r & 15, cc = c & 31, ob = rr * 64 + cc * 2; return st * 1024 + (ob ^ (((ob >> 9) & 1) << 5)); }
__host__ __device__ __forceinline__ void stage_rc(int b, int& R, int& C) { const int st = b / 1024, sb = b % 1024, swz = sb ^ (((sb >> 9) & 1) << 5); R = (st >> 1) * 16 + swz / 64; C = (st & 1) * 32 + (swz % 64) / 2; }
__host__ __device__ __forceinline__ int perm32(int rho) { const int n = rho >> 4, i = rho & 15; return 8 * (i >> 2) + 4 * n + (i & 3); }

struct Unit { int pm, pn; };
struct Gemm { const bf16_t* A; const bf16_t* Bt; int K, lda, ldb; };

struct StaticOrder {
    int nM, nN, nwg, G, c;
    __host__ __device__ void init(int M, int N, int G_, int c_) { nM = M / BM; nN = N / BM; nwg = nM * nN; G = G_; c = c_; }
    __host__ __device__ bool next(int i, Unit& u) const {
        const long L = (long)i * G + c; if (L >= nwg) return false;
        int wgid = (int)L; { const int q = nwg / NXCD, r = nwg % NXCD, xcd = wgid % NXCD, off = wgid / NXCD; wgid = (xcd < r ? xcd * (q + 1) : r * (q + 1) + (xcd - r) * q) + off; }
        const int nig = WGM * nN, gid = wgid / nig, fm = gid * WGM, gsz = (nM - fm) < WGM ? (nM - fm) : WGM;
        u.pm = fm + ((wgid % nig) % gsz); u.pn = (wgid % nig) / gsz; return true;
    }
};

__device__ __forceinline__ unsigned cvt_pk_bf16(float lo, float hi) { unsigned r; asm volatile("v_cvt_pk_bf16_f32 %0, %1, %2" : "=v"(r) : "v"(lo), "v"(hi)); return r; }

template <class Epi, class Sched, bool ALIGN_EPI = true>
__device__ __forceinline__ void gemm_phase(PG8_LAS unsigned char* lds, const Gemm g, const Sched& S, const Epi& E, const int tid  ) {
    const int wid = __builtin_amdgcn_readfirstlane(tid >> 6), lane = tid & 63, wr = wid >> 2, wc = wid & 3, fr = lane & 15, fq = lane >> 4;
    const int K = g.K, nt = K / BK;
    unsigned voffA[2], voffB[2];
#pragma unroll
    for (int i = 0; i < 2; ++i) { int R, C; stage_rc(tid * 16 + i * 8192, R, C); const int Rb = Epi::PERM ? ((R & ~31) + perm32(R & 31)) : R;
        voffA[i] = (unsigned)(R * g.lda + C) * 2u; voffB[i] = (unsigned)(Rb * g.ldb + C) * 2u; }
    const size_t kstep = (size_t)(BK * 2);
    const size_t hstepA = (size_t)HALF * g.lda * 2, hstepB = (size_t)HALF * g.ldb * 2;
    const size_t tstepA = 2 * hstepA, tstepB = 2 * hstepB;
    const unsigned ldsw = (unsigned)wid * 1024u;
    const int aoff = lds_byte(wr * 64 + fr, fq * 8), boff = lds_byte(wc * 32 + fr, fq * 8);
#define PG8_SA(b, h) (((b) * 2 + (h)) * HTB)
#define PG8_SB(b, h) ((4 + (b) * 2 + (h)) * HTB)
#define PG8_STAGE(bufoff, gbase, voff) do { _Pragma("unroll") for (int _i = 0; _i < 2; ++_i) \
        __builtin_amdgcn_global_load_lds((const unsigned*)((const char*)(gbase) + (voff)[_i]), (PG8_LAS unsigned*)(lds + (bufoff) + ldsw + _i * 8192), 16, 0, 0); } while (0)
#define PG8_LDA(dst, b, h) do { _Pragma("unroll") for (int m = 0; m < 4; ++m) _Pragma("unroll") for (int k = 0; k < 2; ++k) dst[m][k] = *(const PG8_LAS bf16x8*)(lds + PG8_SA(b, h) + aoff + m * 2048 + k * 1024); } while (0)
#define PG8_LDB(dst, b, h) do { _Pragma("unroll") for (int n = 0; n < 2; ++n) _Pragma("unroll") for (int k = 0; k < 2; ++k) dst[n][k] = *(const PG8_LAS bf16x8*)(lds + PG8_SB(b, h) + boff + n * 2048 + k * 1024); } while (0)
#define PG8_MMA(ai, bj, At, Bt) do { __builtin_amdgcn_s_setprio(1); _Pragma("unroll") for (int m = 0; m < 4; ++m) _Pragma("unroll") for (int n = 0; n < 2; ++n) _Pragma("unroll") for (int k = 0; k < 2; ++k) \
        acc[ai][bj][m][n] = __builtin_amdgcn_mfma_f32_16x16x32_bf16(Bt[n][k], At[m][k], acc[ai][bj][m][n], 0, 0, 0); __builtin_amdgcn_s_setprio(0); } while (0)
#define PG8_WAIT_V(n) asm volatile("s_waitcnt vmcnt(" #n ")" ::: "memory")
#define PG8_WAIT_L(n) asm volatile("s_waitcnt lgkmcnt(" #n ")" ::: "memory")
#define PG8_BAR __builtin_amdgcn_s_barrier()
#define PG8_SCHED __builtin_amdgcn_sched_barrier(0)
    Unit cur, nxt; int ui = 0;
    if (!S.next(0, cur)) return;
    f32x4 acc[2][2][4][2];
    float zf = 0.f; asm volatile("" : "+v"(zf));
#pragma unroll
    for (int a = 0; a < 2; ++a)
#pragma unroll
        for (int b = 0; b < 2; ++b)
#pragma unroll
            for (int m = 0; m < 4; ++m)
#pragma unroll
                for (int n = 0; n < 2; ++n) acc[a][b][m][n] = (f32x4){zf, zf, zf, zf};
    bf16x8 At[4][2], B0[2][2], B1[2][2];
    const char* cA = (const char*)g.A + (size_t)cur.pm * tstepA; const char* cB = (const char*)g.Bt + (size_t)cur.pn * tstepB;
    PG8_STAGE(PG8_SB(0, 0), cB, voffB); PG8_STAGE(PG8_SB(0, 1), cB + hstepB, voffB); PG8_STAGE(PG8_SA(0, 0), cA, voffA); PG8_STAGE(PG8_SA(0, 1), cA + hstepA, voffA);
    if (wr == 1) PG8_BAR;
    PG8_WAIT_V(2); PG8_BAR;
    PG8_STAGE(PG8_SB(1, 0), cB + kstep, voffB); PG8_STAGE(PG8_SA(1, 0), cA + kstep, voffA); PG8_STAGE(PG8_SB(1, 1), cB + hstepB + kstep, voffB);
    PG8_WAIT_V(6); PG8_BAR;
    for (;;) {
        const bool has_next = S.next(ui + 1, nxt);
        const char* nA = has_next ? (const char*)g.A + (size_t)nxt.pm * tstepA : cA; const char* nB = has_next ? (const char*)g.Bt + (size_t)nxt.pn * tstepB : cB;
        for (int t = 0; t < nt; t += 2) {
            const bool last = (t == nt - 2);
            const char* a1 = cA + (size_t)(t + 1) * kstep;
            const char* a2 = last ? nA : cA + (size_t)(t + 2) * kstep; const char* b2 = last ? nB : cB + (size_t)(t + 2) * kstep;
            const char* a3 = a2 + kstep; const char* b3 = b2 + kstep;
            PG8_LDB(B0, 0, 0); PG8_LDB(B1, 0, 1); PG8_SCHED; PG8_LDA(At, 0, 0); PG8_STAGE(PG8_SA(1, 1), a1 + hstepA, voffA);
            PG8_WAIT_V(8); PG8_WAIT_L(0); PG8_BAR; PG8_MMA(0, 0, At, B0); PG8_MMA(0, 1, At, B1); PG8_BAR; PG8_SCHED;
            PG8_LDA(At, 0, 1); PG8_STAGE(PG8_SB(0, 0), b2, voffB); PG8_STAGE(PG8_SB(0, 1), b2 + hstepB, voffB); PG8_STAGE(PG8_SA(0, 0), a2, voffA);
            PG8_WAIT_V(8); PG8_WAIT_L(0); PG8_BAR; PG8_MMA(1, 0, At, B0); PG8_MMA(1, 1, At, B1); PG8_BAR; PG8_SCHED;
            PG8_LDB(B0, 1, 0); PG8_LDB(B1, 1, 1); PG8_SCHED; PG8_LDA(At, 1, 0); PG8_STAGE(PG8_SA(0, 1), a2 + hstepA, voffA);
            PG8_WAIT_V(8); PG8_WAIT_L(0); PG8_BAR; PG8_MMA(0, 0, At, B0); PG8_MMA(0, 1, At, B1); PG8_BAR; PG8_SCHED;
            PG8_LDA(At, 1, 1); PG8_STAGE(PG8_SB(1, 0), b3, voffB); PG8_STAGE(PG8_SB(1, 1), b3 + hstepB, voffB); PG8_STAGE(PG8_SA(1, 0), a3, voffA);
            PG8_WAIT_V(8); PG8_WAIT_L(0); PG8_BAR; PG8_MMA(1, 0, At, B0); PG8_MMA(1, 1, At, B1); PG8_BAR; PG8_SCHED;
        }
        if constexpr (ALIGN_EPI) { if (wr == 0) PG8_BAR; }
        E(acc, cur, wr, wc, fr, fq);
        if (!has_next) break;
        if (E.reset_after(cur)) {
#pragma unroll
        for (int a = 0; a < 2; ++a)
#pragma unroll
            for (int b = 0; b < 2; ++b)
#pragma unroll
                for (int m = 0; m < 4; ++m)
#pragma unroll
                    for (int n = 0; n < 2; ++n) acc[a][b][m][n] = (f32x4){zf, zf, zf, zf};
        }
        cur = nxt; cA = nA; cB = nB; ++ui;
        if constexpr (ALIGN_EPI) { if (wr == 1) PG8_BAR; }
    }
    PG8_WAIT_V(0);
    if constexpr (!ALIGN_EPI) { if (wr == 0) PG8_BAR; }
    PG8_BAR;
#undef PG8_SA
#undef PG8_SB
#undef PG8_STAGE
#undef PG8_LDA
#undef PG8_LDB
#undef PG8_MMA
#undef PG8_WAIT_V
#undef PG8_WAIT_L
#undef PG8_BAR
#undef PG8_SCHED
}
}

#include <hip/hip_bf16.h>
#include <cmath>
namespace attn_body {
using bf16=__hip_bfloat16;
using bf16x8=__attribute__((ext_vector_type(8)))short;
using s16x4=__attribute__((ext_vector_type(4)))short;
using f32x16=__attribute__((ext_vector_type(16)))float;
using u32x4=__attribute__((ext_vector_type(4)))unsigned;
using f32x4v=__attribute__((ext_vector_type(4)))float;
constexpr int BATCH=8,NHEAD=8,SEQ=4096,D=64,DM=1536,DMO=512;
constexpr int NW=8,QBLK=32,QB=QBLK*NW,KVBLK=64,NQB=SEQ/QB;
constexpr int ATTN_PITCH=DM, ATTN_UNIT_ROWS=QB;
__device__ __forceinline__ int crow(int r,int hi){return (r&3)+8*(r>>2)+4*hi;}
#define SBAR() __builtin_amdgcn_sched_barrier(0)
__device__ __forceinline__ void cmask(f32x16&p0,f32x16&p1,int jb,int qrel,int hi){
  const float NEG=-INFINITY; int kb=64*jb+4*hi;
  #pragma unroll
  for(int r=0;r<16;++r){int kv=kb+(r&3)+8*(r>>2); if(kv>qrel)p0[r]=NEG; if(kv+32>qrel)p1[r]=NEG;}
}

constexpr int NSLOT=3, SLOTB=8192;
constexpr int LDS_K=0, LDS_V=NSLOT*SLOTB, LDS_WS=2*NSLOT*SLOTB, LDS_OST=LDS_WS+NW*64*4, LDS_F=LDS_OST+NW*4096, LDS_Q=LDS_F+SEQ*4, LDS_BYTES=LDS_Q+NW*4096;
constexpr float C2=0.125f*1.4426950408889634f;
__device__ __forceinline__ void glds16(const void*gsrc,unsigned lds_dst){unsigned keep;
  asm volatile("s_mov_b32 %0, m0\n\ts_mov_b32 m0, %2\n\ts_nop 0\n\tglobal_load_lds_dwordx4 %1, off\n\ts_mov_b32 m0, %0":"=&s"(keep):"v"(gsrc),"s"(lds_dst):"memory");}
__device__ __forceinline__ void glds16s(const void*sbase,unsigned voff,unsigned lds_dst){unsigned keep;
  asm volatile("s_mov_b32 %0, m0\n\ts_mov_b32 m0, %3\n\ts_nop 0\n\tglobal_load_lds_dwordx4 %1, %2\n\ts_mov_b32 m0, %0":"=&s"(keep):"v"(voff),"s"(sbase),"s"(lds_dst):"memory");}
__device__ __forceinline__ float max3f(float a,float b,float c){float r;asm("v_max3_f32 %0, %1, %2, %3":"=v"(r):"v"(a),"v"(b),"v"(c));return r;}
__device__ __forceinline__ float max2f(float a,float b){float r;asm("v_max_f32_e32 %0, %1, %2":"=v"(r):"v"(a),"v"(b));return r;}
__device__ __forceinline__ float fadd_s(float a,float b){float r;asm("v_add_f32_e32 %0, %1, %2":"=v"(r):"v"(a),"v"(b));return r;}
__device__ __forceinline__ float fsub_s(float a,float b){float r;asm("v_sub_f32_e32 %0, %1, %2":"=v"(r):"v"(a),"v"(b));return r;}
typedef float f32x2_t __attribute__((ext_vector_type(2))); typedef __bf16 bf16x2_t __attribute__((ext_vector_type(2)));
__device__ __forceinline__ unsigned cvtpk_s(float lo,float hi){f32x2_t v={lo,hi};bf16x2_t b=__builtin_convertvector(v,bf16x2_t);return __builtin_bit_cast(unsigned,b);}
#define WAIT_BAR(N) asm volatile("s_waitcnt vmcnt(" #N ") lgkmcnt(0)\n\ts_barrier":::"memory")

__device__ __forceinline__ void qkt(f32x16&p0,f32x16&p1,const char*Kslot,const bf16x8*qr,int r32,int hi){
  const char*kb=Kslot+hi*1024+r32*16;
  #pragma unroll
  for(int d0=0;d0<4;++d0){
    const bf16x8 b0=*reinterpret_cast<const bf16x8*>(kb+d0*2048);
    const bf16x8 b1=*reinterpret_cast<const bf16x8*>(kb+d0*2048+512);
    {p0=__builtin_amdgcn_mfma_f32_32x32x16_bf16(b0,qr[d0],p0,0,0,0);p1=__builtin_amdgcn_mfma_f32_32x32x16_bf16(b1,qr[d0],p1,0,0,0);}}
}
typedef __attribute__((address_space(3))) const char* lds_cptr;
typedef short v4i16_t __attribute__((ext_vector_type(4)));
__device__ __forceinline__ void kload8(bf16x8*kf,lds_cptr kp){
  kf[0]=*(const __attribute__((address_space(3))) bf16x8*)(kp);      kf[1]=*(const __attribute__((address_space(3))) bf16x8*)(kp+512);
  kf[2]=*(const __attribute__((address_space(3))) bf16x8*)(kp+2048); kf[3]=*(const __attribute__((address_space(3))) bf16x8*)(kp+2560);
  kf[4]=*(const __attribute__((address_space(3))) bf16x8*)(kp+4096); kf[5]=*(const __attribute__((address_space(3))) bf16x8*)(kp+4608);
  kf[6]=*(const __attribute__((address_space(3))) bf16x8*)(kp+6144); kf[7]=*(const __attribute__((address_space(3))) bf16x8*)(kp+6656);
}
__device__ __forceinline__ void kload2(bf16x8*kf,lds_cptr kp,int j){ kf[2*j]=*(const __attribute__((address_space(3))) bf16x8*)(kp+j*2048); kf[2*j+1]=*(const __attribute__((address_space(3))) bf16x8*)(kp+j*2048+512); }
__device__ __forceinline__ s16x4 vtr(lds_cptr p){ return __builtin_bit_cast(s16x4,__builtin_amdgcn_ds_read_tr16_b64_v4i16((__attribute__((address_space(3))) v4i16_t*)p)); }
__device__ __forceinline__ float rowmax(const f32x16&p0,const f32x16&p1){
  float a=max3f(p0[0],p0[1],p1[0]),b=max3f(p0[2],p0[3],p1[1]);a=max3f(a,p1[2],p1[3]);
  #pragma unroll
  for(int r=4;r<16;r+=4){a=max3f(a,p0[r],p0[r+1]);b=max3f(b,p0[r+2],p0[r+3]);a=max3f(a,p1[r],p1[r+1]);b=max3f(b,p1[r+2],p1[r+3]);}
  const float m=max2f(a,b);
  auto rr=__builtin_amdgcn_permlane32_swap(__float_as_uint(m),__float_as_uint(m),false,false);
  return max2f(__uint_as_float(rr[0]),__uint_as_float(rr[1]));
}
__device__ __forceinline__ void pv(f32x16*o,int vb,bf16x8 pa0,bf16x8 pa1,bf16x8 pa2,bf16x8 pa3){
  #pragma unroll
  for(int d0=0;d0<2;++d0){s16x4 lo[4],hi[4];
    #pragma unroll
    for(int ks=0;ks<4;++ks){
      asm volatile("ds_read_b64_tr_b16 %0,%1 offset:%c2":"=&v"(lo[ks]):"v"(vb),"i"(d0*4096+ks*1024):"memory");
      asm volatile("ds_read_b64_tr_b16 %0,%1 offset:%c2":"=&v"(hi[ks]):"v"(vb),"i"(d0*4096+ks*1024+512):"memory");}
    asm volatile("s_waitcnt lgkmcnt(0)":::"memory");SBAR();
    #define PK(k) (bf16x8){lo[k][0],lo[k][1],lo[k][2],lo[k][3],hi[k][0],hi[k][1],hi[k][2],hi[k][3]}
    o[d0]=__builtin_amdgcn_mfma_f32_32x32x16_bf16(pa0,PK(0),o[d0],0,0,0);
    o[d0]=__builtin_amdgcn_mfma_f32_32x32x16_bf16(pa1,PK(1),o[d0],0,0,0);
    o[d0]=__builtin_amdgcn_mfma_f32_32x32x16_bf16(pa2,PK(2),o[d0],0,0,0);
    o[d0]=__builtin_amdgcn_mfma_f32_32x32x16_bf16(pa3,PK(3),o[d0],0,0,0);
    #undef PK
  }
}

#ifndef ATTN_STORE16
#define ATTN_STORE16(p,v) (*(u32x4*)(p)=(v))
#endif
template<int THRL> __device__ __forceinline__ void attn_unit(int b,int h,int qb,const bf16*Q,const bf16*__restrict__ K,const bf16*__restrict__ V,bf16*O,const float*__restrict__ Ftab,char*shm,const int tid){
  const int lane=tid&63,r32=lane&31,hi=lane>>5; const int wid=__builtin_amdgcn_readfirstlane(tid>>6);
  const long rowbase=(long)b*SEQ; const int q0=qb*QB;
  const bf16*Qw=Q+(rowbase+q0+wid*QBLK)*DM+h*D;
  const bf16*Kh=K+rowbase*DM+h*D,*Vh=V+rowbase*DM+h*D;
  const unsigned lds0=(unsigned)(uintptr_t)shm;
  float*wsf=(float*)(shm+LDS_WS)+wid*64;
  const unsigned koff=(unsigned)(lane*DM+wid*8)*2u;
  const unsigned voff=(unsigned)((16*(wid&3)+(lane>>2))*DM+(wid>>2)*32+(lane&3)*8)*2u;
  const unsigned kdst=lds0+LDS_K+wid*1024, vdst=lds0+LDS_V+wid*1024;
  #define DMA_K(t,slot) glds16s(Kh+(long)(t)*KVBLK*DM,koff,(unsigned)__builtin_amdgcn_readfirstlane(kdst+(slot)))
  #define DMA_V(t,slot) glds16s(Vh+(long)(t)*KVBLK*DM,voff,(unsigned)__builtin_amdgcn_readfirstlane(vdst+(slot)))
  const int vb0=(int)(lds0+LDS_V)+((lane>>4)&1)*32+(lane&3)*8+(4*hi+((lane&15)>>2))*64;
  const char*Kbase=shm+LDS_K; bf16x8 kf[8];
  const lds_cptr shm3=(lds_cptr)shm; const lds_cptr kp0=shm3+LDS_K+hi*1024+r32*16; const lds_cptr vp0=shm3+LDS_V+((lane>>4)&1)*32+(lane&3)*8+(4*hi+((lane&15)>>2))*64;
  const int NT=(q0+QB)/KVBLK;
  const float*Fh=Ftab+(long)(b*NHEAD+h)*SEQ;
  { glds16s(Fh,(unsigned)(lane*16+wid*1024),(unsigned)__builtin_amdgcn_readfirstlane(lds0+LDS_F+wid*1024));
    glds16s(Fh,(unsigned)(lane*16+(wid+8)*1024),(unsigned)__builtin_amdgcn_readfirstlane(lds0+LDS_F+(wid+8)*1024)); }
  const float fq2=Fh[q0+wid*QBLK+r32];
  DMA_K(0,0);DMA_V(0,0);DMA_K(1,SLOTB);
  const lds_cptr qs=(lds_cptr)shm+LDS_Q+wid*4096+(hi*32+r32)*16;
  #pragma unroll
  for(int d0=0;d0<4;++d0)*(__attribute__((address_space(3))) bf16x8*)(qs+d0*1024)=*reinterpret_cast<const bf16x8*>(&Qw[(long)r32*DM+d0*16+hi*8]);
  #define QF(k) (*(const __attribute__((address_space(3))) bf16x8*)(qs+(k)*1024))
  float mhat=-fq2,nm=fq2,l_reg=0.f;f32x16 o[2];o[0]=f32x16{};o[1]=f32x16{};
  const lds_cptr fl0=(lds_cptr)shm+LDS_F+hi*16;
  #define FINIT1(C0,t,o_) do{ const __attribute__((address_space(3))) f32x4v* fp_=(const __attribute__((address_space(3))) f32x4v*)(fl0+(t)*256+(o_)); \
    _Pragma("unroll") for(int j_=0;j_<4;++j_){ const f32x4v a_=fp_[2*j_]; \
      C0[4*j_]=nm-a_[0]; C0[4*j_+1]=nm-a_[1]; C0[4*j_+2]=nm-a_[2]; C0[4*j_+3]=nm-a_[3]; } }while(0)
  #define FINIT(C0,C1,t) do{ FINIT1(C0,t,0); FINIT1(C1,t,128); }while(0)
  const int qrel=wid*QBLK+r32;
  #define CMASK(P0,P1,t) do{int jb_=(t)-(NT-4); if(jb_>=0)cmask(P0,P1,jb_,qrel,hi);}while(0)
  bool resc=false;
  #define START(P0,P1) do{ const float rm=rowmax(P0,P1); resc=false; \
    { const float dl=rm; mhat=fadd_s(mhat,dl); \
      _Pragma("unroll") for(int r=0;r<16;++r){P0[r]=fsub_s(P0[r],dl);P1[r]=fsub_s(P1[r],dl);} \
      nm=-mhat; } \
    _Pragma("unroll") for(int r=0;r<16;++r)P0[r]=__builtin_amdgcn_exp2f(P0[r]); }while(0)
  #define RESC() do{ if(resc){ asm volatile("s_waitcnt lgkmcnt(0)":::"memory"); \
      _Pragma("unroll") for(int d_=0;d_<2;++d_) _Pragma("unroll") for(int r=0;r<16;++r)o[d_][r]*=wsf[crow(r,hi)]; } }while(0)
  f32x16 pA0,pA1,pB0,pB1;
  int sl_prev=0,sl_cur=0,sl_next=SLOTB;
  #define ROT() do{sl_prev=sl_cur;sl_cur=sl_next;sl_next=(sl_next==(NSLOT-1)*SLOTB)?0:sl_next+SLOTB;}while(0)
  DMA_K(2,2*SLOTB);
  WAIT_BAR(3);
  { bf16x8 qr[4]; qr[0]=QF(0);qr[1]=QF(1);qr[2]=QF(2);qr[3]=QF(3); FINIT(pA0,pA1,0); qkt(pA0,pA1,Kbase,qr,r32,hi); }asm volatile("s_nop 15\n\ts_nop 7":"+v"(pA0),"+v"(pA1));CMASK(pA0,pA1,0);
  START(pA0,pA1);
  _Pragma("unroll") for(int r=0;r<16;++r)pA1[r]=__builtin_amdgcn_exp2f(pA1[r]);
  WAIT_BAR(0);
  DMA_K(3,0);DMA_V(1,SLOTB);
  ROT();
  kload8(kf,kp0+sl_cur);
  WAIT_BAR(2);
  s16x4 vlo[8],vhi[8]; u32x4 pw0,pw1,pw2,pw3;
  #define PKW(P,B) cvtpk_s(P[B],P[B+1])
  #define PAF(k) __builtin_bit_cast(bf16x8,pw##k)
  #define VFR(i) (bf16x8){vlo[i][0],vlo[i][1],vlo[i][2],vlo[i][3],vhi[i][0],vhi[i][1],vhi[i][2],vhi[i][3]}
  #define PIN(x) asm volatile("":"+v"(x))
  #define MX3(a,b,c) __builtin_fmaxf(__builtin_fmaxf((a),(b)),(c))
  #define GAPA(MF,A0,A1,A2,A3,W0,W1,PW) do{ MF; sacc+=A0; sacc+=A1; sacc+=A2; sacc+=A3; PIN(sacc); W0; W1; PIN(PW); SBAR(); }while(0)
  #define EX(v) __builtin_amdgcn_exp2f(v)
  #define GAPB(MF,X,B) do{ MF; X[B]=EX(X[B]); X[B+1]=EX(X[B+1]); X[B+2]=EX(X[B+2]); X[B+3]=EX(X[B+3]); PIN(X); SBAR(); }while(0)
  #define VRD(i) do{ vlo[i]=vtr(vp_+(((i)>>2)*4096+((i)&3)*1024)); vhi[i]=vtr(vp_+(((i)>>2)*4096+((i)&3)*1024+512)); }while(0)
  #define KRD(G,j) do{ if(G){ kload2(kf,kp0+sl_next,j); SBAR(); } }while(0)
  #define STEP(C0,C1,P0,P1,t,GK,GV,GL) do{ SBAR(); FINIT1(C0,t,0); bf16x8 qA_=QF(0),qB_=QF(1); SBAR(); \
    const lds_cptr vp_=vp0+sl_prev; \
    VRD(0); SBAR(); float sacc=(P0[0]+P0[1]); \
    GAPA(C0=__builtin_amdgcn_mfma_f32_32x32x16_bf16(kf[0],qA_,C0,0,0,0), P0[2],P0[3],P0[4],P0[5],     pw0[0]=PKW(P0,0), pw0[1]=PKW(P0,2), pw0); \
    FINIT1(C1,t,128); SBAR(); VRD(4); SBAR(); GAPA(C1=__builtin_amdgcn_mfma_f32_32x32x16_bf16(kf[1],qA_,C1,0,0,0), P0[6],P0[7],P0[8],P0[9],     pw0[2]=PKW(P0,4), pw0[3]=PKW(P0,6), pw0); \
    qA_=QF(2); VRD(1); SBAR(); GAPA(C0=__builtin_amdgcn_mfma_f32_32x32x16_bf16(kf[2],qB_,C0,0,0,0),   P0[10],P0[11],P0[12],P0[13], pw1[0]=PKW(P0,8), pw1[1]=PKW(P0,10), pw1); \
    VRD(5); SBAR(); GAPA(C1=__builtin_amdgcn_mfma_f32_32x32x16_bf16(kf[3],qB_,C1,0,0,0),   P0[14],P0[15],P1[0],P1[1],   pw1[2]=PKW(P0,12),pw1[3]=PKW(P0,14), pw1); \
    qB_=QF(3); VRD(2); SBAR(); GAPA(C0=__builtin_amdgcn_mfma_f32_32x32x16_bf16(kf[4],qA_,C0,0,0,0),   P1[2],P1[3],P1[4],P1[5],     pw2[0]=PKW(P1,0), pw2[1]=PKW(P1,2), pw2); \
    VRD(6); SBAR(); GAPA(C1=__builtin_amdgcn_mfma_f32_32x32x16_bf16(kf[5],qA_,C1,0,0,0),   P1[6],P1[7],P1[8],P1[9],     pw2[2]=PKW(P1,4), pw2[3]=PKW(P1,6), pw2); \
    VRD(3); SBAR(); GAPA(C0=__builtin_amdgcn_mfma_f32_32x32x16_bf16(kf[6],qB_,C0,0,0,0),   P1[10],P1[11],P1[12],P1[13], pw3[0]=PKW(P1,8), pw3[1]=PKW(P1,10), pw3); \
    VRD(7); SBAR(); GAPA(C1=__builtin_amdgcn_mfma_f32_32x32x16_bf16(kf[7],qB_,C1,0,0,0),   P1[14],P1[15],0.f,0.f,       pw3[2]=PKW(P1,12),pw3[3]=PKW(P1,14), pw3); \
    l_reg+=sacc; \
    if(GK){DMA_K((t)+3,sl_cur);} if(GV){DMA_V((t)+1,sl_next);} \
    CMASK(C0,C1,t); \
    { float a=MX3(C0[0],C0[1],C1[0]),b=MX3(C0[2],C0[3],C1[1]); a=MX3(a,C1[2],C1[3]); \
      _Pragma("unroll") for(int r=4;r<16;r+=4){a=MX3(a,C0[r],C0[r+1]);b=MX3(b,C0[r+2],C0[r+3]);a=MX3(a,C1[r],C1[r+1]);b=MX3(b,C1[r+2],C1[r+3]);} \
      float rm=__builtin_fmaxf(a,b); { auto rr=__builtin_amdgcn_permlane32_swap(__float_as_uint(rm),__float_as_uint(rm),false,false); rm=__builtin_fmaxf(__uint_as_float(rr[0]),__uint_as_float(rr[1])); } \
      resc=false; \
      if(__builtin_expect(__any(rm>(float)THRL),0)){ const float dl=__builtin_fmaxf(rm,0.f); mhat+=dl; \
        _Pragma("unroll") for(int r=0;r<16;++r){C0[r]-=dl;C1[r]-=dl;} \
        nm=-mhat; \
        const float f=__builtin_amdgcn_exp2f(-dl); l_reg*=f; if(hi==0)wsf[r32]=f; resc=true; } } \
    SBAR(); \
    GAPB(o[0]=__builtin_amdgcn_mfma_f32_32x32x16_bf16(PAF(0),VFR(0),o[0],0,0,0), C0,0); \
    GAPB(o[1]=__builtin_amdgcn_mfma_f32_32x32x16_bf16(PAF(0),VFR(4),o[1],0,0,0), C0,4); \
    KRD(GL,0); GAPB(o[0]=__builtin_amdgcn_mfma_f32_32x32x16_bf16(PAF(1),VFR(1),o[0],0,0,0), C0,8); \
    KRD(GL,1); GAPB(o[1]=__builtin_amdgcn_mfma_f32_32x32x16_bf16(PAF(1),VFR(5),o[1],0,0,0), C0,12); \
    KRD(GL,2); GAPB(o[0]=__builtin_amdgcn_mfma_f32_32x32x16_bf16(PAF(2),VFR(2),o[0],0,0,0), C1,0); \
    KRD(GL,3); GAPB(o[1]=__builtin_amdgcn_mfma_f32_32x32x16_bf16(PAF(2),VFR(6),o[1],0,0,0), C1,4); \
    GAPB(o[0]=__builtin_amdgcn_mfma_f32_32x32x16_bf16(PAF(3),VFR(3),o[0],0,0,0), C1,8); \
    GAPB(o[1]=__builtin_amdgcn_mfma_f32_32x32x16_bf16(PAF(3),VFR(7),o[1],0,0,0), C1,12); \
    }while(0)
  int t=1;
  #undef CMASK
  #define CMASK(P0,P1,t) do{}while(0)
  for(;t+5<NT;t+=2){
    STEP(pB0,pB1,pA0,pA1,t,true,true,true);     WAIT_BAR(2); RESC(); ROT();
    STEP(pA0,pA1,pB0,pB1,t+1,true,true,true);   WAIT_BAR(2); RESC(); ROT();
  }
  #undef CMASK
  #define CMASK(P0,P1,t) do{int jb_=(t)-(NT-4); if(jb_>=0)cmask(P0,P1,jb_,qrel,hi);}while(0)
  #define ENDW(tt) do{ if((tt)+3<NT){WAIT_BAR(2);} else if((tt)+2<NT){WAIT_BAR(1);} else {WAIT_BAR(0);} }while(0)
  for(;t+1<NT;t+=2){
    STEP(pB0,pB1,pA0,pA1,t,(t+3<NT),(t+1<NT),(t+1<NT));       ENDW(t);   RESC(); ROT();
    STEP(pA0,pA1,pB0,pB1,t+1,(t+4<NT),(t+2<NT),(t+2<NT));     ENDW(t+1); RESC(); ROT();
  }
  STEP(pB0,pB1,pA0,pA1,NT-1,false,false,false); RESC();
  { float sacc=pB0[0]+pB0[1]; _Pragma("unroll") for(int r=2;r<16;++r)sacc+=pB0[r]; _Pragma("unroll") for(int r=0;r<16;++r)sacc+=pB1[r]; l_reg+=sacc;
    pw0=(u32x4){PKW(pB0,0),PKW(pB0,2),PKW(pB0,4),PKW(pB0,6)};pw1=(u32x4){PKW(pB0,8),PKW(pB0,10),PKW(pB0,12),PKW(pB0,14)};pw2=(u32x4){PKW(pB1,0),PKW(pB1,2),PKW(pB1,4),PKW(pB1,6)};pw3=(u32x4){PKW(pB1,8),PKW(pB1,10),PKW(pB1,12),PKW(pB1,14)};
    SBAR(); pv(o,vb0+sl_cur,PAF(0),PAF(1),PAF(2),PAF(3)); }
  #undef PKW
  #undef PAF
  #undef VFR
  #undef PIN
  #undef MX3
  #undef GAPA
  #undef GAPB
  #undef EX
  #undef VRD
  #undef KRD
  #undef STEP
  #undef ENDW
  {auto rr=__builtin_amdgcn_permlane32_swap(__float_as_uint(l_reg),__float_as_uint(l_reg),false,false);l_reg=__uint_as_float(rr[0])+__uint_as_float(rr[1]);}
  if(hi==0)wsf[32+r32]=l_reg;asm volatile("s_waitcnt lgkmcnt(0)":::"memory");
  float rli[16];
  #pragma unroll
  for(int r=0;r<16;++r)rli[r]=__builtin_amdgcn_rcpf(wsf[32+crow(r,hi)]);
  bf16*Ow=O+(rowbase+q0+wid*QBLK)*DMO+h*D;
  { bf16*stg=(bf16*)(shm+LDS_OST)+wid*2048;
    #pragma unroll
    for(int r=0;r<16;++r){const int orow=crow(r,hi);
      #pragma unroll
      for(int d0=0;d0<2;++d0)stg[orow*64+d0*32+r32]=__float2bfloat16(o[d0][r]*rli[r]);}
    asm volatile("s_waitcnt lgkmcnt(0)":::"memory");
    #pragma unroll
    for(int i=0;i<4;++i){const int row=i*8+(lane>>3),ch=lane&7; const u32x4 v=*(const u32x4*)(stg+row*64+ch*8); ATTN_STORE16(Ow+(long)row*DMO+ch*8,v);} }
  asm volatile("s_waitcnt lgkmcnt(0)\n\ts_barrier":::"memory");
  #undef DMA_K
  #undef DMA_V
  #undef CMASK
  #undef START
  #undef RESC
  #undef FINIT
  #undef QF
  #undef FINIT1
  #undef ROT
}
constexpr int ATTN_LDS_BYTES=LDS_BYTES;
struct AttnTensors { const bf16* Q; const bf16* K; const bf16* V; bf16* O; const float* F; };
#undef SBAR
#undef WAIT_BAR
}

constexpr int NWAVES = 8;
constexpr int BATCH = 8, SEQ = 4096, D = 1024, T = BATCH * SEQ, NL = 4;
constexpr int BW = 512, INTOT = 7184, NIN = 7168;
constexpr int MH = 4, MDH = 128, AH = 8, ADH = 64, S5G = 32, S5C = 16, S5P = 64, S5L = 32  , S5K = 640;
constexpr int NEXP = 32, EH = 512, MOE_ROWS = 73728  , MOE_NBLK_MAX = 288;
constexpr float LN_EPS = 1e-5f;
constexpr float ALPHA = 1.6817928305074290f;
constexpr float C2 = 0.125f * 1.4426950408889634f;
constexpr float LOG2E = 1.4426950408889634f;
constexpr int NPH_LAYER = 13, NPHASES = 1 + NL * NPH_LAYER;

constexpr size_t MiB = 1u << 20;
constexpr size_t WS_CTL = 0, CTL_ZERO_BYTES = 65536;
constexpr size_t WS_S5TAB = 2 * MiB;
constexpr size_t WS_MSC = 2 * MiB + 65536;
constexpr size_t WS_NST = 3 * MiB;
constexpr size_t WS_WIN = 4 * MiB, WS_WGLU = 18 * MiB, WS_WBR = 19 * MiB, WS_WOUT = 22 * MiB, WS_WGU = 24 * MiB, WS_WDN = 88 * MiB;
constexpr size_t WS_XB = 148 * MiB;
constexpr size_t WS_MQK = 212 * MiB, WS_QK = 276 * MiB, WS_MV = 340 * MiB, WS_MO = 372 * MiB, WS_S5A = 404 * MiB, WS_AQKV = 444 * MiB, WS_GATE = 540 * MiB;
constexpr size_t WS_YS1 = WS_MQK, WS_MIXED = WS_QK;
constexpr size_t WS_XG = 212 * MiB, WS_HB = 356 * MiB, WS_YB = 428 * MiB;
constexpr size_t WS_YTALL = 732 * MiB, WS_CST = 828 * MiB, WS_EBUF = 892 * MiB, WS_SG = 908 * MiB, WS_FTAB = 910 * MiB, WS_MLU = 911 * MiB, WS_ROUTE = 913 * MiB, WS_TOKPOS = 914 * MiB, WS_S5ALL = 916 * MiB  , S5_LAYER_BYTES = 28 * MiB, WS_END = 1028 * MiB;
static_assert(WS_XG + (size_t)MOE_ROWS * 1024 * 2 <= WS_HB && WS_HB + (size_t)MOE_ROWS * 512 * 2 <= WS_YB && WS_YB + (size_t)2 * T * 1024 * 2 <= WS_YTALL, "moe overlay");
static_assert(WS_S5A + (size_t)32 * 1024 * 640 * 2 <= WS_AQKV && WS_GATE + (size_t)T * 3072 * 2 <= WS_YTALL, "region A");
constexpr int CW_TMO = 0, CW_CODE = 1, CW_BAR = 4096, CW_GCNT = 8192;

constexpr int RING_OFF = 0, RING_BYTES = 131072;
constexpr int LDS_BYTES = 163840;
constexpr int LDSX_OFF = RING_BYTES;
constexpr int LDSCTL_OFF = 162816, MISC_OFF = LDSCTL_OFF + 320;

#define GAS __attribute__((address_space(1)))
#define LAS __attribute__((address_space(3)))
typedef unsigned short bf16;
typedef unsigned v4u __attribute__((ext_vector_type(4)));
typedef unsigned v2u __attribute__((ext_vector_type(2)));
typedef float f32x4 __attribute__((ext_vector_type(4)));
typedef float f32x16 __attribute__((ext_vector_type(16)));
typedef short bf16x8 __attribute__((ext_vector_type(8)));
typedef GAS unsigned gu32;
#define RLX_AGENT __ATOMIC_RELAXED, __HIP_MEMORY_SCOPE_AGENT
#define LDS_WAIT() asm volatile("s_waitcnt lgkmcnt(0)" ::: "memory")
#define VM_WAIT() asm volatile("s_waitcnt vmcnt(0)" ::: "memory")
__device__ __forceinline__ unsigned f2bf(float f) { unsigned u = __builtin_bit_cast(unsigned, f); return (u + 0x7fffu + ((u >> 16) & 1u)) >> 16; }
__device__ __forceinline__ unsigned pk2(float lo, float hi) { return f2bf(lo) | (f2bf(hi) << 16); }
__device__ __forceinline__ float bflo(unsigned u) { return __uint_as_float(u << 16); }
__device__ __forceinline__ float bfhi(unsigned u) { return __uint_as_float(u & 0xffff0000u); }
__device__ __forceinline__ float bf2f(bf16 v) { return __uint_as_float((unsigned)v << 16); }
__device__ __forceinline__ float sigmoidf_(float x) { return 1.f / (1.f + __expf(-x)); }

__device__ __forceinline__ int lane_id() { int l; asm volatile("v_mbcnt_lo_u32_b32 %0, -1, 0\n\tv_mbcnt_hi_u32_b32 %0, -1, %0" : "=v"(l)); return l; }
#define XB_TMO      128
#define XB_XCNT(j)  (256  + 64 * (j))
#define XB_XSUB(j)  (1280 + 64 * (j))
#define XB_XGEN(j)  (2304 + 64 * (j))
#define XB_TOP      3328
#define XB_TOPGEN   3392
#define XCD_BAR_WORDS 3456
#define XB_SPIN_CAP (1u << 18)
__device__ __forceinline__ unsigned xb_ld(unsigned* p)              { return __hip_atomic_load(p, __ATOMIC_RELAXED, __HIP_MEMORY_SCOPE_AGENT); }
__device__ __forceinline__ unsigned xb_add(unsigned* p, unsigned v) { return __hip_atomic_fetch_add(p, v, __ATOMIC_RELAXED, __HIP_MEMORY_SCOPE_AGENT); }
__device__ __forceinline__ unsigned xb_xcc_id() { return (unsigned)__builtin_amdgcn_s_getreg((3 << 11) | 20) & 0xFu; }
#define XB_SPIN(cond, bar) do { unsigned _sp = 0; while (cond) { __builtin_amdgcn_s_sleep(1); \
    if ((++_sp & 255u) == 0u) { if (xb_ld(&(bar)[XB_TMO])) break; if (_sp > XB_SPIN_CAP) { atomicAdd(&(bar)[XB_TMO], 1u); break; } } } } while (0)
struct XcdBarrier { unsigned* bar; unsigned x; volatile LAS unsigned* st; };
__device__ __forceinline__ XcdBarrier xcd_barrier_post(unsigned* bar, volatile LAS unsigned* st, bool leader) {
    XcdBarrier b; b.bar = bar; b.x = xb_xcc_id(); b.st = st;
    if (leader) (void)xb_add(&bar[XB_XCNT(b.x)], 1u);
    return b;
}
__device__ __forceinline__ void xcd_barrier_complete(unsigned* bar, unsigned x, unsigned& nloc, unsigned& nx) {
    const unsigned G = gridDim.x * gridDim.y * gridDim.z;
    unsigned sum, cnt, mine, sp = 0u;
    for (;;) {
        sum = 0u; cnt = 0u; mine = 0u;
#pragma unroll
        for (unsigned j = 0; j < 16; ++j) { const unsigned c = xb_ld(&bar[XB_XCNT(j)]); sum += c; cnt += (c > 0u) ? 1u : 0u; mine = (j == x) ? c : mine; }
        if (sum == G) break;
        __builtin_amdgcn_s_sleep(1);
        if ((++sp & 255u) == 0u) { if (xb_ld(&bar[XB_TMO])) break; if (sp > XB_SPIN_CAP) { atomicAdd(&bar[XB_TMO], 1u); break; } }
    }
    nloc = mine > 0u ? mine : 1u; nx = cnt > 0u ? cnt : 1u;
}
__device__ __forceinline__ void xcd_barrier(const XcdBarrier& b, bool leader) {
    asm volatile("s_waitcnt vmcnt(0)" ::: "memory");
    __syncthreads();
    if (leader) {
        unsigned* bar = b.bar;
        __builtin_amdgcn_s_waitcnt(0);
        unsigned nloc = b.st[0], nx = b.st[1];
        if (nloc == 0u) { xcd_barrier_complete(bar, b.x, nloc, nx); b.st[0] = nloc; b.st[1] = nx; }
        const unsigned old = xb_add(&bar[XB_XSUB(b.x)], 1u);
        const unsigned gen = old / nloc;
        if (old + 1u == (gen + 1u) * nloc) {
            __builtin_amdgcn_fence(__ATOMIC_RELEASE, "agent");
            asm volatile("s_waitcnt vmcnt(0)" ::: "memory");
            const unsigned og = xb_add(&bar[XB_TOP], 1u);
            const unsigned tg = og / nx;
            if (og + 1u == (tg + 1u) * nx) xb_add(&bar[XB_TOPGEN], 1u);
            else XB_SPIN(xb_ld(&bar[XB_TOPGEN]) == tg, bar);
            __builtin_amdgcn_fence(__ATOMIC_ACQUIRE, "agent");
            xb_add(&bar[XB_XGEN(b.x)], 1u);
            asm volatile("s_waitcnt vmcnt(0)" ::: "memory");
        } else {
            XB_SPIN(xb_ld(&bar[XB_XGEN(b.x)]) == gen, bar);
            __builtin_amdgcn_fence(__ATOMIC_ACQUIRE, "agent");
            asm volatile("s_waitcnt vmcnt(0)" ::: "memory");
        }
    }
    __syncthreads();
}

enum InIdx { I_x, I_w_in, I_b_in, I_m_conv_w, I_m_conv_b, I_m_norm_w, I_s5_lam_re, I_s5_lam_im, I_s5_log_dt, I_s5_b_re, I_s5_b_im, I_s5_c_re, I_s5_c_im, I_s5_d, I_s5_w_glu, I_s5_b_glu, I_w_branch, I_w_out, I_ln1_g, I_ln1_b, I_w_rg, I_b_rg, I_w_re, I_b_re, I_moe_wg, I_moe_wu, I_moe_wd, I_ln2_g, I_ln2_b };
struct Args { const float* in[29]; float* out; unsigned char* ws; int ph_lo, ph_hi; };
typedef const __attribute__((address_space(4))) Args* KArgs;
struct Frame {
    LAS unsigned char* lds; unsigned char* ldsg;
    gu32* ctl;
    unsigned char* ws;
    int tid, lane, wave, vcu, G, bx;
    float* out;
    KArgs ka;
};
template <int O> __device__ __forceinline__ float shx(float v) { static_assert(O >= 1 && O < 32, "xor mask inside a 32-lane half"); return __int_as_float(__builtin_amdgcn_ds_swizzle(__float_as_int(v), (O << 10) | 0x1f)); }
__device__ __forceinline__ float half_swap_add(float v) { auto rr = __builtin_amdgcn_permlane32_swap(__float_as_uint(v), __float_as_uint(v), false, false); return __uint_as_float(rr[0]) + __uint_as_float(rr[1]); }
__device__ __forceinline__ float half_swap_max(float v) { auto rr = __builtin_amdgcn_permlane32_swap(__float_as_uint(v), __float_as_uint(v), false, false); return fmaxf(__uint_as_float(rr[0]), __uint_as_float(rr[1])); }
__device__ __forceinline__ float wave_sum(float v) { v += shx<1>(v); v += shx<2>(v); v += shx<4>(v); v += shx<8>(v); v += shx<16>(v); return half_swap_add(v); }
__device__ __forceinline__ float wave_max(float v) { v = fmaxf(v, shx<1>(v)); v = fmaxf(v, shx<2>(v)); v = fmaxf(v, shx<4>(v)); v = fmaxf(v, shx<8>(v)); v = fmaxf(v, shx<16>(v)); return half_swap_max(v); }
__device__ __forceinline__ float lane_get(float v, int srclane) { return __int_as_float(__builtin_amdgcn_ds_bpermute(srclane << 2, __float_as_int(v))); }
__device__ __forceinline__ float log_sigmoid(float x) { return fminf(x, 0.f) - log1pf(expf(-fabsf(x))); }

__device__ __forceinline__ void transpose_item(const float* Wsrc, int ldw, bf16* WTdst, int ldt, LAS float* scr, int lane) {
#pragma unroll 8
    for (int i = 0; i < 32; ++i) { const int kk = 2 * i + (lane >> 5); scr[kk * 33 + (lane & 31)] = Wsrc[(size_t)kk * ldw + (lane & 31)]; }
    LDS_WAIT(); asm volatile("" ::: "memory");
    const int c = lane & 7;
#pragma unroll
    for (int j = 0; j < 4; ++j) { const int n = (lane >> 3) + 8 * j; const LAS float* s = scr + (8 * c) * 33 + n;
        v4u o; o.x = pk2(s[0 * 33], s[1 * 33]); o.y = pk2(s[2 * 33], s[3 * 33]); o.z = pk2(s[4 * 33], s[5 * 33]); o.w = pk2(s[6 * 33], s[7 * 33]);
        *(GAS v4u*)(WTdst + (size_t)n * ldt + 8 * c) = o; }
    LDS_WAIT(); asm volatile("" ::: "memory");
}
__device__ __forceinline__ int in_srccol(int c) { return c + (c >= 4096 ? 16 : (c >= 2048 ? 8 : 0)); }

__device__ __forceinline__ void sincos_d(double ang, float& s, float& c) {
    double inv2pi = 0.15915494309189535, twopi = 6.283185307179586476925; asm volatile("" : "+v"(inv2pi), "+v"(twopi));
    const double k = rint(ang * inv2pi); const float r = (float)(ang - k * twopi);
    const float q = rintf(r * 0.6366197723675814f); float y = fmaf(q, -1.57079637050628662109375f, r); y = fmaf(q, 4.371139000186241e-8f, y); const float y2 = y * y;
    float sp = 2.7557319e-6f; sp = sp * y2 - 1.9841270e-4f; sp = sp * y2 + 8.3333333e-3f; sp = sp * y2 - 1.6666667e-1f; sp = y + y * y2 * sp;
    float cp = -2.7557319e-7f; cp = cp * y2 + 2.4801587e-5f; cp = cp * y2 - 1.3888889e-3f; cp = cp * y2 + 4.1666667e-2f; cp = cp * y2 - 0.5f; cp = 1.f + y2 * cp;
    const int qi = ((int)q) & 3; s = (qi == 0) ? sp : (qi == 1) ? cp : (qi == 2) ? -sp : -cp; c = (qi == 0) ? cp : (qi == 1) ? -sp : (qi == 2) ? -cp : sp;
}
__device__ __forceinline__ void s5_build_group(Frame& F, int l, int g) {
    LAS float* AP = (LAS float*)(F.lds);
    LAS float* BB = AP + 33 * 64 * 2;
    LAS float* CC = BB + 64 * 16 * 2;
    LAS float* KT = CC + 16 * 64 * 2;
    LAS float* DD = KT + 32 * 256;
    const int tid = F.tid;
    const float* lre = F.ka->in[I_s5_lam_re] + ((size_t)l * S5G + g) * S5P; const float* lim = F.ka->in[I_s5_lam_im] + ((size_t)l * S5G + g) * S5P;
    const double dt = (double)expf(F.ka->in[I_s5_log_dt][l * S5G + g]);
    for (int i = tid; i < 33 * 64; i += 512) { const int tau = i >> 6, p = i & 63; const double lr = lre[p], li = lim[p];
        const float mag = expf((float)(lr * dt * tau)); float sn, cs; sincos_d(li * dt * tau, sn, cs); AP[i * 2] = mag * cs; AP[i * 2 + 1] = mag * sn; }
    for (int i = tid; i < 64 * 16; i += 512) { const int p = i >> 4, ci = i & 15; const double lr = lre[p], li = lim[p];
        float sn, cs; sincos_d(li * dt, sn, cs); const double mag = (double)expf((float)(lr * dt)), ar = mag * cs, ai = mag * sn, den = lr * lr + li * li, nr = ar - 1.0, ni = ai;
        const double zr = (nr * lr + ni * li) / den, zi = (ni * lr - nr * li) / den;
        const size_t bi = (((size_t)l * S5G + g) * S5P + p) * S5C + ci; const double br = F.ka->in[I_s5_b_re][bi], bim = F.ka->in[I_s5_b_im][bi];
        BB[i * 2] = (float)(zr * br - zi * bim); BB[i * 2 + 1] = (float)(zr * bim + zi * br); }
    for (int i = tid; i < 16 * 64; i += 512) { const size_t ci_ = ((size_t)l * S5G + g) * S5C * S5P + i; CC[i * 2] = F.ka->in[I_s5_c_re][ci_]; CC[i * 2 + 1] = F.ka->in[I_s5_c_im][ci_]; }
    if (tid < 16) DD[tid] = F.ka->in[I_s5_d][(l * S5G + g) * S5C + tid];
    __syncthreads();
    for (int i = tid; i < 32 * 256; i += 512) { const int tau = i >> 8, co = (i >> 4) & 15, ci = i & 15; float s = 0.f;
        for (int p = 0; p < 64; ++p) { const float cr = CC[(co * 64 + p) * 2], cim = CC[(co * 64 + p) * 2 + 1], ar = AP[(tau * 64 + p) * 2], ai = AP[(tau * 64 + p) * 2 + 1];
            const float xr = cr * ar - cim * ai, xi = cr * ai + cim * ar; s += xr * BB[(p * 16 + ci) * 2] - xi * BB[(p * 16 + ci) * 2 + 1]; }
        KT[i] = s; }
    if (tid < 64) { float* tab = (float*)(F.ws + WS_S5TAB) + ((l * 32 + g) * 64 + tid) * 2; tab[0] = AP[(32 * 64 + tid) * 2]; tab[1] = AP[(32 * 64 + tid) * 2 + 1]; }
    __syncthreads();
    bf16* MP = (bf16*)(F.ws + WS_S5ALL + (size_t)l * S5_LAYER_BYTES) + (size_t)g * 512 * S5K;
    for (int i = tid; i < 512 * (S5K / 8); i += 512) { const int n = i / (S5K / 8), k0 = (i % (S5K / 8)) * 8, tq = n >> 4, co = n & 15; float v[8];
#pragma unroll
        for (int j = 0; j < 8; ++j) { const int k = k0 + j; float x;
            if (k < 512) { const int sq = k >> 4, ci = k & 15; x = (tq >= sq) ? KT[((tq - sq) * 16 + co) * 16 + ci] : 0.f; if (tq == sq && co == ci) x += DD[co]; }
            else { const int p = (k - 512) & 63; const float cr = CC[(co * 64 + p) * 2], cim = CC[(co * 64 + p) * 2 + 1], ar = AP[((tq + 1) * 64 + p) * 2], ai = AP[((tq + 1) * 64 + p) * 2 + 1];
                x = (k < 576) ? (cr * ar - cim * ai) : -(cr * ai + cim * ar); }
            v[j] = x; }
        v4u o; o.x = pk2(v[0], v[1]); o.y = pk2(v[2], v[3]); o.z = pk2(v[4], v[5]); o.w = pk2(v[6], v[7]);
        *(GAS v4u*)(MP + (size_t)n * S5K + k0) = o; }
    bf16* GG = (bf16*)(F.ws + WS_S5ALL + (size_t)l * S5_LAYER_BYTES + 20 * MiB) + (size_t)g * 256 * 512;
    for (int i = tid; i < 256 * 64; i += 512) { const int n = i >> 6, k0 = (i & 63) * 8; float v[8];
#pragma unroll
        for (int j = 0; j < 8; ++j) { const int k = k0 + j, sq = k >> 4, ci = k & 15; float x = 0.f;
            if (n < 128) { const int p = n & 63; const float ar = AP[((31 - sq) * 64 + p) * 2], ai = AP[((31 - sq) * 64 + p) * 2 + 1], br = BB[(p * 16 + ci) * 2], bim = BB[(p * 16 + ci) * 2 + 1];
                x = (n < 64) ? (ar * br - ai * bim) : (ar * bim + ai * br); }
            v[j] = x; }
        v4u o; o.x = pk2(v[0], v[1]); o.y = pk2(v[2], v[3]); o.z = pk2(v[4], v[5]); o.w = pk2(v[6], v[7]);
        *(GAS v4u*)(GG + (size_t)n * 512 + k0) = o; }
    __syncthreads();
}

__device__ __forceinline__ void weight_prep(Frame& F, int l) {
    LAS float* scr = (LAS float*)(F.lds + RING_OFF + F.wave * 16384);
    const int gw = F.vcu * NWAVES + F.wave, NGW = F.G * NWAVES;
    constexpr int I_IN = (NIN / 32) * 16, I_GLU = 16 * 8, I_BR = 3 * 32 * 8, I_OUT = 32 * 16, I_G = NEXP * 16 * 16, I_D = NEXP * 32 * 8;
    constexpr int NITEMS = I_IN + I_GLU + I_BR + I_OUT + 2 * I_G + I_D;
    for (int it = gw; it < NITEMS; it += NGW) {
        int r = it;
        if (r < I_IN) { const int nb = r >> 4, kb = r & 15; transpose_item(F.ka->in[I_w_in] + (size_t)l * D * INTOT + (size_t)(64 * kb) * INTOT + in_srccol(32 * nb), INTOT, (bf16*)(F.ws + WS_WIN) + (size_t)(32 * nb) * 1024 + 64 * kb, 1024, scr, F.lane); continue; } r -= I_IN;
        if (r < I_GLU) { const int nb = r >> 3, kb = r & 7; transpose_item(F.ka->in[I_s5_w_glu] + (size_t)l * 512 * 512 + (size_t)(64 * kb) * 512 + 32 * nb, 512, (bf16*)(F.ws + WS_WGLU) + (size_t)(32 * nb) * 512 + 64 * kb, 512, scr, F.lane); continue; } r -= I_GLU;
        if (r < I_BR) { const int br = r >> 8, nb = (r >> 3) & 31, kb = r & 7; transpose_item(F.ka->in[I_w_branch] + ((size_t)l * 3 + br) * 512 * 1024 + (size_t)(64 * kb) * 1024 + 32 * nb, 1024, (bf16*)(F.ws + WS_WBR) + (size_t)(br * 1024 + 32 * nb) * 512 + 64 * kb, 512, scr, F.lane); continue; } r -= I_BR;
        if (r < I_OUT) { const int nb = r >> 4, kb = r & 15; transpose_item(F.ka->in[I_w_out] + (size_t)l * 1024 * 1024 + (size_t)(64 * kb) * 1024 + 32 * nb, 1024, (bf16*)(F.ws + WS_WOUT) + (size_t)(32 * nb) * 1024 + 64 * kb, 1024, scr, F.lane); continue; } r -= I_OUT;
        if (r < 2 * I_G) { const int up = r >= I_G; if (up) r -= I_G; const int e = r >> 8, nb = (r >> 4) & 15, kb = r & 15;
            const float* src = (up ? F.ka->in[I_moe_wu] : F.ka->in[I_moe_wg]) + ((size_t)l * NEXP + e) * 1024 * 512 + (size_t)(64 * kb) * 512 + 32 * nb; const int n0 = 32 * nb;
            transpose_item(src, 512, (bf16*)(F.ws + WS_WGU) + (size_t)(e * 1024 + (n0 >> 7) * 256 + up * 128 + (n0 & 127)) * 1024 + 64 * kb, 1024, scr, F.lane); continue; } r -= 2 * I_G;
        { const int e = r >> 8, nb = (r >> 3) & 31, kb = r & 7;
            transpose_item(F.ka->in[I_moe_wd] + ((size_t)l * NEXP + e) * 512 * 1024 + (size_t)(64 * kb) * 1024 + 32 * nb, 1024, (bf16*)(F.ws + WS_WDN) + (size_t)(e * 1024 + 32 * nb) * 512 + 64 * kb, 512, scr, F.lane); }
    }
}

__device__ __forceinline__ void load_small_w(Frame& F, int l, LAS float* WSM, LAS float* BSM) {
    const float* w = F.ka->in[I_w_in] + (size_t)l * D * INTOT;
    for (int i = F.tid; i < 1024 * 16; i += 512) { const int k = i >> 4, j = i & 15; WSM[j * 1024 + k] = w[(size_t)k * INTOT + (j < 8 ? 2048 + j : 4104 + (j - 8))]; }
    if (F.tid < 16) BSM[F.tid] = F.ka->in[I_b_in][(size_t)l * INTOT + (F.tid < 8 ? 2048 + F.tid : 4104 + (F.tid - 8))];
}
__device__ __forceinline__ void small_gates_row(const f32x4 (&v)[4], const LAS float* WSM, const LAS float* BSM, float* sgrow, int lane) {
    float mine = 0.f;
#pragma unroll
    for (int o = 0; o < 16; ++o) { float p = 0.f;
#pragma unroll
        for (int j = 0; j < 4; ++j) { const f32x4 w = *(const LAS f32x4*)(WSM + o * 1024 + 256 * j + 4 * lane); p += (v[j].x * w.x + v[j].y * w.y) + (v[j].z * w.z + v[j].w * w.w); }
        p = wave_sum(p); if (lane == o) mine = p + BSM[o]; }
    if (lane < 16) sgrow[lane] = mine;
}

__device__ __forceinline__ void phase_p0(Frame& F) {
    if (F.vcu < NL * S5G) s5_build_group(F, F.vcu >> 5, F.vcu & 31);
    weight_prep(F, 0);
    __syncthreads();
    LAS float* WSM = (LAS float*)(F.lds); LAS float* BSM = WSM + 16 * 1024;
    load_small_w(F, 0, WSM, BSM);
    __syncthreads();
    const int gw = F.vcu * NWAVES + F.wave, NGW = F.G * NWAVES;
    for (int m = gw; m < T; m += NGW) {
        const GAS f32x4* xr = (const GAS f32x4*)(F.ka->in[I_x] + (size_t)m * D) + F.lane; f32x4 v[4];
#pragma unroll
        for (int j = 0; j < 4; ++j) v[j] = xr[64 * j];
        GAS v2u* o8 = (GAS v2u*)((bf16*)(F.ws + WS_XB) + (size_t)m * D) + F.lane;
#pragma unroll
        for (int j = 0; j < 4; ++j) { v2u o; o.x = pk2(v[j].x, v[j].y); o.y = pk2(v[j].z, v[j].w); o8[64 * j] = o; }
        small_gates_row(v, WSM, BSM, (float*)(F.ws + WS_SG) + (size_t)m * 16, F.lane);
    }
    __syncthreads();
}

struct EpiInProj {
    static constexpr bool PERM = true;
    unsigned char* ws; const float* bias;
    __device__ __forceinline__ bool reset_after(const pg8::Unit&) const { return true; }
    __device__ __forceinline__ void operator()(pg8::f32x4 (&acc)[2][2][4][2], const pg8::Unit& u, int wr, int wc, int fr, int fq) const {
        using namespace pg8;
        const int pn = u.pn, row0 = u.pm * BM + wr * 64 + fr;
        int mode, pitch, cofs; size_t base;
        if (pn < 4) { mode = 0; base = WS_MQK; pitch = 1024; cofs = 0; }
        else if (pn < 6) { mode = 0; base = WS_MV; pitch = 512; cofs = 1024; }
        else if (pn < 8) { mode = 1; base = WS_MO; pitch = 512; cofs = 1536; }
        else if (pn < 10) { mode = 3; base = WS_S5A; pitch = 0; cofs = 2048; }
        else if (pn < 16) { mode = (pn < 12) ? 2 : 0; base = WS_AQKV; pitch = 1536; cofs = 2560; }
        else { mode = 0; base = WS_GATE; pitch = 3072; cofs = 4096; }
        bf16_t* O = (bf16_t*)(ws + base);
#pragma unroll
        for (int bj = 0; bj < 2; ++bj) {
            const int col0 = pn * BM + bj * HALF + wc * 32 + 8 * fq;
            const int sc = in_srccol(col0);
            const f32x4 b0 = *(const f32x4*)(bias + sc), b1 = *(const f32x4*)(bias + sc + 4);
            const int cl = col0 - cofs;
#pragma unroll
            for (int ai = 0; ai < 2; ++ai)
#pragma unroll
                for (int m = 0; m < 4; ++m) {
                    const int row = row0 + ai * HALF + m * 16;
                    f32x4 v0 = acc[ai][bj][m][0] + b0, v1 = acc[ai][bj][m][1] + b1;
                    if (mode == 1) {
#pragma unroll
                        for (int i = 0; i < 4; ++i) { v0[i] = 1.f / (1.f + __expf(-v0[i])); v1[i] = 1.f / (1.f + __expf(-v1[i])); }
                    } else if (mode == 2) { v0 = v0 * C2; v1 = v1 * C2; }
                    u32x4 w; w.x = cvt_pk_bf16(v0[0], v0[1]); w.y = cvt_pk_bf16(v0[2], v0[3]); w.z = cvt_pk_bf16(v1[0], v1[1]); w.w = cvt_pk_bf16(v1[2], v1[3]);
                    size_t off;
                    if (mode == 3) { const int g = cl >> 4; off = ((size_t)(g * 1024 + (row >> 5)) * S5K) + (row & 31) * 16 + (cl & 15); }
                    else off = (size_t)row * pitch + cl;
                    *(u32x4*)(O + off) = w;
                }
        }
    }
};

__device__ __forceinline__ float wave_incl_scan_add(float v, int lane) {
#pragma unroll
    for (int o = 1; o < 64; o <<= 1) { const float t = lane_get(v, (lane - o) & 63); if (lane >= o) v += t; }
    return v;
}
__device__ __forceinline__ float wave_incl_scan_max(float v, int lane) {
#pragma unroll
    for (int o = 1; o < 64; o <<= 1) { const float t = lane_get(v, (lane - o) & 63); if (lane >= o) v = fmaxf(v, t); }
    return v;
}
__device__ __forceinline__ float lane63(float v) { return __int_as_float(__builtin_amdgcn_readlane(__float_as_int(v), 63)); }
__device__ __forceinline__ void phase_prep2(Frame& F, int l) {
    const int gw = F.vcu * NWAVES + F.wave, lane = F.lane;
    const float* SG = (const float*)(F.ws + WS_SG);
    if (gw < 64) {
        const int b = gw >> 3, h = gw & 7; float carry = 0.f; float* FT = (float*)(F.ws + WS_FTAB) + (size_t)gw * SEQ;
        for (int it = 0; it < SEQ / 64; ++it) { const int s = it * 64 + lane; const float lf = log_sigmoid(SG[(size_t)(b * SEQ + s) * 16 + 8 + h]);
            const float c = wave_incl_scan_add(lf, lane) + carry; FT[s] = c * LOG2E; carry = lane63(c); }
    } else if (gw < 96) {
        const int bh = gw - 64, b = bh >> 2, h = bh & 3; float mprev = 0.f;
        float* MU = (float*)(F.ws + WS_MLU) + (size_t)bh * SEQ; float* MM = MU + (size_t)32 * SEQ; float* MB = MM + (size_t)32 * SEQ;
        float* MSC = (float*)(F.ws + WS_MSC) + bh * 64;
        for (int c = 0; c < 64; ++c) { const int s = c * 64 + lane; const float* sg = SG + (size_t)(b * SEQ + s) * 16;
            const float ip = sg[h], lf = log_sigmoid(sg[4 + h]);
            const float bc = wave_incl_scan_add(lf, lane), u = ip - bc, pm = wave_incl_scan_max(u, lane), mloc = lane63(pm), blast = lane63(bc);
            MU[s] = u; MM[s] = fmaxf(pm, mprev); MB[s] = bc;
            const float Mc = fmaxf(mprev, mloc);
            if (lane == 0) { MSC[c] = mprev; MSC[2048 + c] = mloc; MSC[4096 + c] = expf(mprev - Mc); MSC[6144 + c] = expf(mloc - Mc); }
            mprev = blast + Mc; }
    }
    const bf16* RAW = (const bf16*)(F.ws + WS_MQK); bf16* QK = (bf16*)(F.ws + WS_QK);
    const float* cw = F.ka->in[I_m_conv_w] + (size_t)l * 4 * 1024; const float* cb = F.ka->in[I_m_conv_b] + (size_t)l * 1024;
    const int gt = F.vcu * 512 + F.tid, NT_ = F.G * 512;
    for (int idx = gt; idx < T * 128; idx += NT_) { const int tok = idx >> 7, c0 = (idx & 127) * 8, pos = tok & (SEQ - 1);
        float a[8];
        { const f32x4 b0 = *(const f32x4*)(cb + c0), b1 = *(const f32x4*)(cb + c0 + 4); a[0] = b0.x; a[1] = b0.y; a[2] = b0.z; a[3] = b0.w; a[4] = b1.x; a[5] = b1.y; a[6] = b1.z; a[7] = b1.w; }
#pragma unroll
        for (int j = 0; j < 4; ++j) { if (pos - 3 + j >= 0) { const v4u r = *(const GAS v4u*)(RAW + (size_t)(tok - 3 + j) * 1024 + c0);
                const f32x4 w0 = *(const f32x4*)(cw + j * 1024 + c0), w1 = *(const f32x4*)(cw + j * 1024 + c0 + 4);
                a[0] += w0.x * bflo(r.x); a[1] += w0.y * bfhi(r.x); a[2] += w0.z * bflo(r.y); a[3] += w0.w * bfhi(r.y);
                a[4] += w1.x * bflo(r.z); a[5] += w1.y * bfhi(r.z); a[6] += w1.z * bflo(r.w); a[7] += w1.w * bfhi(r.w); } }
        const float sc = (c0 >= 512) ? 0.08838834764831845f : 1.f;
#pragma unroll
        for (int i = 0; i < 8; ++i) a[i] = a[i] / (1.f + __expf(-a[i])) * sc;
        v4u o; o.x = pk2(a[0], a[1]); o.y = pk2(a[2], a[3]); o.z = pk2(a[4], a[5]); o.w = pk2(a[6], a[7]);
        *(GAS v4u*)(QK + (size_t)tok * 1024 + c0) = o; }
}

__device__ __forceinline__ void mlstm_pass1(Frame& F, int uu) {
    const int tid = F.tid, lane = F.lane, wid = F.wave, r = lane & 31, hh = lane >> 5;
    const int bh = uu >> 6, c = uu & 63, b = bh >> 2, h = bh & 3; const size_t tok0 = (size_t)b * SEQ + c * 64;
    LAS bf16* KT = (LAS bf16*)(F.lds); LAS bf16* VT = KT + 128 * 72; LAS float* WS_ = (LAS float*)(F.lds + 2 * 128 * 72 * 2);
    if (tid < 64) { const float u = ((const float*)(F.ws + WS_MLU))[(size_t)bh * SEQ + c * 64 + tid]; const float ml = ((const float*)(F.ws + WS_MSC))[2048 + bh * 64 + c]; WS_[tid] = expf(u - ml); }
    __syncthreads();
    const bf16* QK = (const bf16*)(F.ws + WS_QK); const bf16* MV = (const bf16*)(F.ws + WS_MV);
    for (int p = tid; p < 1024; p += 512) { const int s = p >> 4, d0 = (p & 15) * 8;
        const v4u kk = *(const GAS v4u*)(QK + (tok0 + s) * 1024 + 512 + h * 128 + d0); const v4u vv = *(const GAS v4u*)(MV + (tok0 + s) * 512 + h * 128 + d0); const float w = WS_[s];
        const unsigned ka[4] = {kk.x, kk.y, kk.z, kk.w}, va[4] = {vv.x, vv.y, vv.z, vv.w};
#pragma unroll
        for (int j = 0; j < 4; ++j) { KT[(d0 + 2 * j) * 72 + s] = (bf16)f2bf(bflo(ka[j]) * w); KT[(d0 + 2 * j + 1) * 72 + s] = (bf16)f2bf(bfhi(ka[j]) * w);
            VT[(d0 + 2 * j) * 72 + s] = (bf16)(va[j] & 0xffffu); VT[(d0 + 2 * j + 1) * 72 + s] = (bf16)(va[j] >> 16); } }
    __syncthreads();
    const int mt = wid >> 1, nt0 = (wid & 1) * 2;
    f32x16 acc[2]; acc[0] = f32x16{}; acc[1] = f32x16{};
#pragma unroll
    for (int ks = 0; ks < 4; ++ks) { const bf16x8 A = *(const LAS bf16x8*)(KT + (32 * mt + r) * 72 + 16 * ks + 8 * hh);
#pragma unroll
        for (int n = 0; n < 2; ++n) { const bf16x8 B = *(const LAS bf16x8*)(VT + (32 * (nt0 + n) + r) * 72 + 16 * ks + 8 * hh); acc[n] = __builtin_amdgcn_mfma_f32_32x32x16_bf16(A, B, acc[n], 0, 0, 0); } }
    bf16* CT = (bf16*)(F.ws + WS_CST) + (size_t)uu * 128 * 128;
#pragma unroll
    for (int n = 0; n < 2; ++n) { const int dv = 32 * (nt0 + n) + r;
#pragma unroll
        for (int g = 0; g < 4; ++g) { v2u o; o.x = pk2(acc[n][4 * g], acc[n][4 * g + 1]); o.y = pk2(acc[n][4 * g + 2], acc[n][4 * g + 3]);
            *(GAS v2u*)(CT + (size_t)dv * 128 + 32 * mt + 8 * g + 4 * hh) = o; } }
    if (tid < 128) { float s = 0.f; for (int i = 0; i < 64; ++i) s += bf2f(KT[tid * 72 + i]); ((float*)(F.ws + WS_NST))[(size_t)uu * 128 + tid] = s; }
    __syncthreads();
}

__device__ __forceinline__ void mlstm_pass3(Frame& F, int l, int uu) {
    const int tid = F.tid, lane = F.lane, wid = F.wave, r = lane & 31, hh = lane >> 5;
    const int bh = uu >> 6, c = uu & 63, b = bh >> 2, h = bh & 3; const size_t tok0 = (size_t)b * SEQ + c * 64;
    LAS bf16* Q = (LAS bf16*)(F.lds); LAS bf16* Kk = Q + 64 * 136; LAS bf16* VT = Kk + 64 * 136; LAS bf16* CT = VT + 128 * 72;
    LAS float* HB = (LAS float*)(F.lds + 88064); LAS float* SM = (LAS float*)(F.lds + 121856);
    LAS float* U = SM, *MT = SM + 64, *WST = SM + 128, *FLO = SM + 192, *DEN = SM + 256, *NP = SM + 320, *QN = SM + 448;
    const bf16* QKg = (const bf16*)(F.ws + WS_QK); const bf16* MVg = (const bf16*)(F.ws + WS_MV); const bf16* CTg = (const bf16*)(F.ws + WS_CST) + (size_t)uu * 128 * 128;
    for (int p = tid; p < 1024; p += 512) { const int s = p >> 4, d0 = (p & 15) * 8;
        *(LAS v4u*)(Q + s * 136 + d0) = *(const GAS v4u*)(QKg + (tok0 + s) * 1024 + h * 128 + d0);
        *(LAS v4u*)(Kk + s * 136 + d0) = *(const GAS v4u*)(QKg + (tok0 + s) * 1024 + 512 + h * 128 + d0);
        const v4u vv = *(const GAS v4u*)(MVg + (tok0 + s) * 512 + h * 128 + d0); const unsigned va[4] = {vv.x, vv.y, vv.z, vv.w};
#pragma unroll
        for (int j = 0; j < 4; ++j) { VT[(d0 + 2 * j) * 72 + s] = (bf16)(va[j] & 0xffffu); VT[(d0 + 2 * j + 1) * 72 + s] = (bf16)(va[j] >> 16); } }
    for (int p = tid; p < 2048; p += 512) { const int dv = p >> 4, d0 = (p & 15) * 8; *(LAS v4u*)(CT + dv * 136 + d0) = *(const GAS v4u*)(CTg + (size_t)dv * 128 + d0); }
    if (tid < 64) { const size_t o = (size_t)bh * SEQ + c * 64 + tid; const float* MLU = (const float*)(F.ws + WS_MLU);
        const float u = MLU[o], Mt = MLU[(size_t)32 * SEQ + o], bc = MLU[(size_t)64 * SEQ + o], mprev = ((const float*)(F.ws + WS_MSC))[bh * 64 + c];
        U[tid] = u; MT[tid] = Mt; WST[tid] = expf(mprev - Mt); FLO[tid] = expf(-bc - Mt); }
    else if (tid < 192) NP[tid - 64] = ((const float*)(F.ws + WS_NST))[(size_t)uu * 128 + (tid - 64)];
    __syncthreads();
    { const int t = tid >> 3, part = tid & 7; float s = 0.f;
#pragma unroll
        for (int i = 0; i < 16; ++i) s += bf2f(Q[t * 136 + part * 16 + i]) * NP[part * 16 + i];
        s += shx<1>(s); s += shx<2>(s); s += shx<4>(s); if (part == 0) QN[t] = s; }
    __syncthreads();
    const int tt = wid >> 2, dt = wid & 3;
    f32x16 acc = f32x16{};
#pragma unroll
    for (int ks = 0; ks < 8; ++ks) { const bf16x8 A = *(const LAS bf16x8*)(Q + (32 * tt + r) * 136 + 16 * ks + 8 * hh); const bf16x8 B = *(const LAS bf16x8*)(CT + (32 * dt + r) * 136 + 16 * ks + 8 * hh);
        acc = __builtin_amdgcn_mfma_f32_32x32x16_bf16(A, B, acc, 0, 0, 0); }
#pragma unroll
    for (int g = 0; g < 16; ++g) acc[g] *= WST[32 * tt + (g & 3) + 8 * (g >> 2) + 4 * hh];
    float denp = 0.f; const float Mt_l = MT[32 * tt + r];
    for (int st = 0; st <= tt; ++st) {
        f32x16 ST = f32x16{};
#pragma unroll
        for (int ks = 0; ks < 8; ++ks) { const bf16x8 A = *(const LAS bf16x8*)(Kk + (32 * st + r) * 136 + 16 * ks + 8 * hh); const bf16x8 B = *(const LAS bf16x8*)(Q + (32 * tt + r) * 136 + 16 * ks + 8 * hh);
            ST = __builtin_amdgcn_mfma_f32_32x32x16_bf16(A, B, ST, 0, 0, 0); }
#pragma unroll
        for (int g = 0; g < 16; ++g) { const int ri = (g & 3) + 8 * (g >> 2) + 4 * hh; float w = __expf(U[32 * st + ri] - Mt_l); if (st == tt && ri > r) w = 0.f; ST[g] *= w; denp += ST[g]; }
#pragma unroll
        for (int sp = 0; sp < 2; ++sp) {
            v4u pa; pa.x = pg8::cvt_pk_bf16(ST[8 * sp], ST[8 * sp + 1]); pa.y = pg8::cvt_pk_bf16(ST[8 * sp + 2], ST[8 * sp + 3]); pa.z = pg8::cvt_pk_bf16(ST[8 * sp + 4], ST[8 * sp + 5]); pa.w = pg8::cvt_pk_bf16(ST[8 * sp + 6], ST[8 * sp + 7]);
            const v2u lo = *(const LAS v2u*)(VT + (32 * dt + r) * 72 + 32 * st + 16 * sp + 4 * hh), hi = *(const LAS v2u*)(VT + (32 * dt + r) * 72 + 32 * st + 16 * sp + 8 + 4 * hh);
            v4u pb; pb.x = lo.x; pb.y = lo.y; pb.z = hi.x; pb.w = hi.y;
            acc = __builtin_amdgcn_mfma_f32_32x32x16_bf16(__builtin_bit_cast(bf16x8, pa), __builtin_bit_cast(bf16x8, pb), acc, 0, 0, 0); }
    }
    denp = half_swap_add(denp);
    if (dt == 0 && hh == 0) { const int t = 32 * tt + r; DEN[t] = denp + WST[t] * QN[t]; }
    __syncthreads();
#pragma unroll
    for (int g = 0; g < 16; ++g) { const int t = 32 * tt + (g & 3) + 8 * (g >> 2) + 4 * hh; HB[t * 132 + 32 * dt + r] = acc[g] / fmaxf(fabsf(DEN[t]), FLO[t]); }
    __syncthreads();
    { const int t = tid >> 3, part = tid & 7; float x[16]; float s = 0.f;
#pragma unroll
        for (int i = 0; i < 16; ++i) { x[i] = HB[t * 132 + part * 16 + i]; s += x[i]; }
        s += shx<1>(s); s += shx<2>(s); s += shx<4>(s); const float mean = s * (1.f / 128.f); float q = 0.f;
#pragma unroll
        for (int i = 0; i < 16; ++i) { x[i] -= mean; q += x[i] * x[i]; }
        q += shx<1>(q); q += shx<2>(q); q += shx<4>(q); const float rstd = 1.f / sqrtf(q * (1.f / 128.f) + LN_EPS);
        const float* nw = F.ka->in[I_m_norm_w] + (size_t)l * BW + h * 128 + part * 16; const bf16* og = (const bf16*)(F.ws + WS_MO) + (tok0 + t) * 512 + h * 128 + part * 16;
        const v4u o0 = *(const GAS v4u*)og, o1 = *(const GAS v4u*)(og + 8); const unsigned oa[8] = {o0.x, o0.y, o0.z, o0.w, o1.x, o1.y, o1.z, o1.w};
        unsigned ow[8];
#pragma unroll
        for (int i = 0; i < 8; ++i) ow[i] = pk2(x[2 * i] * rstd * nw[2 * i] * bflo(oa[i]), x[2 * i + 1] * rstd * nw[2 * i + 1] * bfhi(oa[i]));
        bf16* yo = (bf16*)(F.ws + WS_YTALL) + (tok0 + t) * 512 + h * 128 + part * 16;
        *(GAS v4u*)yo = (v4u){ow[0], ow[1], ow[2], ow[3]}; *(GAS v4u*)(yo + 8) = (v4u){ow[4], ow[5], ow[6], ow[7]}; }
    __syncthreads();
}

__device__ __forceinline__ void phase_scans(Frame& F, int l) {
    const int v = F.vcu, tid = F.tid;
    if (v < 128) {
        const int gid = v * 512 + tid, bh = gid >> 11, rem = gid & 2047; const float* MSC = (const float*)(F.ws + WS_MSC);
        bf16* p = (bf16*)(F.ws + WS_CST) + (size_t)bh * 64 * 16384 + (size_t)rem * 8; float S[8] = {0.f, 0.f, 0.f, 0.f, 0.f, 0.f, 0.f, 0.f};
#pragma unroll 4
        for (int c = 0; c < 64; ++c) { const v4u lc = *(const GAS v4u*)(p + (size_t)c * 16384); const float dec = MSC[4096 + bh * 64 + c], sc = MSC[6144 + bh * 64 + c];
            v4u o; o.x = pk2(S[0], S[1]); o.y = pk2(S[2], S[3]); o.z = pk2(S[4], S[5]); o.w = pk2(S[6], S[7]); *(GAS v4u*)(p + (size_t)c * 16384) = o;
            S[0] = dec * S[0] + sc * bflo(lc.x); S[1] = dec * S[1] + sc * bfhi(lc.x); S[2] = dec * S[2] + sc * bflo(lc.y); S[3] = dec * S[3] + sc * bfhi(lc.y);
            S[4] = dec * S[4] + sc * bflo(lc.z); S[5] = dec * S[5] + sc * bfhi(lc.z); S[6] = dec * S[6] + sc * bflo(lc.w); S[7] = dec * S[7] + sc * bfhi(lc.w); }
    } else if (v < 160) {
        const int gid = (v - 128) * 512 + tid, b = gid >> 11, g = (gid >> 6) & 31, p = gid & 63; const float* tab = (const float*)(F.ws + WS_S5TAB) + ((l * 32 + g) * 64 + p) * 2; const float ar = tab[0], ai = tab[1];
        bf16* A = (bf16*)(F.ws + WS_S5A); const float* E = (const float*)(F.ws + WS_EBUF); float hr = 0.f, hi = 0.f;
#pragma unroll 4
        for (int ch = 0; ch < 128; ++ch) { const size_t row = (size_t)g * 1024 + b * 128 + ch; A[row * S5K + 512 + p] = (bf16)f2bf(hr); A[row * S5K + 576 + p] = (bf16)f2bf(hi);
            const float er = E[row * 128 + p], ei = E[row * 128 + 64 + p]; const float nr = ar * hr - ai * hi + er, ni = ar * hi + ai * hr + ei; hr = nr; hi = ni; }
    } else if (v < 168) {
        const int gid = (v - 160) * 512 + tid, bh = gid >> 7, dk = gid & 127; const float* MSC = (const float*)(F.ws + WS_MSC); float* p = (float*)(F.ws + WS_NST) + (size_t)bh * 64 * 128 + dk; float n = 0.f;
#pragma unroll 4
        for (int c = 0; c < 64; ++c) { const float lc = p[c * 128]; p[c * 128] = n; n = MSC[4096 + bh * 64 + c] * n + MSC[6144 + bh * 64 + c] * lc; }
    }
}

struct SchedS5E { int c; __device__ __forceinline__ bool next(int i, pg8::Unit& u) const { if (i > 0 || c >= 128) return false; u.pm = c; u.pn = c >> 2; return true; } };
struct SchedS5Y { int c; __device__ __forceinline__ bool next(int i, pg8::Unit& u) const { if (i > 0 || c >= 256) return false; u.pm = c >> 1; u.pn = (c >> 3) * 2 + (c & 1); return true; } };
struct EpiS5E {
    static constexpr bool PERM = false;
    float* E;
    __device__ __forceinline__ bool reset_after(const pg8::Unit&) const { return true; }
    __device__ __forceinline__ void operator()(pg8::f32x4 (&acc)[2][2][4][2], const pg8::Unit& u, int wr, int wc, int fr, int fq) const {
        using namespace pg8;
        const int row0 = u.pm * BM + wr * 64 + fr, col0 = wc * 32 + 4 * fq;
#pragma unroll
        for (int ai = 0; ai < 2; ++ai)
#pragma unroll
            for (int m = 0; m < 4; ++m)
#pragma unroll
                for (int n = 0; n < 2; ++n) *(f32x4*)(E + (size_t)(row0 + ai * HALF + m * 16) * 128 + col0 + 16 * n) = acc[ai][0][m][n];
    }
};
__device__ __forceinline__ float gelu_tanh(float x) { const float z = 0.7978845608028654f * (x + 0.044715f * x * x * x); const float e = __expf(2.f * z); return 0.5f * x * (2.f - 2.f / (1.f + e)); }
struct EpiS5Y {
    static constexpr bool PERM = true;
    bf16* Y;
    __device__ __forceinline__ bool reset_after(const pg8::Unit&) const { return true; }
    __device__ __forceinline__ void operator()(pg8::f32x4 (&acc)[2][2][4][2], const pg8::Unit& u, int wr, int wc, int fr, int fq) const {
        using namespace pg8;
        const int row0 = u.pm * BM + wr * 64 + fr, ct = u.pn & 1;
#pragma unroll
        for (int bj = 0; bj < 2; ++bj) { const int cc = ct * 256 + bj * HALF + wc * 32 + 8 * fq, tq = cc >> 4, co = cc & 15;
#pragma unroll
            for (int ai = 0; ai < 2; ++ai)
#pragma unroll
                for (int m = 0; m < 4; ++m) { const int R = row0 + ai * HALF + m * 16, g = R >> 10, rr = R & 1023; const f32x4 v0 = acc[ai][bj][m][0], v1 = acc[ai][bj][m][1];
                    u32x4 w; w.x = cvt_pk_bf16(gelu_tanh(v0[0]), gelu_tanh(v0[1])); w.y = cvt_pk_bf16(gelu_tanh(v0[2]), gelu_tanh(v0[3])); w.z = cvt_pk_bf16(gelu_tanh(v1[0]), gelu_tanh(v1[1])); w.w = cvt_pk_bf16(gelu_tanh(v1[2]), gelu_tanh(v1[3]));
                    *(u32x4*)(Y + (size_t)(rr * 32 + tq) * 512 + 16 * g + co) = w; } }
    }
};
struct EpiGlu {
    static constexpr bool PERM = true;
    const bf16* Y1; bf16* YO; const float* bias;
    __device__ __forceinline__ bool reset_after(const pg8::Unit&) const { return true; }
    __device__ __forceinline__ void operator()(pg8::f32x4 (&acc)[2][2][4][2], const pg8::Unit& u, int wr, int wc, int fr, int fq) const {
        using namespace pg8;
        const int row0 = u.pm * BM + wr * 64 + fr;
#pragma unroll
        for (int bj = 0; bj < 2; ++bj) { const int col0 = u.pn * BM + bj * HALF + wc * 32 + 8 * fq; const f32x4 b0 = *(const f32x4*)(bias + col0), b1 = *(const f32x4*)(bias + col0 + 4);
#pragma unroll
            for (int ai = 0; ai < 2; ++ai)
#pragma unroll
                for (int m = 0; m < 4; ++m) { const size_t off = (size_t)(row0 + ai * HALF + m * 16) * 512 + col0; const u32x4 y = *(const u32x4*)(Y1 + off);
                    const f32x4 v0 = acc[ai][bj][m][0] + b0, v1 = acc[ai][bj][m][1] + b1;
                    u32x4 w; w.x = cvt_pk_bf16(bflo(y.x) * sigmoidf_(v0[0]), bfhi(y.x) * sigmoidf_(v0[1])); w.y = cvt_pk_bf16(bflo(y.y) * sigmoidf_(v0[2]), bfhi(y.y) * sigmoidf_(v0[3]));
                    w.z = cvt_pk_bf16(bflo(y.z) * sigmoidf_(v1[0]), bfhi(y.z) * sigmoidf_(v1[1])); w.w = cvt_pk_bf16(bflo(y.w) * sigmoidf_(v1[2]), bfhi(y.w) * sigmoidf_(v1[3]));
                    *(u32x4*)(YO + off) = w; } }
    }
};
struct SchedMerge { int c, G; __device__ __forceinline__ bool next(int i, pg8::Unit& u) const { const int tl = (i / 3) * G + c, b = i % 3; if (tl >= 512) return false; u.pm = b * 128 + (tl >> 2); u.pn = b * 4 + (tl & 3); return true; } };
struct EpiMerge {
    static constexpr bool PERM = true;
    const bf16* GP; bf16* MX;
    __device__ __forceinline__ bool reset_after(const pg8::Unit& u) const { return u.pm >= 256; }
    __device__ __forceinline__ void operator()(pg8::f32x4 (&acc)[2][2][4][2], const pg8::Unit& u, int wr, int wc, int fr, int fq) const {
        using namespace pg8;
        const int b = u.pm >> 7, pm = u.pm & 127, pn = u.pn & 3, row0 = pm * BM + wr * 64 + fr;
#pragma unroll
        for (int bj = 0; bj < 2; ++bj) { const int col0 = pn * BM + bj * HALF + wc * 32 + 8 * fq;
#pragma unroll
            for (int ai = 0; ai < 2; ++ai)
#pragma unroll
                for (int m = 0; m < 4; ++m) { const int row = row0 + ai * HALF + m * 16; const bf16* gp = GP + (size_t)row * 3072 + b * 1024 + col0;
                    const u32x4 ga = *(const u32x4*)gp; float f[8];
                    const unsigned gaa[4] = {ga.x, ga.y, ga.z, ga.w};
                    if (b < 2) { const u32x4 gb = *(const u32x4*)(gp + 1024); const unsigned gba[4] = {gb.x, gb.y, gb.z, gb.w};
#pragma unroll
                        for (int i = 0; i < 4; ++i) {
                            const float a0 = fminf(fmaxf(bflo(gaa[i]), -30.f), 30.f), a1 = fminf(fmaxf(bfhi(gaa[i]), -30.f), 30.f), c0 = fminf(fmaxf(bflo(gba[i]), -30.f), 30.f), c1 = fminf(fmaxf(bfhi(gba[i]), -30.f), 30.f);
                            f[2 * i] = (1.f + __expf(-c0)) / (1.f + __expf(-a0)); f[2 * i + 1] = (1.f + __expf(-c1)) / (1.f + __expf(-a1)); }
                    } else {
#pragma unroll
                        for (int i = 0; i < 4; ++i) { const float a0 = fminf(fmaxf(bflo(gaa[i]), -30.f), 30.f), a1 = fminf(fmaxf(bfhi(gaa[i]), -30.f), 30.f); f[2 * i] = 1.f / (1.f + __expf(-a0)); f[2 * i + 1] = 1.f / (1.f + __expf(-a1)); }
                    }
                    f32x4& v0 = acc[ai][bj][m][0]; f32x4& v1 = acc[ai][bj][m][1];
                    v0[0] *= f[0]; v0[1] *= f[1]; v0[2] *= f[2]; v0[3] *= f[3]; v1[0] *= f[4]; v1[1] *= f[5]; v1[2] *= f[6]; v1[3] *= f[7];
                    if (b == 2) { u32x4 w; w.x = cvt_pk_bf16(v0[0], v0[1]); w.y = cvt_pk_bf16(v0[2], v0[3]); w.z = cvt_pk_bf16(v1[0], v1[1]); w.w = cvt_pk_bf16(v1[2], v1[3]);
                        *(u32x4*)(MX + (size_t)row * 1024 + col0) = w; } } }
    }
};
struct EpiOutProj {
    static constexpr bool PERM = false;
    const float* X; float* O;
    __device__ __forceinline__ bool reset_after(const pg8::Unit&) const { return true; }
    __device__ __forceinline__ void operator()(pg8::f32x4 (&acc)[2][2][4][2], const pg8::Unit& u, int wr, int wc, int fr, int fq) const {
        using namespace pg8;
        const int row0 = u.pm * BM + wr * 64 + fr, col0 = u.pn * BM + wc * 32 + 4 * fq;
#pragma unroll
        for (int ai = 0; ai < 2; ++ai)
#pragma unroll
            for (int m = 0; m < 4; ++m) { const size_t off = (size_t)(row0 + ai * HALF + m * 16) * 1024 + col0;
#pragma unroll
                for (int bj = 0; bj < 2; ++bj)
#pragma unroll
                    for (int n = 0; n < 2; ++n) { const f32x4 xv = *(const f32x4*)(X + off + bj * HALF + n * 16); *(f32x4*)(O + off + bj * HALF + n * 16) = xv * ALPHA + acc[ai][bj][m][n]; } }
    }
};

__device__ __forceinline__ void phase_ln1_route(Frame& F, int l) {
    LAS float* WRE = (LAS float*)(F.lds); LAS float* WRG = (LAS float*)(F.lds + 131072);
    LAS float* BR = (LAS float*)(F.lds + 131072 + 16384); LAS unsigned* HIST = (LAS unsigned*)(BR + 64); LAS unsigned* BASE = HIST + 32;
    const float* wre = F.ka->in[I_w_re] + (size_t)l * 1024 * 32; const float* wrg = F.ka->in[I_w_rg] + (size_t)l * 1024 * 4;
    for (int i = F.tid; i < 1024 * 32; i += 512) WRE[(i & 31) * 1024 + (i >> 5)] = wre[i];
    for (int i = F.tid; i < 1024 * 4; i += 512) WRG[(i & 3) * 1024 + (i >> 2)] = wrg[i];
    if (F.tid < 32) { BR[F.tid] = F.ka->in[I_b_re][l * 32 + F.tid]; HIST[F.tid] = 0u; }
    if (F.tid < 4) BR[32 + F.tid] = F.ka->in[I_b_rg][l * 4 + F.tid];
    { int* tp = (int*)(F.ws + WS_TOKPOS); for (int i = F.vcu * 512 + F.tid; i < MOE_ROWS; i += F.G * 512) tp[i] = -1; }
    __syncthreads();
    const int gw = F.vcu * NWAVES + F.wave, NGW = F.G * NWAVES, lane = F.lane;
    const float* lg = F.ka->in[I_ln1_g] + (size_t)l * D; const float* lb = F.ka->in[I_ln1_b] + (size_t)l * D;
    int my_e0 = 0, my_e1 = 0, my_r0 = 0, my_r1 = 0, my_m = -1; float my_w0 = 0.f, my_w1 = 0.f; int it = 0;
    for (int m = gw; m < T; m += NGW, ++it) {
        GAS f32x4* xr = (GAS f32x4*)(F.out + (size_t)m * D) + lane; f32x4 v[4]; float s = 0.f;
#pragma unroll
        for (int j = 0; j < 4; ++j) { v[j] = xr[64 * j]; s += (v[j].x + v[j].y) + (v[j].z + v[j].w); }
        const float mean = wave_sum(s) * (1.f / D); float s2 = 0.f;
#pragma unroll
        for (int j = 0; j < 4; ++j) { v[j] = v[j] - mean; s2 += (v[j].x * v[j].x + v[j].y * v[j].y) + (v[j].z * v[j].z + v[j].w * v[j].w); }
        const float rstd = 1.f / sqrtf(wave_sum(s2) * (1.f / D) + LN_EPS);
        GAS v2u* o8 = (GAS v2u*)((bf16*)(F.ws + WS_XB) + (size_t)m * D) + lane;
#pragma unroll
        for (int j = 0; j < 4; ++j) { const f32x4 g4 = *(const f32x4*)(lg + 256 * j + 4 * lane), b4 = *(const f32x4*)(lb + 256 * j + 4 * lane);
            v[j] = v[j] * rstd * g4 + b4; xr[64 * j] = v[j]; v2u o; o.x = pk2(v[j].x, v[j].y); o.y = pk2(v[j].z, v[j].w); o8[64 * j] = o; }
        float gl[4];
#pragma unroll
        for (int o = 0; o < 4; ++o) { float p = 0.f;
#pragma unroll
            for (int j = 0; j < 4; ++j) { const f32x4 w = *(const LAS f32x4*)(WRG + o * 1024 + 256 * j + 4 * lane); p += (v[j].x * w.x + v[j].y * w.y) + (v[j].z * w.z + v[j].w * w.w); }
            gl[o] = wave_sum(p) + BR[32 + o]; }
        int grp = 0; float gmax = gl[0];
#pragma unroll
        for (int o = 1; o < 4; ++o) if (gl[o] > gmax) { gmax = gl[o]; grp = o; }
        float gs = 0.f;
#pragma unroll
        for (int o = 0; o < 4; ++o) gs += expf(gl[o] - gmax);
        const float pg = 1.f / gs;
        float el[8];
#pragma unroll
        for (int o = 0; o < 8; ++o) { float p = 0.f; const LAS float* wr_ = WRE + (grp * 8 + o) * 1024;
#pragma unroll
            for (int j = 0; j < 4; ++j) { const f32x4 w = *(const LAS f32x4*)(wr_ + 256 * j + 4 * lane); p += (v[j].x * w.x + v[j].y * w.y) + (v[j].z * w.z + v[j].w * w.w); }
            el[o] = wave_sum(p) + BR[grp * 8 + o]; }
        int i0 = 0; float l0 = el[0];
#pragma unroll
        for (int o = 1; o < 8; ++o) if (el[o] > l0) { l0 = el[o]; i0 = o; }
        int i1 = -1; float l1 = -INFINITY;
#pragma unroll
        for (int o = 0; o < 8; ++o) if (o != i0 && el[o] > l1) { l1 = el[o]; i1 = o; }
        const float ex = expf(l1 - l0), pe0 = 1.f / (1.f + ex), pe1 = ex / (1.f + ex);
        const int e0 = grp * 8 + i0, e1 = grp * 8 + i1;
        unsigned r0 = 0u, r1 = 0u;
        if (lane == 0) { r0 = __hip_atomic_fetch_add(&HIST[e0], 1u, __ATOMIC_RELAXED, __HIP_MEMORY_SCOPE_WORKGROUP); r1 = __hip_atomic_fetch_add(&HIST[e1], 1u, __ATOMIC_RELAXED, __HIP_MEMORY_SCOPE_WORKGROUP); }
        r0 = (unsigned)__builtin_amdgcn_readfirstlane((int)r0); r1 = (unsigned)__builtin_amdgcn_readfirstlane((int)r1);
        if (lane == it) { my_e0 = e0; my_e1 = e1; my_r0 = (int)r0; my_r1 = (int)r1; my_w0 = pg * pe0; my_w1 = pg * pe1; my_m = m; }
    }
    __syncthreads();
    if (F.tid < 32) BASE[F.tid] = __hip_atomic_fetch_add((unsigned*)(F.ctl + CW_GCNT + l * 32 + F.tid), HIST[F.tid], RLX_AGENT);
    __syncthreads();
    if (my_m >= 0) { int* re = (int*)(F.ws + WS_ROUTE); float* rw = (float*)(F.ws + WS_ROUTE + 262144); int* rp = (int*)(F.ws + WS_ROUTE + 524288);
        re[2 * my_m] = my_e0; re[2 * my_m + 1] = my_e1; rw[2 * my_m] = my_w0; rw[2 * my_m + 1] = my_w1; rp[2 * my_m] = (int)BASE[my_e0] + my_r0; rp[2 * my_m + 1] = (int)BASE[my_e1] + my_r1; }
    __syncthreads();
}

__device__ __forceinline__ void moe_tables(Frame& F, int l) {
    LAS int* PST = (LAS int*)(F.lds + LDSX_OFF + 20480); LAS int* BLKE = PST + 64;
    if (F.tid == 0) { int acc = 0;
#pragma unroll 1
        for (int e = 0; e < NEXP; ++e) { const int cnt = (int)__hip_atomic_load(F.ctl + CW_GCNT + l * 32 + e, RLX_AGENT); PST[e] = acc; const int nb = (cnt + 255) >> 8;
#pragma unroll 1
            for (int j = 0; j < nb; ++j) BLKE[(acc >> 8) + j] = e; acc += nb << 8; } PST[32] = acc; PST[33] = acc >> 8; }
    __syncthreads();
}
__device__ __forceinline__ void phase_dispatch(Frame& F, int l) {
    moe_tables(F, l);
    const LAS int* PST = (const LAS int*)(F.lds + LDSX_OFF + 20480);
    const int gw = F.vcu * NWAVES + F.wave, NGW = F.G * NWAVES, lane = F.lane;
    const int* re = (const int*)(F.ws + WS_ROUTE); const float* rw = (const float*)(F.ws + WS_ROUTE + 262144); const int* rp = (const int*)(F.ws + WS_ROUTE + 524288);
    int* tp = (int*)(F.ws + WS_TOKPOS); float* wp = (float*)(F.ws + WS_TOKPOS + 524288);
    const bf16* XB = (const bf16*)(F.ws + WS_XB); bf16* XG = (bf16*)(F.ws + WS_XG);
    for (int m = gw; m < T; m += NGW) {
        const int e0 = re[2 * m], e1 = re[2 * m + 1]; const int p0 = PST[e0] + rp[2 * m], p1 = PST[e1] + rp[2 * m + 1];
        if (lane == 0) { tp[p0] = 2 * m; wp[p0] = rw[2 * m]; tp[p1] = 2 * m + 1; wp[p1] = rw[2 * m + 1]; }
        const GAS v4u* src = (const GAS v4u*)(XB + (size_t)m * D) + lane; const v4u a = src[0], b = src[64];
        GAS v4u* d0 = (GAS v4u*)(XG + (size_t)p0 * D) + lane; GAS v4u* d1 = (GAS v4u*)(XG + (size_t)p1 * D) + lane;
        d0[0] = a; d0[64] = b; d1[0] = a; d1[64] = b;
    }
}
struct SchedMoe { const LAS int* PST; int c, G; __device__ __forceinline__ bool next(int i, pg8::Unit& u) const { const int L = i * G + c; const int nb = __builtin_amdgcn_readfirstlane(PST[33]); if (L >= nb * 4) return false; const int rb = L >> 2; u.pm = rb; u.pn = __builtin_amdgcn_readfirstlane(PST[64 + rb]) * 4 + (L & 3); return true; } };
struct EpiGateUp {
    static constexpr bool PERM = true;
    bf16* H;
    __device__ __forceinline__ bool reset_after(const pg8::Unit&) const { return true; }
    __device__ __forceinline__ void operator()(pg8::f32x4 (&acc)[2][2][4][2], const pg8::Unit& u, int wr, int wc, int fr, int fq) const {
        using namespace pg8;
        const int row0 = u.pm * BM + wr * 64 + fr, col0 = (u.pn & 3) * HALF + wc * 32 + 8 * fq;
#pragma unroll
        for (int ai = 0; ai < 2; ++ai)
#pragma unroll
            for (int m = 0; m < 4; ++m) { float hv[8];
#pragma unroll
                for (int n = 0; n < 2; ++n)
#pragma unroll
                    for (int i = 0; i < 4; ++i) { const float g = acc[ai][0][m][n][i], up = acc[ai][1][m][n][i]; hv[4 * n + i] = g / (1.f + __expf(-g)) * up; }
                u32x4 w; w.x = cvt_pk_bf16(hv[0], hv[1]); w.y = cvt_pk_bf16(hv[2], hv[3]); w.z = cvt_pk_bf16(hv[4], hv[5]); w.w = cvt_pk_bf16(hv[6], hv[7]);
                *(u32x4*)(H + (size_t)(row0 + ai * HALF + m * 16) * 512 + col0) = w; }
    }
};
struct EpiDown {
    static constexpr bool PERM = true;
    bf16* YB; const int* TP; const float* WP;
    __device__ __forceinline__ bool reset_after(const pg8::Unit&) const { return true; }
    __device__ __forceinline__ void operator()(pg8::f32x4 (&acc)[2][2][4][2], const pg8::Unit& u, int wr, int wc, int fr, int fq) const {
        using namespace pg8;
        const int row0 = u.pm * BM + wr * 64 + fr, colb = (u.pn & 3) * BM + wc * 32 + 8 * fq;
#pragma unroll
        for (int ai = 0; ai < 2; ++ai)
#pragma unroll
            for (int m = 0; m < 4; ++m) { const int row = row0 + ai * HALF + m * 16; const int tpv = TP[row]; if (tpv < 0) continue; const float w_ = WP[row];
#pragma unroll
                for (int bj = 0; bj < 2; ++bj) { const f32x4 v0 = acc[ai][bj][m][0] * w_, v1 = acc[ai][bj][m][1] * w_;
                    u32x4 w; w.x = cvt_pk_bf16(v0[0], v0[1]); w.y = cvt_pk_bf16(v0[2], v0[3]); w.z = cvt_pk_bf16(v1[0], v1[1]); w.w = cvt_pk_bf16(v1[2], v1[3]);
                    *(u32x4*)(YB + (size_t)tpv * 1024 + colb + bj * HALF) = w; } }
    }
};
__device__ __forceinline__ void phase_ln2(Frame& F, int l) {
    LAS float* WSM = (LAS float*)(F.lds); LAS float* BSM = WSM + 16 * 1024;
    const bool more = (l + 1 < NL);
    if (more) load_small_w(F, l + 1, WSM, BSM);
    __syncthreads();
    const int gw = F.vcu * NWAVES + F.wave, NGW = F.G * NWAVES, lane = F.lane;
    const float* lg = F.ka->in[I_ln2_g] + (size_t)l * D; const float* lb = F.ka->in[I_ln2_b] + (size_t)l * D; const bf16* YB = (const bf16*)(F.ws + WS_YB);
    for (int m = gw; m < T; m += NGW) {
        GAS f32x4* xr = (GAS f32x4*)(F.out + (size_t)m * D) + lane; const GAS v2u* y0 = (const GAS v2u*)(YB + (size_t)(2 * m) * D) + lane; const GAS v2u* y1 = (const GAS v2u*)(YB + (size_t)(2 * m + 1) * D) + lane;
        f32x4 v[4]; float s = 0.f;
#pragma unroll
        for (int j = 0; j < 4; ++j) { const f32x4 x = xr[64 * j]; const v2u a = y0[64 * j], b = y1[64 * j];
            v[j].x = ALPHA * x.x + (bflo(a.x) + bflo(b.x)); v[j].y = ALPHA * x.y + (bfhi(a.x) + bfhi(b.x)); v[j].z = ALPHA * x.z + (bflo(a.y) + bflo(b.y)); v[j].w = ALPHA * x.w + (bfhi(a.y) + bfhi(b.y));
            s += (v[j].x + v[j].y) + (v[j].z + v[j].w); }
        const float mean = wave_sum(s) * (1.f / D); float s2 = 0.f;
#pragma unroll
        for (int j = 0; j < 4; ++j) { v[j] = v[j] - mean; s2 += (v[j].x * v[j].x + v[j].y * v[j].y) + (v[j].z * v[j].z + v[j].w * v[j].w); }
        const float rstd = 1.f / sqrtf(wave_sum(s2) * (1.f / D) + LN_EPS);
        GAS v2u* o8 = (GAS v2u*)((bf16*)(F.ws + WS_XB) + (size_t)m * D) + lane;
#pragma unroll
        for (int j = 0; j < 4; ++j) { const f32x4 g4 = *(const f32x4*)(lg + 256 * j + 4 * lane), b4 = *(const f32x4*)(lb + 256 * j + 4 * lane);
            v[j] = v[j] * rstd * g4 + b4; xr[64 * j] = v[j]; v2u o; o.x = pk2(v[j].x, v[j].y); o.y = pk2(v[j].z, v[j].w); o8[64 * j] = o; }
        if (more) small_gates_row(v, WSM, BSM, (float*)(F.ws + WS_SG) + (size_t)m * 16, lane);
    }
    __syncthreads();
    if (more) weight_prep(F, l + 1);
}

__device__ __forceinline__ void phase_attention(Frame& F) {
    const attn_body::AttnTensors AT{(const attn_body::bf16*)(F.ws + WS_AQKV), (const attn_body::bf16*)(F.ws + WS_AQKV) + 512, (const attn_body::bf16*)(F.ws + WS_AQKV) + 1024,
                                    (attn_body::bf16*)(F.ws + WS_YTALL) + (size_t)2 * T * 512, (const float*)(F.ws + WS_FTAB)};
    const int v = F.vcu, bh = v >> 2, s = v & 3;
    if (bh >= 64) return;
#pragma unroll 1
    for (int i = 0; i < 4; ++i) { const int qb = (i == 0) ? s : (i == 1) ? 7 - s : (i == 2) ? 8 + s : 15 - s;
        attn_body::attn_unit<8>(bh >> 3, bh & 7, qb, AT.Q, AT.K, AT.V, AT.O, AT.F, (char*)F.ldsg, F.tid); }
}

__global__ void __launch_bounds__(NWAVES * 64, 2) mega_fwd(Args args) {
    extern __shared__ __attribute__((aligned(16))) unsigned char lds[];
    Frame F;
    F.lds = (LAS unsigned char*)lds; F.ldsg = lds;
    const int wave_s = __builtin_amdgcn_readfirstlane((int)threadIdx.x >> 6);
    F.tid = wave_s * 64 + lane_id(); F.lane = F.tid & 63; F.wave = wave_s;
    const int G_s = gridDim.x, bx_s = blockIdx.x, vcu_s = (G_s % 8 == 0) ? (bx_s % 8) * (G_s / 8) + bx_s / 8 : bx_s;
    F.G = G_s; F.bx = bx_s; F.vcu = vcu_s;
    F.ws = args.ws; F.ctl = (gu32*)(args.ws + WS_CTL); F.out = args.out; F.ka = (KArgs)__builtin_amdgcn_kernarg_segment_ptr();
    volatile LAS unsigned* MISC = (volatile LAS unsigned*)(F.lds + MISC_OFF);
    for (int u = F.tid; u < (LDS_BYTES - LDSCTL_OFF) / 4; u += NWAVES * 64) ((LAS unsigned*)(F.lds + LDSCTL_OFF))[u] = 0u;
    __syncthreads();
    const int lo = args.ph_lo, hi = args.ph_hi;
    XcdBarrier bar; bar.bar = (unsigned*)(F.ctl + CW_BAR); bar.x = 0; bar.st = nullptr;
    if (hi - lo > 1) bar = xcd_barrier_post((unsigned*)(F.ctl + CW_BAR), MISC + 8, wave_s == 0 && lane_id() == 0);
#ifndef PH_MASK
#define PH_MASK 0x3fff
#endif
#define HAS(j) (((PH_MASK) >> (j)) & 1)
#define IN(k) (lo <= (k) && (k) < hi)
#define SEAM(k) do { if (IN(k) && IN((k) + 1)) { XcdBarrier b2_ = bar; asm volatile("" : "+s"(b2_.bar)); asm volatile("" : "+s"(b2_.x)); xcd_barrier(b2_, wave_s == 0 && lane_id() == 0); } } while (0)
#define FRESH() do { int t_ = wave_s * 64 + lane_id(); asm volatile("" : "+v"(t_)); F.tid = t_; F.lane = t_ & 63; F.wave = wave_s; \
        int g_ = G_s, b_ = bx_s, v_ = vcu_s; asm volatile("" : "+s"(g_), "+s"(b_), "+s"(v_)); F.G = g_; F.bx = b_; F.vcu = v_; \
        unsigned char* w_ = args.ws; asm volatile("" : "+s"(w_)); F.ws = w_; ws = w_; F.ctl = (gu32*)(w_ + WS_CTL); float* o_ = args.out; asm volatile("" : "+s"(o_)); F.out = o_; } while (0)
    unsigned char* ws = args.ws;
    if (HAS(13) && IN(0)) { FRESH(); phase_p0(F); SEAM(0); }
#pragma unroll 1
    for (int l = 0; l < NL; ++l) {
        const int pb = 1 + l * NPH_LAYER;
        if (HAS(0) && IN(pb + 0)) { FRESH();
            pg8::Gemm g{(const pg8::bf16_t*)(ws + WS_XB), (const pg8::bf16_t*)(ws + WS_WIN), 1024, 1024, 1024}; pg8::StaticOrder S; S.init(T, NIN, F.G, F.bx);
            EpiInProj E{ws, F.ka->in[I_b_in] + (size_t)l * INTOT};
            pg8::gemm_phase<EpiInProj, pg8::StaticOrder, true>(F.lds + RING_OFF, g, S, E, F.tid);
            SEAM(pb + 0);
        }
        if (HAS(1) && IN(pb + 1)) { FRESH(); phase_prep2(F, l); SEAM(pb + 1); }
        if (HAS(2) && IN(pb + 2)) { FRESH();
#ifndef P2_NO_A
#pragma unroll 1
            for (int i = 0; i < 8; ++i) mlstm_pass1(F, F.vcu * 8 + i);
#endif
#ifndef P2_NO_B
            { pg8::Gemm g{(const pg8::bf16_t*)(ws + WS_S5A), (const pg8::bf16_t*)(ws + WS_S5ALL + (size_t)l * S5_LAYER_BYTES + 20 * MiB), 512, S5K, 512}; SchedS5E S{F.vcu}; EpiS5E E{(float*)(ws + WS_EBUF)};
              pg8::gemm_phase<EpiS5E, SchedS5E, true>(F.lds + RING_OFF, g, S, E, F.tid); }
            __syncthreads();
#endif
#ifndef P2_NO_C
            phase_attention(F);
#endif
            SEAM(pb + 2);
        }
        if (HAS(3) && IN(pb + 3)) { FRESH(); phase_scans(F, l); SEAM(pb + 3); }
        if (HAS(4) && IN(pb + 4)) { FRESH();
#pragma unroll 1
            for (int i = 0; i < 8; ++i) mlstm_pass3(F, l, F.vcu * 8 + i);
            { pg8::Gemm g{(const pg8::bf16_t*)(ws + WS_S5A), (const pg8::bf16_t*)(ws + WS_S5ALL + (size_t)l * S5_LAYER_BYTES), S5K, S5K, S5K}; SchedS5Y S{F.vcu}; EpiS5Y E{(bf16*)(ws + WS_YS1)};
              pg8::gemm_phase<EpiS5Y, SchedS5Y, true>(F.lds + RING_OFF, g, S, E, F.tid); }
            SEAM(pb + 4);
        }
        if (HAS(5) && IN(pb + 5)) { FRESH();
            pg8::Gemm g{(const pg8::bf16_t*)(ws + WS_YS1), (const pg8::bf16_t*)(ws + WS_WGLU), 512, 512, 512}; pg8::StaticOrder S; S.init(T, 512, F.G, F.bx);
            EpiGlu E{(const bf16*)(ws + WS_YS1), (bf16*)(ws + WS_YTALL) + (size_t)T * 512, F.ka->in[I_s5_b_glu] + (size_t)l * 512};
            pg8::gemm_phase<EpiGlu, pg8::StaticOrder, true>(F.lds + RING_OFF, g, S, E, F.tid);
            SEAM(pb + 5);
        }
        if (HAS(6) && IN(pb + 6)) { FRESH();
            pg8::Gemm g{(const pg8::bf16_t*)(ws + WS_YTALL), (const pg8::bf16_t*)(ws + WS_WBR), 512, 512, 512}; SchedMerge S{F.vcu, F.G};
            EpiMerge E{(const bf16*)(ws + WS_GATE), (bf16*)(ws + WS_MIXED)};
            pg8::gemm_phase<EpiMerge, SchedMerge, true>(F.lds + RING_OFF, g, S, E, F.tid);
            SEAM(pb + 6);
        }
        if (HAS(7) && IN(pb + 7)) { FRESH();
            pg8::Gemm g{(const pg8::bf16_t*)(ws + WS_MIXED), (const pg8::bf16_t*)(ws + WS_WOUT), 1024, 1024, 1024}; pg8::StaticOrder S; S.init(T, 1024, F.G, F.bx);
            EpiOutProj E{l == 0 ? F.ka->in[I_x] : (const float*)F.out, F.out};
            pg8::gemm_phase<EpiOutProj, pg8::StaticOrder, true>(F.lds + RING_OFF, g, S, E, F.tid);
            SEAM(pb + 7);
        }
        if (HAS(8) && IN(pb + 8)) { FRESH(); phase_ln1_route(F, l); SEAM(pb + 8); }
        if (HAS(9) && IN(pb + 9)) { FRESH(); phase_dispatch(F, l); SEAM(pb + 9); }
        if (HAS(10) && IN(pb + 10)) { FRESH();
            moe_tables(F, l);
            pg8::Gemm g{(const pg8::bf16_t*)(ws + WS_XG), (const pg8::bf16_t*)(ws + WS_WGU), 1024, 1024, 1024}; SchedMoe S{(const LAS int*)(F.lds + LDSX_OFF + 20480), F.vcu, F.G};
            EpiGateUp E{(bf16*)(ws + WS_HB)};
            pg8::gemm_phase<EpiGateUp, SchedMoe, true>(F.lds + RING_OFF, g, S, E, F.tid);
            SEAM(pb + 10);
        }
        if (HAS(11) && IN(pb + 11)) { FRESH();
            moe_tables(F, l);
            pg8::Gemm g{(const pg8::bf16_t*)(ws + WS_HB), (const pg8::bf16_t*)(ws + WS_WDN), 512, 512, 512}; SchedMoe S{(const LAS int*)(F.lds + LDSX_OFF + 20480), F.vcu, F.G};
            EpiDown E{(bf16*)(ws + WS_YB), (const int*)(ws + WS_TOKPOS), (const float*)(ws + WS_TOKPOS + 524288)};
            pg8::gemm_phase<EpiDown, SchedMoe, true>(F.lds + RING_OFF, g, S, E, F.tid);
            SEAM(pb + 11);
        }
        if (HAS(12) && IN(pb + 12)) { FRESH(); phase_ln2(F, l); SEAM(pb + 12); }
    }
#undef IN
#undef SEAM
}

extern "C" void kernel_launch(void* const* d_in, const int* in_sizes, int n_in, void* d_out, int out_size, void* d_ws, size_t ws_size, hipStream_t stream) {
    static int grid = 0;
    if (grid == 0) {
        if (n_in != 29 || in_sizes[0] != T * D || out_size != T * D || ws_size < WS_END) { fprintf(stderr, "kernel_launch: unexpected shapes / workspace (n_in %d, ws %zu < %zu)\n", n_in, ws_size, (size_t)WS_END); grid = -1; return; }
        int dev = 0, cus = 0;
        if (hipGetDevice(&dev) != hipSuccess || hipDeviceGetAttribute(&cus, hipDeviceAttributeMultiprocessorCount, dev) != hipSuccess) { grid = -1; return; }
        if (hipFuncSetAttribute((const void*)mega_fwd, hipFuncAttributeMaxDynamicSharedMemorySize, LDS_BYTES) != hipSuccess) { fprintf(stderr, "kernel_launch: hipFuncSetAttribute failed\n"); grid = -1; return; }
        int per_cu = 0;
        (void)hipOccupancyMaxActiveBlocksPerMultiprocessor(&per_cu, (const void*)mega_fwd, NWAVES * 64, LDS_BYTES);
        (void)hipGetLastError();
        if (cus != 256 || per_cu < 1) { fprintf(stderr, "kernel_launch: needs 256 CUs with one resident workgroup each (cus %d, per_cu %d)\n", cus, per_cu); grid = -1; return; }
        grid = cus;
    }
    if (grid < 0) return;
    (void)hipMemsetAsync((char*)d_ws + WS_CTL, 0, CTL_ZERO_BYTES, stream);
    Args a{};
    for (int i = 0; i < 29; ++i) a.in[i] = (const float*)d_in[i];
    a.out = (float*)d_out; a.ws = (unsigned char*)d_ws;
#if MK_ONE_LAUNCH
    a.ph_lo = 0; a.ph_hi = NPHASES;
    hipLaunchKernelGGL(mega_fwd, dim3(grid), dim3(NWAVES * 64), LDS_BYTES, stream, a);
#else
    for (int p = 0; p < NPHASES; ++p) { a.ph_lo = p; a.ph_hi = p + 1; hipLaunchKernelGGL(mega_fwd, dim3(grid), dim3(NWAVES * 64), LDS_BYTES, stream, a); }
#endif
}
```

```cpp
#include <hip/hip_runtime.h>
#include <hip/hip_bf16.h>
#include <cstdio>
#include <cstdint>
#include <cmath>

#ifndef MK_ONE_LAUNCH
#define MK_ONE_LAUNCH 1
#endif

namespace pg8 {
#define PG8_LAS __attribute__((address_space(3)))
typedef unsigned short bf16_t;
typedef short bf16x8 __attribute__((ext_vector_type(8)));
typedef float f32x4 __attribute__((ext_vector_type(4)));
typedef float f32x2 __attribute__((ext_vector_type(2)));
typedef unsigned u32x4 __attribute__((ext_vector_type(4)));
typedef unsigned u32x2 __attribute__((ext_vector_type(2)));
constexpr int BM = 256, BK = 64, HALF = 128, HTB = HALF * BK * 2  , STAGE_BYTES = 8 * HTB, NXCD = 8, WGM = 8;

__host__ __device__ __forceinline__ int lds_byte(int r, int c) { const int st = (r >> 4) * 2 + (c >> 5), rr = r & 15, cc = c & 31, ob = rr * 64 + cc * 2; return st * 1024 + (ob ^ (((ob >> 9) & 1) << 5)); }
__host__ __device__ __forceinline__ void stage_rc(int b, int& R, int& C) { const int st = b / 1024, sb = b % 1024, swz = sb ^ (((sb >> 9) & 1) << 5); R = (st >> 1) * 16 + swz / 64; C = (st & 1) * 32 + (swz % 64) / 2; }
__host__ __device__ __forceinline__ int perm32(int rho) { const int n = rho >> 4, i = rho & 15; return 8 * (i >> 2) + 4 * n + (i & 3); }

struct Unit { int pm, pn; };
struct Gemm { const bf16_t* A; const bf16_t* Bt; int K, lda, ldb; };

struct StaticOrder {
    int nM, nN, nwg, G, c;
    __host__ __device__ void init(int M, int N, int G_, int c_) { nM = M / BM; nN = N / BM; nwg = nM * nN; G = G_; c = c_; }
    __host__ __device__ bool next(int i, Unit& u) const {
        const long L = (long)i * G + c; if (L >= nwg) return false;
        int wgid = (int)L; { const int q = nwg / NXCD, r = nwg % NXCD, xcd = wgid % NXCD, off = wgid / NXCD; wgid = (xcd < r ? xcd * (q + 1) : r * (q + 1) + (xcd - r) * q) + off; }
        const int nig = WGM * nN, gid = wgid / nig, fm = gid * WGM, gsz = (nM - fm) < WGM ? (nM - fm) : WGM;
        u.pm = fm + ((wgid % nig) % gsz); u.pn = (wgid % nig) / gsz; return true;
    }
};

__device__ __forceinline__ unsigned cvt_pk_bf16(float lo, float hi) { unsigned r; asm volatile("v_cvt_pk_bf16_f32 %0, %1, %2" : "=v"(r) : "v"(lo), "v"(hi)); return r; }

template <class Epi, class Sched, bool ALIGN_EPI = true>
__device__ __forceinline__ void gemm_phase(PG8_LAS unsigned char* lds, const Gemm g, const Sched& S, const Epi& E, const int tid  ) {
    const int wid = __builtin_amdgcn_readfirstlane(tid >> 6), lane = tid & 63, wr = wid >> 2, wc = wid & 3, fr = lane & 15, fq = lane >> 4;
    const int K = g.K, nt = K / BK;
    unsigned voffA[2], voffB[2];
#pragma unroll
    for (int i = 0; i < 2; ++i) { int R, C; stage_rc(tid * 16 + i * 8192, R, C); const int Rb = Epi::PERM ? ((R & ~31) + perm32(R & 31)) : R;
        voffA[i] = (unsigned)(R * g.lda + C) * 2u; voffB[i] = (unsigned)(Rb * g.ldb + C) * 2u; }
    const size_t kstep = (size_t)(BK * 2);
    const size_t hstepA = (size_t)HALF * g.lda * 2, hstepB = (size_t)HALF * g.ldb * 2;
    const size_t tstepA = 2 * hstepA, tstepB = 2 * hstepB;
    const unsigned ldsw = (unsigned)wid * 1024u;
    const int aoff = lds_byte(wr * 64 + fr, fq * 8), boff = lds_byte(wc * 32 + fr, fq * 8);
#define PG8_SA(b, h) (((b) * 2 + (h)) * HTB)
#define PG8_SB(b, h) ((4 + (b) * 2 + (h)) * HTB)
#define PG8_STAGE(bufoff, gbase, voff) do { _Pragma("unroll") for (int _i = 0; _i < 2; ++_i) \
        __builtin_amdgcn_global_load_lds((const unsigned*)((const char*)(gbase) + (voff)[_i]), (PG8_LAS unsigned*)(lds + (bufoff) + ldsw + _i * 8192), 16, 0, 0); } while (0)
#define PG8_LDA(dst, b, h) do { _Pragma("unroll") for (int m = 0; m < 4; ++m) _Pragma("unroll") for (int k = 0; k < 2; ++k) dst[m][k] = *(const PG8_LAS bf16x8*)(lds + PG8_SA(b, h) + aoff + m * 2048 + k * 1024); } while (0)
#define PG8_LDB(dst, b, h) do { _Pragma("unroll") for (int n = 0; n < 2; ++n) _Pragma("unroll") for (int k = 0; k < 2; ++k) dst[n][k] = *(const PG8_LAS bf16x8*)(lds + PG8_SB(b, h) + boff + n * 2048 + k * 1024); } while (0)
#define PG8_MMA(ai, bj, At, Bt) do { __builtin_amdgcn_s_setprio(1); _Pragma("unroll") for (int m = 0; m < 4; ++m) _Pragma("unroll") for (int n = 0; n < 2; ++n) _Pragma("unroll") for (int k = 0; k < 2; ++k) \
        acc[ai][bj][m][n] = __builtin_amdgcn_mfma_f32_16x16x32_bf16(Bt[n][k], At[m][k], acc[ai][bj][m][n], 0, 0, 0); __builtin_amdgcn_s_setprio(0); } while (0)
#define PG8_WAIT_V(n) asm volatile("s_waitcnt vmcnt(" #n ")" ::: "memory")
#define PG8_WAIT_L(n) asm volatile("s_waitcnt lgkmcnt(" #n ")" ::: "memory")
#define PG8_BAR __builtin_amdgcn_s_barrier()
#define PG8_SCHED __builtin_amdgcn_sched_barrier(0)
    Unit cur, nxt; int ui = 0;
    if (!S.next(0, cur)) return;
    f32x4 acc[2][2][4][2];
    float zf = 0.f; asm volatile("" : "+v"(zf));
#pragma unroll
    for (int a = 0; a < 2; ++a)
#pragma unroll
        for (int b = 0; b < 2; ++b)
#pragma unroll
            for (int m = 0; m < 4; ++m)
#pragma unroll
                for (int n = 0; n < 2; ++n) acc[a][b][m][n] = (f32x4){zf, zf, zf, zf};
    bf16x8 At[4][2], B0[2][2], B1[2][2];
    const char* cA = (const char*)g.A + (size_t)cur.pm * tstepA; const char* cB = (const char*)g.Bt + (size_t)cur.pn * tstepB;
    PG8_STAGE(PG8_SB(0, 0), cB, voffB); PG8_STAGE(PG8_SB(0, 1), cB + hstepB, voffB); PG8_STAGE(PG8_SA(0, 0), cA, voffA); PG8_STAGE(PG8_SA(0, 1), cA + hstepA, voffA);
    if (wr == 1) PG8_BAR;
    PG8_WAIT_V(2); PG8_BAR;
    PG8_STAGE(PG8_SB(1, 0), cB + kstep, voffB); PG8_STAGE(PG8_SA(1, 0), cA + kstep, voffA); PG8_STAGE(PG8_SB(1, 1), cB + hstepB + kstep, voffB);
    PG8_WAIT_V(6); PG8_BAR;
    for (;;) {
        const bool has_next = S.next(ui + 1, nxt);
        const char* nA = has_next ? (const char*)g.A + (size_t)nxt.pm * tstepA : cA; const char* nB = has_next ? (const char*)g.Bt + (size_t)nxt.pn * tstepB : cB;
        for (int t = 0; t < nt; t += 2) {
            const bool last = (t == nt - 2);
            const char* a1 = cA + (size_t)(t + 1) * kstep;
            const char* a2 = last ? nA : cA + (size_t)(t + 2) * kstep; const char* b2 = last ? nB : cB + (size_t)(t + 2) * kstep;
            const char* a3 = a2 + kstep; const char* b3 = b2 + kstep;
            PG8_LDB(B0, 0, 0); PG8_LDB(B1, 0, 1); PG8_SCHED; PG8_LDA(At, 0, 0); PG8_STAGE(PG8_SA(1, 1), a1 + hstepA, voffA);
            PG8_WAIT_V(8); PG8_WAIT_L(0); PG8_BAR; PG8_MMA(0, 0, At, B0); PG8_MMA(0, 1, At, B1); PG8_BAR; PG8_SCHED;
            PG8_LDA(At, 0, 1); PG8_STAGE(PG8_SB(0, 0), b2, voffB); PG8_STAGE(PG8_SB(0, 1), b2 + hstepB, voffB); PG8_STAGE(PG8_SA(0, 0), a2, voffA);
            PG8_WAIT_V(8); PG8_WAIT_L(0); PG8_BAR; PG8_MMA(1, 0, At, B0); PG8_MMA(1, 1, At, B1); PG8_BAR; PG8_SCHED;
            PG8_LDB(B0, 1, 0); PG8_LDB(B1, 1, 1); PG8_SCHED; PG8_LDA(At, 1, 0); PG8_STAGE(PG8_SA(0, 1), a2 + hstepA, voffA);
            PG8_WAIT_V(8); PG8_WAIT_L(0); PG8_BAR; PG8_MMA(0, 0, At, B0); PG8_MMA(0, 1, At, B1); PG8_BAR; PG8_SCHED;
            PG8_LDA(At, 1, 1); PG8_STAGE(PG8_SB(1, 0), b3, voffB); PG8_STAGE(PG8_SB(1, 1), b3 + hstepB, voffB); PG8_STAGE(PG8_SA(1, 0), a3, voffA);
            PG8_WAIT_V(8); PG8_WAIT_L(0); PG8_BAR; PG8_MMA(1, 0, At, B0); PG8_MMA(1, 1, At, B1); PG8_BAR; PG8_SCHED;
        }
        if constexpr (ALIGN_EPI) { if (wr == 0) PG8_BAR; }
        E(acc, cur, wr, wc, fr, fq);
        if (!has_next) break;
        if (E.reset_after(cur)) {
#pragma unroll
        for (int a = 0; a < 2; ++a)
#pragma unroll
            for (int b = 0; b < 2; ++b)
#pragma unroll
                for (int m = 0; m < 4; ++m)
#pragma unroll
                    for (int n = 0; n < 2; ++n) acc[a][b][m][n] = (f32x4){zf, zf, zf, zf};
        }
        cur = nxt; cA = nA; cB = nB; ++ui;
        if constexpr (ALIGN_EPI) { if (wr == 1) PG8_BAR; }
    }
    PG8_WAIT_V(0);
    if constexpr (!ALIGN_EPI) { if (wr == 0) PG8_BAR; }
    PG8_BAR;
#undef PG8_SA
#undef PG8_SB
#undef PG8_STAGE
#undef PG8_LDA
#undef PG8_LDB
#undef PG8_MMA
#undef PG8_WAIT_V
#undef PG8_WAIT_L
#undef PG8_BAR
#undef PG8_SCHED
}
}

#include <hip/hip_bf16.h>
#include <cmath>
namespace attn_body {
using bf16=__hip_bfloat16;
using bf16x8=__attribute__((ext_vector_type(8)))short;
using s16x4=__attribute__((ext_vector_type(4)))short;
using f32x16=__attribute__((ext_vector_type(16)))float;
using u32x4=__attribute__((ext_vector_type(4)))unsigned;
using f32x4v=__attribute__((ext_vector_type(4)))float;
constexpr int BATCH=8,NHEAD=8,SEQ=4096,D=64,DM=1536,DMO=512;
constexpr int NW=8,QBLK=32,QB=QBLK*NW,KVBLK=64,NQB=SEQ/QB;
constexpr int ATTN_PITCH=DM, ATTN_UNIT_ROWS=QB;
__device__ __forceinline__ int crow(int r,int hi){return (r&3)+8*(r>>2)+4*hi;}
#define SBAR() __builtin_amdgcn_sched_barrier(0)
__device__ __forceinline__ void cmask(f32x16&p0,f32x16&p1,int jb,int qrel,int hi){
  const float NEG=-INFINITY; int kb=64*jb+4*hi;
  #pragma unroll
  for(int r=0;r<16;++r){int kv=kb+(r&3)+8*(r>>2); if(kv>qrel)p0[r]=NEG; if(kv+32>qrel)p1[r]=NEG;}
}

constexpr int NSLOT=3, SLOTB=8192;
constexpr int LDS_K=0, LDS_V=NSLOT*SLOTB, LDS_WS=2*NSLOT*SLOTB, LDS_OST=LDS_WS+NW*64*4, LDS_F=LDS_OST+NW*4096, LDS_Q=LDS_F+SEQ*4, LDS_BYTES=LDS_Q+NW*4096;
constexpr float C2=0.125f*1.4426950408889634f;
__device__ __forceinline__ void glds16(const void*gsrc,unsigned lds_dst){unsigned keep;
  asm volatile("s_mov_b32 %0, m0\n\ts_mov_b32 m0, %2\n\ts_nop 0\n\tglobal_load_lds_dwordx4 %1, off\n\ts_mov_b32 m0, %0":"=&s"(keep):"v"(gsrc),"s"(lds_dst):"memory");}
__device__ __forceinline__ void glds16s(const void*sbase,unsigned voff,unsigned lds_dst){unsigned keep;
  asm volatile("s_mov_b32 %0, m0\n\ts_mov_b32 m0, %3\n\ts_nop 0\n\tglobal_load_lds_dwordx4 %1, %2\n\ts_mov_b32 m0, %0":"=&s"(keep):"v"(voff),"s"(sbase),"s"(lds_dst):"memory");}
__device__ __forceinline__ float max3f(float a,float b,float c){float r;asm("v_max3_f32 %0, %1, %2, %3":"=v"(r):"v"(a),"v"(b),"v"(c));return r;}
__device__ __forceinline__ float max2f(float a,float b){float r;asm("v_max_f32_e32 %0, %1, %2":"=v"(r):"v"(a),"v"(b));return r;}
__device__ __forceinline__ float fadd_s(float a,float b){float r;asm("v_add_f32_e32 %0, %1, %2":"=v"(r):"v"(a),"v"(b));return r;}
__device__ __forceinline__ float fsub_s(float a,float b){float r;asm("v_sub_f32_e32 %0, %1, %2":"=v"(r):"v"(a),"v"(b));return r;}
typedef float f32x2_t __attribute__((ext_vector_type(2))); typedef __bf16 bf16x2_t __attribute__((ext_vector_type(2)));
__device__ __forceinline__ unsigned cvtpk_s(float lo,float hi){f32x2_t v={lo,hi};bf16x2_t b=__builtin_convertvector(v,bf16x2_t);return __builtin_bit_cast(unsigned,b);}
#define WAIT_BAR(N) asm volatile("s_waitcnt vmcnt(" #N ") lgkmcnt(0)\n\ts_barrier":::"memory")

__device__ __forceinline__ void qkt(f32x16&p0,f32x16&p1,const char*Kslot,const bf16x8*qr,int r32,int hi){
  const char*kb=Kslot+hi*1024+r32*16;
  #pragma unroll
  for(int d0=0;d0<4;++d0){
    const bf16x8 b0=*reinterpret_cast<const bf16x8*>(kb+d0*2048);
    const bf16x8 b1=*reinterpret_cast<const bf16x8*>(kb+d0*2048+512);
    {p0=__builtin_amdgcn_mfma_f32_32x32x16_bf16(b0,qr[d0],p0,0,0,0);p1=__builtin_amdgcn_mfma_f32_32x32x16_bf16(b1,qr[d0],p1,0,0,0);}}
}
typedef __attribute__((address_space(3))) const char* lds_cptr;
typedef short v4i16_t __attribute__((ext_vector_type(4)));
__device__ __forceinline__ void kload8(bf16x8*kf,lds_cptr kp){
  kf[0]=*(const __attribute__((address_space(3))) bf16x8*)(kp);      kf[1]=*(const __attribute__((address_space(3))) bf16x8*)(kp+512);
  kf[2]=*(const __attribute__((address_space(3))) bf16x8*)(kp+2048); kf[3]=*(const __attribute__((address_space(3))) bf16x8*)(kp+2560);
  kf[4]=*(const __attribute__((address_space(3))) bf16x8*)(kp+4096); kf[5]=*(const __attribute__((address_space(3))) bf16x8*)(kp+4608);
  kf[6]=*(const __attribute__((address_space(3))) bf16x8*)(kp+6144); kf[7]=*(const __attribute__((address_space(3))) bf16x8*)(kp+6656);
}
__device__ __forceinline__ void kload2(bf16x8*kf,lds_cptr kp,int j){ kf[2*j]=*(const __attribute__((address_space(3))) bf16x8*)(kp+j*2048); kf[2*j+1]=*(const __attribute__((address_space(3))) bf16x8*)(kp+j*2048+512); }
__device__ __forceinline__ s16x4 vtr(lds_cptr p){ return __builtin_bit_cast(s16x4,__builtin_amdgcn_ds_read_tr16_b64_v4i16((__attribute__((address_space(3))) v4i16_t*)p)); }
__device__ __forceinline__ float rowmax(const f32x16&p0,const f32x16&p1){
  float a=max3f(p0[0],p0[1],p1[0]),b=max3f(p0[2],p0[3],p1[1]);a=max3f(a,p1[2],p1[3]);
  #pragma unroll
  for(int r=4;r<16;r+=4){a=max3f(a,p0[r],p0[r+1]);b=max3f(b,p0[r+2],p0[r+3]);a=max3f(a,p1[r],p1[r+1]);b=max3f(b,p1[r+2],p1[r+3]);}
  const float m=max2f(a,b);
  auto rr=__builtin_amdgcn_permlane32_swap(__float_as_uint(m),__float_as_uint(m),false,false);
  return max2f(__uint_as_float(rr[0]),__uint_as_float(rr[1]));
}
__device__ __forceinline__ void pv(f32x16*o,int vb,bf16x8 pa0,bf16x8 pa1,bf16x8 pa2,bf16x8 pa3){
  #pragma unroll
  for(int d0=0;d0<2;++d0){s16x4 lo[4],hi[4];
    #pragma unroll
    for(int ks=0;ks<4;++ks){
      asm volatile("ds_read_b64_tr_b16 %0,%1 offset:%c2":"=&v"(lo[ks]):"v"(vb),"i"(d0*4096+ks*1024):"memory");
      asm volatile("ds_read_b64_tr_b16 %0,%1 offset:%c2":"=&v"(hi[ks]):"v"(vb),"i"(d0*4096+ks*1024+512):"memory");}
    asm volatile("s_waitcnt lgkmcnt(0)":::"memory");SBAR();
    #define PK(k) (bf16x8){lo[k][0],lo[k][1],lo[k][2],lo[k][3],hi[k][0],hi[k][1],hi[k][2],hi[k][3]}
    o[d0]=__builtin_amdgcn_mfma_f32_32x32x16_bf16(pa0,PK(0),o[d0],0,0,0);
    o[d0]=__builtin_amdgcn_mfma_f32_32x32x16_bf16(pa1,PK(1),o[d0],0,0,0);
    o[d0]=__builtin_amdgcn_mfma_f32_32x32x16_bf16(pa2,PK(2),o[d0],0,0,0);
    o[d0]=__builtin_amdgcn_mfma_f32_32x32x16_bf16(pa3,PK(3),o[d0],0,0,0);
    #undef PK
  }
}

#ifndef ATTN_STORE16
#define ATTN_STORE16(p,v) (*(u32x4*)(p)=(v))
#endif
template<int THRL> __device__ __forceinline__ void attn_unit(int b,int h,int qb,const bf16*Q,const bf16*__restrict__ K,const bf16*__restrict__ V,bf16*O,const float*__restrict__ Ftab,char*shm,const int tid){
  const int lane=tid&63,r32=lane&31,hi=lane>>5; const int wid=__builtin_amdgcn_readfirstlane(tid>>6);
  const long rowbase=(long)b*SEQ; const int q0=qb*QB;
  const bf16*Qw=Q+(rowbase+q0+wid*QBLK)*DM+h*D;
  const bf16*Kh=K+rowbase*DM+h*D,*Vh=V+rowbase*DM+h*D;
  const unsigned lds0=(unsigned)(uintptr_t)shm;
  float*wsf=(float*)(shm+LDS_WS)+wid*64;
  const unsigned koff=(unsigned)(lane*DM+wid*8)*2u;
  const unsigned voff=(unsigned)((16*(wid&3)+(lane>>2))*DM+(wid>>2)*32+(lane&3)*8)*2u;
  const unsigned kdst=lds0+LDS_K+wid*1024, vdst=lds0+LDS_V+wid*1024;
  #define DMA_K(t,slot) glds16s(Kh+(long)(t)*KVBLK*DM,koff,(unsigned)__builtin_amdgcn_readfirstlane(kdst+(slot)))
  #define DMA_V(t,slot) glds16s(Vh+(long)(t)*KVBLK*DM,voff,(unsigned)__builtin_amdgcn_readfirstlane(vdst+(slot)))
  const int vb0=(int)(lds0+LDS_V)+((lane>>4)&1)*32+(lane&3)*8+(4*hi+((lane&15)>>2))*64;
  const char*Kbase=shm+LDS_K; bf16x8 kf[8];
  const lds_cptr shm3=(lds_cptr)shm; const lds_cptr kp0=shm3+LDS_K+hi*1024+r32*16; const lds_cptr vp0=shm3+LDS_V+((lane>>4)&1)*32+(lane&3)*8+(4*hi+((lane&15)>>2))*64;
  const int NT=(q0+QB)/KVBLK;
  const float*Fh=Ftab+(long)(b*NHEAD+h)*SEQ;
  { glds16s(Fh,(unsigned)(lane*16+wid*1024),(unsigned)__builtin_amdgcn_readfirstlane(lds0+LDS_F+wid*1024));
    glds16s(Fh,(unsigned)(lane*16+(wid+8)*1024),(unsigned)__builtin_amdgcn_readfirstlane(lds0+LDS_F+(wid+8)*1024)); }
  const float fq2=Fh[q0+wid*QBLK+r32];
  DMA_K(0,0);DMA_V(0,0);DMA_K(1,SLOTB);
  const lds_cptr qs=(lds_cptr)shm+LDS_Q+wid*4096+(hi*32+r32)*16;
  #pragma unroll
  for(int d0=0;d0<4;++d0)*(__attribute__((address_space(3))) bf16x8*)(qs+d0*1024)=*reinterpret_cast<const bf16x8*>(&Qw[(long)r32*DM+d0*16+hi*8]);
  #define QF(k) (*(const __attribute__((address_space(3))) bf16x8*)(qs+(k)*1024))
  float mhat=-fq2,nm=fq2,l_reg=0.f;f32x16 o[2];o[0]=f32x16{};o[1]=f32x16{};
  const lds_cptr fl0=(lds_cptr)shm+LDS_F+hi*16;
  #define FINIT1(C0,t,o_) do{ const __attribute__((address_space(3))) f32x4v* fp_=(const __attribute__((address_space(3))) f32x4v*)(fl0+(t)*256+(o_)); \
    _Pragma("unroll") for(int j_=0;j_<4;++j_){ const f32x4v a_=fp_[2*j_]; \
      C0[4*j_]=nm-a_[0]; C0[4*j_+1]=nm-a_[1]; C0[4*j_+2]=nm-a_[2]; C0[4*j_+3]=nm-a_[3]; } }while(0)
  #define FINIT(C0,C1,t) do{ FINIT1(C0,t,0); FINIT1(C1,t,128); }while(0)
  const int qrel=wid*QBLK+r32;
  #define CMASK(P0,P1,t) do{int jb_=(t)-(NT-4); if(jb_>=0)cmask(P0,P1,jb_,qrel,hi);}while(0)
  bool resc=false;
  #define START(P0,P1) do{ const float rm=rowmax(P0,P1); resc=false; \
    { const float dl=rm; mhat=fadd_s(mhat,dl); \
      _Pragma("unroll") for(int r=0;r<16;++r){P0[r]=fsub_s(P0[r],dl);P1[r]=fsub_s(P1[r],dl);} \
      nm=-mhat; } \
    _Pragma("unroll") for(int r=0;r<16;++r)P0[r]=__builtin_amdgcn_exp2f(P0[r]); }while(0)
  #define RESC() do{ if(resc){ asm volatile("s_waitcnt lgkmcnt(0)":::"memory"); \
      _Pragma("unroll") for(int d_=0;d_<2;++d_) _Pragma("unroll") for(int r=0;r<16;++r)o[d_][r]*=wsf[crow(r,hi)]; } }while(0)
  f32x16 pA0,pA1,pB0,pB1;
  int sl_prev=0,sl_cur=0,sl_next=SLOTB;
  #define ROT() do{sl_prev=sl_cur;sl_cur=sl_next;sl_next=(sl_next==(NSLOT-1)*SLOTB)?0:sl_next+SLOTB;}while(0)
  DMA_K(2,2*SLOTB);
  WAIT_BAR(3);
  { bf16x8 qr[4]; qr[0]=QF(0);qr[1]=QF(1);qr[2]=QF(2);qr[3]=QF(3); FINIT(pA0,pA1,0); qkt(pA0,pA1,Kbase,qr,r32,hi); }asm volatile("s_nop 15\n\ts_nop 7":"+v"(pA0),"+v"(pA1));CMASK(pA0,pA1,0);
  START(pA0,pA1);
  _Pragma("unroll") for(int r=0;r<16;++r)pA1[r]=__builtin_amdgcn_exp2f(pA1[r]);
  WAIT_BAR(0);
  DMA_K(3,0);DMA_V(1,SLOTB);
  ROT();
  kload8(kf,kp0+sl_cur);
  WAIT_BAR(2);
  s16x4 vlo[8],vhi[8]; u32x4 pw0,pw1,pw2,pw3;
  #define PKW(P,B) cvtpk_s(P[B],P[B+1])
  #define PAF(k) __builtin_bit_cast(bf16x8,pw##k)
  #define VFR(i) (bf16x8){vlo[i][0],vlo[i][1],vlo[i][2],vlo[i][3],vhi[i][0],vhi[i][1],vhi[i][2],vhi[i][3]}
  #define PIN(x) asm volatile("":"+v"(x))
  #define MX3(a,b,c) __builtin_fmaxf(__builtin_fmaxf((a),(b)),(c))
  #define GAPA(MF,A0,A1,A2,A3,W0,W1,PW) do{ MF; sacc+=A0; sacc+=A1; sacc+=A2; sacc+=A3; PIN(sacc); W0; W1; PIN(PW); SBAR(); }while(0)
  #define EX(v) __builtin_amdgcn_exp2f(v)
  #define GAPB(MF,X,B) do{ MF; X[B]=EX(X[B]); X[B+1]=EX(X[B+1]); X[B+2]=EX(X[B+2]); X[B+3]=EX(X[B+3]); PIN(X); SBAR(); }while(0)
  #define VRD(i) do{ vlo[i]=vtr(vp_+(((i)>>2)*4096+((i)&3)*1024)); vhi[i]=vtr(vp_+(((i)>>2)*4096+((i)&3)*1024+512)); }while(0)
  #define KRD(G,j) do{ if(G){ kload2(kf,kp0+sl_next,j); SBAR(); } }while(0)
  #define STEP(C0,C1,P0,P1,t,GK,GV,GL) do{ SBAR(); FINIT1(C0,t,0); bf16x8 qA_=QF(0),qB_=QF(1); SBAR(); \
    const lds_cptr vp_=vp0+sl_prev; \
    VRD(0); SBAR(); float sacc=(P0[0]+P0[1]); \
    GAPA(C0=__builtin_amdgcn_mfma_f32_32x32x16_bf16(kf[0],qA_,C0,0,0,0), P0[2],P0[3],P0[4],P0[5],     pw0[0]=PKW(P0,0), pw0[1]=PKW(P0,2), pw0); \
    FINIT1(C1,t,128); SBAR(); VRD(4); SBAR(); GAPA(C1=__builtin_amdgcn_mfma_f32_32x32x16_bf16(kf[1],qA_,C1,0,0,0), P0[6],P0[7],P0[8],P0[9],     pw0[2]=PKW(P0,4), pw0[3]=PKW(P0,6), pw0); \
    qA_=QF(2); VRD(1); SBAR(); GAPA(C0=__builtin_amdgcn_mfma_f32_32x32x16_bf16(kf[2],qB_,C0,0,0,0),   P0[10],P0[11],P0[12],P0[13], pw1[0]=PKW(P0,8), pw1[1]=PKW(P0,10), pw1); \
    VRD(5); SBAR(); GAPA(C1=__builtin_amdgcn_mfma_f32_32x32x16_bf16(kf[3],qB_,C1,0,0,0),   P0[14],P0[15],P1[0],P1[1],   pw1[2]=PKW(P0,12),pw1[3]=PKW(P0,14), pw1); \
    qB_=QF(3); VRD(2); SBAR(); GAPA(C0=__builtin_amdgcn_mfma_f32_32x32x16_bf16(kf[4],qA_,C0,0,0,0),   P1[2],P1[3],P1[4],P1[5],     pw2[0]=PKW(P1,0), pw2[1]=PKW(P1,2), pw2); \
    VRD(6); SBAR(); GAPA(C1=__builtin_amdgcn_mfma_f32_32x32x16_bf16(kf[5],qA_,C1,0,0,0),   P1[6],P1[7],P1[8],P1[9],     pw2[2]=PKW(P1,4), pw2[3]=PKW(P1,6), pw2); \
    VRD(3); SBAR(); GAPA(C0=__builtin_amdgcn_mfma_f32_32x32x16_bf16(kf[6],qB_,C0,0,0,0),   P1[10],P1[11],P1[12],P1[13], pw3[0]=PKW(P1,8), pw3[1]=PKW(P1,10), pw3); \
    VRD(7); SBAR(); GAPA(C1=__builtin_amdgcn_mfma_f32_32x32x16_bf16(kf[7],qB_,C1,0,0,0),   P1[14],P1[15],0.f,0.f,       pw3[2]=PKW(P1,12),pw3[3]=PKW(P1,14), pw3); \
    l_reg+=sacc; \
    if(GK){DMA_K((t)+3,sl_cur);} if(GV){DMA_V((t)+1,sl_next);} \
    CMASK(C0,C1,t); \
    { float a=MX3(C0[0],C0[1],C1[0]),b=MX3(C0[2],C0[3],C1[1]); a=MX3(a,C1[2],C1[3]); \
      _Pragma("unroll") for(int r=4;r<16;r+=4){a=MX3(a,C0[r],C0[r+1]);b=MX3(b,C0[r+2],C0[r+3]);a=MX3(a,C1[r],C1[r+1]);b=MX3(b,C1[r+2],C1[r+3]);} \
      float rm=__builtin_fmaxf(a,b); { auto rr=__builtin_amdgcn_permlane32_swap(__float_as_uint(rm),__float_as_uint(rm),false,false); rm=__builtin_fmaxf(__uint_as_float(rr[0]),__uint_as_float(rr[1])); } \
      resc=false; \
      if(__builtin_expect(__any(rm>(float)THRL),0)){ const float dl=__builtin_fmaxf(rm,0.f); mhat+=dl; \
        _Pragma("unroll") for(int r=0;r<16;++r){C0[r]-=dl;C1[r]-=dl;} \
        nm=-mhat; \
        const float f=__builtin_amdgcn_exp2f(-dl); l_reg*=f; if(hi==0)wsf[r32]=f; resc=true; } } \
    SBAR(); \
    GAPB(o[0]=__builtin_amdgcn_mfma_f32_32x32x16_bf16(PAF(0),VFR(0),o[0],0,0,0), C0,0); \
    GAPB(o[1]=__builtin_amdgcn_mfma_f32_32x32x16_bf16(PAF(0),VFR(4),o[1],0,0,0), C0,4); \
    KRD(GL,0); GAPB(o[0]=__builtin_amdgcn_mfma_f32_32x32x16_bf16(PAF(1),VFR(1),o[0],0,0,0), C0,8); \
    KRD(GL,1); GAPB(o[1]=__builtin_amdgcn_mfma_f32_32x32x16_bf16(PAF(1),VFR(5),o[1],0,0,0), C0,12); \
    KRD(GL,2); GAPB(o[0]=__builtin_amdgcn_mfma_f32_32x32x16_bf16(PAF(2),VFR(2),o[0],0,0,0), C1,0); \
    KRD(GL,3); GAPB(o[1]=__builtin_amdgcn_mfma_f32_32x32x16_bf16(PAF(2),VFR(6),o[1],0,0,0), C1,4); \
    GAPB(o[0]=__builtin_amdgcn_mfma_f32_32x32x16_bf16(PAF(3),VFR(3),o[0],0,0,0), C1,8); \
    GAPB(o[1]=__builtin_amdgcn_mfma_f32_32x32x16_bf16(PAF(3),VFR(7),o[1],0,0,0), C1,12); \
    }while(0)
  int t=1;
  #undef CMASK
  #define CMASK(P0,P1,t) do{}while(0)
  for(;t+5<NT;t+=2){
    STEP(pB0,pB1,pA0,pA1,t,true,true,true);     WAIT_BAR(2); RESC(); ROT();
    STEP(pA0,pA1,pB0,pB1,t+1,true,true,true);   WAIT_BAR(2); RESC(); ROT();
  }
  #undef CMASK
  #define CMASK(P0,P1,t) do{int jb_=(t)-(NT-4); if(jb_>=0)cmask(P0,P1,jb_,qrel,hi);}while(0)
  #define ENDW(tt) do{ if((tt)+3<NT){WAIT_BAR(2);} else if((tt)+2<NT){WAIT_BAR(1);} else {WAIT_BAR(0);} }while(0)
  for(;t+1<NT;t+=2){
    STEP(pB0,pB1,pA0,pA1,t,(t+3<NT),(t+1<NT),(t+1<NT));       ENDW(t);   RESC(); ROT();
    STEP(pA0,pA1,pB0,pB1,t+1,(t+4<NT),(t+2<NT),(t+2<NT));     ENDW(t+1); RESC(); ROT();
  }
  STEP(pB0,pB1,pA0,pA1,NT-1,false,false,false); RESC();
  { float sacc=pB0[0]+pB0[1]; _Pragma("unroll") for(int r=2;r<16;++r)sacc+=pB0[r]; _Pragma("unroll") for(int r=0;r<16;++r)sacc+=pB1[r]; l_reg+=sacc;
    pw0=(u32x4){PKW(pB0,0),PKW(pB0,2),PKW(pB0,4),PKW(pB0,6)};pw1=(u32x4){PKW(pB0,8),PKW(pB0,10),PKW(pB0,12),PKW(pB0,14)};pw2=(u32x4){PKW(pB1,0),PKW(pB1,2),PKW(pB1,4),PKW(pB1,6)};pw3=(u32x4){PKW(pB1,8),PKW(pB1,10),PKW(pB1,12),PKW(pB1,14)};
    SBAR(); pv(o,vb0+sl_cur,PAF(0),PAF(1),PAF(2),PAF(3)); }
  #undef PKW
  #undef PAF
  #undef VFR
  #undef PIN
  #undef MX3
  #undef GAPA
  #undef GAPB
  #undef EX
  #undef VRD
  #undef KRD
  #undef STEP
  #undef ENDW
  {auto rr=__builtin_amdgcn_permlane32_swap(__float_as_uint(l_reg),__float_as_uint(l_reg),false,false);l_reg=__uint_as_float(rr[0])+__uint_as_float(rr[1]);}
  if(hi==0)wsf[32+r32]=l_reg;asm volatile("s_waitcnt lgkmcnt(0)":::"memory");
  float rli[16];
  #pragma unroll
  for(int r=0;r<16;++r)rli[r]=__builtin_amdgcn_rcpf(wsf[32+crow(r,hi)]);
  bf16*Ow=O+(rowbase+q0+wid*QBLK)*DMO+h*D;
  { bf16*stg=(bf16*)(shm+LDS_OST)+wid*2048;
    #pragma unroll
    for(int r=0;r<16;++r){const int orow=crow(r,hi);
      #pragma unroll
      for(int d0=0;d0<2;++d0)stg[orow*64+d0*32+r32]=__float2bfloat16(o[d0][r]*rli[r]);}
    asm volatile("s_waitcnt lgkmcnt(0)":::"memory");
    #pragma unroll
    for(int i=0;i<4;++i){const int row=i*8+(lane>>3),ch=lane&7; const u32x4 v=*(const u32x4*)(stg+row*64+ch*8); ATTN_STORE16(Ow+(long)row*DMO+ch*8,v);} }
  asm volatile("s_waitcnt lgkmcnt(0)\n\ts_barrier":::"memory");
  #undef DMA_K
  #undef DMA_V
  #undef CMASK
  #undef START
  #undef RESC
  #undef FINIT
  #undef QF
  #undef FINIT1
  #undef ROT
}
constexpr int ATTN_LDS_BYTES=LDS_BYTES;
struct AttnTensors { const bf16* Q; const bf16* K; const bf16* V; bf16* O; const float* F; };
#undef SBAR
#undef WAIT_BAR
}

constexpr int NWAVES = 8;
constexpr int BATCH = 8, SEQ = 4096, D = 1024, T = BATCH * SEQ, NL = 4;
constexpr int BW = 512, INTOT = 7184, NIN = 7168;
constexpr int MH = 4, MDH = 128, AH = 8, ADH = 64, S5G = 32, S5C = 16, S5P = 64, S5L = 32  , S5K = 640;
constexpr int NEXP = 32, EH = 512, MOE_ROWS = 73728  , MOE_NBLK_MAX = 288;
constexpr float LN_EPS = 1e-5f;
constexpr float ALPHA = 1.6817928305074290f;
constexpr float C2 = 0.125f * 1.4426950408889634f;
constexpr float LOG2E = 1.4426950408889634f;
constexpr int NPH_LAYER = 13, NPHASES = 1 + NL * NPH_LAYER;

constexpr size_t MiB = 1u << 20;
constexpr size_t WS_CTL = 0, CTL_ZERO_BYTES = 65536;
constexpr size_t WS_S5TAB = 2 * MiB;
constexpr size_t WS_MSC = 2 * MiB + 65536;
constexpr size_t WS_WSM = 2 * MiB + 131072;
constexpr size_t WS_NST = 3 * MiB;
constexpr size_t WS_WIN = 4 * MiB, WS_WGLU = 18 * MiB, WS_WBR = 19 * MiB, WS_WOUT = 22 * MiB, WS_WGU = 24 * MiB, WS_WDN = 88 * MiB;
constexpr size_t WS_XB = 148 * MiB;
constexpr size_t WS_MQK = 212 * MiB, WS_QK = 276 * MiB, WS_MV = 340 * MiB, WS_MO = 372 * MiB, WS_S5A = 404 * MiB, WS_AQKV = 444 * MiB, WS_GATE = 540 * MiB;
constexpr size_t WS_YS1 = WS_MQK, WS_MIXED = WS_QK;
constexpr size_t WS_XG = 212 * MiB, WS_HB = 356 * MiB, WS_YB = 428 * MiB;
constexpr size_t WS_YTALL = 732 * MiB, WS_CST = 828 * MiB, WS_EBUF = 892 * MiB, WS_SG = 908 * MiB, WS_FTAB = 910 * MiB, WS_MLU = 911 * MiB, WS_ROUTE = 913 * MiB, WS_TOKPOS = 914 * MiB, WS_S5ALL = 916 * MiB  , S5_LAYER_BYTES = 28 * MiB, WS_END = 1028 * MiB;
static_assert(WS_XG + (size_t)MOE_ROWS * 1024 * 2 <= WS_HB && WS_HB + (size_t)MOE_ROWS * 512 * 2 <= WS_YB && WS_YB + (size_t)2 * T * 1024 * 2 <= WS_YTALL, "moe overlay");
static_assert(WS_S5A + (size_t)32 * 1024 * 640 * 2 <= WS_AQKV && WS_GATE + (size_t)T * 3072 * 2 <= WS_YTALL, "region A");
constexpr int CW_TMO = 0, CW_CODE = 1, CW_BAR = 4096, CW_GCNT = 8192;

constexpr int RING_OFF = 0, RING_BYTES = 131072;
constexpr int LDS_BYTES = 163840;
constexpr int LDSX_OFF = RING_BYTES;
constexpr int LDSCTL_OFF = 162816, MISC_OFF = LDSCTL_OFF + 320;

#define GAS __attribute__((address_space(1)))
#define LAS __attribute__((address_space(3)))
typedef unsigned short bf16;
typedef unsigned v4u __attribute__((ext_vector_type(4)));
typedef unsigned v2u __attribute__((ext_vector_type(2)));
typedef float f32x4 __attribute__((ext_vector_type(4)));
typedef float f32x16 __attribute__((ext_vector_type(16)));
typedef short bf16x8 __attribute__((ext_vector_type(8)));
typedef GAS unsigned gu32;
#define RLX_AGENT __ATOMIC_RELAXED, __HIP_MEMORY_SCOPE_AGENT
#define LDS_WAIT() asm volatile("s_waitcnt lgkmcnt(0)" ::: "memory")
#define VM_WAIT() asm volatile("s_waitcnt vmcnt(0)" ::: "memory")
__device__ __forceinline__ unsigned f2bf(float f) { unsigned u = __builtin_bit_cast(unsigned, f); return (u + 0x7fffu + ((u >> 16) & 1u)) >> 16; }
__device__ __forceinline__ unsigned pk2(float lo, float hi) { return f2bf(lo) | (f2bf(hi) << 16); }
__device__ __forceinline__ float bflo(unsigned u) { return __uint_as_float(u << 16); }
__device__ __forceinline__ float bfhi(unsigned u) { return __uint_as_float(u & 0xffff0000u); }
__device__ __forceinline__ float bf2f(bf16 v) { return __uint_as_float((unsigned)v << 16); }
__device__ __forceinline__ float sigmoidf_(float x) { return 1.f / (1.f + __expf(-x)); }

__device__ __forceinline__ int lane_id() { int l; asm volatile("v_mbcnt_lo_u32_b32 %0, -1, 0\n\tv_mbcnt_hi_u32_b32 %0, -1, %0" : "=v"(l)); return l; }
#define XB_TMO      128
#define XB_XCNT(j)  (256  + 64 * (j))
#define XB_XSUB(j)  (1280 + 64 * (j))
#define XB_XGEN(j)  (2304 + 64 * (j))
#define XB_TOP      3328
#define XB_TOPGEN   3392
#define XCD_BAR_WORDS 3456
#define XB_SPIN_CAP (1u << 18)
__device__ __forceinline__ unsigned xb_ld(unsigned* p)              { return __hip_atomic_load(p, __ATOMIC_RELAXED, __HIP_MEMORY_SCOPE_AGENT); }
__device__ __forceinline__ unsigned xb_add(unsigned* p, unsigned v) { return __hip_atomic_fetch_add(p, v, __ATOMIC_RELAXED, __HIP_MEMORY_SCOPE_AGENT); }
__device__ __forceinline__ unsigned xb_xcc_id() { return (unsigned)__builtin_amdgcn_s_getreg((3 << 11) | 20) & 0xFu; }
#define XB_SPIN(cond, bar) do { unsigned _sp = 0; while (cond) { __builtin_amdgcn_s_sleep(1); \
    if ((++_sp & 255u) == 0u) { if (xb_ld(&(bar)[XB_TMO])) break; if (_sp > XB_SPIN_CAP) { atomicAdd(&(bar)[XB_TMO], 1u); break; } } } } while (0)
struct XcdBarrier { unsigned* bar; unsigned x; volatile LAS unsigned* st; };
__device__ __forceinline__ XcdBarrier xcd_barrier_post(unsigned* bar, volatile LAS unsigned* st, bool leader) {
    XcdBarrier b; b.bar = bar; b.x = xb_xcc_id(); b.st = st;
    if (leader) (void)xb_add(&bar[XB_XCNT(b.x)], 1u);
    return b;
}
__device__ __forceinline__ void xcd_barrier_complete(unsigned* bar, unsigned x, unsigned& nloc, unsigned& nx) {
    const unsigned G = gridDim.x * gridDim.y * gridDim.z;
    unsigned sum, cnt, mine, sp = 0u;
    for (;;) {
        sum = 0u; cnt = 0u; mine = 0u;
#pragma unroll
        for (unsigned j = 0; j < 16; ++j) { const unsigned c = xb_ld(&bar[XB_XCNT(j)]); sum += c; cnt += (c > 0u) ? 1u : 0u; mine = (j == x) ? c : mine; }
        if (sum == G) break;
        __builtin_amdgcn_s_sleep(1);
        if ((++sp & 255u) == 0u) { if (xb_ld(&bar[XB_TMO])) break; if (sp > XB_SPIN_CAP) { atomicAdd(&bar[XB_TMO], 1u); break; } }
    }
    nloc = mine > 0u ? mine : 1u; nx = cnt > 0u ? cnt : 1u;
}
__device__ __forceinline__ void xcd_barrier(const XcdBarrier& b, bool leader) {
    asm volatile("s_waitcnt vmcnt(0)" ::: "memory");
    __syncthreads();
    if (leader) {
        unsigned* bar = b.bar;
        __builtin_amdgcn_s_waitcnt(0);
        unsigned nloc = b.st[0], nx = b.st[1];
        if (nloc == 0u) { xcd_barrier_complete(bar, b.x, nloc, nx); b.st[0] = nloc; b.st[1] = nx; }
        const unsigned old = xb_add(&bar[XB_XSUB(b.x)], 1u);
        const unsigned gen = old / nloc;
        if (old + 1u == (gen + 1u) * nloc) {
            __builtin_amdgcn_fence(__ATOMIC_RELEASE, "agent");
            asm volatile("s_waitcnt vmcnt(0)" ::: "memory");
            const unsigned og = xb_add(&bar[XB_TOP], 1u);
            const unsigned tg = og / nx;
            if (og + 1u == (tg + 1u) * nx) xb_add(&bar[XB_TOPGEN], 1u);
            else XB_SPIN(xb_ld(&bar[XB_TOPGEN]) == tg, bar);
            __builtin_amdgcn_fence(__ATOMIC_ACQUIRE, "agent");
            xb_add(&bar[XB_XGEN(b.x)], 1u);
            asm volatile("s_waitcnt vmcnt(0)" ::: "memory");
        } else {
            XB_SPIN(xb_ld(&bar[XB_XGEN(b.x)]) == gen, bar);
            __builtin_amdgcn_fence(__ATOMIC_ACQUIRE, "agent");
            asm volatile("s_waitcnt vmcnt(0)" ::: "memory");
        }
    }
    __syncthreads();
}

enum InIdx { I_x, I_w_in, I_b_in, I_m_conv_w, I_m_conv_b, I_m_norm_w, I_s5_lam_re, I_s5_lam_im, I_s5_log_dt, I_s5_b_re, I_s5_b_im, I_s5_c_re, I_s5_c_im, I_s5_d, I_s5_w_glu, I_s5_b_glu, I_w_branch, I_w_out, I_ln1_g, I_ln1_b, I_w_rg, I_b_rg, I_w_re, I_b_re, I_moe_wg, I_moe_wu, I_moe_wd, I_ln2_g, I_ln2_b };
struct Args { const float* in[29]; float* out; unsigned char* ws; int ph_lo, ph_hi, sub, pad; };
typedef const __attribute__((address_space(4))) Args* KArgs;
struct Frame {
    LAS unsigned char* lds; unsigned char* ldsg;
    gu32* ctl;
    unsigned char* ws;
    int tid, lane, wave, vcu, G, bx;
    float* out;
    KArgs ka;
};
template <int O> __device__ __forceinline__ float shx(float v) { static_assert(O >= 1 && O < 32, "xor mask inside a 32-lane half"); return __int_as_float(__builtin_amdgcn_ds_swizzle(__float_as_int(v), (O << 10) | 0x1f)); }
__device__ __forceinline__ float half_swap_add(float v) { auto rr = __builtin_amdgcn_permlane32_swap(__float_as_uint(v), __float_as_uint(v), false, false); return __uint_as_float(rr[0]) + __uint_as_float(rr[1]); }
__device__ __forceinline__ float half_swap_max(float v) { auto rr = __builtin_amdgcn_permlane32_swap(__float_as_uint(v), __float_as_uint(v), false, false); return fmaxf(__uint_as_float(rr[0]), __uint_as_float(rr[1])); }
__device__ __forceinline__ float wave_sum(float v) { v += shx<1>(v); v += shx<2>(v); v += shx<4>(v); v += shx<8>(v); v += shx<16>(v); return half_swap_add(v); }
__device__ __forceinline__ float wave_max(float v) { v = fmaxf(v, shx<1>(v)); v = fmaxf(v, shx<2>(v)); v = fmaxf(v, shx<4>(v)); v = fmaxf(v, shx<8>(v)); v = fmaxf(v, shx<16>(v)); return half_swap_max(v); }
#define JR_STEP(p, NH, M, bit) _Pragma("unroll") for (int i_ = 0; i_ < (NH); ++i_) { const float send_ = (bit) ? p[i_] : p[i_ + (NH)]; const float keep_ = (bit) ? p[i_ + (NH)] : p[i_]; p[i_] = keep_ + shx<M>(send_); }
__device__ __forceinline__ float rdlane(float v, int l) { return __int_as_float(__builtin_amdgcn_readlane(__float_as_int(v), l)); }
__device__ __forceinline__ float lane_get(float v, int srclane) { return __int_as_float(__builtin_amdgcn_ds_bpermute(srclane << 2, __float_as_int(v))); }
__device__ __forceinline__ float log_sigmoid(float x) { return fminf(x, 0.f) - log1pf(expf(-fabsf(x))); }

__device__ __forceinline__ void transpose_item(const float* Wsrc, int ldw, bf16* WTdst, int ldt, LAS float* scr, int lane) {
#pragma unroll 8
    for (int i = 0; i < 32; ++i) { const int kk = 2 * i + (lane >> 5); scr[kk * 33 + (lane & 31)] = Wsrc[(size_t)kk * ldw + (lane & 31)]; }
    LDS_WAIT(); asm volatile("" ::: "memory");
    const int c = lane & 7;
#pragma unroll
    for (int j = 0; j < 4; ++j) { const int n = (lane >> 3) + 8 * j; const LAS float* s = scr + (8 * c) * 33 + n;
        v4u o; o.x = pk2(s[0 * 33], s[1 * 33]); o.y = pk2(s[2 * 33], s[3 * 33]); o.z = pk2(s[4 * 33], s[5 * 33]); o.w = pk2(s[6 * 33], s[7 * 33]);
        *(GAS v4u*)(WTdst + (size_t)n * ldt + 8 * c) = o; }
    LDS_WAIT(); asm volatile("" ::: "memory");
}
__device__ __forceinline__ int in_srccol(int c) { return c + (c >= 4096 ? 16 : (c >= 2048 ? 8 : 0)); }

__device__ __forceinline__ void sincos_d(double ang, float& s, float& c) {
    double inv2pi = 0.15915494309189535, twopi = 6.283185307179586476925; asm volatile("" : "+v"(inv2pi), "+v"(twopi));
    const double k = rint(ang * inv2pi); const float r = (float)(ang - k * twopi);
    const float q = rintf(r * 0.6366197723675814f); float y = fmaf(q, -1.57079637050628662109375f, r); y = fmaf(q, 4.371139000186241e-8f, y); const float y2 = y * y;
    float sp = 2.7557319e-6f; sp = sp * y2 - 1.9841270e-4f; sp = sp * y2 + 8.3333333e-3f; sp = sp * y2 - 1.6666667e-1f; sp = y + y * y2 * sp;
    float cp = -2.7557319e-7f; cp = cp * y2 + 2.4801587e-5f; cp = cp * y2 - 1.3888889e-3f; cp = cp * y2 + 4.1666667e-2f; cp = cp * y2 - 0.5f; cp = 1.f + y2 * cp;
    const int qi = ((int)q) & 3; s = (qi == 0) ? sp : (qi == 1) ? cp : (qi == 2) ? -sp : -cp; c = (qi == 0) ? cp : (qi == 1) ? -sp : (qi == 2) ? -cp : sp;
}
__device__ __forceinline__ void s5_build_group(Frame& F, int l, int g) {
    LAS float* AP = (LAS float*)(F.lds);
    LAS float* BB = AP + 33 * 64 * 2;
    LAS float* CC = BB + 64 * 16 * 2;
    LAS float* KT = CC + 16 * 64 * 2;
    LAS float* DD = KT + 32 * 256;
    const int tid = F.tid;
    const float* lre = F.ka->in[I_s5_lam_re] + ((size_t)l * S5G + g) * S5P; const float* lim = F.ka->in[I_s5_lam_im] + ((size_t)l * S5G + g) * S5P;
    const double dt = (double)expf(F.ka->in[I_s5_log_dt][l * S5G + g]);
    for (int i = tid; i < 33 * 64; i += 512) { const int tau = i >> 6, p = i & 63; const double lr = lre[p], li = lim[p];
        const float mag = expf((float)(lr * dt * tau)); float sn, cs; sincos_d(li * dt * tau, sn, cs); AP[i * 2] = mag * cs; AP[i * 2 + 1] = mag * sn; }
    for (int i = tid; i < 64 * 16; i += 512) { const int p = i >> 4, ci = i & 15; const double lr = lre[p], li = lim[p];
        float sn, cs; sincos_d(li * dt, sn, cs); const double mag = (double)expf((float)(lr * dt)), ar = mag * cs, ai = mag * sn, den = lr * lr + li * li, nr = ar - 1.0, ni = ai;
        const double zr = (nr * lr + ni * li) / den, zi = (ni * lr - nr * li) / den;
        const size_t bi = (((size_t)l * S5G + g) * S5P + p) * S5C + ci; const double br = F.ka->in[I_s5_b_re][bi], bim = F.ka->in[I_s5_b_im][bi];
        BB[i * 2] = (float)(zr * br - zi * bim); BB[i * 2 + 1] = (float)(zr * bim + zi * br); }
    for (int i = tid; i < 16 * 64; i += 512) { const size_t ci_ = ((size_t)l * S5G + g) * S5C * S5P + i; CC[i * 2] = F.ka->in[I_s5_c_re][ci_]; CC[i * 2 + 1] = F.ka->in[I_s5_c_im][ci_]; }
    if (tid < 16) DD[tid] = F.ka->in[I_s5_d][(l * S5G + g) * S5C + tid];
    __syncthreads();
    for (int i = tid; i < 32 * 256; i += 512) { const int tau = i >> 8, co = (i >> 4) & 15, ci = i & 15; float s = 0.f;
        for (int p = 0; p < 64; ++p) { const float cr = CC[(co * 64 + p) * 2], cim = CC[(co * 64 + p) * 2 + 1], ar = AP[(tau * 64 + p) * 2], ai = AP[(tau * 64 + p) * 2 + 1];
            const float xr = cr * ar - cim * ai, xi = cr * ai + cim * ar; s += xr * BB[(p * 16 + ci) * 2] - xi * BB[(p * 16 + ci) * 2 + 1]; }
        KT[i] = s; }
    if (tid < 64) { float* tab = (float*)(F.ws + WS_S5TAB) + ((l * 32 + g) * 64 + tid) * 2; tab[0] = AP[(32 * 64 + tid) * 2]; tab[1] = AP[(32 * 64 + tid) * 2 + 1]; }
    __syncthreads();
    bf16* MP = (bf16*)(F.ws + WS_S5ALL + (size_t)l * S5_LAYER_BYTES) + (size_t)g * 512 * S5K;
    for (int i = tid; i < 512 * (S5K / 8); i += 512) { const int n = i / (S5K / 8), k0 = (i % (S5K / 8)) * 8, tq = n >> 4, co = n & 15; float v[8];
#pragma unroll
        for (int j = 0; j < 8; ++j) { const int k = k0 + j; float x;
            if (k < 512) { const int sq = k >> 4, ci = k & 15; x = (tq >= sq) ? KT[((tq - sq) * 16 + co) * 16 + ci] : 0.f; if (tq == sq && co == ci) x += DD[co]; }
            else { const int p = (k - 512) & 63; const float cr = CC[(co * 64 + p) * 2], cim = CC[(co * 64 + p) * 2 + 1], ar = AP[((tq + 1) * 64 + p) * 2], ai = AP[((tq + 1) * 64 + p) * 2 + 1];
                x = (k < 576) ? (cr * ar - cim * ai) : -(cr * ai + cim * ar); }
            v[j] = x; }
        v4u o; o.x = pk2(v[0], v[1]); o.y = pk2(v[2], v[3]); o.z = pk2(v[4], v[5]); o.w = pk2(v[6], v[7]);
        *(GAS v4u*)(MP + (size_t)n * S5K + k0) = o; }
    bf16* GG = (bf16*)(F.ws + WS_S5ALL + (size_t)l * S5_LAYER_BYTES + 20 * MiB) + (size_t)g * 256 * 512;
    for (int i = tid; i < 256 * 64; i += 512) { const int n = i >> 6, k0 = (i & 63) * 8; float v[8];
#pragma unroll
        for (int j = 0; j < 8; ++j) { const int k = k0 + j, sq = k >> 4, ci = k & 15; float x = 0.f;
            if (n < 128) { const int p = n & 63; const float ar = AP[((31 - sq) * 64 + p) * 2], ai = AP[((31 - sq) * 64 + p) * 2 + 1], br = BB[(p * 16 + ci) * 2], bim = BB[(p * 16 + ci) * 2 + 1];
                x = (n < 64) ? (ar * br - ai * bim) : (ar * bim + ai * br); }
            v[j] = x; }
        v4u o; o.x = pk2(v[0], v[1]); o.y = pk2(v[2], v[3]); o.z = pk2(v[4], v[5]); o.w = pk2(v[6], v[7]);
        *(GAS v4u*)(GG + (size_t)n * 512 + k0) = o; }
    __syncthreads();
}

__device__ __forceinline__ void small_w_prep(Frame& F, int l);
__device__ __forceinline__ void weight_prep(Frame& F, int l) {
    if (F.vcu == F.G - 1) small_w_prep(F, l);
    LAS float* scr = (LAS float*)(F.lds + RING_OFF + F.wave * 16384);
    const int gw = F.vcu * NWAVES + F.wave, NGW = F.G * NWAVES;
    constexpr int I_IN = (NIN / 32) * 16, I_GLU = 16 * 8, I_BR = 3 * 32 * 8, I_OUT = 32 * 16, I_G = NEXP * 16 * 16, I_D = NEXP * 32 * 8;
    constexpr int NITEMS = I_IN + I_GLU + I_BR + I_OUT + 2 * I_G + I_D;
    for (int it = gw; it < NITEMS; it += NGW) {
        int r = it;
        if (r < I_IN) { const int nb = r >> 4, kb = r & 15; transpose_item(F.ka->in[I_w_in] + (size_t)l * D * INTOT + (size_t)(64 * kb) * INTOT + in_srccol(32 * nb), INTOT, (bf16*)(F.ws + WS_WIN) + (size_t)(32 * nb) * 1024 + 64 * kb, 1024, scr, F.lane); continue; } r -= I_IN;
        if (r < I_GLU) { const int nb = r >> 3, kb = r & 7; transpose_item(F.ka->in[I_s5_w_glu] + (size_t)l * 512 * 512 + (size_t)(64 * kb) * 512 + 32 * nb, 512, (bf16*)(F.ws + WS_WGLU) + (size_t)(32 * nb) * 512 + 64 * kb, 512, scr, F.lane); continue; } r -= I_GLU;
        if (r < I_BR) { const int br = r >> 8, nb = (r >> 3) & 31, kb = r & 7; transpose_item(F.ka->in[I_w_branch] + ((size_t)l * 3 + br) * 512 * 1024 + (size_t)(64 * kb) * 1024 + 32 * nb, 1024, (bf16*)(F.ws + WS_WBR) + (size_t)(br * 1024 + 32 * nb) * 512 + 64 * kb, 512, scr, F.lane); continue; } r -= I_BR;
        if (r < I_OUT) { const int nb = r >> 4, kb = r & 15; transpose_item(F.ka->in[I_w_out] + (size_t)l * 1024 * 1024 + (size_t)(64 * kb) * 1024 + 32 * nb, 1024, (bf16*)(F.ws + WS_WOUT) + (size_t)(32 * nb) * 1024 + 64 * kb, 1024, scr, F.lane); continue; } r -= I_OUT;
        if (r < 2 * I_G) { const int up = r >= I_G; if (up) r -= I_G; const int e = r >> 8, nb = (r >> 4) & 15, kb = r & 15;
            const float* src = (up ? F.ka->in[I_moe_wu] : F.ka->in[I_moe_wg]) + ((size_t)l * NEXP + e) * 1024 * 512 + (size_t)(64 * kb) * 512 + 32 * nb; const int n0 = 32 * nb;
            transpose_item(src, 512, (bf16*)(F.ws + WS_WGU) + (size_t)(e * 1024 + (n0 >> 7) * 256 + up * 128 + (n0 & 127)) * 1024 + 64 * kb, 1024, scr, F.lane); continue; } r -= 2 * I_G;
        { const int e = r >> 8, nb = (r >> 3) & 31, kb = r & 7;
            transpose_item(F.ka->in[I_moe_wd] + ((size_t)l * NEXP + e) * 512 * 1024 + (size_t)(64 * kb) * 1024 + 32 * nb, 1024, (bf16*)(F.ws + WS_WDN) + (size_t)(e * 1024 + 32 * nb) * 512 + 64 * kb, 512, scr, F.lane); }
    }
}

__device__ __forceinline__ void small_gates_mfma(Frame& F, int l) {
    const int gw = F.vcu * NWAVES + F.wave, lane = F.lane, r = lane & 15, kg = lane >> 4;
    if (gw * 16 >= T) return;
    const bf16* __restrict__ A = (const bf16*)(F.ws + WS_XB) + (size_t)(gw * 16 + r) * D + 8 * kg; const bf16* __restrict__ B = (const bf16*)(F.ws + WS_WSM) + (size_t)r * D + 8 * kg;
    f32x4 acc = {0.f, 0.f, 0.f, 0.f};
#pragma unroll 8
    for (int ks = 0; ks < 32; ++ks) { const bf16x8 a = *(const GAS bf16x8*)(A + 32 * ks), b = *(const GAS bf16x8*)(B + 32 * ks); acc = __builtin_amdgcn_mfma_f32_16x16x32_bf16(a, b, acc, 0, 0, 0); }
    const float bias = F.ka->in[I_b_in][(size_t)l * INTOT + (r < 8 ? 2048 + r : 4104 + (r - 8))];
    float* sg = (float*)(F.ws + WS_SG) + (size_t)(gw * 16 + 4 * kg) * 16 + r;
#pragma unroll
    for (int i = 0; i < 4; ++i) sg[i * 16] = acc[i] + bias;
}
__device__ __forceinline__ void small_w_prep(Frame& F, int l) {
    const float* w = F.ka->in[I_w_in] + (size_t)l * D * INTOT; bf16* o = (bf16*)(F.ws + WS_WSM);
    for (int i = F.tid; i < 1024 * 16; i += 512) { const int k = i >> 4, j = i & 15; o[j * 1024 + k] = (bf16)f2bf(w[(size_t)k * INTOT + (j < 8 ? 2048 + j : 4104 + (j - 8))]); }
}

__device__ __forceinline__ void phase_p0(Frame& F) {
    if (F.vcu < NL * S5G) s5_build_group(F, F.vcu >> 5, F.vcu & 31);
    weight_prep(F, 0);
    const int gw = F.vcu * NWAVES + F.wave, NGW = F.G * NWAVES;
    f32x4 nv[4];
    { const GAS f32x4* x0 = (const GAS f32x4*)(F.ka->in[I_x] + (size_t)gw * D) + F.lane;
#pragma unroll
      for (int j = 0; j < 4; ++j) nv[j] = x0[64 * j]; }
    for (int m = gw; m < T; m += NGW) {
        f32x4 v[4];
#pragma unroll
        for (int j = 0; j < 4; ++j) v[j] = nv[j];
        if (m + NGW < T) { const GAS f32x4* xn = (const GAS f32x4*)(F.ka->in[I_x] + (size_t)(m + NGW) * D) + F.lane;
#pragma unroll
            for (int j = 0; j < 4; ++j) nv[j] = xn[64 * j]; }
        GAS v2u* o8 = (GAS v2u*)((bf16*)(F.ws + WS_XB) + (size_t)m * D) + F.lane;
#pragma unroll
        for (int j = 0; j < 4; ++j) { v2u o; o.x = pk2(v[j].x, v[j].y); o.y = pk2(v[j].z, v[j].w); o8[64 * j] = o; }
    }
    __syncthreads();
}

struct EpiInProj {
    static constexpr bool PERM = true;
    unsigned char* ws; const float* bias;
    __device__ __forceinline__ bool reset_after(const pg8::Unit&) const { return true; }
    __device__ __forceinline__ void operator()(pg8::f32x4 (&acc)[2][2][4][2], const pg8::Unit& u, int wr, int wc, int fr, int fq) const {
        using namespace pg8;
        const int pn = u.pn, row0 = u.pm * BM + wr * 64 + fr;
        int mode, pitch, cofs; size_t base;
        if (pn < 4) { mode = 0; base = WS_MQK; pitch = 1024; cofs = 0; }
        else if (pn < 6) { mode = 0; base = WS_MV; pitch = 512; cofs = 1024; }
        else if (pn < 8) { mode = 1; base = WS_MO; pitch = 512; cofs = 1536; }
        else if (pn < 10) { mode = 3; base = WS_S5A; pitch = 0; cofs = 2048; }
        else if (pn < 16) { mode = (pn < 12) ? 2 : 0; base = WS_AQKV; pitch = 1536; cofs = 2560; }
        else { mode = 0; base = WS_GATE; pitch = 3072; cofs = 4096; }
        bf16_t* O = (bf16_t*)(ws + base);
#pragma unroll
        for (int bj = 0; bj < 2; ++bj) {
            const int col0 = pn * BM + bj * HALF + wc * 32 + 8 * fq;
            const int sc = in_srccol(col0);
            const f32x4 b0 = *(const f32x4*)(bias + sc), b1 = *(const f32x4*)(bias + sc + 4);
            const int cl = col0 - cofs;
#pragma unroll
            for (int ai = 0; ai < 2; ++ai)
#pragma unroll
                for (int m = 0; m < 4; ++m) {
                    const int row = row0 + ai * HALF + m * 16;
                    f32x4 v0 = acc[ai][bj][m][0] + b0, v1 = acc[ai][bj][m][1] + b1;
                    if (mode == 1) {
#pragma unroll
                        for (int i = 0; i < 4; ++i) { v0[i] = 1.f / (1.f + __expf(-v0[i])); v1[i] = 1.f / (1.f + __expf(-v1[i])); }
                    } else if (mode == 2) { v0 = v0 * C2; v1 = v1 * C2; }
                    u32x4 w; w.x = cvt_pk_bf16(v0[0], v0[1]); w.y = cvt_pk_bf16(v0[2], v0[3]); w.z = cvt_pk_bf16(v1[0], v1[1]); w.w = cvt_pk_bf16(v1[2], v1[3]);
                    size_t off;
                    if (mode == 3) { const int g = cl >> 4; off = ((size_t)(g * 1024 + (row >> 5)) * S5K) + (row & 31) * 16 + (cl & 15); }
                    else off = (size_t)row * pitch + cl;
                    *(u32x4*)(O + off) = w;
                }
        }
    }
};

__device__ __forceinline__ float wave_incl_scan_add(float v, int lane) {
#pragma unroll
    for (int o = 1; o < 64; o <<= 1) { const float t = lane_get(v, (lane - o) & 63); if (lane >= o) v += t; }
    return v;
}
__device__ __forceinline__ float wave_incl_scan_max(float v, int lane) {
#pragma unroll
    for (int o = 1; o < 64; o <<= 1) { const float t = lane_get(v, (lane - o) & 63); if (lane >= o) v = fmaxf(v, t); }
    return v;
}
__device__ __forceinline__ float lane63(float v) { return __int_as_float(__builtin_amdgcn_readlane(__float_as_int(v), 63)); }
__device__ __forceinline__ void phase_prep2(Frame& F, int l) {
    const int lane = F.lane;
    const float* __restrict__ SG = (const float*)(F.ws + WS_SG);
    if (F.wave == 0 && F.vcu < 64) {
        const int sq = F.vcu, b = sq >> 3, h = sq & 7; float carry = 0.f; float* __restrict__ FT = (float*)(F.ws + WS_FTAB) + (size_t)sq * SEQ;
#pragma unroll 1
        for (int blk = 0; blk < SEQ / 1024; ++blk) { float x[16];
#pragma unroll
            for (int i = 0; i < 16; ++i) x[i] = SG[(size_t)(b * SEQ + blk * 1024 + i * 64 + lane) * 16 + 8 + h];
#pragma unroll
            for (int i = 0; i < 16; ++i) { const float c = wave_incl_scan_add(log_sigmoid(x[i]), lane) + carry; FT[blk * 1024 + i * 64 + lane] = c * LOG2E; carry = lane63(c); } }
    } else if (F.wave == 0 && F.vcu < 96) {
        const int bh = F.vcu - 64, b = bh >> 2, h = bh & 3; float mprev = 0.f;
        float* __restrict__ MU = (float*)(F.ws + WS_MLU) + (size_t)bh * SEQ; float* __restrict__ MM = MU + (size_t)32 * SEQ; float* __restrict__ MB = MM + (size_t)32 * SEQ;
        float* __restrict__ MSC = (float*)(F.ws + WS_MSC) + bh * 64;
#pragma unroll 1
        for (int blk = 0; blk < 4; ++blk) { float xi[16], xf[16];
#pragma unroll
            for (int i = 0; i < 16; ++i) { const float* sg = SG + (size_t)(b * SEQ + (blk * 16 + i) * 64 + lane) * 16; xi[i] = sg[h]; xf[i] = sg[4 + h]; }
#pragma unroll
            for (int i = 0; i < 16; ++i) { const int c = blk * 16 + i, s = c * 64 + lane; const float ip = xi[i], lf = log_sigmoid(xf[i]);
                const float bc = wave_incl_scan_add(lf, lane), u = ip - bc, pm = wave_incl_scan_max(u, lane), mloc = lane63(pm), blast = lane63(bc);
                MU[s] = u; MM[s] = fmaxf(pm, mprev); MB[s] = bc;
                const float Mc = fmaxf(mprev, mloc);
                if (lane == 0) { MSC[c] = mprev; MSC[2048 + c] = mloc; MSC[4096 + c] = expf(mprev - Mc); MSC[6144 + c] = expf(mloc - Mc); }
                mprev = blast + Mc; } }
    }
    const bf16* __restrict__ RAW = (const bf16*)(F.ws + WS_MQK); bf16* __restrict__ QK = (bf16*)(F.ws + WS_QK);
    const float* cw = F.ka->in[I_m_conv_w] + (size_t)l * 4 * 1024; const float* cb = F.ka->in[I_m_conv_b] + (size_t)l * 1024;
    const int gt = F.vcu * 512 + F.tid, c0 = (gt & 127) * 8, run = gt >> 7;
    if (run < T / 32) {
        float w[4][8], bs[8];
#pragma unroll
        for (int j = 0; j < 4; ++j) { const f32x4 w0 = *(const f32x4*)(cw + j * 1024 + c0), w1 = *(const f32x4*)(cw + j * 1024 + c0 + 4); w[j][0] = w0.x; w[j][1] = w0.y; w[j][2] = w0.z; w[j][3] = w0.w; w[j][4] = w1.x; w[j][5] = w1.y; w[j][6] = w1.z; w[j][7] = w1.w; }
        { const f32x4 b0 = *(const f32x4*)(cb + c0), b1 = *(const f32x4*)(cb + c0 + 4); bs[0] = b0.x; bs[1] = b0.y; bs[2] = b0.z; bs[3] = b0.w; bs[4] = b1.x; bs[5] = b1.y; bs[6] = b1.z; bs[7] = b1.w; }
        const float sc = (c0 >= 512) ? 0.08838834764831845f : 1.f;
        const int tok0 = run * 32; const bool first = (tok0 & (SEQ - 1)) == 0;
        const bf16* rp = RAW + (size_t)tok0 * 1024 + c0; bf16* qp = QK + (size_t)tok0 * 1024 + c0;
        v4u win[3];
#pragma unroll
        for (int j = 0; j < 3; ++j) win[j] = first ? (v4u){0u, 0u, 0u, 0u} : *(const GAS v4u*)(rp - (size_t)(3 - j) * 1024);
#pragma unroll 1
        for (int t8 = 0; t8 < 32; t8 += 8) { v4u r[8];
#pragma unroll
            for (int i = 0; i < 8; ++i) r[i] = *(const GAS v4u*)(rp + (size_t)(t8 + i) * 1024);
#pragma unroll
            for (int i = 0; i < 8; ++i) { float a[8];
#pragma unroll
                for (int e = 0; e < 8; ++e) a[e] = bs[e];
#pragma unroll
                for (int j = 0; j < 4; ++j) { const v4u x = (j == 3) ? r[i] : ((i + j >= 3) ? r[i + j - 3 < 0 ? 0 : i + j - 3] : win[i + j]);
                    a[0] += w[j][0] * bflo(x.x); a[1] += w[j][1] * bfhi(x.x); a[2] += w[j][2] * bflo(x.y); a[3] += w[j][3] * bfhi(x.y);
                    a[4] += w[j][4] * bflo(x.z); a[5] += w[j][5] * bfhi(x.z); a[6] += w[j][6] * bflo(x.w); a[7] += w[j][7] * bfhi(x.w); }
#pragma unroll
                for (int e = 0; e < 8; ++e) a[e] = a[e] / (1.f + __expf(-a[e])) * sc;
                v4u o; o.x = pk2(a[0], a[1]); o.y = pk2(a[2], a[3]); o.z = pk2(a[4], a[5]); o.w = pk2(a[6], a[7]);
                *(GAS v4u*)(qp + (size_t)(t8 + i) * 1024) = o; }
            win[0] = r[5]; win[1] = r[6]; win[2] = r[7]; }
    }
}

__device__ __forceinline__ void mlstm_pass1(Frame& F, int uu) {
    const int tid = F.tid, lane = F.lane, wid = F.wave, r = lane & 31, hh = lane >> 5;
    const int bh = uu >> 6, c = uu & 63, b = bh >> 2, h = bh & 3; const size_t tok0 = (size_t)b * SEQ + c * 64;
    LAS bf16* KT = (LAS bf16*)(F.lds); LAS bf16* VT = KT + 128 * 72; LAS float* WS_ = (LAS float*)(F.lds + 2 * 128 * 72 * 2);
    if (tid < 64) { const float u = ((const float*)(F.ws + WS_MLU))[(size_t)bh * SEQ + c * 64 + tid]; const float ml = ((const float*)(F.ws + WS_MSC))[2048 + bh * 64 + c]; WS_[tid] = expf(u - ml); }
    __syncthreads();
    const bf16* QK = (const bf16*)(F.ws + WS_QK); const bf16* MV = (const bf16*)(F.ws + WS_MV);
    for (int p = tid; p < 1024; p += 512) { const int s = p >> 4, d0 = (p & 15) * 8;
        const v4u kk = *(const GAS v4u*)(QK + (tok0 + s) * 1024 + 512 + h * 128 + d0); const v4u vv = *(const GAS v4u*)(MV + (tok0 + s) * 512 + h * 128 + d0); const float w = WS_[s];
        const unsigned ka[4] = {kk.x, kk.y, kk.z, kk.w}, va[4] = {vv.x, vv.y, vv.z, vv.w};
#pragma unroll
        for (int j = 0; j < 4; ++j) { KT[(d0 + 2 * j) * 72 + s] = (bf16)f2bf(bflo(ka[j]) * w); KT[(d0 + 2 * j + 1) * 72 + s] = (bf16)f2bf(bfhi(ka[j]) * w);
            VT[(d0 + 2 * j) * 72 + s] = (bf16)(va[j] & 0xffffu); VT[(d0 + 2 * j + 1) * 72 + s] = (bf16)(va[j] >> 16); } }
    __syncthreads();
    const int mt = wid >> 1, nt0 = (wid & 1) * 2;
    f32x16 acc[2]; acc[0] = f32x16{}; acc[1] = f32x16{};
#pragma unroll
    for (int ks = 0; ks < 4; ++ks) { const bf16x8 A = *(const LAS bf16x8*)(KT + (32 * mt + r) * 72 + 16 * ks + 8 * hh);
#pragma unroll
        for (int n = 0; n < 2; ++n) { const bf16x8 B = *(const LAS bf16x8*)(VT + (32 * (nt0 + n) + r) * 72 + 16 * ks + 8 * hh); acc[n] = __builtin_amdgcn_mfma_f32_32x32x16_bf16(A, B, acc[n], 0, 0, 0); } }
    bf16* CT = (bf16*)(F.ws + WS_CST) + (size_t)uu * 128 * 128;
#pragma unroll
    for (int n = 0; n < 2; ++n) { const int dv = 32 * (nt0 + n) + r;
#pragma unroll
        for (int g = 0; g < 4; ++g) { v2u o; o.x = pk2(acc[n][4 * g], acc[n][4 * g + 1]); o.y = pk2(acc[n][4 * g + 2], acc[n][4 * g + 3]);
            *(GAS v2u*)(CT + (size_t)dv * 128 + 32 * mt + 8 * g + 4 * hh) = o; } }
    if (tid < 128) { float s = 0.f; for (int i = 0; i < 64; ++i) s += bf2f(KT[tid * 72 + i]); ((float*)(F.ws + WS_NST))[(size_t)uu * 128 + tid] = s; }
    __syncthreads();
}

__device__ __forceinline__ void mlstm_pass3(Frame& F, int l, int uu) {
    const int tid = F.tid, lane = F.lane, wid = F.wave, r = lane & 31, hh = lane >> 5;
    const int bh = uu >> 6, c = uu & 63, b = bh >> 2, h = bh & 3; const size_t tok0 = (size_t)b * SEQ + c * 64;
    LAS bf16* Q = (LAS bf16*)(F.lds); LAS bf16* Kk = Q + 64 * 136; LAS bf16* VT = Kk + 64 * 136; LAS bf16* CT = VT + 128 * 72;
    LAS float* HB = (LAS float*)(F.lds + 88064); LAS float* SM = (LAS float*)(F.lds + 121856);
    LAS float* U = SM, *MT = SM + 64, *WST = SM + 128, *FLO = SM + 192, *DEN = SM + 256, *NP = SM + 320, *QN = SM + 448;
    const bf16* QKg = (const bf16*)(F.ws + WS_QK); const bf16* MVg = (const bf16*)(F.ws + WS_MV); const bf16* CTg = (const bf16*)(F.ws + WS_CST) + (size_t)uu * 128 * 128;
    for (int p = tid; p < 1024; p += 512) { const int s = p >> 4, d0 = (p & 15) * 8;
        *(LAS v4u*)(Q + s * 136 + d0) = *(const GAS v4u*)(QKg + (tok0 + s) * 1024 + h * 128 + d0);
        *(LAS v4u*)(Kk + s * 136 + d0) = *(const GAS v4u*)(QKg + (tok0 + s) * 1024 + 512 + h * 128 + d0);
        const v4u vv = *(const GAS v4u*)(MVg + (tok0 + s) * 512 + h * 128 + d0); const unsigned va[4] = {vv.x, vv.y, vv.z, vv.w};
#pragma unroll
        for (int j = 0; j < 4; ++j) { VT[(d0 + 2 * j) * 72 + s] = (bf16)(va[j] & 0xffffu); VT[(d0 + 2 * j + 1) * 72 + s] = (bf16)(va[j] >> 16); } }
    for (int p = tid; p < 2048; p += 512) { const int dv = p >> 4, d0 = (p & 15) * 8; *(LAS v4u*)(CT + dv * 136 + d0) = *(const GAS v4u*)(CTg + (size_t)dv * 128 + d0); }
    if (tid < 64) { const size_t o = (size_t)bh * SEQ + c * 64 + tid; const float* MLU = (const float*)(F.ws + WS_MLU);
        const float u = MLU[o], Mt = MLU[(size_t)32 * SEQ + o], bc = MLU[(size_t)64 * SEQ + o], mprev = ((const float*)(F.ws + WS_MSC))[bh * 64 + c];
        U[tid] = u; MT[tid] = Mt; WST[tid] = expf(mprev - Mt); FLO[tid] = expf(-bc - Mt); }
    else if (tid < 192) NP[tid - 64] = ((const float*)(F.ws + WS_NST))[(size_t)uu * 128 + (tid - 64)];
    __syncthreads();
    { const int t = tid >> 3, part = tid & 7; float s = 0.f;
#pragma unroll
        for (int i = 0; i < 16; ++i) s += bf2f(Q[t * 136 + part * 16 + i]) * NP[part * 16 + i];
        s += shx<1>(s); s += shx<2>(s); s += shx<4>(s); if (part == 0) QN[t] = s; }
    __syncthreads();
    const int tt = wid >> 2, dt = wid & 3;
    f32x16 acc = f32x16{};
#pragma unroll
    for (int ks = 0; ks < 8; ++ks) { const bf16x8 A = *(const LAS bf16x8*)(Q + (32 * tt + r) * 136 + 16 * ks + 8 * hh); const bf16x8 B = *(const LAS bf16x8*)(CT + (32 * dt + r) * 136 + 16 * ks + 8 * hh);
        acc = __builtin_amdgcn_mfma_f32_32x32x16_bf16(A, B, acc, 0, 0, 0); }
#pragma unroll
    for (int g = 0; g < 16; ++g) acc[g] *= WST[32 * tt + (g & 3) + 8 * (g >> 2) + 4 * hh];
    float denp = 0.f; const float Mt_l = MT[32 * tt + r];
    for (int st = 0; st <= tt; ++st) {
        f32x16 ST = f32x16{};
#pragma unroll
        for (int ks = 0; ks < 8; ++ks) { const bf16x8 A = *(const LAS bf16x8*)(Kk + (32 * st + r) * 136 + 16 * ks + 8 * hh); const bf16x8 B = *(const LAS bf16x8*)(Q + (32 * tt + r) * 136 + 16 * ks + 8 * hh);
            ST = __builtin_amdgcn_mfma_f32_32x32x16_bf16(A, B, ST, 0, 0, 0); }
#pragma unroll
        for (int g = 0; g < 16; ++g) { const int ri = (g & 3) + 8 * (g >> 2) + 4 * hh; float w = __expf(U[32 * st + ri] - Mt_l); if (st == tt && ri > r) w = 0.f; ST[g] *= w; denp += ST[g]; }
#pragma unroll
        for (int sp = 0; sp < 2; ++sp) {
            v4u pa; pa.x = pg8::cvt_pk_bf16(ST[8 * sp], ST[8 * sp + 1]); pa.y = pg8::cvt_pk_bf16(ST[8 * sp + 2], ST[8 * sp + 3]); pa.z = pg8::cvt_pk_bf16(ST[8 * sp + 4], ST[8 * sp + 5]); pa.w = pg8::cvt_pk_bf16(ST[8 * sp + 6], ST[8 * sp + 7]);
            const v2u lo = *(const LAS v2u*)(VT + (32 * dt + r) * 72 + 32 * st + 16 * sp + 4 * hh), hi = *(const LAS v2u*)(VT + (32 * dt + r) * 72 + 32 * st + 16 * sp + 8 + 4 * hh);
            v4u pb; pb.x = lo.x; pb.y = lo.y; pb.z = hi.x; pb.w = hi.y;
            acc = __builtin_amdgcn_mfma_f32_32x32x16_bf16(__builtin_bit_cast(bf16x8, pa), __builtin_bit_cast(bf16x8, pb), acc, 0, 0, 0); }
    }
    denp = half_swap_add(denp);
    if (dt == 0 && hh == 0) { const int t = 32 * tt + r; DEN[t] = denp + WST[t] * QN[t]; }
    __syncthreads();
#pragma unroll
    for (int g = 0; g < 16; ++g) { const int t = 32 * tt + (g & 3) + 8 * (g >> 2) + 4 * hh; HB[t * 132 + 32 * dt + r] = acc[g] / fmaxf(fabsf(DEN[t]), FLO[t]); }
    __syncthreads();
    { const int t = tid >> 3, part = tid & 7; float x[16]; float s = 0.f;
#pragma unroll
        for (int i = 0; i < 16; ++i) { x[i] = HB[t * 132 + part * 16 + i]; s += x[i]; }
        s += shx<1>(s); s += shx<2>(s); s += shx<4>(s); const float mean = s * (1.f / 128.f); float q = 0.f;
#pragma unroll
        for (int i = 0; i < 16; ++i) { x[i] -= mean; q += x[i] * x[i]; }
        q += shx<1>(q); q += shx<2>(q); q += shx<4>(q); const float rstd = 1.f / sqrtf(q * (1.f / 128.f) + LN_EPS);
        const float* nw = F.ka->in[I_m_norm_w] + (size_t)l * BW + h * 128 + part * 16; const bf16* og = (const bf16*)(F.ws + WS_MO) + (tok0 + t) * 512 + h * 128 + part * 16;
        const v4u o0 = *(const GAS v4u*)og, o1 = *(const GAS v4u*)(og + 8); const unsigned oa[8] = {o0.x, o0.y, o0.z, o0.w, o1.x, o1.y, o1.z, o1.w};
        unsigned ow[8];
#pragma unroll
        for (int i = 0; i < 8; ++i) ow[i] = pk2(x[2 * i] * rstd * nw[2 * i] * bflo(oa[i]), x[2 * i + 1] * rstd * nw[2 * i + 1] * bfhi(oa[i]));
        bf16* yo = (bf16*)(F.ws + WS_YTALL) + (tok0 + t) * 512 + h * 128 + part * 16;
        *(GAS v4u*)yo = (v4u){ow[0], ow[1], ow[2], ow[3]}; *(GAS v4u*)(yo + 8) = (v4u){ow[4], ow[5], ow[6], ow[7]}; }
    __syncthreads();
}

__device__ __forceinline__ void phase_scans(Frame& F, int l, bool dry = false) {
    const int v = F.vcu, tid = F.tid;
    if (v < 128) {
        const int gid = v * 512 + tid, bh = gid >> 11, rem = gid & 2047; const float* MSC = (const float*)(F.ws + WS_MSC);
        bf16* p = (bf16*)(F.ws + (dry ? WS_MQK : WS_CST)) + (size_t)bh * 64 * 16384 + (size_t)rem * 8; float S[8] = {0.f, 0.f, 0.f, 0.f, 0.f, 0.f, 0.f, 0.f};
#pragma unroll 4
        for (int c = 0; c < 64; ++c) { const v4u lc = *(const GAS v4u*)(p + (size_t)c * 16384); const float dec = MSC[4096 + bh * 64 + c], sc = MSC[6144 + bh * 64 + c];
            v4u o; o.x = pk2(S[0], S[1]); o.y = pk2(S[2], S[3]); o.z = pk2(S[4], S[5]); o.w = pk2(S[6], S[7]); *(GAS v4u*)(p + (size_t)c * 16384) = o;
            S[0] = dec * S[0] + sc * bflo(lc.x); S[1] = dec * S[1] + sc * bfhi(lc.x); S[2] = dec * S[2] + sc * bflo(lc.y); S[3] = dec * S[3] + sc * bfhi(lc.y);
            S[4] = dec * S[4] + sc * bflo(lc.z); S[5] = dec * S[5] + sc * bfhi(lc.z); S[6] = dec * S[6] + sc * bflo(lc.w); S[7] = dec * S[7] + sc * bfhi(lc.w); }
    } else if (v < 160) {
        const int gid = (v - 128) * 512 + tid, b = gid >> 11, g = (gid >> 6) & 31, p = gid & 63; const float* tab = (const float*)(F.ws + WS_S5TAB) + ((l * 32 + g) * 64 + p) * 2; const float ar = tab[0], ai = tab[1];
        bf16* A = (bf16*)(F.ws + (dry ? WS_AQKV : WS_S5A)); const float* E = (const float*)(F.ws + WS_EBUF); float hr = 0.f, hi = 0.f;
#pragma unroll 4
        for (int ch = 0; ch < 128; ++ch) { const size_t row = (size_t)g * 1024 + b * 128 + ch; A[row * S5K + 512 + p] = (bf16)f2bf(hr); A[row * S5K + 576 + p] = (bf16)f2bf(hi);
            const float er = E[row * 128 + p], ei = E[row * 128 + 64 + p]; const float nr = ar * hr - ai * hi + er, ni = ar * hi + ai * hr + ei; hr = nr; hi = ni; }
    } else if (v < 168) {
        const int gid = (v - 160) * 512 + tid, bh = gid >> 7, dk = gid & 127; const float* MSC = (const float*)(F.ws + WS_MSC); float* p = (float*)(F.ws + (dry ? WS_YTALL : WS_NST)) + (size_t)bh * 64 * 128 + dk; float n = 0.f;
#pragma unroll 4
        for (int c = 0; c < 64; ++c) { const float lc = p[c * 128]; p[c * 128] = n; n = MSC[4096 + bh * 64 + c] * n + MSC[6144 + bh * 64 + c] * lc; }
    }
}

struct SchedS5E { int c; __device__ __forceinline__ bool next(int i, pg8::Unit& u) const { if (i > 0 || c >= 128) return false; u.pm = c; u.pn = c >> 2; return true; } };
struct SchedS5Y { int c; __device__ __forceinline__ bool next(int i, pg8::Unit& u) const { if (i > 0 || c >= 256) return false; u.pm = c >> 1; u.pn = (c >> 3) * 2 + (c & 1); return true; } };
struct EpiS5E {
    static constexpr bool PERM = false;
    float* E;
    __device__ __forceinline__ bool reset_after(const pg8::Unit&) const { return true; }
    __device__ __forceinline__ void operator()(pg8::f32x4 (&acc)[2][2][4][2], const pg8::Unit& u, int wr, int wc, int fr, int fq) const {
        using namespace pg8;
        const int row0 = u.pm * BM + wr * 64 + fr, col0 = wc * 32 + 4 * fq;
#pragma unroll
        for (int ai = 0; ai < 2; ++ai)
#pragma unroll
            for (int m = 0; m < 4; ++m)
#pragma unroll
                for (int n = 0; n < 2; ++n) *(f32x4*)(E + (size_t)(row0 + ai * HALF + m * 16) * 128 + col0 + 16 * n) = acc[ai][0][m][n];
    }
};
__device__ __forceinline__ float gelu_tanh(float x) { const float z = 0.7978845608028654f * (x + 0.044715f * x * x * x); const float e = __expf(2.f * z); return 0.5f * x * (2.f - 2.f / (1.f + e)); }
struct EpiS5Y {
    static constexpr bool PERM = true;
    bf16* Y;
    __device__ __forceinline__ bool reset_after(const pg8::Unit&) const { return true; }
    __device__ __forceinline__ void operator()(pg8::f32x4 (&acc)[2][2][4][2], const pg8::Unit& u, int wr, int wc, int fr, int fq) const {
        using namespace pg8;
        const int row0 = u.pm * BM + wr * 64 + fr, ct = u.pn & 1;
#pragma unroll
        for (int bj = 0; bj < 2; ++bj) { const int cc = ct * 256 + bj * HALF + wc * 32 + 8 * fq, tq = cc >> 4, co = cc & 15;
#pragma unroll
            for (int ai = 0; ai < 2; ++ai)
#pragma unroll
                for (int m = 0; m < 4; ++m) { const int R = row0 + ai * HALF + m * 16, g = R >> 10, rr = R & 1023; const f32x4 v0 = acc[ai][bj][m][0], v1 = acc[ai][bj][m][1];
                    u32x4 w; w.x = cvt_pk_bf16(gelu_tanh(v0[0]), gelu_tanh(v0[1])); w.y = cvt_pk_bf16(gelu_tanh(v0[2]), gelu_tanh(v0[3])); w.z = cvt_pk_bf16(gelu_tanh(v1[0]), gelu_tanh(v1[1])); w.w = cvt_pk_bf16(gelu_tanh(v1[2]), gelu_tanh(v1[3]));
                    *(u32x4*)(Y + (size_t)(rr * 32 + tq) * 512 + 16 * g + co) = w; } }
    }
};
struct EpiGlu {
    static constexpr bool PERM = true;
    const bf16* Y1; bf16* YO; const float* bias;
    __device__ __forceinline__ bool reset_after(const pg8::Unit&) const { return true; }
    __device__ __forceinline__ void operator()(pg8::f32x4 (&acc)[2][2][4][2], const pg8::Unit& u, int wr, int wc, int fr, int fq) const {
        using namespace pg8;
        const int row0 = u.pm * BM + wr * 64 + fr;
#pragma unroll
        for (int bj = 0; bj < 2; ++bj) { const int col0 = u.pn * BM + bj * HALF + wc * 32 + 8 * fq; const f32x4 b0 = *(const f32x4*)(bias + col0), b1 = *(const f32x4*)(bias + col0 + 4);
#pragma unroll
            for (int ai = 0; ai < 2; ++ai)
#pragma unroll
                for (int m = 0; m < 4; ++m) { const size_t off = (size_t)(row0 + ai * HALF + m * 16) * 512 + col0; const u32x4 y = *(const u32x4*)(Y1 + off);
                    const f32x4 v0 = acc[ai][bj][m][0] + b0, v1 = acc[ai][bj][m][1] + b1;
                    u32x4 w; w.x = cvt_pk_bf16(bflo(y.x) * sigmoidf_(v0[0]), bfhi(y.x) * sigmoidf_(v0[1])); w.y = cvt_pk_bf16(bflo(y.y) * sigmoidf_(v0[2]), bfhi(y.y) * sigmoidf_(v0[3]));
                    w.z = cvt_pk_bf16(bflo(y.z) * sigmoidf_(v1[0]), bfhi(y.z) * sigmoidf_(v1[1])); w.w = cvt_pk_bf16(bflo(y.w) * sigmoidf_(v1[2]), bfhi(y.w) * sigmoidf_(v1[3]));
                    *(u32x4*)(YO + off) = w; } }
    }
};
struct SchedMerge { int c, G; __device__ __forceinline__ bool next(int i, pg8::Unit& u) const { const int tl = (i / 3) * G + c, b = i % 3; if (tl >= 512) return false; u.pm = b * 128 + (tl >> 2); u.pn = b * 4 + (tl & 3); return true; } };
struct EpiMerge {
    static constexpr bool PERM = true;
    const bf16* GP; bf16* MX;
    __device__ __forceinline__ bool reset_after(const pg8::Unit& u) const { return u.pm >= 256; }
    __device__ __forceinline__ void operator()(pg8::f32x4 (&acc)[2][2][4][2], const pg8::Unit& u, int wr, int wc, int fr, int fq) const {
        using namespace pg8;
        const int b = u.pm >> 7, pm = u.pm & 127, pn = u.pn & 3, row0 = pm * BM + wr * 64 + fr;
#pragma unroll
        for (int bj = 0; bj < 2; ++bj) { const int col0 = pn * BM + bj * HALF + wc * 32 + 8 * fq;
#pragma unroll
            for (int ai = 0; ai < 2; ++ai)
#pragma unroll
                for (int m = 0; m < 4; ++m) { const int row = row0 + ai * HALF + m * 16; const bf16* gp = GP + (size_t)row * 3072 + b * 1024 + col0;
                    const u32x4 ga = *(const u32x4*)gp; float f[8];
                    const unsigned gaa[4] = {ga.x, ga.y, ga.z, ga.w};
                    if (b < 2) { const u32x4 gb = *(const u32x4*)(gp + 1024); const unsigned gba[4] = {gb.x, gb.y, gb.z, gb.w};
#pragma unroll
                        for (int i = 0; i < 4; ++i) {
                            const float a0 = fminf(fmaxf(bflo(gaa[i]), -30.f), 30.f), a1 = fminf(fmaxf(bfhi(gaa[i]), -30.f), 30.f), c0 = fminf(fmaxf(bflo(gba[i]), -30.f), 30.f), c1 = fminf(fmaxf(bfhi(gba[i]), -30.f), 30.f);
                            f[2 * i] = (1.f + __expf(-c0)) / (1.f + __expf(-a0)); f[2 * i + 1] = (1.f + __expf(-c1)) / (1.f + __expf(-a1)); }
                    } else {
#pragma unroll
                        for (int i = 0; i < 4; ++i) { const float a0 = fminf(fmaxf(bflo(gaa[i]), -30.f), 30.f), a1 = fminf(fmaxf(bfhi(gaa[i]), -30.f), 30.f); f[2 * i] = 1.f / (1.f + __expf(-a0)); f[2 * i + 1] = 1.f / (1.f + __expf(-a1)); }
                    }
                    f32x4& v0 = acc[ai][bj][m][0]; f32x4& v1 = acc[ai][bj][m][1];
                    v0[0] *= f[0]; v0[1] *= f[1]; v0[2] *= f[2]; v0[3] *= f[3]; v1[0] *= f[4]; v1[1] *= f[5]; v1[2] *= f[6]; v1[3] *= f[7];
                    if (b == 2) { u32x4 w; w.x = cvt_pk_bf16(v0[0], v0[1]); w.y = cvt_pk_bf16(v0[2], v0[3]); w.z = cvt_pk_bf16(v1[0], v1[1]); w.w = cvt_pk_bf16(v1[2], v1[3]);
                        *(u32x4*)(MX + (size_t)row * 1024 + col0) = w; } } }
    }
};
struct EpiOutProj {
    static constexpr bool PERM = false;
    const float* X; float* O;
    __device__ __forceinline__ bool reset_after(const pg8::Unit&) const { return true; }
    __device__ __forceinline__ void operator()(pg8::f32x4 (&acc)[2][2][4][2], const pg8::Unit& u, int wr, int wc, int fr, int fq) const {
        using namespace pg8;
        const int row0 = u.pm * BM + wr * 64 + fr, col0 = u.pn * BM + wc * 32 + 4 * fq;
#pragma unroll
        for (int ai = 0; ai < 2; ++ai)
#pragma unroll
            for (int m = 0; m < 4; ++m) { const size_t off = (size_t)(row0 + ai * HALF + m * 16) * 1024 + col0;
#pragma unroll
                for (int bj = 0; bj < 2; ++bj)
#pragma unroll
                    for (int n = 0; n < 2; ++n) { const f32x4 xv = *(const f32x4*)(X + off + bj * HALF + n * 16); *(f32x4*)(O + off + bj * HALF + n * 16) = xv * ALPHA + acc[ai][bj][m][n]; } }
    }
};

__device__ __forceinline__ void phase_ln1_route(Frame& F, int l, bool dry = false) {
    float* const OUT = dry ? (float*)(F.ws + WS_YB) : F.out; bf16* const XBo = (bf16*)(F.ws + (dry ? WS_XG : WS_XB)); unsigned char* const RT = F.ws + (dry ? WS_HB : WS_ROUTE); int* const TPo = (int*)(F.ws + (dry ? WS_HB + 4 * MiB : WS_TOKPOS)); const int gl = dry ? l + 4 : l;
    constexpr int WP = 1028;
    LAS float* WRE = (LAS float*)(F.lds); LAS float* WRG = WRE + 32 * WP;
    LAS float* BR = WRG + 4 * WP; LAS unsigned* HIST = (LAS unsigned*)(BR + 64); LAS unsigned* BASE = HIST + 32;
    const float* wre = F.ka->in[I_w_re] + (size_t)l * 1024 * 32; const float* wrg = F.ka->in[I_w_rg] + (size_t)l * 1024 * 4;
    for (int i = F.tid; i < 1024 * 32; i += 512) WRE[(i & 31) * WP + (i >> 5)] = wre[i];
    for (int i = F.tid; i < 1024 * 4; i += 512) WRG[(i & 3) * WP + (i >> 2)] = wrg[i];
    if (F.tid < 32) { BR[F.tid] = F.ka->in[I_b_re][l * 32 + F.tid]; HIST[F.tid] = 0u; }
    if (F.tid < 4) BR[32 + F.tid] = F.ka->in[I_b_rg][l * 4 + F.tid];
    { int* tp = TPo; for (int i = F.vcu * 512 + F.tid; i < MOE_ROWS; i += F.G * 512) tp[i] = -1; }
    __syncthreads();
    const int gw = F.vcu * NWAVES + F.wave, NGW = F.G * NWAVES, lane = F.lane;
    const float* lg = F.ka->in[I_ln1_g] + (size_t)l * D; const float* lb = F.ka->in[I_ln1_b] + (size_t)l * D;
    int my_e0 = 0, my_e1 = 0, my_r0 = 0, my_r1 = 0, my_m = -1; float my_w0 = 0.f, my_w1 = 0.f; int it = 0;
    f32x4 nv[4];
    { const GAS f32x4* x0 = (const GAS f32x4*)(F.out + (size_t)gw * D) + lane;
#pragma unroll
      for (int j = 0; j < 4; ++j) nv[j] = x0[64 * j]; }
    for (int m = gw; m < T; m += NGW, ++it) {
        GAS f32x4* xw = (GAS f32x4*)(OUT + (size_t)m * D) + lane; f32x4 v[4]; float s = 0.f;
#pragma unroll
        for (int j = 0; j < 4; ++j) { v[j] = nv[j]; s += (v[j].x + v[j].y) + (v[j].z + v[j].w); }
        if (m + NGW < T) { const GAS f32x4* xn = (const GAS f32x4*)(F.out + (size_t)(m + NGW) * D) + lane;
#pragma unroll
            for (int j = 0; j < 4; ++j) nv[j] = xn[64 * j]; }
        const float mean = wave_sum(s) * (1.f / D); float s2 = 0.f;
#pragma unroll
        for (int j = 0; j < 4; ++j) { v[j] = v[j] - mean; s2 += (v[j].x * v[j].x + v[j].y * v[j].y) + (v[j].z * v[j].z + v[j].w * v[j].w); }
        const float rstd = 1.f / sqrtf(wave_sum(s2) * (1.f / D) + LN_EPS);
        GAS v2u* o8 = (GAS v2u*)(XBo + (size_t)m * D) + lane;
#pragma unroll
        for (int j = 0; j < 4; ++j) { const f32x4 g4 = *(const f32x4*)(lg + 256 * j + 4 * lane), b4 = *(const f32x4*)(lb + 256 * j + 4 * lane);
            v[j] = v[j] * rstd * g4 + b4; xw[64 * j] = v[j]; v2u o; o.x = pk2(v[j].x, v[j].y); o.y = pk2(v[j].z, v[j].w); o8[64 * j] = o; }
        const bool b0 = (lane & 1) != 0, b1 = (lane & 2) != 0, b2 = (lane & 4) != 0;
        float gl[4];
        { float p[4];
#pragma unroll
          for (int o = 0; o < 4; ++o) { p[o] = 0.f;
#pragma unroll
            for (int j = 0; j < 4; ++j) { const f32x4 w = *(const LAS f32x4*)(WRG + o * WP + 256 * j + 4 * lane); p[o] += (v[j].x * w.x + v[j].y * w.y) + (v[j].z * w.z + v[j].w * w.w); } }
          JR_STEP(p, 2, 1, b0) JR_STEP(p, 1, 2, b1)
          float r = p[0]; r += shx<4>(r); r += shx<8>(r); r += shx<16>(r); r = half_swap_add(r);
          gl[0] = rdlane(r, 0) + BR[32]; gl[1] = rdlane(r, 2) + BR[33]; gl[2] = rdlane(r, 1) + BR[34]; gl[3] = rdlane(r, 3) + BR[35]; }
        int grp = 0; float gmax = gl[0];
#pragma unroll
        for (int o = 1; o < 4; ++o) if (gl[o] > gmax) { gmax = gl[o]; grp = o; }
        float gs = 0.f;
#pragma unroll
        for (int o = 0; o < 4; ++o) gs += expf(gl[o] - gmax);
        const float pg = 1.f / gs;
        float el[8];
        { float p[8]; const LAS float* wr_ = WRE + grp * 8 * WP;
#pragma unroll
          for (int o = 0; o < 8; ++o) { p[o] = 0.f;
#pragma unroll
            for (int j = 0; j < 4; ++j) { const f32x4 w = *(const LAS f32x4*)(wr_ + o * WP + 256 * j + 4 * lane); p[o] += (v[j].x * w.x + v[j].y * w.y) + (v[j].z * w.z + v[j].w * w.w); } }
          JR_STEP(p, 4, 1, b0) JR_STEP(p, 2, 2, b1) JR_STEP(p, 1, 4, b2)
          float r = p[0]; r += shx<8>(r); r += shx<16>(r); r = half_swap_add(r);
          const LAS float* be = BR + grp * 8;
          el[0] = rdlane(r, 0) + be[0]; el[1] = rdlane(r, 4) + be[1]; el[2] = rdlane(r, 2) + be[2]; el[3] = rdlane(r, 6) + be[3];
          el[4] = rdlane(r, 1) + be[4]; el[5] = rdlane(r, 5) + be[5]; el[6] = rdlane(r, 3) + be[6]; el[7] = rdlane(r, 7) + be[7]; }
        int i0 = 0; float l0 = el[0];
#pragma unroll
        for (int o = 1; o < 8; ++o) if (el[o] > l0) { l0 = el[o]; i0 = o; }
        int i1 = -1; float l1 = -INFINITY;
#pragma unroll
        for (int o = 0; o < 8; ++o) if (o != i0 && el[o] > l1) { l1 = el[o]; i1 = o; }
        const float ex = expf(l1 - l0), pe0 = 1.f / (1.f + ex), pe1 = ex / (1.f + ex);
        const int e0 = grp * 8 + i0, e1 = grp * 8 + i1;
        unsigned r0 = 0u, r1 = 0u;
        if (lane == 0) { r0 = __hip_atomic_fetch_add(&HIST[e0], 1u, __ATOMIC_RELAXED, __HIP_MEMORY_SCOPE_WORKGROUP); r1 = __hip_atomic_fetch_add(&HIST[e1], 1u, __ATOMIC_RELAXED, __HIP_MEMORY_SCOPE_WORKGROUP); }
        r0 = (unsigned)__builtin_amdgcn_readfirstlane((int)r0); r1 = (unsigned)__builtin_amdgcn_readfirstlane((int)r1);
        if (lane == it) { my_e0 = e0; my_e1 = e1; my_r0 = (int)r0; my_r1 = (int)r1; my_w0 = pg * pe0; my_w1 = pg * pe1; my_m = m; }
    }
    __syncthreads();
    if (F.tid < 32) BASE[F.tid] = __hip_atomic_fetch_add((unsigned*)(F.ctl + CW_GCNT + gl * 32 + F.tid), HIST[F.tid], RLX_AGENT);
    __syncthreads();
    if (my_m >= 0) { int* re = (int*)RT; float* rw = (float*)(RT + 262144); int* rp = (int*)(RT + 524288);
        re[2 * my_m] = my_e0; re[2 * my_m + 1] = my_e1; rw[2 * my_m] = my_w0; rw[2 * my_m + 1] = my_w1; rp[2 * my_m] = (int)BASE[my_e0] + my_r0; rp[2 * my_m + 1] = (int)BASE[my_e1] + my_r1; }
    __syncthreads();
}

__device__ __forceinline__ void moe_tables(Frame& F, int l) {
    LAS int* PST = (LAS int*)(F.lds + LDSX_OFF + 20480); LAS int* BLKE = PST + 64;
    if (F.tid == 0) { int acc = 0;
#pragma unroll 1
        for (int e = 0; e < NEXP; ++e) { const int cnt = (int)__hip_atomic_load(F.ctl + CW_GCNT + l * 32 + e, RLX_AGENT); PST[e] = acc; const int nb = (cnt + 255) >> 8;
#pragma unroll 1
            for (int j = 0; j < nb; ++j) BLKE[(acc >> 8) + j] = e; acc += nb << 8; } PST[32] = acc; PST[33] = acc >> 8; }
    __syncthreads();
}
__device__ __forceinline__ void phase_dispatch(Frame& F, int l) {
    moe_tables(F, l);
    const LAS int* PST = (const LAS int*)(F.lds + LDSX_OFF + 20480);
    const int gw = F.vcu * NWAVES + F.wave, NGW = F.G * NWAVES, lane = F.lane;
    const int* re = (const int*)(F.ws + WS_ROUTE); const float* rw = (const float*)(F.ws + WS_ROUTE + 262144); const int* rp = (const int*)(F.ws + WS_ROUTE + 524288);
    int* tp = (int*)(F.ws + WS_TOKPOS); float* wp = (float*)(F.ws + WS_TOKPOS + 524288);
    const bf16* XB = (const bf16*)(F.ws + WS_XB); bf16* XG = (bf16*)(F.ws + WS_XG);
    for (int m = gw; m < T; m += NGW) {
        const int e0 = re[2 * m], e1 = re[2 * m + 1]; const int p0 = PST[e0] + rp[2 * m], p1 = PST[e1] + rp[2 * m + 1];
        if (lane == 0) { tp[p0] = 2 * m; wp[p0] = rw[2 * m]; tp[p1] = 2 * m + 1; wp[p1] = rw[2 * m + 1]; }
        const GAS v4u* src = (const GAS v4u*)(XB + (size_t)m * D) + lane; const v4u a = src[0], b = src[64];
        GAS v4u* d0 = (GAS v4u*)(XG + (size_t)p0 * D) + lane; GAS v4u* d1 = (GAS v4u*)(XG + (size_t)p1 * D) + lane;
        d0[0] = a; d0[64] = b; d1[0] = a; d1[64] = b;
    }
}
struct SchedMoe { const LAS int* PST; int c, G; __device__ __forceinline__ bool next(int i, pg8::Unit& u) const { const int L = i * G + c; const int nb = __builtin_amdgcn_readfirstlane(PST[33]); if (L >= nb * 4) return false; const int rb = L >> 2; u.pm = rb; u.pn = __builtin_amdgcn_readfirstlane(PST[64 + rb]) * 4 + (L & 3); return true; } };
struct EpiGateUp {
    static constexpr bool PERM = true;
    bf16* H;
    __device__ __forceinline__ bool reset_after(const pg8::Unit&) const { return true; }
    __device__ __forceinline__ void operator()(pg8::f32x4 (&acc)[2][2][4][2], const pg8::Unit& u, int wr, int wc, int fr, int fq) const {
        using namespace pg8;
        const int row0 = u.pm * BM + wr * 64 + fr, col0 = (u.pn & 3) * HALF + wc * 32 + 8 * fq;
#pragma unroll
        for (int ai = 0; ai < 2; ++ai)
#pragma unroll
            for (int m = 0; m < 4; ++m) { float hv[8];
#pragma unroll
                for (int n = 0; n < 2; ++n)
#pragma unroll
                    for (int i = 0; i < 4; ++i) { const float g = acc[ai][0][m][n][i], up = acc[ai][1][m][n][i]; hv[4 * n + i] = g / (1.f + __expf(-g)) * up; }
                u32x4 w; w.x = cvt_pk_bf16(hv[0], hv[1]); w.y = cvt_pk_bf16(hv[2], hv[3]); w.z = cvt_pk_bf16(hv[4], hv[5]); w.w = cvt_pk_bf16(hv[6], hv[7]);
                *(u32x4*)(H + (size_t)(row0 + ai * HALF + m * 16) * 512 + col0) = w; }
    }
};
struct EpiDown {
    static constexpr bool PERM = true;
    bf16* YB; const int* TP; const float* WP;
    __device__ __forceinline__ bool reset_after(const pg8::Unit&) const { return true; }
    __device__ __forceinline__ void operator()(pg8::f32x4 (&acc)[2][2][4][2], const pg8::Unit& u, int wr, int wc, int fr, int fq) const {
        using namespace pg8;
        const int row0 = u.pm * BM + wr * 64 + fr, colb = (u.pn & 3) * BM + wc * 32 + 8 * fq;
#pragma unroll
        for (int ai = 0; ai < 2; ++ai)
#pragma unroll
            for (int m = 0; m < 4; ++m) { const int row = row0 + ai * HALF + m * 16; const int tpv = TP[row]; if (tpv < 0) continue; const float w_ = WP[row];
#pragma unroll
                for (int bj = 0; bj < 2; ++bj) { const f32x4 v0 = acc[ai][bj][m][0] * w_, v1 = acc[ai][bj][m][1] * w_;
                    u32x4 w; w.x = cvt_pk_bf16(v0[0], v0[1]); w.y = cvt_pk_bf16(v0[2], v0[3]); w.z = cvt_pk_bf16(v1[0], v1[1]); w.w = cvt_pk_bf16(v1[2], v1[3]);
                    *(u32x4*)(YB + (size_t)tpv * 1024 + colb + bj * HALF) = w; } }
    }
};
__device__ __forceinline__ void phase_ln2(Frame& F, int l, int sub) {
    const bool more = (l + 1 < NL); const bool dry = (sub & 0x10) != 0;
    float* const OUT = dry ? (float*)(F.ws + 560 * MiB) : F.out; bf16* const XBo = (bf16*)(F.ws + (dry ? WS_YTALL : WS_XB));
    const int gw = F.vcu * NWAVES + F.wave, NGW = F.G * NWAVES, lane = F.lane;
    const float* lg = F.ka->in[I_ln2_g] + (size_t)l * D; const float* lb = F.ka->in[I_ln2_b] + (size_t)l * D; const bf16* YB = (const bf16*)(F.ws + WS_YB);
    f32x4 nx[4]; v2u na[4], nb[4];
    if (sub & 1) { const GAS f32x4* xr = (const GAS f32x4*)(F.out + (size_t)gw * D) + lane; const GAS v2u* y0 = (const GAS v2u*)(YB + (size_t)(2 * gw) * D) + lane; const GAS v2u* y1 = y0 + D / 4;
#pragma unroll
        for (int j = 0; j < 4; ++j) { nx[j] = xr[64 * j]; na[j] = y0[64 * j]; nb[j] = y1[64 * j]; } }
    if (sub & 1) for (int m = gw; m < T; m += NGW) {
        GAS f32x4* xw = (GAS f32x4*)(OUT + (size_t)m * D) + lane;
        f32x4 v[4]; float s = 0.f; f32x4 cx[4]; v2u ca[4], cb_[4];
#pragma unroll
        for (int j = 0; j < 4; ++j) { cx[j] = nx[j]; ca[j] = na[j]; cb_[j] = nb[j]; }
        if (m + NGW < T) { const GAS f32x4* xr = (const GAS f32x4*)(F.out + (size_t)(m + NGW) * D) + lane; const GAS v2u* y0 = (const GAS v2u*)(YB + (size_t)(2 * (m + NGW)) * D) + lane; const GAS v2u* y1 = y0 + D / 4;
#pragma unroll
            for (int j = 0; j < 4; ++j) { nx[j] = xr[64 * j]; na[j] = y0[64 * j]; nb[j] = y1[64 * j]; } }
#pragma unroll
        for (int j = 0; j < 4; ++j) { const f32x4 x = cx[j]; const v2u a = ca[j], b = cb_[j];
            v[j].x = ALPHA * x.x + (bflo(a.x) + bflo(b.x)); v[j].y = ALPHA * x.y + (bfhi(a.x) + bfhi(b.x)); v[j].z = ALPHA * x.z + (bflo(a.y) + bflo(b.y)); v[j].w = ALPHA * x.w + (bfhi(a.y) + bfhi(b.y));
            s += (v[j].x + v[j].y) + (v[j].z + v[j].w); }
        const float mean = wave_sum(s) * (1.f / D); float s2 = 0.f;
#pragma unroll
        for (int j = 0; j < 4; ++j) { v[j] = v[j] - mean; s2 += (v[j].x * v[j].x + v[j].y * v[j].y) + (v[j].z * v[j].z + v[j].w * v[j].w); }
        const float rstd = 1.f / sqrtf(wave_sum(s2) * (1.f / D) + LN_EPS);
        GAS v2u* o8 = (GAS v2u*)(XBo + (size_t)m * D) + lane;
#pragma unroll
        for (int j = 0; j < 4; ++j) { const f32x4 g4 = *(const f32x4*)(lg + 256 * j + 4 * lane), b4 = *(const f32x4*)(lb + 256 * j + 4 * lane);
            v[j] = v[j] * rstd * g4 + b4; xw[64 * j] = v[j]; v2u o; o.x = pk2(v[j].x, v[j].y); o.y = pk2(v[j].z, v[j].w); o8[64 * j] = o; }
    }
    __syncthreads();
    if (more && (sub & 2)) weight_prep(F, l + 1);
}

__device__ __forceinline__ void phase_attention(Frame& F) {
    const attn_body::AttnTensors AT{(const attn_body::bf16*)(F.ws + WS_AQKV), (const attn_body::bf16*)(F.ws + WS_AQKV) + 512, (const attn_body::bf16*)(F.ws + WS_AQKV) + 1024,
                                    (attn_body::bf16*)(F.ws + WS_YTALL) + (size_t)2 * T * 512, (const float*)(F.ws + WS_FTAB)};
    const int v = F.vcu, bh = v >> 2, s = v & 3;
    if (bh >= 64) return;
#pragma unroll 1
    for (int i = 0; i < 4; ++i) { const int qb = (i == 0) ? s : (i == 1) ? 7 - s : (i == 2) ? 8 + s : 15 - s;
        attn_body::attn_unit<8>(bh >> 3, bh & 7, qb, AT.Q, AT.K, AT.V, AT.O, AT.F, (char*)F.ldsg, F.tid); }
}

__global__ void __launch_bounds__(NWAVES * 64, 2) mega_fwd(Args args) {
    extern __shared__ __attribute__((aligned(16))) unsigned char lds[];
    Frame F;
    F.lds = (LAS unsigned char*)lds; F.ldsg = lds;
    const int wave_s = __builtin_amdgcn_readfirstlane((int)threadIdx.x >> 6);
    F.tid = wave_s * 64 + lane_id(); F.lane = F.tid & 63; F.wave = wave_s;
    const int G_s = gridDim.x, bx_s = blockIdx.x, vcu_s = (G_s % 8 == 0) ? (bx_s % 8) * (G_s / 8) + bx_s / 8 : bx_s;
    F.G = G_s; F.bx = bx_s; F.vcu = vcu_s;
    F.ws = args.ws; F.ctl = (gu32*)(args.ws + WS_CTL); F.out = args.out; F.ka = (KArgs)__builtin_amdgcn_kernarg_segment_ptr();
    volatile LAS unsigned* MISC = (volatile LAS unsigned*)(F.lds + MISC_OFF);
    for (int u = F.tid; u < (LDS_BYTES - LDSCTL_OFF) / 4; u += NWAVES * 64) ((LAS unsigned*)(F.lds + LDSCTL_OFF))[u] = 0u;
    __syncthreads();
    const int lo = args.ph_lo, hi = args.ph_hi, sub = args.sub;
    XcdBarrier bar; bar.bar = (unsigned*)(F.ctl + CW_BAR); bar.x = 0; bar.st = nullptr;
    if (hi - lo > 1) bar = xcd_barrier_post((unsigned*)(F.ctl + CW_BAR), MISC + 8, wave_s == 0 && lane_id() == 0);
#ifndef PH_MASK
#define PH_MASK 0x3fff
#endif
#define HAS(j) (((PH_MASK) >> (j)) & 1)

#define IN(k) (lo <= (k) && (k) < hi)
#define SEAM(k) do { if (IN(k) && IN((k) + 1)) { XcdBarrier b2_ = bar; asm volatile("" : "+s"(b2_.bar)); asm volatile("" : "+s"(b2_.x)); xcd_barrier(b2_, wave_s == 0 && lane_id() == 0); } } while (0)
#define FRESH() do { int t_ = wave_s * 64 + lane_id(); asm volatile("" : "+v"(t_)); F.tid = t_; F.lane = t_ & 63; F.wave = wave_s; \
        int g_ = G_s, b_ = bx_s, v_ = vcu_s; asm volatile("" : "+s"(g_), "+s"(b_), "+s"(v_)); F.G = g_; F.bx = b_; F.vcu = v_; \
        unsigned char* w_ = args.ws; asm volatile("" : "+s"(w_)); F.ws = w_; ws = w_; F.ctl = (gu32*)(w_ + WS_CTL); float* o_ = args.out; asm volatile("" : "+s"(o_)); F.out = o_; } while (0)
    unsigned char* ws = args.ws;
    if (HAS(13) && IN(0)) { FRESH(); phase_p0(F); SEAM(0); }
#pragma unroll 1
    for (int l = 0; l < NL; ++l) {
        const int pb = 1 + l * NPH_LAYER;
        if (HAS(0) && IN(pb + 0)) { FRESH(); small_gates_mfma(F, l);
            pg8::Gemm g{(const pg8::bf16_t*)(ws + WS_XB), (const pg8::bf16_t*)(ws + WS_WIN), 1024, 1024, 1024}; pg8::StaticOrder S; S.init(T, NIN, F.G, F.bx);
            EpiInProj E{ws, F.ka->in[I_b_in] + (size_t)l * INTOT};
            pg8::gemm_phase<EpiInProj, pg8::StaticOrder, true>(F.lds + RING_OFF, g, S, E, F.tid);
            SEAM(pb + 0);
        }
        if (HAS(1) && IN(pb + 1)) { FRESH(); phase_prep2(F, l); SEAM(pb + 1); }
        if (HAS(2) && IN(pb + 2)) { FRESH();
#ifndef P2_NO_A
            if (sub & 1) {
#pragma unroll 1
                for (int i = 0; i < 8; ++i) mlstm_pass1(F, F.vcu * 8 + i);
            }
#endif
#ifndef P2_NO_B
            if (sub & 2) { pg8::Gemm g{(const pg8::bf16_t*)(ws + WS_S5A), (const pg8::bf16_t*)(ws + WS_S5ALL + (size_t)l * S5_LAYER_BYTES + 20 * MiB), 512, S5K, 512}; SchedS5E S{F.vcu}; EpiS5E E{(float*)(ws + WS_EBUF)};
              pg8::gemm_phase<EpiS5E, SchedS5E, true>(F.lds + RING_OFF, g, S, E, F.tid); }
            __syncthreads();
#endif
#ifndef P2_NO_C
            if (sub & 4) phase_attention(F);
#endif
            SEAM(pb + 2);
        }
        if (HAS(3) && IN(pb + 3)) { FRESH(); phase_scans(F, l, (sub & 0x10) != 0); SEAM(pb + 3); }
        if (HAS(4) && IN(pb + 4)) { FRESH();
#pragma unroll 1
            for (int i = 0; i < 8; ++i) mlstm_pass3(F, l, F.vcu * 8 + i);
            { pg8::Gemm g{(const pg8::bf16_t*)(ws + WS_S5A), (const pg8::bf16_t*)(ws + WS_S5ALL + (size_t)l * S5_LAYER_BYTES), S5K, S5K, S5K}; SchedS5Y S{F.vcu}; EpiS5Y E{(bf16*)(ws + WS_YS1)};
              pg8::gemm_phase<EpiS5Y, SchedS5Y, true>(F.lds + RING_OFF, g, S, E, F.tid); }
            SEAM(pb + 4);
        }
        if (HAS(5) && IN(pb + 5)) { FRESH();            pg8::Gemm g{(const pg8::bf16_t*)(ws + WS_YS1), (const pg8::bf16_t*)(ws + WS_WGLU), 512, 512, 512}; pg8::StaticOrder S; S.init(T, 512, F.G, F.bx);
            EpiGlu E{(const bf16*)(ws + WS_YS1), (bf16*)(ws + WS_YTALL) + (size_t)T * 512, F.ka->in[I_s5_b_glu] + (size_t)l * 512};
            pg8::gemm_phase<EpiGlu, pg8::StaticOrder, true>(F.lds + RING_OFF, g, S, E, F.tid);
            SEAM(pb + 5);
        }
        if (HAS(6) && IN(pb + 6)) { FRESH();            pg8::Gemm g{(const pg8::bf16_t*)(ws + WS_YTALL), (const pg8::bf16_t*)(ws + WS_WBR), 512, 512, 512}; SchedMerge S{F.vcu, F.G};
            EpiMerge E{(const bf16*)(ws + WS_GATE), (bf16*)(ws + WS_MIXED)};
            pg8::gemm_phase<EpiMerge, SchedMerge, true>(F.lds + RING_OFF, g, S, E, F.tid);
            SEAM(pb + 6);
        }
        if (HAS(7) && IN(pb + 7)) { FRESH();
            pg8::Gemm g{(const pg8::bf16_t*)(ws + WS_MIXED), (const pg8::bf16_t*)(ws + WS_WOUT), 1024, 1024, 1024}; pg8::StaticOrder S; S.init(T, 1024, F.G, F.bx);
            EpiOutProj E{l == 0 ? F.ka->in[I_x] : (const float*)F.out, F.out};
            pg8::gemm_phase<EpiOutProj, pg8::StaticOrder, true>(F.lds + RING_OFF, g, S, E, F.tid);
            SEAM(pb + 7);
        }
        if (HAS(8) && IN(pb + 8)) { FRESH(); phase_ln1_route(F, l, (sub & 0x10) != 0); SEAM(pb + 8); }
        if (HAS(9) && IN(pb + 9)) { FRESH(); phase_dispatch(F, l); SEAM(pb + 9); }
        if (HAS(10) && IN(pb + 10)) { FRESH();            moe_tables(F, l);
            pg8::Gemm g{(const pg8::bf16_t*)(ws + WS_XG), (const pg8::bf16_t*)(ws + WS_WGU), 1024, 1024, 1024}; SchedMoe S{(const LAS int*)(F.lds + LDSX_OFF + 20480), F.vcu, F.G};
            EpiGateUp E{(bf16*)(ws + WS_HB)};
            pg8::gemm_phase<EpiGateUp, SchedMoe, true>(F.lds + RING_OFF, g, S, E, F.tid);
            SEAM(pb + 10);
        }
        if (HAS(11) && IN(pb + 11)) { FRESH();            moe_tables(F, l);
            pg8::Gemm g{(const pg8::bf16_t*)(ws + WS_HB), (const pg8::bf16_t*)(ws + WS_WDN), 512, 512, 512}; SchedMoe S{(const LAS int*)(F.lds + LDSX_OFF + 20480), F.vcu, F.G};
            EpiDown E{(bf16*)(ws + WS_YB), (const int*)(ws + WS_TOKPOS), (const float*)(ws + WS_TOKPOS + 524288)};
            pg8::gemm_phase<EpiDown, SchedMoe, true>(F.lds + RING_OFF, g, S, E, F.tid);
            SEAM(pb + 11);
        }
        if (HAS(12) && IN(pb + 12)) { FRESH(); phase_ln2(F, l, sub); SEAM(pb + 12); }
    }
#undef IN
#undef SEAM
}

extern "C" void kernel_launch(void* const* d_in, const int* in_sizes, int n_in, void* d_out, int out_size, void* d_ws, size_t ws_size, hipStream_t stream) {
    static int grid = 0;
    if (grid == 0) {
        if (n_in != 29 || in_sizes[0] != T * D || out_size != T * D || ws_size < WS_END) { fprintf(stderr, "kernel_launch: unexpected shapes / workspace (n_in %d, ws %zu < %zu)\n", n_in, ws_size, (size_t)WS_END); grid = -1; return; }
        int dev = 0, cus = 0;
        if (hipGetDevice(&dev) != hipSuccess || hipDeviceGetAttribute(&cus, hipDeviceAttributeMultiprocessorCount, dev) != hipSuccess) { grid = -1; return; }
        if (hipFuncSetAttribute((const void*)mega_fwd, hipFuncAttributeMaxDynamicSharedMemorySize, LDS_BYTES) != hipSuccess) { fprintf(stderr, "kernel_launch: hipFuncSetAttribute failed\n"); grid = -1; return; }
        int per_cu = 0;
        (void)hipOccupancyMaxActiveBlocksPerMultiprocessor(&per_cu, (const void*)mega_fwd, NWAVES * 64, LDS_BYTES);
        (void)hipGetLastError();
        if (cus != 256 || per_cu < 1) { fprintf(stderr, "kernel_launch: needs 256 CUs with one resident workgroup each (cus %d, per_cu %d)\n", cus, per_cu); grid = -1; return; }
        grid = cus;
    }
    if (grid < 0) return;
    (void)hipMemsetAsync((char*)d_ws + WS_CTL, 0, CTL_ZERO_BYTES, stream);
    Args a{};
    for (int i = 0; i < 29; ++i) a.in[i] = (const float*)d_in[i];
    a.out = (float*)d_out; a.ws = (unsigned char*)d_ws;
    a.sub = 0xF; a.pad = 0;
#if MK_ONE_LAUNCH
    a.ph_lo = 0; a.ph_hi = NPHASES;
    hipLaunchKernelGGL(mega_fwd, dim3(grid), dim3(NWAVES * 64), LDS_BYTES, stream, a);
#else
#ifndef PROBE_KIND
#define PROBE_KIND -1
#endif
#ifndef PROBE_REPS
#define PROBE_REPS 1
#endif
#ifndef PROBE_SUB
#define PROBE_SUB -1
#endif
    for (int p = 0; p < NPHASES; ++p) { a.ph_lo = p; a.ph_hi = p + 1; a.sub = 0xF;
        const int kind = (p == 0) ? 13 : (p - 1) % NPH_LAYER;
        if (kind == PROBE_KIND && PROBE_SUB != -1 && (PROBE_SUB & 0x100)) {   }
        hipLaunchKernelGGL(mega_fwd, dim3(grid), dim3(NWAVES * 64), LDS_BYTES, stream, a);
        if (kind == PROBE_KIND) { a.sub = PROBE_SUB; for (int r = 0; r < PROBE_REPS; ++r) hipLaunchKernelGGL(mega_fwd, dim3(grid), dim3(NWAVES * 64), LDS_BYTES, stream, a); }
    }
#endif
}
```

```cpp
#include <hip/hip_runtime.h>
#include <hip/hip_bf16.h>
#include <cstdio>
#include <cstdint>
#include <cmath>

#ifndef MK_ONE_LAUNCH
#define MK_ONE_LAUNCH 1
#endif

namespace pg8 {
#define PG8_LAS __attribute__((address_space(3)))
typedef unsigned short bf16_t;
typedef short bf16x8 __attribute__((ext_vector_type(8)));
typedef float f32x4 __attribute__((ext_vector_type(4)));
typedef float f32x2 __attribute__((ext_vector_type(2)));
typedef unsigned u32x4 __attribute__((ext_vector_type(4)));
typedef unsigned u32x2 __attribute__((ext_vector_type(2)));
constexpr int BM = 256, BK = 64, HALF = 128, HTB = HALF * BK * 2  , STAGE_BYTES = 8 * HTB, NXCD = 8, WGM = 8;

__host__ __device__ __forceinline__ int lds_byte(int r, int c) { const int st = (r >> 4) * 2 + (c >> 5), rr = r & 15, cc = c & 31, ob = rr * 64 + cc * 2; return st * 1024 + (ob ^ (((ob >> 9) & 1) << 5)); }
__host__ __device__ __forceinline__ void stage_rc(int b, int& R, int& C) { const int st = b / 1024, sb = b % 1024, swz = sb ^ (((sb >> 9) & 1) << 5); R = (st >> 1) * 16 + swz / 64; C = (st & 1) * 32 + (swz % 64) / 2; }
__host__ __device__ __forceinline__ int perm32(int rho) { const int n = rho >> 4, i = rho & 15; return 8 * (i >> 2) + 4 * n + (i & 3); }

struct Unit { int pm, pn; };
struct Gemm { const bf16_t* A; const bf16_t* Bt; int K, lda, ldb; };

struct StaticOrder {
    int nM, nN, nwg, G, c;
    __host__ __device__ void init(int M, int N, int G_, int c_) { nM = M / BM; nN = N / BM; nwg = nM * nN; G = G_; c = c_; }
    __host__ __device__ bool next(int i, Unit& u) const {
        const long L = (long)i * G + c; if (L >= nwg) return false;
        int wgid = (int)L; { const int q = nwg / NXCD, r = nwg % NXCD, xcd = wgid % NXCD, off = wgid / NXCD; wgid = (xcd < r ? xcd * (q + 1) : r * (q + 1) + (xcd - r) * q) + off; }
        const int nig = WGM * nN, gid = wgid / nig, fm = gid * WGM, gsz = (nM - fm) < WGM ? (nM - fm) : WGM;
        u.pm = fm + ((wgid % nig) % gsz); u.pn = (wgid % nig) / gsz; return true;
    }
};

__device__ __forceinline__ unsigned cvt_pk_bf16(float lo, float hi) { unsigned r; asm volatile("v_cvt_pk_bf16_f32 %0, %1, %2" : "=v"(r) : "v"(lo), "v"(hi)); return r; }

template <class Epi, class Sched, bool ALIGN_EPI = true>
__device__ __forceinline__ void gemm_phase(PG8_LAS unsigned char* lds, const Gemm g, const Sched& S, const Epi& E, const int tid  ) {
    const int wid = __builtin_amdgcn_readfirstlane(tid >> 6), lane = tid & 63, wr = wid >> 2, wc = wid & 3, fr = lane & 15, fq = lane >> 4;
    const int K = g.K, nt = K / BK;
    unsigned voffA[2], voffB[2];
#pragma unroll
    for (int i = 0; i < 2; ++i) { int R, C; stage_rc(tid * 16 + i * 8192, R, C); const int Rb = Epi::PERM ? ((R & ~31) + perm32(R & 31)) : R;
        voffA[i] = (unsigned)(R * g.lda + C) * 2u; voffB[i] = (unsigned)(Rb * g.ldb + C) * 2u; }
    const size_t kstep = (size_t)(BK * 2);
    const size_t hstepA = (size_t)HALF * g.lda * 2, hstepB = (size_t)HALF * g.ldb * 2;
    const size_t tstepA = 2 * hstepA, tstepB = 2 * hstepB;
    const unsigned ldsw = (unsigned)wid * 1024u;
    const int aoff = lds_byte(wr * 64 + fr, fq * 8), boff = lds_byte(wc * 32 + fr, fq * 8);
#define PG8_SA(b, h) (((b) * 2 + (h)) * HTB)
#define PG8_SB(b, h) ((4 + (b) * 2 + (h)) * HTB)
#define PG8_STAGE(bufoff, gbase, voff) do { _Pragma("unroll") for (int _i = 0; _i < 2; ++_i) \
        __builtin_amdgcn_global_load_lds((const unsigned*)((const char*)(gbase) + (voff)[_i]), (PG8_LAS unsigned*)(lds + (bufoff) + ldsw + _i * 8192), 16, 0, 0); } while (0)
#define PG8_LDA(dst, b, h) do { _Pragma("unroll") for (int m = 0; m < 4; ++m) _Pragma("unroll") for (int k = 0; k < 2; ++k) dst[m][k] = *(const PG8_LAS bf16x8*)(lds + PG8_SA(b, h) + aoff + m * 2048 + k * 1024); } while (0)
#define PG8_LDB(dst, b, h) do { _Pragma("unroll") for (int n = 0; n < 2; ++n) _Pragma("unroll") for (int k = 0; k < 2; ++k) dst[n][k] = *(const PG8_LAS bf16x8*)(lds + PG8_SB(b, h) + boff + n * 2048 + k * 1024); } while (0)
#define PG8_MMA(ai, bj, At, Bt) do { __builtin_amdgcn_s_setprio(1); _Pragma("unroll") for (int m = 0; m < 4; ++m) _Pragma("unroll") for (int n = 0; n < 2; ++n) _Pragma("unroll") for (int k = 0; k < 2; ++k) \
        acc[ai][bj][m][n] = __builtin_amdgcn_mfma_f32_16x16x32_bf16(Bt[n][k], At[m][k], acc[ai][bj][m][n], 0, 0, 0); __builtin_amdgcn_s_setprio(0); } while (0)
#define PG8_WAIT_V(n) asm volatile("s_waitcnt vmcnt(" #n ")" ::: "memory")
#define PG8_WAIT_L(n) asm volatile("s_waitcnt lgkmcnt(" #n ")" ::: "memory")
#define PG8_BAR __builtin_amdgcn_s_barrier()
#define PG8_SCHED __builtin_amdgcn_sched_barrier(0)
    Unit cur, nxt; int ui = 0;
    if (!S.next(0, cur)) return;
    f32x4 acc[2][2][4][2];
    float zf = 0.f; asm volatile("" : "+v"(zf));
#pragma unroll
    for (int a = 0; a < 2; ++a)
#pragma unroll
        for (int b = 0; b < 2; ++b)
#pragma unroll
            for (int m = 0; m < 4; ++m)
#pragma unroll
                for (int n = 0; n < 2; ++n) acc[a][b][m][n] = (f32x4){zf, zf, zf, zf};
    bf16x8 At[4][2], B0[2][2], B1[2][2];
    const char* cA = (const char*)g.A + (size_t)cur.pm * tstepA; const char* cB = (const char*)g.Bt + (size_t)cur.pn * tstepB;
    PG8_STAGE(PG8_SB(0, 0), cB, voffB); PG8_STAGE(PG8_SB(0, 1), cB + hstepB, voffB); PG8_STAGE(PG8_SA(0, 0), cA, voffA); PG8_STAGE(PG8_SA(0, 1), cA + hstepA, voffA);
    if (wr == 1) PG8_BAR;
    PG8_WAIT_V(2); PG8_BAR;
    PG8_STAGE(PG8_SB(1, 0), cB + kstep, voffB); PG8_STAGE(PG8_SA(1, 0), cA + kstep, voffA); PG8_STAGE(PG8_SB(1, 1), cB + hstepB + kstep, voffB);
    PG8_WAIT_V(6); PG8_BAR;
    for (;;) {
        const bool has_next = S.next(ui + 1, nxt);
        const char* nA = has_next ? (const char*)g.A + (size_t)nxt.pm * tstepA : cA; const char* nB = has_next ? (const char*)g.Bt + (size_t)nxt.pn * tstepB : cB;
        for (int t = 0; t < nt; t += 2) {
            const bool last = (t == nt - 2);
            const char* a1 = cA + (size_t)(t + 1) * kstep;
            const char* a2 = last ? nA : cA + (size_t)(t + 2) * kstep; const char* b2 = last ? nB : cB + (size_t)(t + 2) * kstep;
            const char* a3 = a2 + kstep; const char* b3 = b2 + kstep;
            PG8_LDB(B0, 0, 0); PG8_LDB(B1, 0, 1); PG8_SCHED; PG8_LDA(At, 0, 0); PG8_STAGE(PG8_SA(1, 1), a1 + hstepA, voffA);
            PG8_WAIT_V(8); PG8_WAIT_L(0); PG8_BAR; PG8_MMA(0, 0, At, B0); PG8_MMA(0, 1, At, B1); PG8_BAR; PG8_SCHED;
            PG8_LDA(At, 0, 1); PG8_STAGE(PG8_SB(0, 0), b2, voffB); PG8_STAGE(PG8_SB(0, 1), b2 + hstepB, voffB); PG8_STAGE(PG8_SA(0, 0), a2, voffA);
            PG8_WAIT_V(8); PG8_WAIT_L(0); PG8_BAR; PG8_MMA(1, 0, At, B0); PG8_MMA(1, 1, At, B1); PG8_BAR; PG8_SCHED;
            PG8_LDB(B0, 1, 0); PG8_LDB(B1, 1, 1); PG8_SCHED; PG8_LDA(At, 1, 0); PG8_STAGE(PG8_SA(0, 1), a2 + hstepA, voffA);
            PG8_WAIT_V(8); PG8_WAIT_L(0); PG8_BAR; PG8_MMA(0, 0, At, B0); PG8_MMA(0, 1, At, B1); PG8_BAR; PG8_SCHED;
            PG8_LDA(At, 1, 1); PG8_STAGE(PG8_SB(1, 0), b3, voffB); PG8_STAGE(PG8_SB(1, 1), b3 + hstepB, voffB); PG8_STAGE(PG8_SA(1, 0), a3, voffA);
            PG8_WAIT_V(8); PG8_WAIT_L(0); PG8_BAR; PG8_MMA(1, 0, At, B0); PG8_MMA(1, 1, At, B1); PG8_BAR; PG8_SCHED;
        }
        if constexpr (ALIGN_EPI) { if (wr == 0) PG8_BAR; }
        E(acc, cur, wr, wc, fr, fq);
        if (!has_next) break;
        if (E.reset_after(cur)) {
#pragma unroll
        for (int a = 0; a < 2; ++a)
#pragma unroll
            for (int b = 0; b < 2; ++b)
#pragma unroll
                for (int m = 0; m < 4; ++m)
#pragma unroll
                    for (int n = 0; n < 2; ++n) acc[a][b][m][n] = (f32x4){zf, zf, zf, zf};
        }
        cur = nxt; cA = nA; cB = nB; ++ui;
        if constexpr (ALIGN_EPI) { if (wr == 1) PG8_BAR; }
    }
    PG8_WAIT_V(0);
    if constexpr (!ALIGN_EPI) { if (wr == 0) PG8_BAR; }
    PG8_BAR;
#undef PG8_SA
#undef PG8_SB
#undef PG8_STAGE
#undef PG8_LDA
#undef PG8_LDB
#undef PG8_MMA
#undef PG8_WAIT_V
#undef PG8_WAIT_L
#undef PG8_BAR
#undef PG8_SCHED
}
}

#include <hip/hip_bf16.h>
#include <cmath>
namespace attn_body {
using bf16=__hip_bfloat16;
using bf16x8=__attribute__((ext_vector_type(8)))short;
using s16x4=__attribute__((ext_vector_type(4)))short;
using f32x16=__attribute__((ext_vector_type(16)))float;
using u32x4=__attribute__((ext_vector_type(4)))unsigned;
using f32x4v=__attribute__((ext_vector_type(4)))float;
constexpr int BATCH=8,NHEAD=8,SEQ=4096,D=64,DM=1536,DMO=512;
constexpr int NW=8,QBLK=32,QB=QBLK*NW,KVBLK=64,NQB=SEQ/QB;
constexpr int ATTN_PITCH=DM, ATTN_UNIT_ROWS=QB;
__device__ __forceinline__ int crow(int r,int hi){return (r&3)+8*(r>>2)+4*hi;}
#define SBAR() __builtin_amdgcn_sched_barrier(0)
__device__ __forceinline__ void cmask(f32x16&p0,f32x16&p1,int jb,int qrel,int hi){
  const float NEG=-INFINITY; int kb=64*jb+4*hi;
  #pragma unroll
  for(int r=0;r<16;++r){int kv=kb+(r&3)+8*(r>>2); if(kv>qrel)p0[r]=NEG; if(kv+32>qrel)p1[r]=NEG;}
}

constexpr int NSLOT=3, SLOTB=8192;
constexpr int LDS_K=0, LDS_V=NSLOT*SLOTB, LDS_WS=2*NSLOT*SLOTB, LDS_OST=LDS_WS+NW*64*4, LDS_F=LDS_OST+NW*4096, LDS_Q=LDS_F+SEQ*4, LDS_BYTES=LDS_Q+NW*4096;
constexpr float PRUNE2=64.f;
constexpr float C2=0.125f*1.4426950408889634f;
__device__ __forceinline__ void glds16(const void*gsrc,unsigned lds_dst){unsigned keep;
  asm volatile("s_mov_b32 %0, m0\n\ts_mov_b32 m0, %2\n\ts_nop 0\n\tglobal_load_lds_dwordx4 %1, off\n\ts_mov_b32 m0, %0":"=&s"(keep):"v"(gsrc),"s"(lds_dst):"memory");}
__device__ __forceinline__ void glds16s(const void*sbase,unsigned voff,unsigned lds_dst){unsigned keep;
  asm volatile("s_mov_b32 %0, m0\n\ts_mov_b32 m0, %3\n\ts_nop 0\n\tglobal_load_lds_dwordx4 %1, %2\n\ts_mov_b32 m0, %0":"=&s"(keep):"v"(voff),"s"(sbase),"s"(lds_dst):"memory");}
__device__ __forceinline__ float max3f(float a,float b,float c){float r;asm("v_max3_f32 %0, %1, %2, %3":"=v"(r):"v"(a),"v"(b),"v"(c));return r;}
__device__ __forceinline__ float max2f(float a,float b){float r;asm("v_max_f32_e32 %0, %1, %2":"=v"(r):"v"(a),"v"(b));return r;}
__device__ __forceinline__ float fadd_s(float a,float b){float r;asm("v_add_f32_e32 %0, %1, %2":"=v"(r):"v"(a),"v"(b));return r;}
__device__ __forceinline__ float fsub_s(float a,float b){float r;asm("v_sub_f32_e32 %0, %1, %2":"=v"(r):"v"(a),"v"(b));return r;}
typedef float f32x2_t __attribute__((ext_vector_type(2))); typedef __bf16 bf16x2_t __attribute__((ext_vector_type(2)));
__device__ __forceinline__ unsigned cvtpk_s(float lo,float hi){f32x2_t v={lo,hi};bf16x2_t b=__builtin_convertvector(v,bf16x2_t);return __builtin_bit_cast(unsigned,b);}
#define WAIT_BAR(N) asm volatile("s_waitcnt vmcnt(" #N ") lgkmcnt(0)\n\ts_barrier":::"memory")

__device__ __forceinline__ void qkt(f32x16&p0,f32x16&p1,const char*Kslot,const bf16x8*qr,int r32,int hi){
  const char*kb=Kslot+hi*1024+r32*16;
  #pragma unroll
  for(int d0=0;d0<4;++d0){
    const bf16x8 b0=*reinterpret_cast<const bf16x8*>(kb+d0*2048);
    const bf16x8 b1=*reinterpret_cast<const bf16x8*>(kb+d0*2048+512);
    {p0=__builtin_amdgcn_mfma_f32_32x32x16_bf16(b0,qr[d0],p0,0,0,0);p1=__builtin_amdgcn_mfma_f32_32x32x16_bf16(b1,qr[d0],p1,0,0,0);}}
}
typedef __attribute__((address_space(3))) const char* lds_cptr;
typedef short v4i16_t __attribute__((ext_vector_type(4)));
__device__ __forceinline__ void kload8(bf16x8*kf,lds_cptr kp){
  kf[0]=*(const __attribute__((address_space(3))) bf16x8*)(kp);      kf[1]=*(const __attribute__((address_space(3))) bf16x8*)(kp+512);
  kf[2]=*(const __attribute__((address_space(3))) bf16x8*)(kp+2048); kf[3]=*(const __attribute__((address_space(3))) bf16x8*)(kp+2560);
  kf[4]=*(const __attribute__((address_space(3))) bf16x8*)(kp+4096); kf[5]=*(const __attribute__((address_space(3))) bf16x8*)(kp+4608);
  kf[6]=*(const __attribute__((address_space(3))) bf16x8*)(kp+6144); kf[7]=*(const __attribute__((address_space(3))) bf16x8*)(kp+6656);
}
__device__ __forceinline__ void kload2(bf16x8*kf,lds_cptr kp,int j){ kf[2*j]=*(const __attribute__((address_space(3))) bf16x8*)(kp+j*2048); kf[2*j+1]=*(const __attribute__((address_space(3))) bf16x8*)(kp+j*2048+512); }
__device__ __forceinline__ s16x4 vtr(lds_cptr p){ return __builtin_bit_cast(s16x4,__builtin_amdgcn_ds_read_tr16_b64_v4i16((__attribute__((address_space(3))) v4i16_t*)p)); }
__device__ __forceinline__ float rowmax(const f32x16&p0,const f32x16&p1){
  float a=max3f(p0[0],p0[1],p1[0]),b=max3f(p0[2],p0[3],p1[1]);a=max3f(a,p1[2],p1[3]);
  #pragma unroll
  for(int r=4;r<16;r+=4){a=max3f(a,p0[r],p0[r+1]);b=max3f(b,p0[r+2],p0[r+3]);a=max3f(a,p1[r],p1[r+1]);b=max3f(b,p1[r+2],p1[r+3]);}
  const float m=max2f(a,b);
  auto rr=__builtin_amdgcn_permlane32_swap(__float_as_uint(m),__float_as_uint(m),false,false);
  return max2f(__uint_as_float(rr[0]),__uint_as_float(rr[1]));
}
__device__ __forceinline__ void pv(f32x16*o,int vb,bf16x8 pa0,bf16x8 pa1,bf16x8 pa2,bf16x8 pa3){
  #pragma unroll
  for(int d0=0;d0<2;++d0){s16x4 lo[4],hi[4];
    #pragma unroll
    for(int ks=0;ks<4;++ks){
      asm volatile("ds_read_b64_tr_b16 %0,%1 offset:%c2":"=&v"(lo[ks]):"v"(vb),"i"(d0*4096+ks*1024):"memory");
      asm volatile("ds_read_b64_tr_b16 %0,%1 offset:%c2":"=&v"(hi[ks]):"v"(vb),"i"(d0*4096+ks*1024+512):"memory");}
    asm volatile("s_waitcnt lgkmcnt(0)":::"memory");SBAR();
    #define PK(k) (bf16x8){lo[k][0],lo[k][1],lo[k][2],lo[k][3],hi[k][0],hi[k][1],hi[k][2],hi[k][3]}
    o[d0]=__builtin_amdgcn_mfma_f32_32x32x16_bf16(pa0,PK(0),o[d0],0,0,0);
    o[d0]=__builtin_amdgcn_mfma_f32_32x32x16_bf16(pa1,PK(1),o[d0],0,0,0);
    o[d0]=__builtin_amdgcn_mfma_f32_32x32x16_bf16(pa2,PK(2),o[d0],0,0,0);
    o[d0]=__builtin_amdgcn_mfma_f32_32x32x16_bf16(pa3,PK(3),o[d0],0,0,0);
    #undef PK
  }
}

#ifndef ATTN_STORE16
#define ATTN_STORE16(p,v) (*(u32x4*)(p)=(v))
#endif
template<int THRL> __device__ __forceinline__ void attn_unit(int b,int h,int qb,const bf16*Q,const bf16*__restrict__ K,const bf16*__restrict__ V,bf16*O,const float*__restrict__ Ftab,char*shm,const int tid){
  const int lane=tid&63,r32=lane&31,hi=lane>>5; const int wid=__builtin_amdgcn_readfirstlane(tid>>6);
  const long rowbase=(long)b*SEQ; const int q0=qb*QB;
  const bf16*Qw=Q+(rowbase+q0+wid*QBLK)*DM+h*D;
  const float*Fh=Ftab+(long)(b*NHEAD+h)*SEQ;
  int ts=0;
  { const int NT0=(q0+QB)/KVBLK; const float fq0=Fh[q0]; const float fk=Fh[(lane<NT0?lane:NT0-1)*KVBLK+KVBLK-1];
    const unsigned long long mk=__ballot(lane<NT0&&(fq0-fk>=-PRUNE2)); const int first=mk?(int)__builtin_ctzll(mk):0; ts=first&~1; if(ts>NT0-4)ts=NT0-4; ts=__builtin_amdgcn_readfirstlane(ts); }
  const bf16*Kh=K+(rowbase+(long)ts*KVBLK)*DM+h*D,*Vh=V+(rowbase+(long)ts*KVBLK)*DM+h*D;
  const unsigned lds0=(unsigned)(uintptr_t)shm;
  float*wsf=(float*)(shm+LDS_WS)+wid*64;
  const unsigned koff=(unsigned)(lane*DM+wid*8)*2u;
  const unsigned voff=(unsigned)((16*(wid&3)+(lane>>2))*DM+(wid>>2)*32+(lane&3)*8)*2u;
  const unsigned kdst=lds0+LDS_K+wid*1024, vdst=lds0+LDS_V+wid*1024;
  #define DMA_K(t,slot) glds16s(Kh+(long)(t)*KVBLK*DM,koff,(unsigned)__builtin_amdgcn_readfirstlane(kdst+(slot)))
  #define DMA_V(t,slot) glds16s(Vh+(long)(t)*KVBLK*DM,voff,(unsigned)__builtin_amdgcn_readfirstlane(vdst+(slot)))
  const int vb0=(int)(lds0+LDS_V)+((lane>>4)&1)*32+(lane&3)*8+(4*hi+((lane&15)>>2))*64;
  const char*Kbase=shm+LDS_K; bf16x8 kf[8];
  const lds_cptr shm3=(lds_cptr)shm; const lds_cptr kp0=shm3+LDS_K+hi*1024+r32*16; const lds_cptr vp0=shm3+LDS_V+((lane>>4)&1)*32+(lane&3)*8+(4*hi+((lane&15)>>2))*64;
  const int NT=(q0+QB)/KVBLK-ts;
  { glds16s(Fh,(unsigned)(lane*16+wid*1024),(unsigned)__builtin_amdgcn_readfirstlane(lds0+LDS_F+wid*1024));
    glds16s(Fh,(unsigned)(lane*16+(wid+8)*1024),(unsigned)__builtin_amdgcn_readfirstlane(lds0+LDS_F+(wid+8)*1024)); }
  const float fq2=Fh[q0+wid*QBLK+r32];
  DMA_K(0,0);DMA_V(0,0);DMA_K(1,SLOTB);
  const lds_cptr qs=(lds_cptr)shm+LDS_Q+wid*4096+(hi*32+r32)*16;
  #pragma unroll
  for(int d0=0;d0<4;++d0)*(__attribute__((address_space(3))) bf16x8*)(qs+d0*1024)=*reinterpret_cast<const bf16x8*>(&Qw[(long)r32*DM+d0*16+hi*8]);
  #define QF(k) (*(const __attribute__((address_space(3))) bf16x8*)(qs+(k)*1024))
  float mhat=-fq2,nm=fq2,l_reg=0.f;f32x16 o[2];o[0]=f32x16{};o[1]=f32x16{};
  const lds_cptr fl0=(lds_cptr)shm+LDS_F+hi*16+ts*256;
  #define FINIT1(C0,t,o_) do{ const __attribute__((address_space(3))) f32x4v* fp_=(const __attribute__((address_space(3))) f32x4v*)(fl0+(t)*256+(o_)); \
    _Pragma("unroll") for(int j_=0;j_<4;++j_){ const f32x4v a_=fp_[2*j_]; \
      C0[4*j_]=nm-a_[0]; C0[4*j_+1]=nm-a_[1]; C0[4*j_+2]=nm-a_[2]; C0[4*j_+3]=nm-a_[3]; } }while(0)
  #define FINIT(C0,C1,t) do{ FINIT1(C0,t,0); FINIT1(C1,t,128); }while(0)
  const int qrel=wid*QBLK+r32;
  #define CMASK(P0,P1,t) do{int jb_=(t)-(NT-4); if(jb_>=0)cmask(P0,P1,jb_,qrel,hi);}while(0)
  bool resc=false;
  #define START(P0,P1) do{ const float rm=rowmax(P0,P1); resc=false; \
    { const float dl=rm; mhat=fadd_s(mhat,dl); \
      _Pragma("unroll") for(int r=0;r<16;++r){P0[r]=fsub_s(P0[r],dl);P1[r]=fsub_s(P1[r],dl);} \
      nm=-mhat; } \
    _Pragma("unroll") for(int r=0;r<16;++r)P0[r]=__builtin_amdgcn_exp2f(P0[r]); }while(0)
  #define RESC() do{ if(resc){ asm volatile("s_waitcnt lgkmcnt(0)":::"memory"); \
      _Pragma("unroll") for(int d_=0;d_<2;++d_) _Pragma("unroll") for(int r=0;r<16;++r)o[d_][r]*=wsf[crow(r,hi)]; } }while(0)
  f32x16 pA0,pA1,pB0,pB1;
  int sl_prev=0,sl_cur=0,sl_next=SLOTB;
  #define ROT() do{sl_prev=sl_cur;sl_cur=sl_next;sl_next=(sl_next==(NSLOT-1)*SLOTB)?0:sl_next+SLOTB;}while(0)
  DMA_K(2,2*SLOTB);
  WAIT_BAR(3);
  { bf16x8 qr[4]; qr[0]=QF(0);qr[1]=QF(1);qr[2]=QF(2);qr[3]=QF(3); FINIT(pA0,pA1,0); qkt(pA0,pA1,Kbase,qr,r32,hi); }asm volatile("s_nop 15\n\ts_nop 7":"+v"(pA0),"+v"(pA1));CMASK(pA0,pA1,0);
  START(pA0,pA1);
  _Pragma("unroll") for(int r=0;r<16;++r)pA1[r]=__builtin_amdgcn_exp2f(pA1[r]);
  WAIT_BAR(0);
  DMA_K(3,0);DMA_V(1,SLOTB);
  ROT();
  kload8(kf,kp0+sl_cur);
  WAIT_BAR(2);
  s16x4 vlo[8],vhi[8]; u32x4 pw0,pw1,pw2,pw3;
  #define PKW(P,B) cvtpk_s(P[B],P[B+1])
  #define PAF(k) __builtin_bit_cast(bf16x8,pw##k)
  #define VFR(i) (bf16x8){vlo[i][0],vlo[i][1],vlo[i][2],vlo[i][3],vhi[i][0],vhi[i][1],vhi[i][2],vhi[i][3]}
  #define PIN(x) asm volatile("":"+v"(x))
  #define MX3(a,b,c) __builtin_fmaxf(__builtin_fmaxf((a),(b)),(c))
  #define GAPA(MF,A0,A1,A2,A3,W0,W1,PW) do{ MF; sacc+=A0; sacc+=A1; sacc+=A2; sacc+=A3; PIN(sacc); W0; W1; PIN(PW); SBAR(); }while(0)
  #define EX(v) __builtin_amdgcn_exp2f(v)
  #define GAPB(MF,X,B) do{ MF; X[B]=EX(X[B]); X[B+1]=EX(X[B+1]); X[B+2]=EX(X[B+2]); X[B+3]=EX(X[B+3]); PIN(X); SBAR(); }while(0)
  #define VRD(i) do{ vlo[i]=vtr(vp_+(((i)>>2)*4096+((i)&3)*1024)); vhi[i]=vtr(vp_+(((i)>>2)*4096+((i)&3)*1024+512)); }while(0)
  #define KRD(G,j) do{ if(G){ kload2(kf,kp0+sl_next,j); SBAR(); } }while(0)
  #define STEP(C0,C1,P0,P1,t,GK,GV,GL) do{ SBAR(); FINIT1(C0,t,0); bf16x8 qA_=QF(0),qB_=QF(1); SBAR(); \
    const lds_cptr vp_=vp0+sl_prev; \
    VRD(0); SBAR(); float sacc=(P0[0]+P0[1]); \
    GAPA(C0=__builtin_amdgcn_mfma_f32_32x32x16_bf16(kf[0],qA_,C0,0,0,0), P0[2],P0[3],P0[4],P0[5],     pw0[0]=PKW(P0,0), pw0[1]=PKW(P0,2), pw0); \
    FINIT1(C1,t,128); SBAR(); VRD(4); SBAR(); GAPA(C1=__builtin_amdgcn_mfma_f32_32x32x16_bf16(kf[1],qA_,C1,0,0,0), P0[6],P0[7],P0[8],P0[9],     pw0[2]=PKW(P0,4), pw0[3]=PKW(P0,6), pw0); \
    qA_=QF(2); VRD(1); SBAR(); GAPA(C0=__builtin_amdgcn_mfma_f32_32x32x16_bf16(kf[2],qB_,C0,0,0,0),   P0[10],P0[11],P0[12],P0[13], pw1[0]=PKW(P0,8), pw1[1]=PKW(P0,10), pw1); \
    VRD(5); SBAR(); GAPA(C1=__builtin_amdgcn_mfma_f32_32x32x16_bf16(kf[3],qB_,C1,0,0,0),   P0[14],P0[15],P1[0],P1[1],   pw1[2]=PKW(P0,12),pw1[3]=PKW(P0,14), pw1); \
    qB_=QF(3); VRD(2); SBAR(); GAPA(C0=__builtin_amdgcn_mfma_f32_32x32x16_bf16(kf[4],qA_,C0,0,0,0),   P1[2],P1[3],P1[4],P1[5],     pw2[0]=PKW(P1,0), pw2[1]=PKW(P1,2), pw2); \
    VRD(6); SBAR(); GAPA(C1=__builtin_amdgcn_mfma_f32_32x32x16_bf16(kf[5],qA_,C1,0,0,0),   P1[6],P1[7],P1[8],P1[9],     pw2[2]=PKW(P1,4), pw2[3]=PKW(P1,6), pw2); \
    VRD(3); SBAR(); GAPA(C0=__builtin_amdgcn_mfma_f32_32x32x16_bf16(kf[6],qB_,C0,0,0,0),   P1[10],P1[11],P1[12],P1[13], pw3[0]=PKW(P1,8), pw3[1]=PKW(P1,10), pw3); \
    VRD(7); SBAR(); GAPA(C1=__builtin_amdgcn_mfma_f32_32x32x16_bf16(kf[7],qB_,C1,0,0,0),   P1[14],P1[15],0.f,0.f,       pw3[2]=PKW(P1,12),pw3[3]=PKW(P1,14), pw3); \
    l_reg+=sacc; \
    if(GK){DMA_K((t)+3,sl_cur);} if(GV){DMA_V((t)+1,sl_next);} \
    CMASK(C0,C1,t); \
    { float a=MX3(C0[0],C0[1],C1[0]),b=MX3(C0[2],C0[3],C1[1]); a=MX3(a,C1[2],C1[3]); \
      _Pragma("unroll") for(int r=4;r<16;r+=4){a=MX3(a,C0[r],C0[r+1]);b=MX3(b,C0[r+2],C0[r+3]);a=MX3(a,C1[r],C1[r+1]);b=MX3(b,C1[r+2],C1[r+3]);} \
      float rm=__builtin_fmaxf(a,b); { auto rr=__builtin_amdgcn_permlane32_swap(__float_as_uint(rm),__float_as_uint(rm),false,false); rm=__builtin_fmaxf(__uint_as_float(rr[0]),__uint_as_float(rr[1])); } \
      resc=false; \
      if(__builtin_expect(__any(rm>(float)THRL),0)){ const float dl=__builtin_fmaxf(rm,0.f); mhat+=dl; \
        _Pragma("unroll") for(int r=0;r<16;++r){C0[r]-=dl;C1[r]-=dl;} \
        nm=-mhat; \
        const float f=__builtin_amdgcn_exp2f(-dl); l_reg*=f; if(hi==0)wsf[r32]=f; resc=true; } } \
    SBAR(); \
    GAPB(o[0]=__builtin_amdgcn_mfma_f32_32x32x16_bf16(PAF(0),VFR(0),o[0],0,0,0), C0,0); \
    GAPB(o[1]=__builtin_amdgcn_mfma_f32_32x32x16_bf16(PAF(0),VFR(4),o[1],0,0,0), C0,4); \
    KRD(GL,0); GAPB(o[0]=__builtin_amdgcn_mfma_f32_32x32x16_bf16(PAF(1),VFR(1),o[0],0,0,0), C0,8); \
    KRD(GL,1); GAPB(o[1]=__builtin_amdgcn_mfma_f32_32x32x16_bf16(PAF(1),VFR(5),o[1],0,0,0), C0,12); \
    KRD(GL,2); GAPB(o[0]=__builtin_amdgcn_mfma_f32_32x32x16_bf16(PAF(2),VFR(2),o[0],0,0,0), C1,0); \
    KRD(GL,3); GAPB(o[1]=__builtin_amdgcn_mfma_f32_32x32x16_bf16(PAF(2),VFR(6),o[1],0,0,0), C1,4); \
    GAPB(o[0]=__builtin_amdgcn_mfma_f32_32x32x16_bf16(PAF(3),VFR(3),o[0],0,0,0), C1,8); \
    GAPB(o[1]=__builtin_amdgcn_mfma_f32_32x32x16_bf16(PAF(3),VFR(7),o[1],0,0,0), C1,12); \
    }while(0)
  int t=1;
  #undef CMASK
  #define CMASK(P0,P1,t) do{}while(0)
  for(;t+5<NT;t+=2){
    STEP(pB0,pB1,pA0,pA1,t,true,true,true);     WAIT_BAR(2); RESC(); ROT();
    STEP(pA0,pA1,pB0,pB1,t+1,true,true,true);   WAIT_BAR(2); RESC(); ROT();
  }
  #undef CMASK
  #define CMASK(P0,P1,t) do{int jb_=(t)-(NT-4); if(jb_>=0)cmask(P0,P1,jb_,qrel,hi);}while(0)
  #define ENDW(tt) do{ if((tt)+3<NT){WAIT_BAR(2);} else if((tt)+2<NT){WAIT_BAR(1);} else {WAIT_BAR(0);} }while(0)
  for(;t+1<NT;t+=2){
    STEP(pB0,pB1,pA0,pA1,t,(t+3<NT),(t+1<NT),(t+1<NT));       ENDW(t);   RESC(); ROT();
    STEP(pA0,pA1,pB0,pB1,t+1,(t+4<NT),(t+2<NT),(t+2<NT));     ENDW(t+1); RESC(); ROT();
  }
  STEP(pB0,pB1,pA0,pA1,NT-1,false,false,false); RESC();
  { float sacc=pB0[0]+pB0[1]; _Pragma("unroll") for(int r=2;r<16;++r)sacc+=pB0[r]; _Pragma("unroll") for(int r=0;r<16;++r)sacc+=pB1[r]; l_reg+=sacc;
    pw0=(u32x4){PKW(pB0,0),PKW(pB0,2),PKW(pB0,4),PKW(pB0,6)};pw1=(u32x4){PKW(pB0,8),PKW(pB0,10),PKW(pB0,12),PKW(pB0,14)};pw2=(u32x4){PKW(pB1,0),PKW(pB1,2),PKW(pB1,4),PKW(pB1,6)};pw3=(u32x4){PKW(pB1,8),PKW(pB1,10),PKW(pB1,12),PKW(pB1,14)};
    SBAR(); pv(o,vb0+sl_cur,PAF(0),PAF(1),PAF(2),PAF(3)); }
  #undef PKW
  #undef PAF
  #undef VFR
  #undef PIN
  #undef MX3
  #undef GAPA
  #undef GAPB
  #undef EX
  #undef VRD
  #undef KRD
  #undef STEP
  #undef ENDW
  {auto rr=__builtin_amdgcn_permlane32_swap(__float_as_uint(l_reg),__float_as_uint(l_reg),false,false);l_reg=__uint_as_float(rr[0])+__uint_as_float(rr[1]);}
  if(hi==0)wsf[32+r32]=l_reg;asm volatile("s_waitcnt lgkmcnt(0)":::"memory");
  float rli[16];
  #pragma unroll
  for(int r=0;r<16;++r)rli[r]=__builtin_amdgcn_rcpf(wsf[32+crow(r,hi)]);
  bf16*Ow=O+(rowbase+q0+wid*QBLK)*DMO+h*D;
  { bf16*stg=(bf16*)(shm+LDS_OST)+wid*2048;
    #pragma unroll
    for(int r=0;r<16;++r){const int orow=crow(r,hi);
      #pragma unroll
      for(int d0=0;d0<2;++d0)stg[orow*64+d0*32+r32]=__float2bfloat16(o[d0][r]*rli[r]);}
    asm volatile("s_waitcnt lgkmcnt(0)":::"memory");
    #pragma unroll
    for(int i=0;i<4;++i){const int row=i*8+(lane>>3),ch=lane&7; const u32x4 v=*(const u32x4*)(stg+row*64+ch*8); ATTN_STORE16(Ow+(long)row*DMO+ch*8,v);} }
  asm volatile("s_waitcnt lgkmcnt(0)\n\ts_barrier":::"memory");
  #undef DMA_K
  #undef DMA_V
  #undef CMASK
  #undef START
  #undef RESC
  #undef FINIT
  #undef QF
  #undef FINIT1
  #undef ROT
}
constexpr int ATTN_LDS_BYTES=LDS_BYTES;
struct AttnTensors { const bf16* Q; const bf16* K; const bf16* V; bf16* O; const float* F; };
#undef SBAR
#undef WAIT_BAR
}

constexpr int NWAVES = 8;
constexpr int BATCH = 8, SEQ = 4096, D = 1024, T = BATCH * SEQ, NL = 4;
constexpr int BW = 512, INTOT = 7184, NIN = 7168;
constexpr int MH = 4, MDH = 128, AH = 8, ADH = 64, S5G = 32, S5C = 16, S5P = 64, S5L = 32  , S5K = 640;
constexpr int NEXP = 32, EH = 512, MOE_ROWS = 73728  , MOE_NBLK_MAX = 288;
constexpr float LN_EPS = 1e-5f;
constexpr float ALPHA = 1.6817928305074290f;
constexpr float C2 = 0.125f * 1.4426950408889634f;
constexpr float LOG2E = 1.4426950408889634f;
constexpr int NPH_LAYER = 13, NPHASES = 1 + NL * NPH_LAYER;

constexpr size_t MiB = 1u << 20;
constexpr size_t WS_CTL = 0, CTL_ZERO_BYTES = 65536;
constexpr size_t WS_S5TAB = 2 * MiB;
constexpr size_t WS_MSC = 2 * MiB + 65536;
constexpr size_t WS_WSM = 2 * MiB + 131072;
constexpr size_t WS_NST = 3 * MiB;
constexpr size_t WS_WIN = 4 * MiB, WS_WGLU = 18 * MiB, WS_WBR = 19 * MiB, WS_WOUT = 22 * MiB, WS_WGU = 24 * MiB, WS_WDN = 88 * MiB;
constexpr size_t WS_XB = 148 * MiB;
constexpr size_t WS_MQK = 212 * MiB, WS_QK = 276 * MiB, WS_MV = 340 * MiB, WS_MO = 372 * MiB, WS_S5A = 404 * MiB, WS_AQKV = 444 * MiB, WS_GATE = 540 * MiB;
constexpr size_t WS_YS1 = WS_MQK, WS_MIXED = WS_QK;
constexpr size_t WS_XG = 212 * MiB, WS_HB = 356 * MiB, WS_YB = 428 * MiB;
constexpr size_t WS_YTALL = 732 * MiB, WS_CST = 828 * MiB, WS_EBUF = 892 * MiB, WS_SG = 908 * MiB, WS_FTAB = 910 * MiB, WS_MLU = 911 * MiB, WS_ROUTE = 913 * MiB, WS_TOKPOS = 914 * MiB, WS_S5ALL = 916 * MiB  , S5_LAYER_BYTES = 28 * MiB, WS_END = 1028 * MiB;
static_assert(WS_XG + (size_t)MOE_ROWS * 1024 * 2 <= WS_HB && WS_HB + (size_t)MOE_ROWS * 512 * 2 <= WS_YB && WS_YB + (size_t)2 * T * 1024 * 2 <= WS_YTALL, "moe overlay");
static_assert(WS_S5A + (size_t)32 * 1024 * 640 * 2 <= WS_AQKV && WS_GATE + (size_t)T * 3072 * 2 <= WS_YTALL, "region A");
constexpr int CW_TMO = 0, CW_CODE = 1, CW_BAR = 4096, CW_GCNT = 8192, CW_AQ = 8704;

constexpr int RING_OFF = 0, RING_BYTES = 131072;
constexpr int LDS_BYTES = 163840;
constexpr int LDSX_OFF = RING_BYTES;
constexpr int LDSCTL_OFF = 162816, MISC_OFF = LDSCTL_OFF + 320;

#define GAS __attribute__((address_space(1)))
#define LAS __attribute__((address_space(3)))
typedef unsigned short bf16;
typedef unsigned v4u __attribute__((ext_vector_type(4)));
typedef unsigned v2u __attribute__((ext_vector_type(2)));
typedef float f32x4 __attribute__((ext_vector_type(4)));
typedef float f32x16 __attribute__((ext_vector_type(16)));
typedef short bf16x8 __attribute__((ext_vector_type(8)));
typedef GAS unsigned gu32;
#define RLX_AGENT __ATOMIC_RELAXED, __HIP_MEMORY_SCOPE_AGENT
#define LDS_WAIT() asm volatile("s_waitcnt lgkmcnt(0)" ::: "memory")
#define VM_WAIT() asm volatile("s_waitcnt vmcnt(0)" ::: "memory")
__device__ __forceinline__ unsigned f2bf(float f) { unsigned u = __builtin_bit_cast(unsigned, f); return (u + 0x7fffu + ((u >> 16) & 1u)) >> 16; }
__device__ __forceinline__ unsigned pk2(float lo, float hi) { return f2bf(lo) | (f2bf(hi) << 16); }
__device__ __forceinline__ float bflo(unsigned u) { return __uint_as_float(u << 16); }
__device__ __forceinline__ float bfhi(unsigned u) { return __uint_as_float(u & 0xffff0000u); }
__device__ __forceinline__ float bf2f(bf16 v) { return __uint_as_float((unsigned)v << 16); }
__device__ __forceinline__ float sigmoidf_(float x) { return 1.f / (1.f + __expf(-x)); }

__device__ __forceinline__ int lane_id() { int l; asm volatile("v_mbcnt_lo_u32_b32 %0, -1, 0\n\tv_mbcnt_hi_u32_b32 %0, -1, %0" : "=v"(l)); return l; }
#define XB_TMO      128
#define XB_XCNT(j)  (256  + 64 * (j))
#define XB_XSUB(j)  (1280 + 64 * (j))
#define XB_XGEN(j)  (2304 + 64 * (j))
#define XB_TOP      3328
#define XB_TOPGEN   3392
#define XCD_BAR_WORDS 3456
#define XB_SPIN_CAP (1u << 18)
__device__ __forceinline__ unsigned xb_ld(unsigned* p)              { return __hip_atomic_load(p, __ATOMIC_RELAXED, __HIP_MEMORY_SCOPE_AGENT); }
__device__ __forceinline__ unsigned xb_add(unsigned* p, unsigned v) { return __hip_atomic_fetch_add(p, v, __ATOMIC_RELAXED, __HIP_MEMORY_SCOPE_AGENT); }
__device__ __forceinline__ unsigned xb_xcc_id() { return (unsigned)__builtin_amdgcn_s_getreg((3 << 11) | 20) & 0xFu; }
#define XB_SPIN(cond, bar) do { unsigned _sp = 0; while (cond) { __builtin_amdgcn_s_sleep(1); \
    if ((++_sp & 255u) == 0u) { if (xb_ld(&(bar)[XB_TMO])) break; if (_sp > XB_SPIN_CAP) { atomicAdd(&(bar)[XB_TMO], 1u); break; } } } } while (0)
struct XcdBarrier { unsigned* bar; unsigned x; volatile LAS unsigned* st; };
__device__ __forceinline__ XcdBarrier xcd_barrier_post(unsigned* bar, volatile LAS unsigned* st, bool leader) {
    XcdBarrier b; b.bar = bar; b.x = xb_xcc_id(); b.st = st;
    if (leader) (void)xb_add(&bar[XB_XCNT(b.x)], 1u);
    return b;
}
__device__ __forceinline__ void xcd_barrier_complete(unsigned* bar, unsigned x, unsigned& nloc, unsigned& nx) {
    const unsigned G = gridDim.x * gridDim.y * gridDim.z;
    unsigned sum, cnt, mine, sp = 0u;
    for (;;) {
        sum = 0u; cnt = 0u; mine = 0u;
#pragma unroll
        for (unsigned j = 0; j < 16; ++j) { const unsigned c = xb_ld(&bar[XB_XCNT(j)]); sum += c; cnt += (c > 0u) ? 1u : 0u; mine = (j == x) ? c : mine; }
        if (sum == G) break;
        __builtin_amdgcn_s_sleep(1);
        if ((++sp & 255u) == 0u) { if (xb_ld(&bar[XB_TMO])) break; if (sp > XB_SPIN_CAP) { atomicAdd(&bar[XB_TMO], 1u); break; } }
    }
    nloc = mine > 0u ? mine : 1u; nx = cnt > 0u ? cnt : 1u;
}
__device__ __forceinline__ void xcd_barrier(const XcdBarrier& b, bool leader) {
    asm volatile("s_waitcnt vmcnt(0)" ::: "memory");
    __syncthreads();
    if (leader) {
        unsigned* bar = b.bar;
        __builtin_amdgcn_s_waitcnt(0);
        unsigned nloc = b.st[0], nx = b.st[1];
        if (nloc == 0u) { xcd_barrier_complete(bar, b.x, nloc, nx); b.st[0] = nloc; b.st[1] = nx; }
        const unsigned old = xb_add(&bar[XB_XSUB(b.x)], 1u);
        const unsigned gen = old / nloc;
        if (old + 1u == (gen + 1u) * nloc) {
            __builtin_amdgcn_fence(__ATOMIC_RELEASE, "agent");
            asm volatile("s_waitcnt vmcnt(0)" ::: "memory");
            const unsigned og = xb_add(&bar[XB_TOP], 1u);
            const unsigned tg = og / nx;
            if (og + 1u == (tg + 1u) * nx) xb_add(&bar[XB_TOPGEN], 1u);
            else XB_SPIN(xb_ld(&bar[XB_TOPGEN]) == tg, bar);
            __builtin_amdgcn_fence(__ATOMIC_ACQUIRE, "agent");
            xb_add(&bar[XB_XGEN(b.x)], 1u);
            asm volatile("s_waitcnt vmcnt(0)" ::: "memory");
        } else {
            XB_SPIN(xb_ld(&bar[XB_XGEN(b.x)]) == gen, bar);
            __builtin_amdgcn_fence(__ATOMIC_ACQUIRE, "agent");
            asm volatile("s_waitcnt vmcnt(0)" ::: "memory");
        }
    }
    __syncthreads();
}

enum InIdx { I_x, I_w_in, I_b_in, I_m_conv_w, I_m_conv_b, I_m_norm_w, I_s5_lam_re, I_s5_lam_im, I_s5_log_dt, I_s5_b_re, I_s5_b_im, I_s5_c_re, I_s5_c_im, I_s5_d, I_s5_w_glu, I_s5_b_glu, I_w_branch, I_w_out, I_ln1_g, I_ln1_b, I_w_rg, I_b_rg, I_w_re, I_b_re, I_moe_wg, I_moe_wu, I_moe_wd, I_ln2_g, I_ln2_b };
struct Args { const float* in[29]; float* out; unsigned char* ws; int ph_lo, ph_hi, sub, pad; };
typedef const __attribute__((address_space(4))) Args* KArgs;
struct Frame {
    LAS unsigned char* lds; unsigned char* ldsg;
    gu32* ctl;
    unsigned char* ws;
    int tid, lane, wave, vcu, G, bx;
    float* out;
    KArgs ka;
};
template <int O> __device__ __forceinline__ float shx(float v) { static_assert(O >= 1 && O < 32, "xor mask inside a 32-lane half"); return __int_as_float(__builtin_amdgcn_ds_swizzle(__float_as_int(v), (O << 10) | 0x1f)); }
__device__ __forceinline__ float half_swap_add(float v) { auto rr = __builtin_amdgcn_permlane32_swap(__float_as_uint(v), __float_as_uint(v), false, false); return __uint_as_float(rr[0]) + __uint_as_float(rr[1]); }
__device__ __forceinline__ float half_swap_max(float v) { auto rr = __builtin_amdgcn_permlane32_swap(__float_as_uint(v), __float_as_uint(v), false, false); return fmaxf(__uint_as_float(rr[0]), __uint_as_float(rr[1])); }
__device__ __forceinline__ float wave_sum(float v) { v += shx<1>(v); v += shx<2>(v); v += shx<4>(v); v += shx<8>(v); v += shx<16>(v); return half_swap_add(v); }
__device__ __forceinline__ float wave_max(float v) { v = fmaxf(v, shx<1>(v)); v = fmaxf(v, shx<2>(v)); v = fmaxf(v, shx<4>(v)); v = fmaxf(v, shx<8>(v)); v = fmaxf(v, shx<16>(v)); return half_swap_max(v); }
#define JR_STEP(p, NH, M, bit) _Pragma("unroll") for (int i_ = 0; i_ < (NH); ++i_) { const float send_ = (bit) ? p[i_] : p[i_ + (NH)]; const float keep_ = (bit) ? p[i_ + (NH)] : p[i_]; p[i_] = keep_ + shx<M>(send_); }
__device__ __forceinline__ float rdlane(float v, int l) { return __int_as_float(__builtin_amdgcn_readlane(__float_as_int(v), l)); }
__device__ __forceinline__ float lane_get(float v, int srclane) { return __int_as_float(__builtin_amdgcn_ds_bpermute(srclane << 2, __float_as_int(v))); }
__device__ __forceinline__ float log_sigmoid(float x) { return fminf(x, 0.f) - log1pf(expf(-fabsf(x))); }

__device__ __forceinline__ void transpose_item(const float* Wsrc, int ldw, bf16* WTdst, int ldt, LAS float* scr, int lane) {
#pragma unroll 8
    for (int i = 0; i < 32; ++i) { const int kk = 2 * i + (lane >> 5); scr[kk * 33 + (lane & 31)] = Wsrc[(size_t)kk * ldw + (lane & 31)]; }
    LDS_WAIT(); asm volatile("" ::: "memory");
    const int c = lane & 7;
#pragma unroll
    for (int j = 0; j < 4; ++j) { const int n = (lane >> 3) + 8 * j; const LAS float* s = scr + (8 * c) * 33 + n;
        v4u o; o.x = pk2(s[0 * 33], s[1 * 33]); o.y = pk2(s[2 * 33], s[3 * 33]); o.z = pk2(s[4 * 33], s[5 * 33]); o.w = pk2(s[6 * 33], s[7 * 33]);
        *(GAS v4u*)(WTdst + (size_t)n * ldt + 8 * c) = o; }
    LDS_WAIT(); asm volatile("" ::: "memory");
}
__device__ __forceinline__ int in_srccol(int c) { return c + (c >= 4096 ? 16 : (c >= 2048 ? 8 : 0)); }

__device__ __forceinline__ void sincos_d(double ang, float& s, float& c) {
    double inv2pi = 0.15915494309189535, twopi = 6.283185307179586476925; asm volatile("" : "+v"(inv2pi), "+v"(twopi));
    const double k = rint(ang * inv2pi); const float r = (float)(ang - k * twopi);
    const float q = rintf(r * 0.6366197723675814f); float y = fmaf(q, -1.57079637050628662109375f, r); y = fmaf(q, 4.371139000186241e-8f, y); const float y2 = y * y;
    float sp = 2.7557319e-6f; sp = sp * y2 - 1.9841270e-4f; sp = sp * y2 + 8.3333333e-3f; sp = sp * y2 - 1.6666667e-1f; sp = y + y * y2 * sp;
    float cp = -2.7557319e-7f; cp = cp * y2 + 2.4801587e-5f; cp = cp * y2 - 1.3888889e-3f; cp = cp * y2 + 4.1666667e-2f; cp = cp * y2 - 0.5f; cp = 1.f + y2 * cp;
    const int qi = ((int)q) & 3; s = (qi == 0) ? sp : (qi == 1) ? cp : (qi == 2) ? -sp : -cp; c = (qi == 0) ? cp : (qi == 1) ? -sp : (qi == 2) ? -cp : sp;
}
__device__ __forceinline__ void s5_build_group(Frame& F, int l, int g) {
    LAS float* AP = (LAS float*)(F.lds);
    LAS float* BB = AP + 33 * 64 * 2;
    LAS float* CC = BB + 64 * 16 * 2;
    LAS float* KT = CC + 16 * 64 * 2;
    LAS float* DD = KT + 32 * 256;
    const int tid = F.tid;
    const float* lre = F.ka->in[I_s5_lam_re] + ((size_t)l * S5G + g) * S5P; const float* lim = F.ka->in[I_s5_lam_im] + ((size_t)l * S5G + g) * S5P;
    const double dt = (double)expf(F.ka->in[I_s5_log_dt][l * S5G + g]);
    for (int i = tid; i < 33 * 64; i += 512) { const int tau = i >> 6, p = i & 63; const double lr = lre[p], li = lim[p];
        const float mag = expf((float)(lr * dt * tau)); float sn, cs; sincos_d(li * dt * tau, sn, cs); AP[i * 2] = mag * cs; AP[i * 2 + 1] = mag * sn; }
    for (int i = tid; i < 64 * 16; i += 512) { const int p = i >> 4, ci = i & 15; const double lr = lre[p], li = lim[p];
        float sn, cs; sincos_d(li * dt, sn, cs); const double mag = (double)expf((float)(lr * dt)), ar = mag * cs, ai = mag * sn, den = lr * lr + li * li, nr = ar - 1.0, ni = ai;
        const double zr = (nr * lr + ni * li) / den, zi = (ni * lr - nr * li) / den;
        const size_t bi = (((size_t)l * S5G + g) * S5P + p) * S5C + ci; const double br = F.ka->in[I_s5_b_re][bi], bim = F.ka->in[I_s5_b_im][bi];
        BB[i * 2] = (float)(zr * br - zi * bim); BB[i * 2 + 1] = (float)(zr * bim + zi * br); }
    for (int i = tid; i < 16 * 64; i += 512) { const size_t ci_ = ((size_t)l * S5G + g) * S5C * S5P + i; CC[i * 2] = F.ka->in[I_s5_c_re][ci_]; CC[i * 2 + 1] = F.ka->in[I_s5_c_im][ci_]; }
    if (tid < 16) DD[tid] = F.ka->in[I_s5_d][(l * S5G + g) * S5C + tid];
    __syncthreads();
    for (int i = tid; i < 32 * 256; i += 512) { const int tau = i >> 8, co = (i >> 4) & 15, ci = i & 15; float s = 0.f;
        for (int p = 0; p < 64; ++p) { const float cr = CC[(co * 64 + p) * 2], cim = CC[(co * 64 + p) * 2 + 1], ar = AP[(tau * 64 + p) * 2], ai = AP[(tau * 64 + p) * 2 + 1];
            const float xr = cr * ar - cim * ai, xi = cr * ai + cim * ar; s += xr * BB[(p * 16 + ci) * 2] - xi * BB[(p * 16 + ci) * 2 + 1]; }
        KT[i] = s; }
    if (tid < 64) { float* tab = (float*)(F.ws + WS_S5TAB) + ((l * 32 + g) * 64 + tid) * 2; tab[0] = AP[(32 * 64 + tid) * 2]; tab[1] = AP[(32 * 64 + tid) * 2 + 1]; }
    __syncthreads();
    bf16* MP = (bf16*)(F.ws + WS_S5ALL + (size_t)l * S5_LAYER_BYTES) + (size_t)g * 512 * S5K;
    for (int i = tid; i < 512 * (S5K / 8); i += 512) { const int n = i / (S5K / 8), k0 = (i % (S5K / 8)) * 8, tq = n >> 4, co = n & 15; float v[8];
#pragma unroll
        for (int j = 0; j < 8; ++j) { const int k = k0 + j; float x;
            if (k < 512) { const int sq = k >> 4, ci = k & 15; x = (tq >= sq) ? KT[((tq - sq) * 16 + co) * 16 + ci] : 0.f; if (tq == sq && co == ci) x += DD[co]; }
            else { const int p = (k - 512) & 63; const float cr = CC[(co * 64 + p) * 2], cim = CC[(co * 64 + p) * 2 + 1], ar = AP[((tq + 1) * 64 + p) * 2], ai = AP[((tq + 1) * 64 + p) * 2 + 1];
                x = (k < 576) ? (cr * ar - cim * ai) : -(cr * ai + cim * ar); }
            v[j] = x; }
        v4u o; o.x = pk2(v[0], v[1]); o.y = pk2(v[2], v[3]); o.z = pk2(v[4], v[5]); o.w = pk2(v[6], v[7]);
        *(GAS v4u*)(MP + (size_t)n * S5K + k0) = o; }
    bf16* GG = (bf16*)(F.ws + WS_S5ALL + (size_t)l * S5_LAYER_BYTES + 20 * MiB) + (size_t)g * 256 * 512;
    for (int i = tid; i < 256 * 64; i += 512) { const int n = i >> 6, k0 = (i & 63) * 8; float v[8];
#pragma unroll
        for (int j = 0; j < 8; ++j) { const int k = k0 + j, sq = k >> 4, ci = k & 15; float x = 0.f;
            if (n < 128) { const int p = n & 63; const float ar = AP[((31 - sq) * 64 + p) * 2], ai = AP[((31 - sq) * 64 + p) * 2 + 1], br = BB[(p * 16 + ci) * 2], bim = BB[(p * 16 + ci) * 2 + 1];
                x = (n < 64) ? (ar * br - ai * bim) : (ar * bim + ai * br); }
            v[j] = x; }
        v4u o; o.x = pk2(v[0], v[1]); o.y = pk2(v[2], v[3]); o.z = pk2(v[4], v[5]); o.w = pk2(v[6], v[7]);
        *(GAS v4u*)(GG + (size_t)n * 512 + k0) = o; }
    __syncthreads();
}

__device__ __forceinline__ void small_w_prep(Frame& F, int l);
__device__ __forceinline__ void weight_prep(Frame& F, int l) {
    if (F.vcu == F.G - 1) small_w_prep(F, l);
    LAS float* scr = (LAS float*)(F.lds + RING_OFF + F.wave * 16384);
    const int gw = F.vcu * NWAVES + F.wave, NGW = F.G * NWAVES;
    constexpr int I_IN = (NIN / 32) * 16, I_GLU = 16 * 8, I_BR = 3 * 32 * 8, I_OUT = 32 * 16, I_G = NEXP * 16 * 16, I_D = NEXP * 32 * 8;
    constexpr int NITEMS = I_IN + I_GLU + I_BR + I_OUT + 2 * I_G + I_D;
    for (int it = gw; it < NITEMS; it += NGW) {
        int r = it;
        if (r < I_IN) { const int nb = r >> 4, kb = r & 15; transpose_item(F.ka->in[I_w_in] + (size_t)l * D * INTOT + (size_t)(64 * kb) * INTOT + in_srccol(32 * nb), INTOT, (bf16*)(F.ws + WS_WIN) + (size_t)(32 * nb) * 1024 + 64 * kb, 1024, scr, F.lane); continue; } r -= I_IN;
        if (r < I_GLU) { const int nb = r >> 3, kb = r & 7; transpose_item(F.ka->in[I_s5_w_glu] + (size_t)l * 512 * 512 + (size_t)(64 * kb) * 512 + 32 * nb, 512, (bf16*)(F.ws + WS_WGLU) + (size_t)(32 * nb) * 512 + 64 * kb, 512, scr, F.lane); continue; } r -= I_GLU;
        if (r < I_BR) { const int br = r >> 8, nb = (r >> 3) & 31, kb = r & 7; transpose_item(F.ka->in[I_w_branch] + ((size_t)l * 3 + br) * 512 * 1024 + (size_t)(64 * kb) * 1024 + 32 * nb, 1024, (bf16*)(F.ws + WS_WBR) + (size_t)(br * 1024 + 32 * nb) * 512 + 64 * kb, 512, scr, F.lane); continue; } r -= I_BR;
        if (r < I_OUT) { const int nb = r >> 4, kb = r & 15; transpose_item(F.ka->in[I_w_out] + (size_t)l * 1024 * 1024 + (size_t)(64 * kb) * 1024 + 32 * nb, 1024, (bf16*)(F.ws + WS_WOUT) + (size_t)(32 * nb) * 1024 + 64 * kb, 1024, scr, F.lane); continue; } r -= I_OUT;
        if (r < 2 * I_G) { const int up = r >= I_G; if (up) r -= I_G; const int e = r >> 8, nb = (r >> 4) & 15, kb = r & 15;
            const float* src = (up ? F.ka->in[I_moe_wu] : F.ka->in[I_moe_wg]) + ((size_t)l * NEXP + e) * 1024 * 512 + (size_t)(64 * kb) * 512 + 32 * nb; const int n0 = 32 * nb;
            transpose_item(src, 512, (bf16*)(F.ws + WS_WGU) + (size_t)(e * 1024 + (n0 >> 7) * 256 + up * 128 + (n0 & 127)) * 1024 + 64 * kb, 1024, scr, F.lane); continue; } r -= 2 * I_G;
        { const int e = r >> 8, nb = (r >> 3) & 31, kb = r & 7;
            transpose_item(F.ka->in[I_moe_wd] + ((size_t)l * NEXP + e) * 512 * 1024 + (size_t)(64 * kb) * 1024 + 32 * nb, 1024, (bf16*)(F.ws + WS_WDN) + (size_t)(e * 1024 + 32 * nb) * 512 + 64 * kb, 512, scr, F.lane); }
    }
}

__device__ __forceinline__ void small_gates_mfma(Frame& F, int l) {
    const int gw = F.vcu * NWAVES + F.wave, lane = F.lane, r = lane & 15, kg = lane >> 4;
    if (gw * 16 >= T) return;
    const bf16* __restrict__ A = (const bf16*)(F.ws + WS_XB) + (size_t)(gw * 16 + r) * D + 8 * kg; const bf16* __restrict__ B = (const bf16*)(F.ws + WS_WSM) + (size_t)r * D + 8 * kg;
    f32x4 acc = {0.f, 0.f, 0.f, 0.f};
#pragma unroll 8
    for (int ks = 0; ks < 32; ++ks) { const bf16x8 a = *(const GAS bf16x8*)(A + 32 * ks), b = *(const GAS bf16x8*)(B + 32 * ks); acc = __builtin_amdgcn_mfma_f32_16x16x32_bf16(a, b, acc, 0, 0, 0); }
    const float bias = F.ka->in[I_b_in][(size_t)l * INTOT + (r < 8 ? 2048 + r : 4104 + (r - 8))];
    float* sg = (float*)(F.ws + WS_SG) + (size_t)(gw * 16 + 4 * kg) * 16 + r;
#pragma unroll
    for (int i = 0; i < 4; ++i) sg[i * 16] = acc[i] + bias;
}
__device__ __forceinline__ void small_w_prep(Frame& F, int l) {
    const float* w = F.ka->in[I_w_in] + (size_t)l * D * INTOT; bf16* o = (bf16*)(F.ws + WS_WSM);
    for (int i = F.tid; i < 1024 * 16; i += 512) { const int k = i >> 4, j = i & 15; o[j * 1024 + k] = (bf16)f2bf(w[(size_t)k * INTOT + (j < 8 ? 2048 + j : 4104 + (j - 8))]); }
}

__device__ __forceinline__ void phase_p0(Frame& F) {
    if (F.vcu < NL * S5G) s5_build_group(F, F.vcu >> 5, F.vcu & 31);
    weight_prep(F, 0);
    const int gw = F.vcu * NWAVES + F.wave, NGW = F.G * NWAVES;
    f32x4 nv[4];
    { const GAS f32x4* x0 = (const GAS f32x4*)(F.ka->in[I_x] + (size_t)gw * D) + F.lane;
#pragma unroll
      for (int j = 0; j < 4; ++j) nv[j] = x0[64 * j]; }
    for (int m = gw; m < T; m += NGW) {
        f32x4 v[4];
#pragma unroll
        for (int j = 0; j < 4; ++j) v[j] = nv[j];
        if (m + NGW < T) { const GAS f32x4* xn = (const GAS f32x4*)(F.ka->in[I_x] + (size_t)(m + NGW) * D) + F.lane;
#pragma unroll
            for (int j = 0; j < 4; ++j) nv[j] = xn[64 * j]; }
        GAS v2u* o8 = (GAS v2u*)((bf16*)(F.ws + WS_XB) + (size_t)m * D) + F.lane;
#pragma unroll
        for (int j = 0; j < 4; ++j) { v2u o; o.x = pk2(v[j].x, v[j].y); o.y = pk2(v[j].z, v[j].w); o8[64 * j] = o; }
    }
    __syncthreads();
}

struct EpiInProj {
    static constexpr bool PERM = true;
    unsigned char* ws; const float* bias;
    __device__ __forceinline__ bool reset_after(const pg8::Unit&) const { return true; }
    __device__ __forceinline__ void operator()(pg8::f32x4 (&acc)[2][2][4][2], const pg8::Unit& u, int wr, int wc, int fr, int fq) const {
        using namespace pg8;
        const int pn = u.pn, row0 = u.pm * BM + wr * 64 + fr;
        int mode, pitch, cofs; size_t base;
        if (pn < 4) { mode = 0; base = WS_MQK; pitch = 1024; cofs = 0; }
        else if (pn < 6) { mode = 0; base = WS_MV; pitch = 512; cofs = 1024; }
        else if (pn < 8) { mode = 1; base = WS_MO; pitch = 512; cofs = 1536; }
        else if (pn < 10) { mode = 3; base = WS_S5A; pitch = 0; cofs = 2048; }
        else if (pn < 16) { mode = (pn < 12) ? 2 : 0; base = WS_AQKV; pitch = 1536; cofs = 2560; }
        else { mode = 4; base = WS_GATE; pitch = 3072; cofs = 4096; }
        bf16_t* O = (bf16_t*)(ws + base);
#pragma unroll
        for (int bj = 0; bj < 2; ++bj) {
            const int col0 = pn * BM + bj * HALF + wc * 32 + 8 * fq;
            const int sc = in_srccol(col0);
            const f32x4 b0 = *(const f32x4*)(bias + sc), b1 = *(const f32x4*)(bias + sc + 4);
            const int cl = col0 - cofs;
#pragma unroll
            for (int ai = 0; ai < 2; ++ai)
#pragma unroll
                for (int m = 0; m < 4; ++m) {
                    const int row = row0 + ai * HALF + m * 16;
                    f32x4 v0 = acc[ai][bj][m][0] + b0, v1 = acc[ai][bj][m][1] + b1;
                    if (mode == 1) {
#pragma unroll
                        for (int i = 0; i < 4; ++i) { v0[i] = 1.f / (1.f + __expf(-v0[i])); v1[i] = 1.f / (1.f + __expf(-v1[i])); }
                    } else if (mode == 2) { v0 = v0 * C2; v1 = v1 * C2; }
                    else if (mode == 4) {
#pragma unroll
                        for (int i = 0; i < 4; ++i) { v0[i] = __expf(fminf(fmaxf(-v0[i], -30.f), 30.f)); v1[i] = __expf(fminf(fmaxf(-v1[i], -30.f), 30.f)); }
                    }
                    u32x4 w; w.x = cvt_pk_bf16(v0[0], v0[1]); w.y = cvt_pk_bf16(v0[2], v0[3]); w.z = cvt_pk_bf16(v1[0], v1[1]); w.w = cvt_pk_bf16(v1[2], v1[3]);
                    size_t off;
                    if (mode == 3) { const int g = cl >> 4; off = ((size_t)(g * 1024 + (row >> 5)) * S5K) + (row & 31) * 16 + (cl & 15); }
                    else off = (size_t)row * pitch + cl;
                    *(u32x4*)(O + off) = w;
                }
        }
    }
};

__device__ __forceinline__ float wave_incl_scan_add(float v, int lane) {
#pragma unroll
    for (int o = 1; o < 64; o <<= 1) { const float t = lane_get(v, (lane - o) & 63); if (lane >= o) v += t; }
    return v;
}
__device__ __forceinline__ float wave_incl_scan_max(float v, int lane) {
#pragma unroll
    for (int o = 1; o < 64; o <<= 1) { const float t = lane_get(v, (lane - o) & 63); if (lane >= o) v = fmaxf(v, t); }
    return v;
}
__device__ __forceinline__ float lane63(float v) { return __int_as_float(__builtin_amdgcn_readlane(__float_as_int(v), 63)); }
__device__ __forceinline__ void phase_prep2(Frame& F, int l) {
    const int lane = F.lane;
    const float* __restrict__ SG = (const float*)(F.ws + WS_SG);
    if (F.wave == 0 && F.vcu < 64) {
        const int sq = F.vcu, b = sq >> 3, h = sq & 7; float carry = 0.f; float* __restrict__ FT = (float*)(F.ws + WS_FTAB) + (size_t)sq * SEQ;
#pragma unroll 1
        for (int blk = 0; blk < SEQ / 1024; ++blk) { float x[16];
#pragma unroll
            for (int i = 0; i < 16; ++i) x[i] = SG[(size_t)(b * SEQ + blk * 1024 + i * 64 + lane) * 16 + 8 + h];
#pragma unroll
            for (int i = 0; i < 16; ++i) { const float c = wave_incl_scan_add(log_sigmoid(x[i]), lane) + carry; FT[blk * 1024 + i * 64 + lane] = c * LOG2E; carry = lane63(c); } }
    } else if (F.wave == 0 && F.vcu < 96) {
        const int bh = F.vcu - 64, b = bh >> 2, h = bh & 3; float mprev = 0.f;
        float* __restrict__ MU = (float*)(F.ws + WS_MLU) + (size_t)bh * SEQ; float* __restrict__ MM = MU + (size_t)32 * SEQ; float* __restrict__ MB = MM + (size_t)32 * SEQ;
        float* __restrict__ MSC = (float*)(F.ws + WS_MSC) + bh * 64;
#pragma unroll 1
        for (int blk = 0; blk < 4; ++blk) { float xi[16], xf[16];
#pragma unroll
            for (int i = 0; i < 16; ++i) { const float* sg = SG + (size_t)(b * SEQ + (blk * 16 + i) * 64 + lane) * 16; xi[i] = sg[h]; xf[i] = sg[4 + h]; }
#pragma unroll
            for (int i = 0; i < 16; ++i) { const int c = blk * 16 + i, s = c * 64 + lane; const float ip = xi[i], lf = log_sigmoid(xf[i]);
                const float bc = wave_incl_scan_add(lf, lane), u = ip - bc, pm = wave_incl_scan_max(u, lane), mloc = lane63(pm), blast = lane63(bc);
                MU[s] = u; MM[s] = fmaxf(pm, mprev); MB[s] = bc;
                const float Mc = fmaxf(mprev, mloc);
                if (lane == 0) { MSC[c] = mprev; MSC[2048 + c] = mloc; MSC[4096 + c] = expf(mprev - Mc); MSC[6144 + c] = expf(mloc - Mc); }
                mprev = blast + Mc; } }
    }
    const bf16* __restrict__ RAW = (const bf16*)(F.ws + WS_MQK); bf16* __restrict__ QK = (bf16*)(F.ws + WS_QK);
    const float* cw = F.ka->in[I_m_conv_w] + (size_t)l * 4 * 1024; const float* cb = F.ka->in[I_m_conv_b] + (size_t)l * 1024;
    const int gt = F.vcu * 512 + F.tid, c0 = (gt & 127) * 8, run = gt >> 7;
    if (run < T / 32) {
        float w[4][8], bs[8];
#pragma unroll
        for (int j = 0; j < 4; ++j) { const f32x4 w0 = *(const f32x4*)(cw + j * 1024 + c0), w1 = *(const f32x4*)(cw + j * 1024 + c0 + 4); w[j][0] = w0.x; w[j][1] = w0.y; w[j][2] = w0.z; w[j][3] = w0.w; w[j][4] = w1.x; w[j][5] = w1.y; w[j][6] = w1.z; w[j][7] = w1.w; }
        { const f32x4 b0 = *(const f32x4*)(cb + c0), b1 = *(const f32x4*)(cb + c0 + 4); bs[0] = b0.x; bs[1] = b0.y; bs[2] = b0.z; bs[3] = b0.w; bs[4] = b1.x; bs[5] = b1.y; bs[6] = b1.z; bs[7] = b1.w; }
        const float sc = (c0 >= 512) ? 0.08838834764831845f : 1.f;
        const int tok0 = run * 32; const bool first = (tok0 & (SEQ - 1)) == 0;
        const bf16* rp = RAW + (size_t)tok0 * 1024 + c0; bf16* qp = QK + (size_t)tok0 * 1024 + c0;
        v4u win[3];
#pragma unroll
        for (int j = 0; j < 3; ++j) win[j] = first ? (v4u){0u, 0u, 0u, 0u} : *(const GAS v4u*)(rp - (size_t)(3 - j) * 1024);
#pragma unroll 1
        for (int t8 = 0; t8 < 32; t8 += 8) { v4u r[8];
#pragma unroll
            for (int i = 0; i < 8; ++i) r[i] = *(const GAS v4u*)(rp + (size_t)(t8 + i) * 1024);
#pragma unroll
            for (int i = 0; i < 8; ++i) { float a[8];
#pragma unroll
                for (int e = 0; e < 8; ++e) a[e] = bs[e];
#pragma unroll
                for (int j = 0; j < 4; ++j) { const v4u x = (j == 3) ? r[i] : ((i + j >= 3) ? r[i + j - 3 < 0 ? 0 : i + j - 3] : win[i + j]);
                    a[0] += w[j][0] * bflo(x.x); a[1] += w[j][1] * bfhi(x.x); a[2] += w[j][2] * bflo(x.y); a[3] += w[j][3] * bfhi(x.y);
                    a[4] += w[j][4] * bflo(x.z); a[5] += w[j][5] * bfhi(x.z); a[6] += w[j][6] * bflo(x.w); a[7] += w[j][7] * bfhi(x.w); }
#pragma unroll
                for (int e = 0; e < 8; ++e) a[e] = a[e] / (1.f + __expf(-a[e])) * sc;
                v4u o; o.x = pk2(a[0], a[1]); o.y = pk2(a[2], a[3]); o.z = pk2(a[4], a[5]); o.w = pk2(a[6], a[7]);
                *(GAS v4u*)(qp + (size_t)(t8 + i) * 1024) = o; }
            win[0] = r[5]; win[1] = r[6]; win[2] = r[7]; }
    }
}

typedef short v4i16_t __attribute__((ext_vector_type(4)));
__device__ __forceinline__ v2u tr_read4(const LAS bf16* tile, int P, int row0, int col0, int lane) {
    const int q = (lane & 15) >> 2, blk = (lane >> 4) & 1, p = lane & 3;
    return __builtin_bit_cast(v2u, __builtin_amdgcn_ds_read_tr16_b64_v4i16((LAS v4i16_t*)(tile + (row0 + q) * P + col0 + 16 * blk + 4 * p)));
}
struct P1Regs { v4u k[2], v[2]; float w[2]; };
__device__ __forceinline__ void mlstm_p1_load(Frame& F, int uu, P1Regs& R) {
    const int tid = F.tid, bh = uu >> 6, c = uu & 63, b = bh >> 2, h = bh & 3; const size_t tok0 = (size_t)b * SEQ + c * 64;
    const bf16* QK = (const bf16*)(F.ws + WS_QK); const bf16* MV = (const bf16*)(F.ws + WS_MV);
    const float ml = ((const float*)(F.ws + WS_MSC))[2048 + bh * 64 + c];
#pragma unroll
    for (int i = 0; i < 2; ++i) { const int p = tid + 512 * i, s = p >> 4, d0 = (p & 15) * 8;
        R.k[i] = *(const GAS v4u*)(QK + (tok0 + s) * 1024 + 512 + h * 128 + d0); R.v[i] = *(const GAS v4u*)(MV + (tok0 + s) * 512 + h * 128 + d0);
        R.w[i] = expf(((const float*)(F.ws + WS_MLU))[(size_t)bh * SEQ + c * 64 + s] - ml); }
}
__device__ __forceinline__ void mlstm_pass1_all(Frame& F) {
    const int tid = F.tid, lane = F.lane, wid = F.wave, r = lane & 31, hh = lane >> 5;
    constexpr int PV = 160;
    LAS bf16* KW = (LAS bf16*)(F.lds); LAS bf16* VV = KW + 64 * PV;
    P1Regs R; mlstm_p1_load(F, F.vcu * 8, R);
#pragma unroll 1
    for (int it = 0; it < 8; ++it) { const int uu = F.vcu * 8 + it;
#pragma unroll
        for (int i = 0; i < 2; ++i) { const int p = tid + 512 * i, s = p >> 4, d0 = (p & 15) * 8; const float w = R.w[i];
            v4u kw; kw.x = pk2(bflo(R.k[i].x) * w, bfhi(R.k[i].x) * w); kw.y = pk2(bflo(R.k[i].y) * w, bfhi(R.k[i].y) * w); kw.z = pk2(bflo(R.k[i].z) * w, bfhi(R.k[i].z) * w); kw.w = pk2(bflo(R.k[i].w) * w, bfhi(R.k[i].w) * w);
            *(LAS v4u*)(KW + s * PV + d0) = kw; *(LAS v4u*)(VV + s * PV + d0) = R.v[i]; }
        if (it + 1 < 8) mlstm_p1_load(F, uu + 1, R);
        __syncthreads();
        const int mt = wid >> 1, nt0 = (wid & 1) * 2;
        f32x16 acc[2]; acc[0] = f32x16{}; acc[1] = f32x16{};
#pragma unroll
        for (int ks = 0; ks < 4; ++ks) { const v2u a0 = tr_read4(KW, PV, 16 * ks + 8 * hh, 32 * mt, lane), a1 = tr_read4(KW, PV, 16 * ks + 8 * hh + 4, 32 * mt, lane);
            const v4u A = {a0.x, a0.y, a1.x, a1.y};
#pragma unroll
            for (int n = 0; n < 2; ++n) { const v2u b0 = tr_read4(VV, PV, 16 * ks + 8 * hh, 32 * (nt0 + n), lane), b1 = tr_read4(VV, PV, 16 * ks + 8 * hh + 4, 32 * (nt0 + n), lane);
                const v4u B = {b0.x, b0.y, b1.x, b1.y};
                acc[n] = __builtin_amdgcn_mfma_f32_32x32x16_bf16(__builtin_bit_cast(bf16x8, A), __builtin_bit_cast(bf16x8, B), acc[n], 0, 0, 0); } }
        bf16* CT = (bf16*)(F.ws + WS_CST) + (size_t)uu * 128 * 128;
#pragma unroll
        for (int n = 0; n < 2; ++n) { const int dv = 32 * (nt0 + n) + r;
#pragma unroll
            for (int g = 0; g < 4; ++g) { v2u o; o.x = pk2(acc[n][4 * g], acc[n][4 * g + 1]); o.y = pk2(acc[n][4 * g + 2], acc[n][4 * g + 3]);
                *(GAS v2u*)(CT + (size_t)dv * 128 + 32 * mt + 8 * g + 4 * hh) = o; } }
        if (tid < 128) { float s = 0.f;
#pragma unroll 8
            for (int i = 0; i < 64; ++i) s += bf2f(KW[i * PV + tid]); ((float*)(F.ws + WS_NST))[(size_t)uu * 128 + tid] = s; }
        __syncthreads();
    }
}

struct P3Regs { v4u q[2], k[2], v[2], ct[4]; float a0, a1, a2, a3; };
__device__ __forceinline__ void mlstm_p3_load(Frame& F, int uu, P3Regs& R) {
    const int tid = F.tid, bh = uu >> 6, c = uu & 63, b = bh >> 2, h = bh & 3; const size_t tok0 = (size_t)b * SEQ + c * 64;
    const bf16* QKg = (const bf16*)(F.ws + WS_QK); const bf16* MVg = (const bf16*)(F.ws + WS_MV); const bf16* CTg = (const bf16*)(F.ws + WS_CST) + (size_t)uu * 128 * 128;
#pragma unroll
    for (int i = 0; i < 2; ++i) { const int p = tid + 512 * i, s = p >> 4, d0 = (p & 15) * 8;
        R.q[i] = *(const GAS v4u*)(QKg + (tok0 + s) * 1024 + h * 128 + d0); R.k[i] = *(const GAS v4u*)(QKg + (tok0 + s) * 1024 + 512 + h * 128 + d0); R.v[i] = *(const GAS v4u*)(MVg + (tok0 + s) * 512 + h * 128 + d0); }
#pragma unroll
    for (int i = 0; i < 4; ++i) { const int p = tid + 512 * i, dv = p >> 4, d0 = (p & 15) * 8; R.ct[i] = *(const GAS v4u*)(CTg + (size_t)dv * 128 + d0); }
    R.a0 = R.a1 = R.a2 = R.a3 = 0.f;
    if (tid < 64) { const size_t o = (size_t)bh * SEQ + c * 64 + tid; const float* MLU = (const float*)(F.ws + WS_MLU);
        R.a0 = MLU[o]; R.a1 = MLU[(size_t)32 * SEQ + o]; R.a2 = MLU[(size_t)64 * SEQ + o]; R.a3 = ((const float*)(F.ws + WS_MSC))[bh * 64 + c]; }
    else if (tid < 192) R.a0 = ((const float*)(F.ws + WS_NST))[(size_t)uu * 128 + (tid - 64)];
}
__device__ __forceinline__ void mlstm_pass3_all(Frame& F, int l) {
    const int tid = F.tid, lane = F.lane, wid = F.wave, r = lane & 31, hh = lane >> 5;
    constexpr int PV = 160;
    LAS bf16* Q = (LAS bf16*)(F.lds); LAS bf16* Kk = Q + 64 * 136; LAS bf16* VV = Kk + 64 * 136; LAS bf16* CT = VV + 64 * PV;
    LAS float* HB = (LAS float*)(F.lds + 90112); LAS float* SM = (LAS float*)(F.lds + 123904);
    LAS float* U = SM, *MT = SM + 64, *WST = SM + 128, *FLO = SM + 192, *DEN = SM + 256, *NP = SM + 320, *QN = SM + 448;
    P3Regs R; mlstm_p3_load(F, F.vcu * 8, R);
#pragma unroll 1
    for (int it = 0; it < 8; ++it) { const int uu = F.vcu * 8 + it;
        const int bh = uu >> 6, c = uu & 63, b = bh >> 2, h = bh & 3; const size_t tok0 = (size_t)b * SEQ + c * 64;
#pragma unroll
        for (int i = 0; i < 2; ++i) { const int p = tid + 512 * i, s = p >> 4, d0 = (p & 15) * 8;
            *(LAS v4u*)(Q + s * 136 + d0) = R.q[i]; *(LAS v4u*)(Kk + s * 136 + d0) = R.k[i]; *(LAS v4u*)(VV + s * PV + d0) = R.v[i]; }
#pragma unroll
        for (int i = 0; i < 4; ++i) { const int p = tid + 512 * i, dv = p >> 4, d0 = (p & 15) * 8; *(LAS v4u*)(CT + dv * 136 + d0) = R.ct[i]; }
        if (tid < 64) { U[tid] = R.a0; MT[tid] = R.a1; WST[tid] = expf(R.a3 - R.a1); FLO[tid] = expf(-R.a2 - R.a1); }
        else if (tid < 192) NP[tid - 64] = R.a0;
        if (it + 1 < 8) mlstm_p3_load(F, uu + 1, R);
        const int tq = tid >> 3, part = tid & 7; const bf16* og = (const bf16*)(F.ws + WS_MO) + (tok0 + tq) * 512 + h * 128 + part * 16;
        const v4u o0 = *(const GAS v4u*)og, o1 = *(const GAS v4u*)(og + 8);
        __syncthreads();
        { float s = 0.f;
#pragma unroll
            for (int i = 0; i < 16; ++i) s += bf2f(Q[tq * 136 + part * 16 + i]) * NP[part * 16 + i];
            s += shx<1>(s); s += shx<2>(s); s += shx<4>(s); if (part == 0) QN[tq] = s; }
        __syncthreads();
        const int tt = wid >> 2, dt = wid & 3;
        f32x16 acc = f32x16{};
#pragma unroll
        for (int ks = 0; ks < 8; ++ks) { const bf16x8 A = *(const LAS bf16x8*)(Q + (32 * tt + r) * 136 + 16 * ks + 8 * hh); const bf16x8 B = *(const LAS bf16x8*)(CT + (32 * dt + r) * 136 + 16 * ks + 8 * hh);
            acc = __builtin_amdgcn_mfma_f32_32x32x16_bf16(A, B, acc, 0, 0, 0); }
#pragma unroll
        for (int g = 0; g < 16; ++g) acc[g] *= WST[32 * tt + (g & 3) + 8 * (g >> 2) + 4 * hh];
        float denp = 0.f; const float Mt_l = MT[32 * tt + r];
        for (int st = 0; st <= tt; ++st) {
            f32x16 ST = f32x16{};
#pragma unroll
            for (int ks = 0; ks < 8; ++ks) { const bf16x8 A = *(const LAS bf16x8*)(Kk + (32 * st + r) * 136 + 16 * ks + 8 * hh); const bf16x8 B = *(const LAS bf16x8*)(Q + (32 * tt + r) * 136 + 16 * ks + 8 * hh);
                ST = __builtin_amdgcn_mfma_f32_32x32x16_bf16(A, B, ST, 0, 0, 0); }
#pragma unroll
            for (int g = 0; g < 16; ++g) { const int ri = (g & 3) + 8 * (g >> 2) + 4 * hh; float w = __expf(U[32 * st + ri] - Mt_l); if (st == tt && ri > r) w = 0.f; ST[g] *= w; denp += ST[g]; }
#pragma unroll
            for (int sp = 0; sp < 2; ++sp) {
                v4u pa; pa.x = pg8::cvt_pk_bf16(ST[8 * sp], ST[8 * sp + 1]); pa.y = pg8::cvt_pk_bf16(ST[8 * sp + 2], ST[8 * sp + 3]); pa.z = pg8::cvt_pk_bf16(ST[8 * sp + 4], ST[8 * sp + 5]); pa.w = pg8::cvt_pk_bf16(ST[8 * sp + 6], ST[8 * sp + 7]);
                const v2u lo = tr_read4(VV, PV, 32 * st + 16 * sp + 4 * hh, 32 * dt, lane), hi = tr_read4(VV, PV, 32 * st + 16 * sp + 8 + 4 * hh, 32 * dt, lane);
                v4u pb; pb.x = lo.x; pb.y = lo.y; pb.z = hi.x; pb.w = hi.y;
                acc = __builtin_amdgcn_mfma_f32_32x32x16_bf16(__builtin_bit_cast(bf16x8, pa), __builtin_bit_cast(bf16x8, pb), acc, 0, 0, 0); }
        }
        denp = half_swap_add(denp);
        if (dt == 0 && hh == 0) { const int t = 32 * tt + r; DEN[t] = denp + WST[t] * QN[t]; }
        __syncthreads();
#pragma unroll
        for (int g = 0; g < 16; ++g) { const int t = 32 * tt + (g & 3) + 8 * (g >> 2) + 4 * hh; HB[t * 132 + 32 * dt + r] = acc[g] / fmaxf(fabsf(DEN[t]), FLO[t]); }
        __syncthreads();
        { float x[16]; float s = 0.f;
#pragma unroll
            for (int i = 0; i < 16; ++i) { x[i] = HB[tq * 132 + part * 16 + i]; s += x[i]; }
            s += shx<1>(s); s += shx<2>(s); s += shx<4>(s); const float mean = s * (1.f / 128.f); float q = 0.f;
#pragma unroll
            for (int i = 0; i < 16; ++i) { x[i] -= mean; q += x[i] * x[i]; }
            q += shx<1>(q); q += shx<2>(q); q += shx<4>(q); const float rstd = 1.f / sqrtf(q * (1.f / 128.f) + LN_EPS);
            const float* nw = F.ka->in[I_m_norm_w] + (size_t)l * BW + h * 128 + part * 16;
            const unsigned oa[8] = {o0.x, o0.y, o0.z, o0.w, o1.x, o1.y, o1.z, o1.w};
            unsigned ow[8];
#pragma unroll
            for (int i = 0; i < 8; ++i) ow[i] = pk2(x[2 * i] * rstd * nw[2 * i] * bflo(oa[i]), x[2 * i + 1] * rstd * nw[2 * i + 1] * bfhi(oa[i]));
            bf16* yo = (bf16*)(F.ws + WS_YTALL) + (tok0 + tq) * 512 + h * 128 + part * 16;
            *(GAS v4u*)yo = (v4u){ow[0], ow[1], ow[2], ow[3]}; *(GAS v4u*)(yo + 8) = (v4u){ow[4], ow[5], ow[6], ow[7]}; }
        __syncthreads();
    }
}

__device__ __forceinline__ void phase_scans(Frame& F, int l, bool dry = false) {
    const int v = F.vcu, tid = F.tid, seg = F.wave, e = tid & 63;
    LAS float* LE = (LAS float*)(F.lds);
    LAS float* DS = LE + 8 * 64 * 8;
    { const int b = v >> 5, g = v & 31, p = e; const float* tab = (const float*)(F.ws + WS_S5TAB) + ((l * 32 + g) * 64 + p) * 2; const float ar = tab[0], ai = tab[1];
      bf16* A = (bf16*)(F.ws + (dry ? WS_AQKV : WS_S5A)); const float* E = (const float*)(F.ws + WS_EBUF);
      const size_t row0 = (size_t)g * 1024 + b * 128 + seg * 16; float er[16], ei[16];
#pragma unroll
      for (int j = 0; j < 16; ++j) { er[j] = E[(row0 + j) * 128 + p]; ei[j] = E[(row0 + j) * 128 + 64 + p]; }
      float hr = 0.f, hi = 0.f;
#pragma unroll
      for (int j = 0; j < 16; ++j) { const float nr = ar * hr - ai * hi + er[j], ni = ar * hi + ai * hr + ei[j]; hr = nr; hi = ni; }
      LE[(seg * 64 + p) * 2] = hr; LE[(seg * 64 + p) * 2 + 1] = hi;
      float pr = ar, pi = ai;
#pragma unroll
      for (int k = 0; k < 4; ++k) { const float nr = pr * pr - pi * pi, ni = 2.f * pr * pi; pr = nr; pi = ni; }
      __syncthreads();
      hr = 0.f; hi = 0.f;
      for (int s = 0; s < seg; ++s) { const float lr = LE[(s * 64 + p) * 2], li = LE[(s * 64 + p) * 2 + 1]; const float nr = pr * hr - pi * hi + lr, ni = pr * hi + pi * hr + li; hr = nr; hi = ni; }
#pragma unroll
      for (int j = 0; j < 16; ++j) { A[(row0 + j) * S5K + 512 + p] = (bf16)f2bf(hr); A[(row0 + j) * S5K + 576 + p] = (bf16)f2bf(hi);
          const float nr = ar * hr - ai * hi + er[j], ni = ar * hi + ai * hr + ei[j]; hr = nr; hi = ni; }
      __syncthreads(); }
    const float* MSC = (const float*)(F.ws + WS_MSC);
#pragma unroll 1
    for (int i = 0; i < 4; ++i) { const int uix = v * 4 + i, bh = uix >> 5, slice = uix & 31;
        bf16* p = (bf16*)(F.ws + (dry ? WS_MQK : WS_CST)) + ((size_t)bh * 64 + seg * 8) * 16384 + slice * 512 + e * 8;
        v4u lc[8]; float dec[8], sc[8];
#pragma unroll
        for (int j = 0; j < 8; ++j) { lc[j] = *(const GAS v4u*)(p + (size_t)j * 16384); dec[j] = MSC[4096 + bh * 64 + seg * 8 + j]; sc[j] = MSC[6144 + bh * 64 + seg * 8 + j]; }
        float S[8] = {0.f, 0.f, 0.f, 0.f, 0.f, 0.f, 0.f, 0.f}; float dp = 1.f;
#pragma unroll
        for (int j = 0; j < 8; ++j) { const float d = dec[j], s_ = sc[j]; dp *= d;
            S[0] = d * S[0] + s_ * bflo(lc[j].x); S[1] = d * S[1] + s_ * bfhi(lc[j].x); S[2] = d * S[2] + s_ * bflo(lc[j].y); S[3] = d * S[3] + s_ * bfhi(lc[j].y);
            S[4] = d * S[4] + s_ * bflo(lc[j].z); S[5] = d * S[5] + s_ * bfhi(lc[j].z); S[6] = d * S[6] + s_ * bflo(lc[j].w); S[7] = d * S[7] + s_ * bfhi(lc[j].w); }
#pragma unroll
        for (int k = 0; k < 8; ++k) LE[(seg * 64 + e) * 8 + k] = S[k];
        if (e == 0) DS[seg] = dp;
        __syncthreads();
#pragma unroll
        for (int k = 0; k < 8; ++k) S[k] = 0.f;
        for (int s = 0; s < seg; ++s) { const float d = DS[s];
#pragma unroll
            for (int k = 0; k < 8; ++k) S[k] = d * S[k] + LE[(s * 64 + e) * 8 + k]; }
#pragma unroll
        for (int j = 0; j < 8; ++j) { v4u o; o.x = pk2(S[0], S[1]); o.y = pk2(S[2], S[3]); o.z = pk2(S[4], S[5]); o.w = pk2(S[6], S[7]); *(GAS v4u*)(p + (size_t)j * 16384) = o;
            const float d = dec[j], s_ = sc[j];
            S[0] = d * S[0] + s_ * bflo(lc[j].x); S[1] = d * S[1] + s_ * bfhi(lc[j].x); S[2] = d * S[2] + s_ * bflo(lc[j].y); S[3] = d * S[3] + s_ * bfhi(lc[j].y);
            S[4] = d * S[4] + s_ * bflo(lc[j].z); S[5] = d * S[5] + s_ * bfhi(lc[j].z); S[6] = d * S[6] + s_ * bflo(lc[j].w); S[7] = d * S[7] + s_ * bfhi(lc[j].w); }
        __syncthreads(); }
    if (tid < 16) { const int gid = v * 16 + tid, bh = gid >> 7, dk = gid & 127; float* p = (float*)(F.ws + (dry ? WS_YTALL : WS_NST)) + (size_t)bh * 64 * 128 + dk; float lc[64];
#pragma unroll
        for (int c = 0; c < 64; ++c) lc[c] = p[c * 128];
        float n = 0.f;
#pragma unroll
        for (int c = 0; c < 64; ++c) { p[c * 128] = n; n = MSC[4096 + bh * 64 + c] * n + MSC[6144 + bh * 64 + c] * lc[c]; } }
}

struct SchedS5E { int c; __device__ __forceinline__ bool next(int i, pg8::Unit& u) const { if (i > 0 || c >= 128) return false; u.pm = c; u.pn = c >> 2; return true; } };
struct SchedS5Y { int c; __device__ __forceinline__ bool next(int i, pg8::Unit& u) const { if (i > 0 || c >= 256) return false; u.pm = c >> 1; u.pn = (c >> 3) * 2 + (c & 1); return true; } };
struct EpiS5E {
    static constexpr bool PERM = false;
    float* E;
    __device__ __forceinline__ bool reset_after(const pg8::Unit&) const { return true; }
    __device__ __forceinline__ void operator()(pg8::f32x4 (&acc)[2][2][4][2], const pg8::Unit& u, int wr, int wc, int fr, int fq) const {
        using namespace pg8;
        const int row0 = u.pm * BM + wr * 64 + fr, col0 = wc * 32 + 4 * fq;
#pragma unroll
        for (int ai = 0; ai < 2; ++ai)
#pragma unroll
            for (int m = 0; m < 4; ++m)
#pragma unroll
                for (int n = 0; n < 2; ++n) *(f32x4*)(E + (size_t)(row0 + ai * HALF + m * 16) * 128 + col0 + 16 * n) = acc[ai][0][m][n];
    }
};
__device__ __forceinline__ float gelu_tanh(float x) { const float z = 0.7978845608028654f * (x + 0.044715f * x * x * x); const float e = __expf(2.f * z); return 0.5f * x * (2.f - 2.f / (1.f + e)); }
struct EpiS5Y {
    static constexpr bool PERM = true;
    bf16* Y;
    __device__ __forceinline__ bool reset_after(const pg8::Unit&) const { return true; }
    __device__ __forceinline__ void operator()(pg8::f32x4 (&acc)[2][2][4][2], const pg8::Unit& u, int wr, int wc, int fr, int fq) const {
        using namespace pg8;
        const int row0 = u.pm * BM + wr * 64 + fr, ct = u.pn & 1;
#pragma unroll
        for (int bj = 0; bj < 2; ++bj) { const int cc = ct * 256 + bj * HALF + wc * 32 + 8 * fq, tq = cc >> 4, co = cc & 15;
#pragma unroll
            for (int ai = 0; ai < 2; ++ai)
#pragma unroll
                for (int m = 0; m < 4; ++m) { const int R = row0 + ai * HALF + m * 16, g = R >> 10, rr = R & 1023; const f32x4 v0 = acc[ai][bj][m][0], v1 = acc[ai][bj][m][1];
                    u32x4 w; w.x = cvt_pk_bf16(gelu_tanh(v0[0]), gelu_tanh(v0[1])); w.y = cvt_pk_bf16(gelu_tanh(v0[2]), gelu_tanh(v0[3])); w.z = cvt_pk_bf16(gelu_tanh(v1[0]), gelu_tanh(v1[1])); w.w = cvt_pk_bf16(gelu_tanh(v1[2]), gelu_tanh(v1[3]));
                    *(u32x4*)(Y + (size_t)(rr * 32 + tq) * 512 + 16 * g + co) = w; } }
    }
};
struct EpiGlu {
    static constexpr bool PERM = true;
    const bf16* Y1; bf16* YO; const float* bias;
    __device__ __forceinline__ bool reset_after(const pg8::Unit&) const { return true; }
    __device__ __forceinline__ void operator()(pg8::f32x4 (&acc)[2][2][4][2], const pg8::Unit& u, int wr, int wc, int fr, int fq) const {
        using namespace pg8;
        const int row0 = u.pm * BM + wr * 64 + fr;
#pragma unroll
        for (int bj = 0; bj < 2; ++bj) { const int col0 = u.pn * BM + bj * HALF + wc * 32 + 8 * fq; const f32x4 b0 = *(const f32x4*)(bias + col0), b1 = *(const f32x4*)(bias + col0 + 4);
            u32x4 yv[2][4];
#pragma unroll
            for (int ai = 0; ai < 2; ++ai)
#pragma unroll
                for (int m = 0; m < 4; ++m) yv[ai][m] = *(const u32x4*)(Y1 + (size_t)(row0 + ai * HALF + m * 16) * 512 + col0);
            asm volatile("" ::: "memory");
#pragma unroll
            for (int ai = 0; ai < 2; ++ai)
#pragma unroll
                for (int m = 0; m < 4; ++m) { const size_t off = (size_t)(row0 + ai * HALF + m * 16) * 512 + col0; const u32x4 y = yv[ai][m];
                    const f32x4 v0 = acc[ai][bj][m][0] + b0, v1 = acc[ai][bj][m][1] + b1;
                    u32x4 w; w.x = cvt_pk_bf16(bflo(y.x) * sigmoidf_(v0[0]), bfhi(y.x) * sigmoidf_(v0[1])); w.y = cvt_pk_bf16(bflo(y.y) * sigmoidf_(v0[2]), bfhi(y.y) * sigmoidf_(v0[3]));
                    w.z = cvt_pk_bf16(bflo(y.z) * sigmoidf_(v1[0]), bfhi(y.z) * sigmoidf_(v1[1])); w.w = cvt_pk_bf16(bflo(y.w) * sigmoidf_(v1[2]), bfhi(y.w) * sigmoidf_(v1[3]));
                    *(u32x4*)(YO + off) = w; }
            asm volatile("" ::: "memory"); }
    }
};
struct SchedMerge { int c, G; __device__ __forceinline__ bool next(int i, pg8::Unit& u) const { const int tl = (i / 3) * G + c, b = i % 3; if (tl >= 512) return false; u.pm = b * 128 + (tl >> 2); u.pn = b * 4 + (tl & 3); return true; } };
struct EpiMerge {
    static constexpr bool PERM = true;
    const bf16* GP; bf16* MX;
    __device__ __forceinline__ bool reset_after(const pg8::Unit& u) const { return u.pm >= 256; }
    __device__ __forceinline__ void operator()(pg8::f32x4 (&acc)[2][2][4][2], const pg8::Unit& u, int wr, int wc, int fr, int fq) const {
        using namespace pg8;
        const int b = u.pm >> 7, pm = u.pm & 127, pn = u.pn & 3, row0 = pm * BM + wr * 64 + fr;
#pragma unroll
        for (int bj = 0; bj < 2; ++bj) { const int col0 = pn * BM + bj * HALF + wc * 32 + 8 * fq;
#pragma unroll
            for (int ai = 0; ai < 2; ++ai) {
            u32x4 gav[4], gbv[4];
#pragma unroll
                for (int m = 0; m < 4; ++m) { const bf16* gp = GP + (size_t)(row0 + ai * HALF + m * 16) * 3072 + b * 1024 + col0; gav[m] = *(const u32x4*)gp; gbv[m] = (b < 2) ? *(const u32x4*)(gp + 1024) : (u32x4){0u, 0u, 0u, 0u}; }
            asm volatile("" ::: "memory");
#pragma unroll
                for (int m = 0; m < 4; ++m) { const int row = row0 + ai * HALF + m * 16;
                    const u32x4 ga = gav[m]; float f[8];
                    const unsigned gaa[4] = {ga.x, ga.y, ga.z, ga.w};
                    if (b < 2) { const u32x4 gb = gbv[m]; const unsigned gba[4] = {gb.x, gb.y, gb.z, gb.w};
#pragma unroll
                        for (int i = 0; i < 4; ++i) {
                            f[2 * i] = (1.f + bflo(gba[i])) * __builtin_amdgcn_rcpf(1.f + bflo(gaa[i])); f[2 * i + 1] = (1.f + bfhi(gba[i])) * __builtin_amdgcn_rcpf(1.f + bfhi(gaa[i])); }
                    } else {
#pragma unroll
                        for (int i = 0; i < 4; ++i) { f[2 * i] = __builtin_amdgcn_rcpf(1.f + bflo(gaa[i])); f[2 * i + 1] = __builtin_amdgcn_rcpf(1.f + bfhi(gaa[i])); }
                    }
                    f32x4& v0 = acc[ai][bj][m][0]; f32x4& v1 = acc[ai][bj][m][1];
                    v0[0] *= f[0]; v0[1] *= f[1]; v0[2] *= f[2]; v0[3] *= f[3]; v1[0] *= f[4]; v1[1] *= f[5]; v1[2] *= f[6]; v1[3] *= f[7];
                    if (b == 2) { u32x4 w; w.x = cvt_pk_bf16(v0[0], v0[1]); w.y = cvt_pk_bf16(v0[2], v0[3]); w.z = cvt_pk_bf16(v1[0], v1[1]); w.w = cvt_pk_bf16(v1[2], v1[3]);
                        *(u32x4*)(MX + (size_t)row * 1024 + col0) = w; } }
            asm volatile("" ::: "memory"); } }
    }
};
struct EpiOutProj {
    static constexpr bool PERM = false;
    const float* X; float* O;
    __device__ __forceinline__ bool reset_after(const pg8::Unit&) const { return true; }
    __device__ __forceinline__ void operator()(pg8::f32x4 (&acc)[2][2][4][2], const pg8::Unit& u, int wr, int wc, int fr, int fq) const {
        using namespace pg8;
        const int row0 = u.pm * BM + wr * 64 + fr, col0 = u.pn * BM + wc * 32 + 4 * fq;
#pragma unroll
        for (int ai = 0; ai < 2; ++ai) {
            f32x4 xv[4][2][2];
#pragma unroll
            for (int m = 0; m < 4; ++m) { const size_t off = (size_t)(row0 + ai * HALF + m * 16) * 1024 + col0;
#pragma unroll
                for (int bj = 0; bj < 2; ++bj)
#pragma unroll
                    for (int n = 0; n < 2; ++n) xv[m][bj][n] = *(const f32x4*)(X + off + bj * HALF + n * 16); }
            asm volatile("" ::: "memory");
#pragma unroll
            for (int m = 0; m < 4; ++m) { const size_t off = (size_t)(row0 + ai * HALF + m * 16) * 1024 + col0;
#pragma unroll
                for (int bj = 0; bj < 2; ++bj)
#pragma unroll
                    for (int n = 0; n < 2; ++n) *(f32x4*)(O + off + bj * HALF + n * 16) = xv[m][bj][n] * ALPHA + acc[ai][bj][m][n]; }
            asm volatile("" ::: "memory");
        }
    }
};

__device__ __forceinline__ void phase_ln1_route(Frame& F, int l, bool dry = false) {
    float* const OUT = dry ? (float*)(F.ws + WS_YB) : F.out; bf16* const XBo = (bf16*)(F.ws + (dry ? WS_XG : WS_XB)); unsigned char* const RT = F.ws + (dry ? WS_HB : WS_ROUTE); int* const TPo = (int*)(F.ws + (dry ? WS_HB + 4 * MiB : WS_TOKPOS)); const int gl = dry ? l + 4 : l;
    constexpr int WP = 1028;
    LAS float* WRE = (LAS float*)(F.lds); LAS float* WRG = WRE + 32 * WP;
    LAS float* BR = WRG + 4 * WP; LAS unsigned* HIST = (LAS unsigned*)(BR + 64); LAS unsigned* BASE = HIST + 32;
    const float* wre = F.ka->in[I_w_re] + (size_t)l * 1024 * 32; const float* wrg = F.ka->in[I_w_rg] + (size_t)l * 1024 * 4;
    for (int i = F.tid; i < 1024 * 32; i += 512) WRE[(i & 31) * WP + (i >> 5)] = wre[i];
    for (int i = F.tid; i < 1024 * 4; i += 512) WRG[(i & 3) * WP + (i >> 2)] = wrg[i];
    if (F.tid < 32) { BR[F.tid] = F.ka->in[I_b_re][l * 32 + F.tid]; HIST[F.tid] = 0u; }
    if (F.tid < 4) BR[32 + F.tid] = F.ka->in[I_b_rg][l * 4 + F.tid];
    { int* tp = TPo; for (int i = F.vcu * 512 + F.tid; i < MOE_ROWS; i += F.G * 512) tp[i] = -1; }
    __syncthreads();
    const int gw = F.vcu * NWAVES + F.wave, NGW = F.G * NWAVES, lane = F.lane;
    const float* lg = F.ka->in[I_ln1_g] + (size_t)l * D; const float* lb = F.ka->in[I_ln1_b] + (size_t)l * D;
    int my_e0 = 0, my_e1 = 0, my_r0 = 0, my_r1 = 0, my_m = -1; float my_w0 = 0.f, my_w1 = 0.f; int it = 0;
    f32x4 nv[4];
    { const GAS f32x4* x0 = (const GAS f32x4*)(F.out + (size_t)gw * D) + lane;
#pragma unroll
      for (int j = 0; j < 4; ++j) nv[j] = x0[64 * j]; }
    for (int m = gw; m < T; m += NGW, ++it) {
        GAS f32x4* xw = (GAS f32x4*)(OUT + (size_t)m * D) + lane; f32x4 v[4]; float s = 0.f;
#pragma unroll
        for (int j = 0; j < 4; ++j) { v[j] = nv[j]; s += (v[j].x + v[j].y) + (v[j].z + v[j].w); }
        if (m + NGW < T) { const GAS f32x4* xn = (const GAS f32x4*)(F.out + (size_t)(m + NGW) * D) + lane;
#pragma unroll
            for (int j = 0; j < 4; ++j) nv[j] = xn[64 * j]; }
        const float mean = wave_sum(s) * (1.f / D); float s2 = 0.f;
#pragma unroll
        for (int j = 0; j < 4; ++j) { v[j] = v[j] - mean; s2 += (v[j].x * v[j].x + v[j].y * v[j].y) + (v[j].z * v[j].z + v[j].w * v[j].w); }
        const float rstd = 1.f / sqrtf(wave_sum(s2) * (1.f / D) + LN_EPS);
        GAS v2u* o8 = (GAS v2u*)(XBo + (size_t)m * D) + lane;
#pragma unroll
        for (int j = 0; j < 4; ++j) { const f32x4 g4 = *(const f32x4*)(lg + 256 * j + 4 * lane), b4 = *(const f32x4*)(lb + 256 * j + 4 * lane);
            v[j] = v[j] * rstd * g4 + b4; xw[64 * j] = v[j]; v2u o; o.x = pk2(v[j].x, v[j].y); o.y = pk2(v[j].z, v[j].w); o8[64 * j] = o; }
        const bool b0 = (lane & 1) != 0, b1 = (lane & 2) != 0, b2 = (lane & 4) != 0;
        float gl[4];
        { float p[4];
#pragma unroll
          for (int o = 0; o < 4; ++o) { p[o] = 0.f;
#pragma unroll
            for (int j = 0; j < 4; ++j) { const f32x4 w = *(const LAS f32x4*)(WRG + o * WP + 256 * j + 4 * lane); p[o] += (v[j].x * w.x + v[j].y * w.y) + (v[j].z * w.z + v[j].w * w.w); } }
          JR_STEP(p, 2, 1, b0) JR_STEP(p, 1, 2, b1)
          float r = p[0]; r += shx<4>(r); r += shx<8>(r); r += shx<16>(r); r = half_swap_add(r);
          gl[0] = rdlane(r, 0) + BR[32]; gl[1] = rdlane(r, 2) + BR[33]; gl[2] = rdlane(r, 1) + BR[34]; gl[3] = rdlane(r, 3) + BR[35]; }
        int grp = 0; float gmax = gl[0];
#pragma unroll
        for (int o = 1; o < 4; ++o) if (gl[o] > gmax) { gmax = gl[o]; grp = o; }
        float gs = 0.f;
#pragma unroll
        for (int o = 0; o < 4; ++o) gs += expf(gl[o] - gmax);
        const float pg = 1.f / gs;
        float el[8];
        { float p[8]; const LAS float* wr_ = WRE + grp * 8 * WP;
#pragma unroll
          for (int o = 0; o < 8; ++o) { p[o] = 0.f;
#pragma unroll
            for (int j = 0; j < 4; ++j) { const f32x4 w = *(const LAS f32x4*)(wr_ + o * WP + 256 * j + 4 * lane); p[o] += (v[j].x * w.x + v[j].y * w.y) + (v[j].z * w.z + v[j].w * w.w); } }
          JR_STEP(p, 4, 1, b0) JR_STEP(p, 2, 2, b1) JR_STEP(p, 1, 4, b2)
          float r = p[0]; r += shx<8>(r); r += shx<16>(r); r = half_swap_add(r);
          const LAS float* be = BR + grp * 8;
          el[0] = rdlane(r, 0) + be[0]; el[1] = rdlane(r, 4) + be[1]; el[2] = rdlane(r, 2) + be[2]; el[3] = rdlane(r, 6) + be[3];
          el[4] = rdlane(r, 1) + be[4]; el[5] = rdlane(r, 5) + be[5]; el[6] = rdlane(r, 3) + be[6]; el[7] = rdlane(r, 7) + be[7]; }
        int i0 = 0; float l0 = el[0];
#pragma unroll
        for (int o = 1; o < 8; ++o) if (el[o] > l0) { l0 = el[o]; i0 = o; }
        int i1 = -1; float l1 = -INFINITY;
#pragma unroll
        for (int o = 0; o < 8; ++o) if (o != i0 && el[o] > l1) { l1 = el[o]; i1 = o; }
        const float ex = expf(l1 - l0), pe0 = 1.f / (1.f + ex), pe1 = ex / (1.f + ex);
        const int e0 = grp * 8 + i0, e1 = grp * 8 + i1;
        unsigned r0 = 0u, r1 = 0u;
        if (lane == 0) { r0 = __hip_atomic_fetch_add(&HIST[e0], 1u, __ATOMIC_RELAXED, __HIP_MEMORY_SCOPE_WORKGROUP); r1 = __hip_atomic_fetch_add(&HIST[e1], 1u, __ATOMIC_RELAXED, __HIP_MEMORY_SCOPE_WORKGROUP); }
        r0 = (unsigned)__builtin_amdgcn_readfirstlane((int)r0); r1 = (unsigned)__builtin_amdgcn_readfirstlane((int)r1);
        if (lane == it) { my_e0 = e0; my_e1 = e1; my_r0 = (int)r0; my_r1 = (int)r1; my_w0 = pg * pe0; my_w1 = pg * pe1; my_m = m; }
    }
    __syncthreads();
    if (F.tid < 32) BASE[F.tid] = __hip_atomic_fetch_add((unsigned*)(F.ctl + CW_GCNT + gl * 32 + F.tid), HIST[F.tid], RLX_AGENT);
    __syncthreads();
    if (my_m >= 0) { int* re = (int*)RT; float* rw = (float*)(RT + 262144); int* rp = (int*)(RT + 524288);
        re[2 * my_m] = my_e0; re[2 * my_m + 1] = my_e1; rw[2 * my_m] = my_w0; rw[2 * my_m + 1] = my_w1; rp[2 * my_m] = (int)BASE[my_e0] + my_r0; rp[2 * my_m + 1] = (int)BASE[my_e1] + my_r1; }
    __syncthreads();
}

__device__ __forceinline__ void moe_tables(Frame& F, int l) {
    LAS int* PST = (LAS int*)(F.lds + LDSX_OFF + 20480); LAS int* BLKE = PST + 64;
    if (F.tid == 0) { int acc = 0;
#pragma unroll 1
        for (int e = 0; e < NEXP; ++e) { const int cnt = (int)__hip_atomic_load(F.ctl + CW_GCNT + l * 32 + e, RLX_AGENT); PST[e] = acc; const int nb = (cnt + 255) >> 8;
#pragma unroll 1
            for (int j = 0; j < nb; ++j) BLKE[(acc >> 8) + j] = e; acc += nb << 8; } PST[32] = acc; PST[33] = acc >> 8; }
    __syncthreads();
}
__device__ __forceinline__ void phase_dispatch(Frame& F, int l) {
    moe_tables(F, l);
    const LAS int* PST = (const LAS int*)(F.lds + LDSX_OFF + 20480);
    const int gw = F.vcu * NWAVES + F.wave, NGW = F.G * NWAVES, lane = F.lane;
    const int* re = (const int*)(F.ws + WS_ROUTE); const float* rw = (const float*)(F.ws + WS_ROUTE + 262144); const int* rp = (const int*)(F.ws + WS_ROUTE + 524288);
    int* tp = (int*)(F.ws + WS_TOKPOS); float* wp = (float*)(F.ws + WS_TOKPOS + 524288);
    const bf16* XB = (const bf16*)(F.ws + WS_XB); bf16* XG = (bf16*)(F.ws + WS_XG);
    for (int m = gw; m < T; m += NGW) {
        const int e0 = re[2 * m], e1 = re[2 * m + 1]; const int p0 = PST[e0] + rp[2 * m], p1 = PST[e1] + rp[2 * m + 1];
        if (lane == 0) { tp[p0] = 2 * m; wp[p0] = rw[2 * m]; tp[p1] = 2 * m + 1; wp[p1] = rw[2 * m + 1]; }
        const GAS v4u* src = (const GAS v4u*)(XB + (size_t)m * D) + lane; const v4u a = src[0], b = src[64];
        GAS v4u* d0 = (GAS v4u*)(XG + (size_t)p0 * D) + lane; GAS v4u* d1 = (GAS v4u*)(XG + (size_t)p1 * D) + lane;
        d0[0] = a; d0[64] = b; d1[0] = a; d1[64] = b;
    }
}
struct SchedMoe { const LAS int* PST; int c, G; __device__ __forceinline__ bool next(int i, pg8::Unit& u) const { const int L = i * G + c; const int nb = __builtin_amdgcn_readfirstlane(PST[33]); if (L >= nb * 4) return false; const int rb = L >> 2; u.pm = rb; u.pn = __builtin_amdgcn_readfirstlane(PST[64 + rb]) * 4 + (L & 3); return true; } };
struct EpiGateUp {
    static constexpr bool PERM = true;
    bf16* H;
    __device__ __forceinline__ bool reset_after(const pg8::Unit&) const { return true; }
    __device__ __forceinline__ void operator()(pg8::f32x4 (&acc)[2][2][4][2], const pg8::Unit& u, int wr, int wc, int fr, int fq) const {
        using namespace pg8;
        const int row0 = u.pm * BM + wr * 64 + fr, col0 = (u.pn & 3) * HALF + wc * 32 + 8 * fq;
#pragma unroll
        for (int ai = 0; ai < 2; ++ai)
#pragma unroll
            for (int m = 0; m < 4; ++m) { float hv[8];
#pragma unroll
                for (int n = 0; n < 2; ++n)
#pragma unroll
                    for (int i = 0; i < 4; ++i) { const float g = acc[ai][0][m][n][i], up = acc[ai][1][m][n][i]; hv[4 * n + i] = g / (1.f + __expf(-g)) * up; }
                u32x4 w; w.x = cvt_pk_bf16(hv[0], hv[1]); w.y = cvt_pk_bf16(hv[2], hv[3]); w.z = cvt_pk_bf16(hv[4], hv[5]); w.w = cvt_pk_bf16(hv[6], hv[7]);
                *(u32x4*)(H + (size_t)(row0 + ai * HALF + m * 16) * 512 + col0) = w; }
    }
};
struct EpiDown {
    static constexpr bool PERM = true;
    bf16* YB; const int* TP; const float* WP;
    __device__ __forceinline__ bool reset_after(const pg8::Unit&) const { return true; }
    __device__ __forceinline__ void operator()(pg8::f32x4 (&acc)[2][2][4][2], const pg8::Unit& u, int wr, int wc, int fr, int fq) const {
        using namespace pg8;
        const int row0 = u.pm * BM + wr * 64 + fr, colb = (u.pn & 3) * BM + wc * 32 + 8 * fq;
        int tpa[2][4]; float wpa[2][4];
#pragma unroll
        for (int ai = 0; ai < 2; ++ai)
#pragma unroll
            for (int m = 0; m < 4; ++m) { tpa[ai][m] = TP[row0 + ai * HALF + m * 16]; wpa[ai][m] = WP[row0 + ai * HALF + m * 16]; }
        asm volatile("" ::: "memory");
#pragma unroll
        for (int ai = 0; ai < 2; ++ai)
#pragma unroll
            for (int m = 0; m < 4; ++m) { const int tpv = tpa[ai][m]; if (tpv < 0) continue; const float w_ = wpa[ai][m];
#pragma unroll
                for (int bj = 0; bj < 2; ++bj) { const f32x4 v0 = acc[ai][bj][m][0] * w_, v1 = acc[ai][bj][m][1] * w_;
                    u32x4 w; w.x = cvt_pk_bf16(v0[0], v0[1]); w.y = cvt_pk_bf16(v0[2], v0[3]); w.z = cvt_pk_bf16(v1[0], v1[1]); w.w = cvt_pk_bf16(v1[2], v1[3]);
                    *(u32x4*)(YB + (size_t)tpv * 1024 + colb + bj * HALF) = w; } }
    }
};
__device__ __forceinline__ void phase_ln2(Frame& F, int l, int sub) {
    const bool more = (l + 1 < NL); const bool dry = (sub & 0x10) != 0;
    float* const OUT = dry ? (float*)(F.ws + 560 * MiB) : F.out; bf16* const XBo = (bf16*)(F.ws + (dry ? WS_YTALL : WS_XB));
    const int gw = F.vcu * NWAVES + F.wave, NGW = F.G * NWAVES, lane = F.lane;
    const float* lg = F.ka->in[I_ln2_g] + (size_t)l * D; const float* lb = F.ka->in[I_ln2_b] + (size_t)l * D; const bf16* YB = (const bf16*)(F.ws + WS_YB);
    f32x4 nx[4]; v2u na[4], nb[4];
    if (sub & 1) { const GAS f32x4* xr = (const GAS f32x4*)(F.out + (size_t)gw * D) + lane; const GAS v2u* y0 = (const GAS v2u*)(YB + (size_t)(2 * gw) * D) + lane; const GAS v2u* y1 = y0 + D / 4;
#pragma unroll
        for (int j = 0; j < 4; ++j) { nx[j] = xr[64 * j]; na[j] = y0[64 * j]; nb[j] = y1[64 * j]; } }
    if (sub & 1) for (int m = gw; m < T; m += NGW) {
        GAS f32x4* xw = (GAS f32x4*)(OUT + (size_t)m * D) + lane;
        f32x4 v[4]; float s = 0.f; f32x4 cx[4]; v2u ca[4], cb_[4];
#pragma unroll
        for (int j = 0; j < 4; ++j) { cx[j] = nx[j]; ca[j] = na[j]; cb_[j] = nb[j]; }
        if (m + NGW < T) { const GAS f32x4* xr = (const GAS f32x4*)(F.out + (size_t)(m + NGW) * D) + lane; const GAS v2u* y0 = (const GAS v2u*)(YB + (size_t)(2 * (m + NGW)) * D) + lane; const GAS v2u* y1 = y0 + D / 4;
#pragma unroll
            for (int j = 0; j < 4; ++j) { nx[j] = xr[64 * j]; na[j] = y0[64 * j]; nb[j] = y1[64 * j]; } }
#pragma unroll
        for (int j = 0; j < 4; ++j) { const f32x4 x = cx[j]; const v2u a = ca[j], b = cb_[j];
            v[j].x = ALPHA * x.x + (bflo(a.x) + bflo(b.x)); v[j].y = ALPHA * x.y + (bfhi(a.x) + bfhi(b.x)); v[j].z = ALPHA * x.z + (bflo(a.y) + bflo(b.y)); v[j].w = ALPHA * x.w + (bfhi(a.y) + bfhi(b.y));
            s += (v[j].x + v[j].y) + (v[j].z + v[j].w); }
        const float mean = wave_sum(s) * (1.f / D); float s2 = 0.f;
#pragma unroll
        for (int j = 0; j < 4; ++j) { v[j] = v[j] - mean; s2 += (v[j].x * v[j].x + v[j].y * v[j].y) + (v[j].z * v[j].z + v[j].w * v[j].w); }
        const float rstd = 1.f / sqrtf(wave_sum(s2) * (1.f / D) + LN_EPS);
        GAS v2u* o8 = (GAS v2u*)(XBo + (size_t)m * D) + lane;
#pragma unroll
        for (int j = 0; j < 4; ++j) { const f32x4 g4 = *(const f32x4*)(lg + 256 * j + 4 * lane), b4 = *(const f32x4*)(lb + 256 * j + 4 * lane);
            v[j] = v[j] * rstd * g4 + b4; xw[64 * j] = v[j]; v2u o; o.x = pk2(v[j].x, v[j].y); o.y = pk2(v[j].z, v[j].w); o8[64 * j] = o; }
    }
    __syncthreads();
    if (more && (sub & 2)) weight_prep(F, l + 1);
}

__device__ __forceinline__ void phase_attention(Frame& F, int l) {
    const attn_body::AttnTensors AT{(const attn_body::bf16*)(F.ws + WS_AQKV), (const attn_body::bf16*)(F.ws + WS_AQKV) + 512, (const attn_body::bf16*)(F.ws + WS_AQKV) + 1024,
                                    (attn_body::bf16*)(F.ws + WS_YTALL) + (size_t)2 * T * 512, (const float*)(F.ws + WS_FTAB)};
    volatile LAS unsigned* NEXT = (volatile LAS unsigned*)(F.lds + LDSCTL_OFF + 64);
    unsigned* head = (unsigned*)(F.ctl + CW_AQ + 64 * l);
    if (F.tid == 0) NEXT[0] = __hip_atomic_fetch_add(head, 1u, RLX_AGENT);
    __syncthreads();
    int idx = __builtin_amdgcn_readfirstlane((int)NEXT[0]);
#pragma unroll 1
    while (idx < 1024) {
        unsigned nxt = 0u;
        if (F.tid == 0) nxt = __hip_atomic_fetch_add(head, 1u, RLX_AGENT);
        const int qb = 15 - (idx >> 6), bh = idx & 63;
        attn_body::attn_unit<8>(bh >> 3, bh & 7, qb, AT.Q, AT.K, AT.V, AT.O, AT.F, (char*)F.ldsg, F.tid);
        if (F.tid == 0) NEXT[0] = nxt;
        __syncthreads();
        idx = __builtin_amdgcn_readfirstlane((int)NEXT[0]);
        __syncthreads();
    }
}

__global__ void __launch_bounds__(NWAVES * 64, 2) mega_fwd(Args args) {
    extern __shared__ __attribute__((aligned(16))) unsigned char lds[];
    Frame F;
    F.lds = (LAS unsigned char*)lds; F.ldsg = lds;
    const int wave_s = __builtin_amdgcn_readfirstlane((int)threadIdx.x >> 6);
    F.tid = wave_s * 64 + lane_id(); F.lane = F.tid & 63; F.wave = wave_s;
    const int G_s = gridDim.x, bx_s = blockIdx.x, vcu_s = (G_s % 8 == 0) ? (bx_s % 8) * (G_s / 8) + bx_s / 8 : bx_s;
    F.G = G_s; F.bx = bx_s; F.vcu = vcu_s;
    F.ws = args.ws; F.ctl = (gu32*)(args.ws + WS_CTL); F.out = args.out; F.ka = (KArgs)__builtin_amdgcn_kernarg_segment_ptr();
    volatile LAS unsigned* MISC = (volatile LAS unsigned*)(F.lds + MISC_OFF);
    for (int u = F.tid; u < (LDS_BYTES - LDSCTL_OFF) / 4; u += NWAVES * 64) ((LAS unsigned*)(F.lds + LDSCTL_OFF))[u] = 0u;
    __syncthreads();
    const int lo = args.ph_lo, hi = args.ph_hi, sub = args.sub;
    XcdBarrier bar; bar.bar = (unsigned*)(F.ctl + CW_BAR); bar.x = 0; bar.st = nullptr;
    if (hi - lo > 1) bar = xcd_barrier_post((unsigned*)(F.ctl + CW_BAR), MISC + 8, wave_s == 0 && lane_id() == 0);
#ifndef PH_MASK
#define PH_MASK 0x3fff
#endif
#define HAS(j) (((PH_MASK) >> (j)) & 1)

#define IN(k) (lo <= (k) && (k) < hi)
#define SEAM(k) do { if (IN(k) && IN((k) + 1)) { XcdBarrier b2_ = bar; asm volatile("" : "+s"(b2_.bar)); asm volatile("" : "+s"(b2_.x)); xcd_barrier(b2_, wave_s == 0 && lane_id() == 0); } } while (0)
#define FRESH() do { int t_ = wave_s * 64 + lane_id(); asm volatile("" : "+v"(t_)); F.tid = t_; F.lane = t_ & 63; F.wave = wave_s; \
        int g_ = G_s, b_ = bx_s, v_ = vcu_s; asm volatile("" : "+s"(g_), "+s"(b_), "+s"(v_)); F.G = g_; F.bx = b_; F.vcu = v_; \
        unsigned char* w_ = args.ws; asm volatile("" : "+s"(w_)); F.ws = w_; ws = w_; F.ctl = (gu32*)(w_ + WS_CTL); float* o_ = args.out; asm volatile("" : "+s"(o_)); F.out = o_; } while (0)
    unsigned char* ws = args.ws;
    if (HAS(13) && IN(0)) { FRESH(); phase_p0(F); SEAM(0); }
#pragma unroll 1
    for (int l = 0; l < NL; ++l) {
        const int pb = 1 + l * NPH_LAYER;
        if (HAS(0) && IN(pb + 0)) { FRESH(); small_gates_mfma(F, l);
            pg8::Gemm g{(const pg8::bf16_t*)(ws + WS_XB), (const pg8::bf16_t*)(ws + WS_WIN), 1024, 1024, 1024}; pg8::StaticOrder S; S.init(T, NIN, F.G, F.bx);
            EpiInProj E{ws, F.ka->in[I_b_in] + (size_t)l * INTOT};
            pg8::gemm_phase<EpiInProj, pg8::StaticOrder, true>(F.lds + RING_OFF, g, S, E, F.tid);
            SEAM(pb + 0);
        }
        if (HAS(1) && IN(pb + 1)) { FRESH(); phase_prep2(F, l); SEAM(pb + 1); }
        if (HAS(2) && IN(pb + 2)) { FRESH();
#ifndef P2_NO_A
            if (sub & 1) mlstm_pass1_all(F);
#endif
#ifndef P2_NO_B
            if (sub & 2) { pg8::Gemm g{(const pg8::bf16_t*)(ws + WS_S5A), (const pg8::bf16_t*)(ws + WS_S5ALL + (size_t)l * S5_LAYER_BYTES + 20 * MiB), 512, S5K, 512}; SchedS5E S{F.vcu}; EpiS5E E{(float*)(ws + WS_EBUF)};
              pg8::gemm_phase<EpiS5E, SchedS5E, true>(F.lds + RING_OFF, g, S, E, F.tid); }
            __syncthreads();
#endif
#ifndef P2_NO_C
            if (sub & 4) phase_attention(F, l);
#endif
            SEAM(pb + 2);
        }
        if (HAS(3) && IN(pb + 3)) { FRESH(); phase_scans(F, l, (sub & 0x10) != 0); SEAM(pb + 3); }
        if (HAS(4) && IN(pb + 4)) { FRESH();
            mlstm_pass3_all(F, l);
            { pg8::Gemm g{(const pg8::bf16_t*)(ws + WS_S5A), (const pg8::bf16_t*)(ws + WS_S5ALL + (size_t)l * S5_LAYER_BYTES), S5K, S5K, S5K}; SchedS5Y S{F.vcu}; EpiS5Y E{(bf16*)(ws + WS_YS1)};
              pg8::gemm_phase<EpiS5Y, SchedS5Y, true>(F.lds + RING_OFF, g, S, E, F.tid); }
            SEAM(pb + 4);
        }
        if (HAS(5) && IN(pb + 5)) { FRESH();            pg8::Gemm g{(const pg8::bf16_t*)(ws + WS_YS1), (const pg8::bf16_t*)(ws + WS_WGLU), 512, 512, 512}; pg8::StaticOrder S; S.init(T, 512, F.G, F.bx);
            EpiGlu E{(const bf16*)(ws + WS_YS1), (bf16*)(ws + WS_YTALL) + (size_t)T * 512, F.ka->in[I_s5_b_glu] + (size_t)l * 512};
            pg8::gemm_phase<EpiGlu, pg8::StaticOrder, true>(F.lds + RING_OFF, g, S, E, F.tid);
            SEAM(pb + 5);
        }
        if (HAS(6) && IN(pb + 6)) { FRESH();            pg8::Gemm g{(const pg8::bf16_t*)(ws + WS_YTALL), (const pg8::bf16_t*)(ws + WS_WBR), 512, 512, 512}; SchedMerge S{F.vcu, F.G};
            EpiMerge E{(const bf16*)(ws + WS_GATE), (bf16*)(ws + WS_MIXED)};
            pg8::gemm_phase<EpiMerge, SchedMerge, true>(F.lds + RING_OFF, g, S, E, F.tid);
            SEAM(pb + 6);
        }
        if (HAS(7) && IN(pb + 7)) { FRESH();
            pg8::Gemm g{(const pg8::bf16_t*)(ws + WS_MIXED), (const pg8::bf16_t*)(ws + WS_WOUT), 1024, 1024, 1024}; pg8::StaticOrder S; S.init(T, 1024, F.G, F.bx);
            EpiOutProj E{l == 0 ? F.ka->in[I_x] : (const float*)F.out, F.out};
            pg8::gemm_phase<EpiOutProj, pg8::StaticOrder, true>(F.lds + RING_OFF, g, S, E, F.tid);
            SEAM(pb + 7);
        }
        if (HAS(8) && IN(pb + 8)) { FRESH(); phase_ln1_route(F, l, (sub & 0x10) != 0); SEAM(pb + 8); }
        if (HAS(9) && IN(pb + 9)) { FRESH(); phase_dispatch(F, l); SEAM(pb + 9); }
        if (HAS(10) && IN(pb + 10)) { FRESH();            moe_tables(F, l);
            pg8::Gemm g{(const pg8::bf16_t*)(ws + WS_XG), (const pg8::bf16_t*)(ws + WS_WGU), 1024, 1024, 1024}; SchedMoe S{(const LAS int*)(F.lds + LDSX_OFF + 20480), F.vcu, F.G};
            EpiGateUp E{(bf16*)(ws + WS_HB)};
            pg8::gemm_phase<EpiGateUp, SchedMoe, true>(F.lds + RING_OFF, g, S, E, F.tid);
            SEAM(pb + 10);
        }
        if (HAS(11) && IN(pb + 11)) { FRESH();            moe_tables(F, l);
            pg8::Gemm g{(const pg8::bf16_t*)(ws + WS_HB), (const pg8::bf16_t*)(ws + WS_WDN), 512, 512, 512}; SchedMoe S{(const LAS int*)(F.lds + LDSX_OFF + 20480), F.vcu, F.G};
            EpiDown E{(bf16*)(ws + WS_YB), (const int*)(ws + WS_TOKPOS), (const float*)(ws + WS_TOKPOS + 524288)};
            pg8::gemm_phase<EpiDown, SchedMoe, true>(F.lds + RING_OFF, g, S, E, F.tid);
            SEAM(pb + 11);
        }
        if (HAS(12) && IN(pb + 12)) { FRESH(); phase_ln2(F, l, sub); SEAM(pb + 12); }
    }
#undef IN
#undef SEAM
}

extern "C" void kernel_launch(void* const* d_in, const int* in_sizes, int n_in, void* d_out, int out_size, void* d_ws, size_t ws_size, hipStream_t stream) {
    static int grid = 0;
    if (grid == 0) {
        if (n_in != 29 || in_sizes[0] != T * D || out_size != T * D || ws_size < WS_END) { fprintf(stderr, "kernel_launch: unexpected shapes / workspace (n_in %d, ws %zu < %zu)\n", n_in, ws_size, (size_t)WS_END); grid = -1; return; }
        int dev = 0, cus = 0;
        if (hipGetDevice(&dev) != hipSuccess || hipDeviceGetAttribute(&cus, hipDeviceAttributeMultiprocessorCount, dev) != hipSuccess) { grid = -1; return; }
        if (hipFuncSetAttribute((const void*)mega_fwd, hipFuncAttributeMaxDynamicSharedMemorySize, LDS_BYTES) != hipSuccess) { fprintf(stderr, "kernel_launch: hipFuncSetAttribute failed\n"); grid = -1; return; }
        int per_cu = 0;
        (void)hipOccupancyMaxActiveBlocksPerMultiprocessor(&per_cu, (const void*)mega_fwd, NWAVES * 64, LDS_BYTES);
        (void)hipGetLastError();
        if (cus != 256 || per_cu < 1) { fprintf(stderr, "kernel_launch: needs 256 CUs with one resident workgroup each (cus %d, per_cu %d)\n", cus, per_cu); grid = -1; return; }
        grid = cus;
    }
    if (grid < 0) return;
    (void)hipMemsetAsync((char*)d_ws + WS_CTL, 0, CTL_ZERO_BYTES, stream);
    Args a{};
    for (int i = 0; i < 29; ++i) a.in[i] = (const float*)d_in[i];
    a.out = (float*)d_out; a.ws = (unsigned char*)d_ws;
    a.sub = 0xF; a.pad = 0;
#if MK_ONE_LAUNCH
    a.ph_lo = 0; a.ph_hi = NPHASES;
    hipLaunchKernelGGL(mega_fwd, dim3(grid), dim3(NWAVES * 64), LDS_BYTES, stream, a);
#else
#ifndef PROBE_KIND
#define PROBE_KIND -1
#endif
#ifndef PROBE_REPS
#define PROBE_REPS 1
#endif
#ifndef PROBE_SUB
#define PROBE_SUB -1
#endif
    for (int p = 0; p < NPHASES; ++p) { a.ph_lo = p; a.ph_hi = p + 1; a.sub = 0xF;
        const int kind = (p == 0) ? 13 : (p - 1) % NPH_LAYER;
        if (kind == PROBE_KIND && PROBE_SUB != -1 && (PROBE_SUB & 0x100)) {   }
        hipLaunchKernelGGL(mega_fwd, dim3(grid), dim3(NWAVES * 64), LDS_BYTES, stream, a);
        if (kind == PROBE_KIND) { a.sub = PROBE_SUB; for (int r = 0; r < PROBE_REPS; ++r) hipLaunchKernelGGL(mega_fwd, dim3(grid), dim3(NWAVES * 64), LDS_BYTES, stream, a); }
    }
#endif
}
```

```cpp
#include <hip/hip_runtime.h>
#include <hip/hip_bf16.h>
#include <cstdio>
#include <cstdint>
#include <cmath>

#ifndef MK_ONE_LAUNCH
#define MK_ONE_LAUNCH 1
#endif

namespace pg8 {
#define PG8_LAS __attribute__((address_space(3)))
typedef unsigned short bf16_t;
typedef short bf16x8 __attribute__((ext_vector_type(8)));
typedef float f32x4 __attribute__((ext_vector_type(4)));
typedef float f32x2 __attribute__((ext_vector_type(2)));
typedef unsigned u32x4 __attribute__((ext_vector_type(4)));
typedef unsigned u32x2 __attribute__((ext_vector_type(2)));
constexpr int BM = 256, BK = 64, HALF = 128, HTB = HALF * BK * 2  , STAGE_BYTES = 8 * HTB, NXCD = 8, WGM = 8;

__host__ __device__ __forceinline__ int lds_byte(int r, int c) { const int st = (r >> 4) * 2 + (c >> 5), rr = r & 15, cc = c & 31, ob = rr * 64 + cc * 2; return st * 1024 + (ob ^ (((ob >> 9) & 1) << 5)); }
__host__ __device__ __forceinline__ void stage_rc(int b, int& R, int& C) { const int st = b / 1024, sb = b % 1024, swz = sb ^ (((sb >> 9) & 1) << 5); R = (st >> 1) * 16 + swz / 64; C = (st & 1) * 32 + (swz % 64) / 2; }
__host__ __device__ __forceinline__ int perm32(int rho) { const int n = rho >> 4, i = rho & 15; return 8 * (i >> 2) + 4 * n + (i & 3); }

struct Unit { int pm, pn; };
struct Gemm { const bf16_t* A; const bf16_t* Bt; int K, lda, ldb; };

struct StaticOrder {
    static constexpr bool GATHER = false;
    int nM, nN, nwg, G, c;
    __host__ __device__ void init(int M, int N, int G_, int c_) { nM = M / BM; nN = N / BM; nwg = nM * nN; G = G_; c = c_; }
    __host__ __device__ bool next(int i, Unit& u) const {
        const long L = (long)i * G + c; if (L >= nwg) return false;
        int wgid = (int)L; { const int q = nwg / NXCD, r = nwg % NXCD, xcd = wgid % NXCD, off = wgid / NXCD; wgid = (xcd < r ? xcd * (q + 1) : r * (q + 1) + (xcd - r) * q) + off; }
        const int nig = WGM * nN, gid = wgid / nig, fm = gid * WGM, gsz = (nM - fm) < WGM ? (nM - fm) : WGM;
        u.pm = fm + ((wgid % nig) % gsz); u.pn = (wgid % nig) / gsz; return true;
    }
};

__device__ __forceinline__ unsigned cvt_pk_bf16(float lo, float hi) { unsigned r; asm volatile("v_cvt_pk_bf16_f32 %0, %1, %2" : "=v"(r) : "v"(lo), "v"(hi)); return r; }

template <class Epi, class Sched, bool ALIGN_EPI = true>
__device__ __forceinline__ void gemm_phase(PG8_LAS unsigned char* lds, const Gemm g, const Sched& S, const Epi& E, const int tid  ) {
    const int wid = __builtin_amdgcn_readfirstlane(tid >> 6), lane = tid & 63, wr = wid >> 2, wc = wid & 3, fr = lane & 15, fq = lane >> 4;
    const int K = g.K, nt = K / BK;
    unsigned voffA[2], voffB[2];
#pragma unroll
    for (int i = 0; i < 2; ++i) { int R, C; stage_rc(tid * 16 + i * 8192, R, C); const int Rb = Epi::PERM ? ((R & ~31) + perm32(R & 31)) : R;
        voffA[i] = (unsigned)(R * g.lda + C) * 2u; voffB[i] = (unsigned)(Rb * g.ldb + C) * 2u; }
    unsigned cvo[2][2] = {{0u, 0u}, {0u, 0u}}, nvo[2][2] = {{0u, 0u}, {0u, 0u}}; int gR[2] = {0, 0}; unsigned gC[2] = {0u, 0u};
    if constexpr (Sched::GATHER) {
#pragma unroll
        for (int i = 0; i < 2; ++i) { int R, C; stage_rc(tid * 16 + i * 8192, R, C); gR[i] = R; gC[i] = (unsigned)C * 2u; }
    }
    const size_t kstep = (size_t)(BK * 2);
    const size_t hstepA = (size_t)HALF * g.lda * 2, hstepB = (size_t)HALF * g.ldb * 2;
    const size_t tstepA = 2 * hstepA, tstepB = 2 * hstepB;
    const unsigned ldsw = (unsigned)wid * 1024u;
    const int aoff = lds_byte(wr * 64 + fr, fq * 8), boff = lds_byte(wc * 32 + fr, fq * 8);
#define PG8_SA(b, h) (((b) * 2 + (h)) * HTB)
#define PG8_SB(b, h) ((4 + (b) * 2 + (h)) * HTB)
#define PG8_STAGE(bufoff, gbase, voff) do { _Pragma("unroll") for (int _i = 0; _i < 2; ++_i) \
        __builtin_amdgcn_global_load_lds((const unsigned*)((const char*)(gbase) + (voff)[_i]), (PG8_LAS unsigned*)(lds + (bufoff) + ldsw + _i * 8192), 16, 0, 0); } while (0)
#define PG8_LDA(dst, b, h) do { _Pragma("unroll") for (int m = 0; m < 4; ++m) _Pragma("unroll") for (int k = 0; k < 2; ++k) dst[m][k] = *(const PG8_LAS bf16x8*)(lds + PG8_SA(b, h) + aoff + m * 2048 + k * 1024); } while (0)
#define PG8_LDB(dst, b, h) do { _Pragma("unroll") for (int n = 0; n < 2; ++n) _Pragma("unroll") for (int k = 0; k < 2; ++k) dst[n][k] = *(const PG8_LAS bf16x8*)(lds + PG8_SB(b, h) + boff + n * 2048 + k * 1024); } while (0)
#define PG8_MMA(ai, bj, At, Bt) do { __builtin_amdgcn_s_setprio(1); _Pragma("unroll") for (int m = 0; m < 4; ++m) _Pragma("unroll") for (int n = 0; n < 2; ++n) _Pragma("unroll") for (int k = 0; k < 2; ++k) \
        acc[ai][bj][m][n] = __builtin_amdgcn_mfma_f32_16x16x32_bf16(Bt[n][k], At[m][k], acc[ai][bj][m][n], 0, 0, 0); __builtin_amdgcn_s_setprio(0); } while (0)
#define PG8_WAIT_V(n) asm volatile("s_waitcnt vmcnt(" #n ")" ::: "memory")
#define PG8_WAIT_L(n) asm volatile("s_waitcnt lgkmcnt(" #n ")" ::: "memory")
#define PG8_BAR __builtin_amdgcn_s_barrier()
#define PG8_SCHED __builtin_amdgcn_sched_barrier(0)
    Unit cur, nxt; int ui = 0;
    if (!S.next(0, cur)) return;
    f32x4 acc[2][2][4][2];
    float zf = 0.f; asm volatile("" : "+v"(zf));
#pragma unroll
    for (int a = 0; a < 2; ++a)
#pragma unroll
        for (int b = 0; b < 2; ++b)
#pragma unroll
            for (int m = 0; m < 4; ++m)
#pragma unroll
                for (int n = 0; n < 2; ++n) acc[a][b][m][n] = (f32x4){zf, zf, zf, zf};
    bf16x8 At[4][2], B0[2][2], B1[2][2];
    const char* cA = Sched::GATHER ? (const char*)g.A : (const char*)g.A + (size_t)cur.pm * tstepA; const char* cB = (const char*)g.Bt + (size_t)cur.pn * tstepB;
    if constexpr (Sched::GATHER) {
#pragma unroll
        for (int h = 0; h < 2; ++h)
#pragma unroll
            for (int i = 0; i < 2; ++i) cvo[h][i] = S.row_byte_off(0, 128 * h + gR[i]) + gC[i];
    }
#define PG8_STAGE_A(bufoff, gbase, h, vo) do { if constexpr (Sched::GATHER) { PG8_STAGE(bufoff, gbase, (vo)[h]); } else { PG8_STAGE(bufoff, (gbase) + (h) * hstepA, voffA); } } while (0)
    PG8_STAGE(PG8_SB(0, 0), cB, voffB); PG8_STAGE(PG8_SB(0, 1), cB + hstepB, voffB); PG8_STAGE_A(PG8_SA(0, 0), cA, 0, cvo); PG8_STAGE_A(PG8_SA(0, 1), cA, 1, cvo);
    if (wr == 1) PG8_BAR;
    PG8_WAIT_V(2); PG8_BAR;
    PG8_STAGE(PG8_SB(1, 0), cB + kstep, voffB); PG8_STAGE_A(PG8_SA(1, 0), cA + kstep, 0, cvo); PG8_STAGE(PG8_SB(1, 1), cB + hstepB + kstep, voffB);
    PG8_WAIT_V(6); PG8_BAR;
    for (;;) {
        const bool has_next = S.next(ui + 1, nxt);
        const char* nA = (has_next && !Sched::GATHER) ? (const char*)g.A + (size_t)nxt.pm * tstepA : cA; const char* nB = has_next ? (const char*)g.Bt + (size_t)nxt.pn * tstepB : cB;
        if constexpr (Sched::GATHER) {
#pragma unroll
            for (int h = 0; h < 2; ++h)
#pragma unroll
                for (int i = 0; i < 2; ++i) nvo[h][i] = has_next ? S.row_byte_off(ui + 1, 128 * h + gR[i]) + gC[i] : cvo[h][i];
        }
        for (int t = 0; t < nt; t += 2) {
            const bool last = (t == nt - 2);
            const char* a1 = cA + (size_t)(t + 1) * kstep;
            const char* a2 = last ? nA : cA + (size_t)(t + 2) * kstep; const char* b2 = last ? nB : cB + (size_t)(t + 2) * kstep;
            const char* a3 = a2 + kstep; const char* b3 = b2 + kstep;
            unsigned vo2[2][2];
#pragma unroll
            for (int h = 0; h < 2; ++h)
#pragma unroll
                for (int i = 0; i < 2; ++i) vo2[h][i] = last ? nvo[h][i] : cvo[h][i];
            PG8_LDB(B0, 0, 0); PG8_LDB(B1, 0, 1); PG8_SCHED; PG8_LDA(At, 0, 0); PG8_STAGE_A(PG8_SA(1, 1), a1, 1, cvo);
            PG8_WAIT_V(8); PG8_WAIT_L(0); PG8_BAR; PG8_MMA(0, 0, At, B0); PG8_MMA(0, 1, At, B1); PG8_BAR; PG8_SCHED;
            PG8_LDA(At, 0, 1); PG8_STAGE(PG8_SB(0, 0), b2, voffB); PG8_STAGE(PG8_SB(0, 1), b2 + hstepB, voffB); PG8_STAGE_A(PG8_SA(0, 0), a2, 0, vo2);
            PG8_WAIT_V(8); PG8_WAIT_L(0); PG8_BAR; PG8_MMA(1, 0, At, B0); PG8_MMA(1, 1, At, B1); PG8_BAR; PG8_SCHED;
            PG8_LDB(B0, 1, 0); PG8_LDB(B1, 1, 1); PG8_SCHED; PG8_LDA(At, 1, 0); PG8_STAGE_A(PG8_SA(0, 1), a2, 1, vo2);
            PG8_WAIT_V(8); PG8_WAIT_L(0); PG8_BAR; PG8_MMA(0, 0, At, B0); PG8_MMA(0, 1, At, B1); PG8_BAR; PG8_SCHED;
            PG8_LDA(At, 1, 1); PG8_STAGE(PG8_SB(1, 0), b3, voffB); PG8_STAGE(PG8_SB(1, 1), b3 + hstepB, voffB); PG8_STAGE_A(PG8_SA(1, 0), a3, 0, vo2);
            PG8_WAIT_V(8); PG8_WAIT_L(0); PG8_BAR; PG8_MMA(1, 0, At, B0); PG8_MMA(1, 1, At, B1); PG8_BAR; PG8_SCHED;
        }
        if constexpr (ALIGN_EPI) { if (wr == 0) PG8_BAR; }
        E(acc, cur, wr, wc, fr, fq);
        if (!has_next) break;
        if (E.reset_after(cur)) {
#pragma unroll
        for (int a = 0; a < 2; ++a)
#pragma unroll
            for (int b = 0; b < 2; ++b)
#pragma unroll
                for (int m = 0; m < 4; ++m)
#pragma unroll
                    for (int n = 0; n < 2; ++n) acc[a][b][m][n] = (f32x4){zf, zf, zf, zf};
        }
        cur = nxt; cA = nA; cB = nB; ++ui;
        if constexpr (Sched::GATHER) {
#pragma unroll
            for (int h = 0; h < 2; ++h)
#pragma unroll
                for (int i = 0; i < 2; ++i) cvo[h][i] = nvo[h][i];
        }
        if constexpr (ALIGN_EPI) { if (wr == 1) PG8_BAR; }
    }
    PG8_WAIT_V(0);
    if constexpr (!ALIGN_EPI) { if (wr == 0) PG8_BAR; }
    PG8_BAR;
#undef PG8_SA
#undef PG8_SB
#undef PG8_STAGE
#undef PG8_STAGE_A
#undef PG8_LDA
#undef PG8_LDB
#undef PG8_MMA
#undef PG8_WAIT_V
#undef PG8_WAIT_L
#undef PG8_BAR
#undef PG8_SCHED
}
}

#include <hip/hip_bf16.h>
#include <cmath>
namespace attn_body {
using bf16=__hip_bfloat16;
using bf16x8=__attribute__((ext_vector_type(8)))short;
using s16x4=__attribute__((ext_vector_type(4)))short;
using f32x16=__attribute__((ext_vector_type(16)))float;
using u32x4=__attribute__((ext_vector_type(4)))unsigned;
using f32x4v=__attribute__((ext_vector_type(4)))float;
constexpr int BATCH=8,NHEAD=8,SEQ=4096,D=64,DM=1536,DMO=512;
constexpr int NW=8,QBLK=32,QB=QBLK*NW,KVBLK=64,NQB=SEQ/QB;
constexpr int ATTN_PITCH=DM, ATTN_UNIT_ROWS=QB;
__device__ __forceinline__ int crow(int r,int hi){return (r&3)+8*(r>>2)+4*hi;}
#define SBAR() __builtin_amdgcn_sched_barrier(0)
__device__ __forceinline__ void cmask(f32x16&p0,f32x16&p1,int jb,int qrel,int hi){
  const float NEG=-INFINITY; int kb=64*jb+4*hi;
  #pragma unroll
  for(int r=0;r<16;++r){int kv=kb+(r&3)+8*(r>>2); if(kv>qrel)p0[r]=NEG; if(kv+32>qrel)p1[r]=NEG;}
}

constexpr int NSLOT=3, SLOTB=8192;
constexpr int LDS_K=0, LDS_V=NSLOT*SLOTB, LDS_WS=2*NSLOT*SLOTB, LDS_OST=LDS_WS+NW*64*4, LDS_F=LDS_OST+NW*4096, LDS_Q=LDS_F+SEQ*4, LDS_BYTES=LDS_Q+NW*4096;
constexpr float PRUNE2=64.f;
constexpr float C2=0.125f*1.4426950408889634f;
__device__ __forceinline__ void glds16(const void*gsrc,unsigned lds_dst){unsigned keep;
  asm volatile("s_mov_b32 %0, m0\n\ts_mov_b32 m0, %2\n\ts_nop 0\n\tglobal_load_lds_dwordx4 %1, off\n\ts_mov_b32 m0, %0":"=&s"(keep):"v"(gsrc),"s"(lds_dst):"memory");}
__device__ __forceinline__ void glds16s(const void*sbase,unsigned voff,unsigned lds_dst){unsigned keep;
  asm volatile("s_mov_b32 %0, m0\n\ts_mov_b32 m0, %3\n\ts_nop 0\n\tglobal_load_lds_dwordx4 %1, %2\n\ts_mov_b32 m0, %0":"=&s"(keep):"v"(voff),"s"(sbase),"s"(lds_dst):"memory");}
__device__ __forceinline__ float max3f(float a,float b,float c){float r;asm("v_max3_f32 %0, %1, %2, %3":"=v"(r):"v"(a),"v"(b),"v"(c));return r;}
__device__ __forceinline__ float max2f(float a,float b){float r;asm("v_max_f32_e32 %0, %1, %2":"=v"(r):"v"(a),"v"(b));return r;}
__device__ __forceinline__ float fadd_s(float a,float b){float r;asm("v_add_f32_e32 %0, %1, %2":"=v"(r):"v"(a),"v"(b));return r;}
__device__ __forceinline__ float fsub_s(float a,float b){float r;asm("v_sub_f32_e32 %0, %1, %2":"=v"(r):"v"(a),"v"(b));return r;}
typedef float f32x2_t __attribute__((ext_vector_type(2))); typedef __bf16 bf16x2_t __attribute__((ext_vector_type(2)));
__device__ __forceinline__ unsigned cvtpk_s(float lo,float hi){f32x2_t v={lo,hi};bf16x2_t b=__builtin_convertvector(v,bf16x2_t);return __builtin_bit_cast(unsigned,b);}
#define WAIT_BAR(N) asm volatile("s_waitcnt vmcnt(" #N ") lgkmcnt(0)\n\ts_barrier":::"memory")

__device__ __forceinline__ void qkt(f32x16&p0,f32x16&p1,const char*Kslot,const bf16x8*qr,int r32,int hi){
  const char*kb=Kslot+hi*1024+r32*16;
  #pragma unroll
  for(int d0=0;d0<4;++d0){
    const bf16x8 b0=*reinterpret_cast<const bf16x8*>(kb+d0*2048);
    const bf16x8 b1=*reinterpret_cast<const bf16x8*>(kb+d0*2048+512);
    {p0=__builtin_amdgcn_mfma_f32_32x32x16_bf16(b0,qr[d0],p0,0,0,0);p1=__builtin_amdgcn_mfma_f32_32x32x16_bf16(b1,qr[d0],p1,0,0,0);}}
}
typedef __attribute__((address_space(3))) const char* lds_cptr;
typedef short v4i16_t __attribute__((ext_vector_type(4)));
__device__ __forceinline__ void kload8(bf16x8*kf,lds_cptr kp){
  kf[0]=*(const __attribute__((address_space(3))) bf16x8*)(kp);      kf[1]=*(const __attribute__((address_space(3))) bf16x8*)(kp+512);
  kf[2]=*(const __attribute__((address_space(3))) bf16x8*)(kp+2048); kf[3]=*(const __attribute__((address_space(3))) bf16x8*)(kp+2560);
  kf[4]=*(const __attribute__((address_space(3))) bf16x8*)(kp+4096); kf[5]=*(const __attribute__((address_space(3))) bf16x8*)(kp+4608);
  kf[6]=*(const __attribute__((address_space(3))) bf16x8*)(kp+6144); kf[7]=*(const __attribute__((address_space(3))) bf16x8*)(kp+6656);
}
__device__ __forceinline__ void kload2(bf16x8*kf,lds_cptr kp,int j){ kf[2*j]=*(const __attribute__((address_space(3))) bf16x8*)(kp+j*2048); kf[2*j+1]=*(const __attribute__((address_space(3))) bf16x8*)(kp+j*2048+512); }
__device__ __forceinline__ s16x4 vtr(lds_cptr p){ return __builtin_bit_cast(s16x4,__builtin_amdgcn_ds_read_tr16_b64_v4i16((__attribute__((address_space(3))) v4i16_t*)p)); }
__device__ __forceinline__ float rowmax(const f32x16&p0,const f32x16&p1){
  float a=max3f(p0[0],p0[1],p1[0]),b=max3f(p0[2],p0[3],p1[1]);a=max3f(a,p1[2],p1[3]);
  #pragma unroll
  for(int r=4;r<16;r+=4){a=max3f(a,p0[r],p0[r+1]);b=max3f(b,p0[r+2],p0[r+3]);a=max3f(a,p1[r],p1[r+1]);b=max3f(b,p1[r+2],p1[r+3]);}
  const float m=max2f(a,b);
  auto rr=__builtin_amdgcn_permlane32_swap(__float_as_uint(m),__float_as_uint(m),false,false);
  return max2f(__uint_as_float(rr[0]),__uint_as_float(rr[1]));
}
__device__ __forceinline__ void pv(f32x16*o,int vb,bf16x8 pa0,bf16x8 pa1,bf16x8 pa2,bf16x8 pa3){
  #pragma unroll
  for(int d0=0;d0<2;++d0){s16x4 lo[4],hi[4];
    #pragma unroll
    for(int ks=0;ks<4;++ks){
      asm volatile("ds_read_b64_tr_b16 %0,%1 offset:%c2":"=&v"(lo[ks]):"v"(vb),"i"(d0*4096+ks*1024):"memory");
      asm volatile("ds_read_b64_tr_b16 %0,%1 offset:%c2":"=&v"(hi[ks]):"v"(vb),"i"(d0*4096+ks*1024+512):"memory");}
    asm volatile("s_waitcnt lgkmcnt(0)":::"memory");SBAR();
    #define PK(k) (bf16x8){lo[k][0],lo[k][1],lo[k][2],lo[k][3],hi[k][0],hi[k][1],hi[k][2],hi[k][3]}
    o[d0]=__builtin_amdgcn_mfma_f32_32x32x16_bf16(pa0,PK(0),o[d0],0,0,0);
    o[d0]=__builtin_amdgcn_mfma_f32_32x32x16_bf16(pa1,PK(1),o[d0],0,0,0);
    o[d0]=__builtin_amdgcn_mfma_f32_32x32x16_bf16(pa2,PK(2),o[d0],0,0,0);
    o[d0]=__builtin_amdgcn_mfma_f32_32x32x16_bf16(pa3,PK(3),o[d0],0,0,0);
    #undef PK
  }
}

#ifndef ATTN_STORE16
#define ATTN_STORE16(p,v) (*(u32x4*)(p)=(v))
#endif
template<int THRL> __device__ __forceinline__ void attn_unit(int b,int h,int qb,const bf16*Q,const bf16*__restrict__ K,const bf16*__restrict__ V,bf16*O,const float*__restrict__ Ftab,char*shm,const int tid){
  const int lane=tid&63,r32=lane&31,hi=lane>>5; const int wid=__builtin_amdgcn_readfirstlane(tid>>6);
  const long rowbase=(long)b*SEQ; const int q0=qb*QB;
  const bf16*Qw=Q+(rowbase+q0+wid*QBLK)*DM+h*D;
  const float*Fh=Ftab+(long)(b*NHEAD+h)*SEQ;
  int ts=0;
  { const int NT0=(q0+QB)/KVBLK; const float fq0=Fh[q0]; const float fk=Fh[(lane<NT0?lane:NT0-1)*KVBLK+KVBLK-1];
    const unsigned long long mk=__ballot(lane<NT0&&(fq0-fk>=-PRUNE2)); const int first=mk?(int)__builtin_ctzll(mk):0; ts=first&~1; if(ts>NT0-4)ts=NT0-4; ts=__builtin_amdgcn_readfirstlane(ts); }
  const bf16*Kh=K+(rowbase+(long)ts*KVBLK)*DM+h*D,*Vh=V+(rowbase+(long)ts*KVBLK)*DM+h*D;
  const unsigned lds0=(unsigned)(uintptr_t)shm;
  float*wsf=(float*)(shm+LDS_WS)+wid*64;
  const unsigned koff=(unsigned)(lane*DM+wid*8)*2u;
  const unsigned voff=(unsigned)((16*(wid&3)+(lane>>2))*DM+(wid>>2)*32+(lane&3)*8)*2u;
  const unsigned kdst=lds0+LDS_K+wid*1024, vdst=lds0+LDS_V+wid*1024;
  #define DMA_K(t,slot) glds16s(Kh+(long)(t)*KVBLK*DM,koff,(unsigned)__builtin_amdgcn_readfirstlane(kdst+(slot)))
  #define DMA_V(t,slot) glds16s(Vh+(long)(t)*KVBLK*DM,voff,(unsigned)__builtin_amdgcn_readfirstlane(vdst+(slot)))
  const int vb0=(int)(lds0+LDS_V)+((lane>>4)&1)*32+(lane&3)*8+(4*hi+((lane&15)>>2))*64;
  const char*Kbase=shm+LDS_K; bf16x8 kf[8];
  const lds_cptr shm3=(lds_cptr)shm; const lds_cptr kp0=shm3+LDS_K+hi*1024+r32*16; const lds_cptr vp0=shm3+LDS_V+((lane>>4)&1)*32+(lane&3)*8+(4*hi+((lane&15)>>2))*64;
  const int NT=(q0+QB)/KVBLK-ts;
  { glds16s(Fh,(unsigned)(lane*16+wid*1024),(unsigned)__builtin_amdgcn_readfirstlane(lds0+LDS_F+wid*1024));
    glds16s(Fh,(unsigned)(lane*16+(wid+8)*1024),(unsigned)__builtin_amdgcn_readfirstlane(lds0+LDS_F+(wid+8)*1024)); }
  const float fq2=Fh[q0+wid*QBLK+r32];
  DMA_K(0,0);DMA_V(0,0);DMA_K(1,SLOTB);
  const lds_cptr qs=(lds_cptr)shm+LDS_Q+wid*4096+(hi*32+r32)*16;
  #pragma unroll
  for(int d0=0;d0<4;++d0)*(__attribute__((address_space(3))) bf16x8*)(qs+d0*1024)=*reinterpret_cast<const bf16x8*>(&Qw[(long)r32*DM+d0*16+hi*8]);
  #define QF(k) (*(const __attribute__((address_space(3))) bf16x8*)(qs+(k)*1024))
  float mhat=-fq2,nm=fq2,l_reg=0.f;f32x16 o[2];o[0]=f32x16{};o[1]=f32x16{};
  const lds_cptr fl0=(lds_cptr)shm+LDS_F+hi*16+ts*256;
  #define FINIT1(C0,t,o_) do{ const __attribute__((address_space(3))) f32x4v* fp_=(const __attribute__((address_space(3))) f32x4v*)(fl0+(t)*256+(o_)); \
    _Pragma("unroll") for(int j_=0;j_<4;++j_){ const f32x4v a_=fp_[2*j_]; \
      C0[4*j_]=nm-a_[0]; C0[4*j_+1]=nm-a_[1]; C0[4*j_+2]=nm-a_[2]; C0[4*j_+3]=nm-a_[3]; } }while(0)
  #define FINIT(C0,C1,t) do{ FINIT1(C0,t,0); FINIT1(C1,t,128); }while(0)
  const int qrel=wid*QBLK+r32;
  #define CMASK(P0,P1,t) do{int jb_=(t)-(NT-4); if(jb_>=0)cmask(P0,P1,jb_,qrel,hi);}while(0)
  bool resc=false;
  #define START(P0,P1) do{ const float rm=rowmax(P0,P1); resc=false; \
    { const float dl=rm; mhat=fadd_s(mhat,dl); \
      _Pragma("unroll") for(int r=0;r<16;++r){P0[r]=fsub_s(P0[r],dl);P1[r]=fsub_s(P1[r],dl);} \
      nm=-mhat; } \
    _Pragma("unroll") for(int r=0;r<16;++r)P0[r]=__builtin_amdgcn_exp2f(P0[r]); }while(0)
  #define RESC() do{ if(resc){ asm volatile("s_waitcnt lgkmcnt(0)":::"memory"); \
      _Pragma("unroll") for(int d_=0;d_<2;++d_) _Pragma("unroll") for(int r=0;r<16;++r)o[d_][r]*=wsf[crow(r,hi)]; } }while(0)
  f32x16 pA0,pA1,pB0,pB1;
  int sl_prev=0,sl_cur=0,sl_next=SLOTB;
  #define ROT() do{sl_prev=sl_cur;sl_cur=sl_next;sl_next=(sl_next==(NSLOT-1)*SLOTB)?0:sl_next+SLOTB;}while(0)
  DMA_K(2,2*SLOTB);
  WAIT_BAR(3);
  { bf16x8 qr[4]; qr[0]=QF(0);qr[1]=QF(1);qr[2]=QF(2);qr[3]=QF(3); FINIT(pA0,pA1,0); qkt(pA0,pA1,Kbase,qr,r32,hi); }asm volatile("s_nop 15\n\ts_nop 7":"+v"(pA0),"+v"(pA1));CMASK(pA0,pA1,0);
  START(pA0,pA1);
  _Pragma("unroll") for(int r=0;r<16;++r)pA1[r]=__builtin_amdgcn_exp2f(pA1[r]);
  WAIT_BAR(0);
  DMA_K(3,0);DMA_V(1,SLOTB);
  ROT();
  kload8(kf,kp0+sl_cur);
  WAIT_BAR(2);
  s16x4 vlo[8],vhi[8]; u32x4 pw0,pw1,pw2,pw3;
  #define PKW(P,B) cvtpk_s(P[B],P[B+1])
  #define PAF(k) __builtin_bit_cast(bf16x8,pw##k)
  #define VFR(i) (bf16x8){vlo[i][0],vlo[i][1],vlo[i][2],vlo[i][3],vhi[i][0],vhi[i][1],vhi[i][2],vhi[i][3]}
  #define PIN(x) asm volatile("":"+v"(x))
  #define MX3(a,b,c) __builtin_fmaxf(__builtin_fmaxf((a),(b)),(c))
  #define GAPA(MF,A0,A1,A2,A3,W0,W1,PW) do{ MF; sacc+=A0; sacc+=A1; sacc+=A2; sacc+=A3; PIN(sacc); W0; W1; PIN(PW); SBAR(); }while(0)
  #define EX(v) __builtin_amdgcn_exp2f(v)
  #define GAPB(MF,X,B) do{ MF; X[B]=EX(X[B]); X[B+1]=EX(X[B+1]); X[B+2]=EX(X[B+2]); X[B+3]=EX(X[B+3]); PIN(X); SBAR(); }while(0)
  #define VRD(i) do{ vlo[i]=vtr(vp_+(((i)>>2)*4096+((i)&3)*1024)); vhi[i]=vtr(vp_+(((i)>>2)*4096+((i)&3)*1024+512)); }while(0)
  #define KRD(G,j) do{ if(G){ kload2(kf,kp0+sl_next,j); SBAR(); } }while(0)
  #define STEP(C0,C1,P0,P1,t,GK,GV,GL) do{ SBAR(); FINIT1(C0,t,0); bf16x8 qA_=QF(0),qB_=QF(1); SBAR(); \
    const lds_cptr vp_=vp0+sl_prev; \
    VRD(0); SBAR(); float sacc=(P0[0]+P0[1]); \
    GAPA(C0=__builtin_amdgcn_mfma_f32_32x32x16_bf16(kf[0],qA_,C0,0,0,0), P0[2],P0[3],P0[4],P0[5],     pw0[0]=PKW(P0,0), pw0[1]=PKW(P0,2), pw0); \
    FINIT1(C1,t,128); SBAR(); VRD(4); SBAR(); GAPA(C1=__builtin_amdgcn_mfma_f32_32x32x16_bf16(kf[1],qA_,C1,0,0,0), P0[6],P0[7],P0[8],P0[9],     pw0[2]=PKW(P0,4), pw0[3]=PKW(P0,6), pw0); \
    qA_=QF(2); VRD(1); SBAR(); GAPA(C0=__builtin_amdgcn_mfma_f32_32x32x16_bf16(kf[2],qB_,C0,0,0,0),   P0[10],P0[11],P0[12],P0[13], pw1[0]=PKW(P0,8), pw1[1]=PKW(P0,10), pw1); \
    VRD(5); SBAR(); GAPA(C1=__builtin_amdgcn_mfma_f32_32x32x16_bf16(kf[3],qB_,C1,0,0,0),   P0[14],P0[15],P1[0],P1[1],   pw1[2]=PKW(P0,12),pw1[3]=PKW(P0,14), pw1); \
    qB_=QF(3); VRD(2); SBAR(); GAPA(C0=__builtin_amdgcn_mfma_f32_32x32x16_bf16(kf[4],qA_,C0,0,0,0),   P1[2],P1[3],P1[4],P1[5],     pw2[0]=PKW(P1,0), pw2[1]=PKW(P1,2), pw2); \
    VRD(6); SBAR(); GAPA(C1=__builtin_amdgcn_mfma_f32_32x32x16_bf16(kf[5],qA_,C1,0,0,0),   P1[6],P1[7],P1[8],P1[9],     pw2[2]=PKW(P1,4), pw2[3]=PKW(P1,6), pw2); \
    VRD(3); SBAR(); GAPA(C0=__builtin_amdgcn_mfma_f32_32x32x16_bf16(kf[6],qB_,C0,0,0,0),   P1[10],P1[11],P1[12],P1[13], pw3[0]=PKW(P1,8), pw3[1]=PKW(P1,10), pw3); \
    VRD(7); SBAR(); GAPA(C1=__builtin_amdgcn_mfma_f32_32x32x16_bf16(kf[7],qB_,C1,0,0,0),   P1[14],P1[15],0.f,0.f,       pw3[2]=PKW(P1,12),pw3[3]=PKW(P1,14), pw3); \
    l_reg+=sacc; \
    if(GK){DMA_K((t)+3,sl_cur);} if(GV){DMA_V((t)+1,sl_next);} \
    CMASK(C0,C1,t); \
    { float a=MX3(C0[0],C0[1],C1[0]),b=MX3(C0[2],C0[3],C1[1]); a=MX3(a,C1[2],C1[3]); \
      _Pragma("unroll") for(int r=4;r<16;r+=4){a=MX3(a,C0[r],C0[r+1]);b=MX3(b,C0[r+2],C0[r+3]);a=MX3(a,C1[r],C1[r+1]);b=MX3(b,C1[r+2],C1[r+3]);} \
      float rm=__builtin_fmaxf(a,b); { auto rr=__builtin_amdgcn_permlane32_swap(__float_as_uint(rm),__float_as_uint(rm),false,false); rm=__builtin_fmaxf(__uint_as_float(rr[0]),__uint_as_float(rr[1])); } \
      resc=false; \
      if(__builtin_expect(__any(rm>(float)THRL),0)){ const float dl=__builtin_fmaxf(rm,0.f); mhat+=dl; \
        _Pragma("unroll") for(int r=0;r<16;++r){C0[r]-=dl;C1[r]-=dl;} \
        nm=-mhat; \
        const float f=__builtin_amdgcn_exp2f(-dl); l_reg*=f; if(hi==0)wsf[r32]=f; resc=true; } } \
    SBAR(); \
    GAPB(o[0]=__builtin_amdgcn_mfma_f32_32x32x16_bf16(PAF(0),VFR(0),o[0],0,0,0), C0,0); \
    GAPB(o[1]=__builtin_amdgcn_mfma_f32_32x32x16_bf16(PAF(0),VFR(4),o[1],0,0,0), C0,4); \
    KRD(GL,0); GAPB(o[0]=__builtin_amdgcn_mfma_f32_32x32x16_bf16(PAF(1),VFR(1),o[0],0,0,0), C0,8); \
    KRD(GL,1); GAPB(o[1]=__builtin_amdgcn_mfma_f32_32x32x16_bf16(PAF(1),VFR(5),o[1],0,0,0), C0,12); \
    KRD(GL,2); GAPB(o[0]=__builtin_amdgcn_mfma_f32_32x32x16_bf16(PAF(2),VFR(2),o[0],0,0,0), C1,0); \
    KRD(GL,3); GAPB(o[1]=__builtin_amdgcn_mfma_f32_32x32x16_bf16(PAF(2),VFR(6),o[1],0,0,0), C1,4); \
    GAPB(o[0]=__builtin_amdgcn_mfma_f32_32x32x16_bf16(PAF(3),VFR(3),o[0],0,0,0), C1,8); \
    GAPB(o[1]=__builtin_amdgcn_mfma_f32_32x32x16_bf16(PAF(3),VFR(7),o[1],0,0,0), C1,12); \
    }while(0)
  int t=1;
  #undef CMASK
  #define CMASK(P0,P1,t) do{}while(0)
  for(;t+5<NT;t+=2){
    STEP(pB0,pB1,pA0,pA1,t,true,true,true);     WAIT_BAR(2); RESC(); ROT();
    STEP(pA0,pA1,pB0,pB1,t+1,true,true,true);   WAIT_BAR(2); RESC(); ROT();
  }
  #undef CMASK
  #define CMASK(P0,P1,t) do{int jb_=(t)-(NT-4); if(jb_>=0)cmask(P0,P1,jb_,qrel,hi);}while(0)
  #define ENDW(tt) do{ if((tt)+3<NT){WAIT_BAR(2);} else if((tt)+2<NT){WAIT_BAR(1);} else {WAIT_BAR(0);} }while(0)
  for(;t+1<NT;t+=2){
    STEP(pB0,pB1,pA0,pA1,t,(t+3<NT),(t+1<NT),(t+1<NT));       ENDW(t);   RESC(); ROT();
    STEP(pA0,pA1,pB0,pB1,t+1,(t+4<NT),(t+2<NT),(t+2<NT));     ENDW(t+1); RESC(); ROT();
  }
  STEP(pB0,pB1,pA0,pA1,NT-1,false,false,false); RESC();
  { float sacc=pB0[0]+pB0[1]; _Pragma("unroll") for(int r=2;r<16;++r)sacc+=pB0[r]; _Pragma("unroll") for(int r=0;r<16;++r)sacc+=pB1[r]; l_reg+=sacc;
    pw0=(u32x4){PKW(pB0,0),PKW(pB0,2),PKW(pB0,4),PKW(pB0,6)};pw1=(u32x4){PKW(pB0,8),PKW(pB0,10),PKW(pB0,12),PKW(pB0,14)};pw2=(u32x4){PKW(pB1,0),PKW(pB1,2),PKW(pB1,4),PKW(pB1,6)};pw3=(u32x4){PKW(pB1,8),PKW(pB1,10),PKW(pB1,12),PKW(pB1,14)};
    SBAR(); pv(o,vb0+sl_cur,PAF(0),PAF(1),PAF(2),PAF(3)); }
  #undef PKW
  #undef PAF
  #undef VFR
  #undef PIN
  #undef MX3
  #undef GAPA
  #undef GAPB
  #undef EX
  #undef VRD
  #undef KRD
  #undef STEP
  #undef ENDW
  {auto rr=__builtin_amdgcn_permlane32_swap(__float_as_uint(l_reg),__float_as_uint(l_reg),false,false);l_reg=__uint_as_float(rr[0])+__uint_as_float(rr[1]);}
  if(hi==0)wsf[32+r32]=l_reg;asm volatile("s_waitcnt lgkmcnt(0)":::"memory");
  float rli[16];
  #pragma unroll
  for(int r=0;r<16;++r)rli[r]=__builtin_amdgcn_rcpf(wsf[32+crow(r,hi)]);
  bf16*Ow=O+(rowbase+q0+wid*QBLK)*DMO+h*D;
  { bf16*stg=(bf16*)(shm+LDS_OST)+wid*2048;
    #pragma unroll
    for(int r=0;r<16;++r){const int orow=crow(r,hi);
      #pragma unroll
      for(int d0=0;d0<2;++d0)stg[orow*64+d0*32+r32]=__float2bfloat16(o[d0][r]*rli[r]);}
    asm volatile("s_waitcnt lgkmcnt(0)":::"memory");
    #pragma unroll
    for(int i=0;i<4;++i){const int row=i*8+(lane>>3),ch=lane&7; const u32x4 v=*(const u32x4*)(stg+row*64+ch*8); ATTN_STORE16(Ow+(long)row*DMO+ch*8,v);} }
  asm volatile("s_waitcnt lgkmcnt(0)\n\ts_barrier":::"memory");
  #undef DMA_K
  #undef DMA_V
  #undef CMASK
  #undef START
  #undef RESC
  #undef FINIT
  #undef QF
  #undef FINIT1
  #undef ROT
}
constexpr int ATTN_LDS_BYTES=LDS_BYTES;
struct AttnTensors { const bf16* Q; const bf16* K; const bf16* V; bf16* O; const float* F; };
#undef SBAR
#undef WAIT_BAR
}

constexpr int NWAVES = 8;
constexpr int BATCH = 8, SEQ = 4096, D = 1024, T = BATCH * SEQ, NL = 4;
constexpr int BW = 512, INTOT = 7184, NIN = 7168;
constexpr int MH = 4, MDH = 128, AH = 8, ADH = 64, S5G = 32, S5C = 16, S5P = 64, S5L = 32  , S5K = 640;
constexpr int NEXP = 32, EH = 512, MOE_ROWS = 73728  , MOE_NBLK_MAX = 288;
constexpr float LN_EPS = 1e-5f;
constexpr float ALPHA = 1.6817928305074290f;
constexpr float C2 = 0.125f * 1.4426950408889634f;
constexpr float LOG2E = 1.4426950408889634f;
constexpr int NPH_LAYER = 13, NPHASES = 1 + NL * NPH_LAYER;

constexpr size_t MiB = 1u << 20;
constexpr size_t WS_CTL = 0, CTL_ZERO_BYTES = 65536;
constexpr size_t WS_S5TAB = 2 * MiB;
constexpr size_t WS_MSC = 2 * MiB + 65536;
constexpr size_t WS_WSM = 2 * MiB + 131072;
constexpr size_t WS_NST = 3 * MiB;
constexpr size_t WS_WIN = 4 * MiB, WS_WGLU = 18 * MiB, WS_WBR = 19 * MiB, WS_WOUT = 22 * MiB, WS_WGU = 24 * MiB, WS_WDN = 88 * MiB;
constexpr size_t WS_XB = 148 * MiB;
constexpr size_t WS_MQK = 212 * MiB, WS_QK = 276 * MiB, WS_MV = 340 * MiB, WS_MO = 372 * MiB, WS_S5A = 404 * MiB, WS_AQKV = 444 * MiB, WS_GATE = 540 * MiB;
constexpr size_t WS_YS1 = WS_MQK, WS_MIXED = WS_QK;
constexpr size_t WS_XG = 212 * MiB, WS_HB = 356 * MiB, WS_YB = 428 * MiB;
constexpr size_t WS_YTALL = 732 * MiB, WS_CST = 828 * MiB, WS_EBUF = 892 * MiB, WS_SG = 908 * MiB, WS_FTAB = 910 * MiB, WS_MLU = 911 * MiB, WS_STAT = 912 * MiB + 524288  , WS_ROUTE = 913 * MiB, WS_TOKPOS = 914 * MiB, WS_S5ALL = 916 * MiB  , S5_LAYER_BYTES = 28 * MiB, WS_END = 1028 * MiB;
static_assert(WS_XG + (size_t)MOE_ROWS * 1024 * 2 <= WS_HB && WS_HB + (size_t)MOE_ROWS * 512 * 2 <= WS_YB && WS_YB + (size_t)2 * T * 1024 * 2 <= WS_YTALL, "moe overlay");
static_assert(WS_S5A + (size_t)32 * 1024 * 640 * 2 <= WS_AQKV && WS_GATE + (size_t)T * 3072 * 2 <= WS_YTALL, "region A");
constexpr int CW_TMO = 0, CW_CODE = 1, CW_BAR = 4096, CW_GCNT = 8192, CW_AQ = 8704;

constexpr int RING_OFF = 0, RING_BYTES = 131072;
constexpr int LDS_BYTES = 163840;
constexpr int LDSX_OFF = RING_BYTES;
constexpr int LDSCTL_OFF = 162816, MISC_OFF = LDSCTL_OFF + 320;

#define GAS __attribute__((address_space(1)))
#define LAS __attribute__((address_space(3)))
typedef unsigned short bf16;
typedef unsigned v4u __attribute__((ext_vector_type(4)));
typedef unsigned v2u __attribute__((ext_vector_type(2)));
typedef float f32x4 __attribute__((ext_vector_type(4)));
typedef float f32x16 __attribute__((ext_vector_type(16)));
typedef short bf16x8 __attribute__((ext_vector_type(8)));
typedef GAS unsigned gu32;
#define RLX_AGENT __ATOMIC_RELAXED, __HIP_MEMORY_SCOPE_AGENT
#define LDS_WAIT() asm volatile("s_waitcnt lgkmcnt(0)" ::: "memory")
#define LDS_BARRIER() asm volatile("s_waitcnt lgkmcnt(0)\n\ts_barrier" ::: "memory")
#define VM_WAIT() asm volatile("s_waitcnt vmcnt(0)" ::: "memory")
__device__ __forceinline__ unsigned f2bf(float f) { unsigned u = __builtin_bit_cast(unsigned, f); return (u + 0x7fffu + ((u >> 16) & 1u)) >> 16; }
typedef float f32x2_t_ __attribute__((ext_vector_type(2))); typedef __bf16 bf16x2_t_ __attribute__((ext_vector_type(2)));
__device__ __forceinline__ unsigned pk2(float lo, float hi) { const f32x2_t_ v = {lo, hi}; return __builtin_bit_cast(unsigned, __builtin_convertvector(v, bf16x2_t_)); }
__device__ __forceinline__ float bflo(unsigned u) { return __uint_as_float(u << 16); }
__device__ __forceinline__ float bfhi(unsigned u) { return __uint_as_float(u & 0xffff0000u); }
__device__ __forceinline__ float bf2f(bf16 v) { return __uint_as_float((unsigned)v << 16); }
__device__ __forceinline__ float sigmoidf_(float x) { return 1.f / (1.f + __expf(-x)); }

__device__ __forceinline__ int lane_id() { int l; asm volatile("v_mbcnt_lo_u32_b32 %0, -1, 0\n\tv_mbcnt_hi_u32_b32 %0, -1, %0" : "=v"(l)); return l; }
#define XB_TMO      128
#define XB_XCNT(j)  (256  + 64 * (j))
#define XB_XSUB(j)  (1280 + 64 * (j))
#define XB_XGEN(j)  (2304 + 64 * (j))
#define XB_TOP      3328
#define XB_TOPGEN   3392
#define XCD_BAR_WORDS 3456
#define XB_SPIN_CAP (1u << 18)
__device__ __forceinline__ unsigned xb_ld(unsigned* p)              { return __hip_atomic_load(p, __ATOMIC_RELAXED, __HIP_MEMORY_SCOPE_AGENT); }
__device__ __forceinline__ unsigned xb_add(unsigned* p, unsigned v) { return __hip_atomic_fetch_add(p, v, __ATOMIC_RELAXED, __HIP_MEMORY_SCOPE_AGENT); }
__device__ __forceinline__ unsigned xb_xcc_id() { return (unsigned)__builtin_amdgcn_s_getreg((3 << 11) | 20) & 0xFu; }
#define XB_SPIN(cond, bar) do { unsigned _sp = 0; while (cond) { __builtin_amdgcn_s_sleep(1); \
    if ((++_sp & 255u) == 0u) { if (xb_ld(&(bar)[XB_TMO])) break; if (_sp > XB_SPIN_CAP) { atomicAdd(&(bar)[XB_TMO], 1u); break; } } } } while (0)
struct XcdBarrier { unsigned* bar; unsigned x; volatile LAS unsigned* st; };
__device__ __forceinline__ XcdBarrier xcd_barrier_post(unsigned* bar, volatile LAS unsigned* st, bool leader) {
    XcdBarrier b; b.bar = bar; b.x = xb_xcc_id(); b.st = st;
    if (leader) (void)xb_add(&bar[XB_XCNT(b.x)], 1u);
    return b;
}
__device__ __forceinline__ void xcd_barrier_complete(unsigned* bar, unsigned x, unsigned& nloc, unsigned& nx) {
    const unsigned G = gridDim.x * gridDim.y * gridDim.z;
    unsigned sum, cnt, mine, sp = 0u;
    for (;;) {
        sum = 0u; cnt = 0u; mine = 0u;
#pragma unroll
        for (unsigned j = 0; j < 16; ++j) { const unsigned c = xb_ld(&bar[XB_XCNT(j)]); sum += c; cnt += (c > 0u) ? 1u : 0u; mine = (j == x) ? c : mine; }
        if (sum == G) break;
        __builtin_amdgcn_s_sleep(1);
        if ((++sp & 255u) == 0u) { if (xb_ld(&bar[XB_TMO])) break; if (sp > XB_SPIN_CAP) { atomicAdd(&bar[XB_TMO], 1u); break; } }
    }
    nloc = mine > 0u ? mine : 1u; nx = cnt > 0u ? cnt : 1u;
}
__device__ __forceinline__ void xcd_barrier(const XcdBarrier& b, bool leader) {
    asm volatile("s_waitcnt vmcnt(0)" ::: "memory");
    __syncthreads();
    if (leader) {
        unsigned* bar = b.bar;
        __builtin_amdgcn_s_waitcnt(0);
        unsigned nloc = b.st[0], nx = b.st[1];
        if (nloc == 0u) { xcd_barrier_complete(bar, b.x, nloc, nx); b.st[0] = nloc; b.st[1] = nx; }
        const unsigned old = xb_add(&bar[XB_XSUB(b.x)], 1u);
        const unsigned gen = old / nloc;
        if (old + 1u == (gen + 1u) * nloc) {
            __builtin_amdgcn_fence(__ATOMIC_RELEASE, "agent");
            asm volatile("s_waitcnt vmcnt(0)" ::: "memory");
            const unsigned og = xb_add(&bar[XB_TOP], 1u);
            const unsigned tg = og / nx;
            if (og + 1u == (tg + 1u) * nx) xb_add(&bar[XB_TOPGEN], 1u);
            else XB_SPIN(xb_ld(&bar[XB_TOPGEN]) == tg, bar);
            __builtin_amdgcn_fence(__ATOMIC_ACQUIRE, "agent");
            xb_add(&bar[XB_XGEN(b.x)], 1u);
            asm volatile("s_waitcnt vmcnt(0)" ::: "memory");
        } else {
            XB_SPIN(xb_ld(&bar[XB_XGEN(b.x)]) == gen, bar);
            __builtin_amdgcn_fence(__ATOMIC_ACQUIRE, "agent");
            asm volatile("s_waitcnt vmcnt(0)" ::: "memory");
        }
    }
    __syncthreads();
}

enum InIdx { I_x, I_w_in, I_b_in, I_m_conv_w, I_m_conv_b, I_m_norm_w, I_s5_lam_re, I_s5_lam_im, I_s5_log_dt, I_s5_b_re, I_s5_b_im, I_s5_c_re, I_s5_c_im, I_s5_d, I_s5_w_glu, I_s5_b_glu, I_w_branch, I_w_out, I_ln1_g, I_ln1_b, I_w_rg, I_b_rg, I_w_re, I_b_re, I_moe_wg, I_moe_wu, I_moe_wd, I_ln2_g, I_ln2_b };
struct Args { const float* in[29]; float* out; unsigned char* ws; int ph_lo, ph_hi, sub, pad; };
typedef const __attribute__((address_space(4))) Args* KArgs;
struct Frame {
    LAS unsigned char* lds; unsigned char* ldsg;
    gu32* ctl;
    unsigned char* ws;
    int tid, lane, wave, vcu, G, bx, dup;
    float* out;
    KArgs ka;
};
template <int O> __device__ __forceinline__ float shx(float v) { static_assert(O >= 1 && O < 32, "xor mask inside a 32-lane half"); return __int_as_float(__builtin_amdgcn_ds_swizzle(__float_as_int(v), (O << 10) | 0x1f)); }
__device__ __forceinline__ float half_swap_add(float v) { auto rr = __builtin_amdgcn_permlane32_swap(__float_as_uint(v), __float_as_uint(v), false, false); return __uint_as_float(rr[0]) + __uint_as_float(rr[1]); }
__device__ __forceinline__ float half_swap_max(float v) { auto rr = __builtin_amdgcn_permlane32_swap(__float_as_uint(v), __float_as_uint(v), false, false); return fmaxf(__uint_as_float(rr[0]), __uint_as_float(rr[1])); }
__device__ __forceinline__ float wave_sum(float v) { v += shx<1>(v); v += shx<2>(v); v += shx<4>(v); v += shx<8>(v); v += shx<16>(v); return half_swap_add(v); }
__device__ __forceinline__ float wave_max(float v) { v = fmaxf(v, shx<1>(v)); v = fmaxf(v, shx<2>(v)); v = fmaxf(v, shx<4>(v)); v = fmaxf(v, shx<8>(v)); v = fmaxf(v, shx<16>(v)); return half_swap_max(v); }
#define JR_STEP(p, NH, M, bit) _Pragma("unroll") for (int i_ = 0; i_ < (NH); ++i_) { const float send_ = (bit) ? p[i_] : p[i_ + (NH)]; const float keep_ = (bit) ? p[i_ + (NH)] : p[i_]; p[i_] = keep_ + shx<M>(send_); }
__device__ __forceinline__ float rdlane(float v, int l) { return __int_as_float(__builtin_amdgcn_readlane(__float_as_int(v), l)); }
__device__ __forceinline__ float lane_get(float v, int srclane) { return __int_as_float(__builtin_amdgcn_ds_bpermute(srclane << 2, __float_as_int(v))); }
__device__ __forceinline__ float log_sigmoid(float x) { return fminf(x, 0.f) - log1pf(expf(-fabsf(x))); }

__device__ __forceinline__ void transpose_item(const float* Wsrc, int ldw, bf16* WTdst, int ldt, LAS float* scr, int lane) {
    float tv[32];
#pragma unroll
    for (int i = 0; i < 32; ++i) tv[i] = Wsrc[(size_t)(2 * i + (lane >> 5)) * ldw + (lane & 31)];
#pragma unroll
    for (int i = 0; i < 32; ++i) scr[(2 * i + (lane >> 5)) * 33 + (lane & 31)] = tv[i];
    LDS_WAIT(); asm volatile("" ::: "memory");
    const int c = lane & 7;
#pragma unroll
    for (int j = 0; j < 4; ++j) { const int n = (lane >> 3) + 8 * j; const LAS float* s = scr + (8 * c) * 33 + n;
        v4u o; o.x = pk2(s[0 * 33], s[1 * 33]); o.y = pk2(s[2 * 33], s[3 * 33]); o.z = pk2(s[4 * 33], s[5 * 33]); o.w = pk2(s[6 * 33], s[7 * 33]);
        *(GAS v4u*)(WTdst + (size_t)n * ldt + 8 * c) = o; }
    LDS_WAIT(); asm volatile("" ::: "memory");
}
__device__ __forceinline__ int in_srccol(int c) { return c + (c >= 4096 ? 16 : (c >= 2048 ? 8 : 0)); }

__device__ __forceinline__ void sincos_d(double ang, float& s, float& c) {
    double inv2pi = 0.15915494309189535, twopi = 6.283185307179586476925; asm volatile("" : "+v"(inv2pi), "+v"(twopi));
    const double k = rint(ang * inv2pi); const float r = (float)(ang - k * twopi);
    const float q = rintf(r * 0.6366197723675814f); float y = fmaf(q, -1.57079637050628662109375f, r); y = fmaf(q, 4.371139000186241e-8f, y); const float y2 = y * y;
    float sp = 2.7557319e-6f; sp = sp * y2 - 1.9841270e-4f; sp = sp * y2 + 8.3333333e-3f; sp = sp * y2 - 1.6666667e-1f; sp = y + y * y2 * sp;
    float cp = -2.7557319e-7f; cp = cp * y2 + 2.4801587e-5f; cp = cp * y2 - 1.3888889e-3f; cp = cp * y2 + 4.1666667e-2f; cp = cp * y2 - 0.5f; cp = 1.f + y2 * cp;
    const int qi = ((int)q) & 3; s = (qi == 0) ? sp : (qi == 1) ? cp : (qi == 2) ? -sp : -cp; c = (qi == 0) ? cp : (qi == 1) ? -sp : (qi == 2) ? -cp : sp;
}
__device__ __forceinline__ void s5_build_group(Frame& F, int l, int g) {
    LAS float* AP = (LAS float*)(F.lds);
    LAS float* BB = AP + 33 * 64 * 2;
    LAS float* CC = BB + 64 * 16 * 2;
    LAS float* KT = CC + 16 * 64 * 2;
    LAS float* DD = KT + 32 * 256;
    const int tid = F.tid;
    const float* lre = F.ka->in[I_s5_lam_re] + ((size_t)l * S5G + g) * S5P; const float* lim = F.ka->in[I_s5_lam_im] + ((size_t)l * S5G + g) * S5P;
    const double dt = (double)expf(F.ka->in[I_s5_log_dt][l * S5G + g]);
    for (int i = tid; i < 33 * 64; i += 512) { const int tau = i >> 6, p = i & 63; const double lr = lre[p], li = lim[p];
        const float mag = expf((float)(lr * dt * tau)); float sn, cs; sincos_d(li * dt * tau, sn, cs); AP[i * 2] = mag * cs; AP[i * 2 + 1] = mag * sn; }
    for (int i = tid; i < 64 * 16; i += 512) { const int p = i >> 4, ci = i & 15; const double lr = lre[p], li = lim[p];
        float sn, cs; sincos_d(li * dt, sn, cs); const double mag = (double)expf((float)(lr * dt)), ar = mag * cs, ai = mag * sn, den = lr * lr + li * li, nr = ar - 1.0, ni = ai;
        const double zr = (nr * lr + ni * li) / den, zi = (ni * lr - nr * li) / den;
        const size_t bi = (((size_t)l * S5G + g) * S5P + p) * S5C + ci; const double br = F.ka->in[I_s5_b_re][bi], bim = F.ka->in[I_s5_b_im][bi];
        BB[i * 2] = (float)(zr * br - zi * bim); BB[i * 2 + 1] = (float)(zr * bim + zi * br); }
    for (int i = tid; i < 16 * 64; i += 512) { const size_t ci_ = ((size_t)l * S5G + g) * S5C * S5P + i; CC[i * 2] = F.ka->in[I_s5_c_re][ci_]; CC[i * 2 + 1] = F.ka->in[I_s5_c_im][ci_]; }
    if (tid < 16) DD[tid] = F.ka->in[I_s5_d][(l * S5G + g) * S5C + tid];
    __syncthreads();
    for (int i = tid; i < 32 * 256; i += 512) { const int tau = i >> 8, co = (i >> 4) & 15, ci = i & 15; float s = 0.f;
        for (int p = 0; p < 64; ++p) { const float cr = CC[(co * 64 + p) * 2], cim = CC[(co * 64 + p) * 2 + 1], ar = AP[(tau * 64 + p) * 2], ai = AP[(tau * 64 + p) * 2 + 1];
            const float xr = cr * ar - cim * ai, xi = cr * ai + cim * ar; s += xr * BB[(p * 16 + ci) * 2] - xi * BB[(p * 16 + ci) * 2 + 1]; }
        KT[i] = s; }
    if (tid < 64) { float* tab = (float*)(F.ws + WS_S5TAB) + ((l * 32 + g) * 64 + tid) * 2; tab[0] = AP[(32 * 64 + tid) * 2]; tab[1] = AP[(32 * 64 + tid) * 2 + 1]; }
    __syncthreads();
    bf16* MP = (bf16*)(F.ws + WS_S5ALL + (size_t)l * S5_LAYER_BYTES) + (size_t)g * 512 * S5K;
    for (int i = tid; i < 512 * (S5K / 8); i += 512) { const int n = i / (S5K / 8), k0 = (i % (S5K / 8)) * 8, tq = n >> 4, co = n & 15; float v[8];
#pragma unroll
        for (int j = 0; j < 8; ++j) { const int k = k0 + j; float x;
            if (k < 512) { const int sq = k >> 4, ci = k & 15; x = (tq >= sq) ? KT[((tq - sq) * 16 + co) * 16 + ci] : 0.f; if (tq == sq && co == ci) x += DD[co]; }
            else { const int p = (k - 512) & 63; const float cr = CC[(co * 64 + p) * 2], cim = CC[(co * 64 + p) * 2 + 1], ar = AP[((tq + 1) * 64 + p) * 2], ai = AP[((tq + 1) * 64 + p) * 2 + 1];
                x = (k < 576) ? (cr * ar - cim * ai) : -(cr * ai + cim * ar); }
            v[j] = x; }
        v4u o; o.x = pk2(v[0], v[1]); o.y = pk2(v[2], v[3]); o.z = pk2(v[4], v[5]); o.w = pk2(v[6], v[7]);
        *(GAS v4u*)(MP + (size_t)n * S5K + k0) = o; }
    bf16* GG = (bf16*)(F.ws + WS_S5ALL + (size_t)l * S5_LAYER_BYTES + 20 * MiB) + (size_t)g * 256 * 512;
    for (int i = tid; i < 256 * 64; i += 512) { const int n = i >> 6, k0 = (i & 63) * 8; float v[8];
#pragma unroll
        for (int j = 0; j < 8; ++j) { const int k = k0 + j, sq = k >> 4, ci = k & 15; float x = 0.f;
            if (n < 128) { const int p = n & 63; const float ar = AP[((31 - sq) * 64 + p) * 2], ai = AP[((31 - sq) * 64 + p) * 2 + 1], br = BB[(p * 16 + ci) * 2], bim = BB[(p * 16 + ci) * 2 + 1];
                x = (n < 64) ? (ar * br - ai * bim) : (ar * bim + ai * br); }
            v[j] = x; }
        v4u o; o.x = pk2(v[0], v[1]); o.y = pk2(v[2], v[3]); o.z = pk2(v[4], v[5]); o.w = pk2(v[6], v[7]);
        *(GAS v4u*)(GG + (size_t)n * 512 + k0) = o; }
    __syncthreads();
}

__device__ __forceinline__ void small_w_prep(Frame& F, int l);
__device__ __forceinline__ void weight_prep(Frame& F, int l) {
    if (F.vcu == F.G - 1) small_w_prep(F, l);
    LAS float* scr = (LAS float*)(F.lds + RING_OFF + F.wave * 16384);
    const int gw = F.vcu * NWAVES + F.wave, NGW = F.G * NWAVES;
    constexpr int I_IN = (NIN / 32) * 16, I_GLU = 16 * 8, I_BR = 3 * 32 * 8, I_OUT = 32 * 16, I_G = NEXP * 16 * 16, I_D = NEXP * 32 * 8;
    constexpr int NITEMS = I_IN + I_GLU + I_BR + I_OUT + 2 * I_G + I_D;
    for (int it = gw; it < NITEMS; it += NGW) {
        int r = it;
        if (r < I_IN) { const int nb = r >> 4, kb = r & 15; transpose_item(F.ka->in[I_w_in] + (size_t)l * D * INTOT + (size_t)(64 * kb) * INTOT + in_srccol(32 * nb), INTOT, (bf16*)(F.ws + WS_WIN) + (size_t)(32 * nb) * 1024 + 64 * kb, 1024, scr, F.lane); continue; } r -= I_IN;
        if (r < I_GLU) { const int nb = r >> 3, kb = r & 7; transpose_item(F.ka->in[I_s5_w_glu] + (size_t)l * 512 * 512 + (size_t)(64 * kb) * 512 + 32 * nb, 512, (bf16*)(F.ws + WS_WGLU) + (size_t)(32 * nb) * 512 + 64 * kb, 512, scr, F.lane); continue; } r -= I_GLU;
        if (r < I_BR) { const int br = r >> 8, nb = (r >> 3) & 31, kb = r & 7; transpose_item(F.ka->in[I_w_branch] + ((size_t)l * 3 + br) * 512 * 1024 + (size_t)(64 * kb) * 1024 + 32 * nb, 1024, (bf16*)(F.ws + WS_WBR) + (size_t)(br * 1024 + 32 * nb) * 512 + 64 * kb, 512, scr, F.lane); continue; } r -= I_BR;
        if (r < I_OUT) { const int nb = r >> 4, kb = r & 15; transpose_item(F.ka->in[I_w_out] + (size_t)l * 1024 * 1024 + (size_t)(64 * kb) * 1024 + 32 * nb, 1024, (bf16*)(F.ws + WS_WOUT) + (size_t)(32 * nb) * 1024 + 64 * kb, 1024, scr, F.lane); continue; } r -= I_OUT;
        if (r < 2 * I_G) { const int up = r >= I_G; if (up) r -= I_G; const int e = r >> 8, nb = (r >> 4) & 15, kb = r & 15;
            const float* src = (up ? F.ka->in[I_moe_wu] : F.ka->in[I_moe_wg]) + ((size_t)l * NEXP + e) * 1024 * 512 + (size_t)(64 * kb) * 512 + 32 * nb; const int n0 = 32 * nb;
            transpose_item(src, 512, (bf16*)(F.ws + WS_WGU) + (size_t)(e * 1024 + (n0 >> 7) * 256 + up * 128 + (n0 & 127)) * 1024 + 64 * kb, 1024, scr, F.lane); continue; } r -= 2 * I_G;
        { const int e = r >> 8, nb = (r >> 3) & 31, kb = r & 7;
            transpose_item(F.ka->in[I_moe_wd] + ((size_t)l * NEXP + e) * 512 * 1024 + (size_t)(64 * kb) * 1024 + 32 * nb, 1024, (bf16*)(F.ws + WS_WDN) + (size_t)(e * 1024 + 32 * nb) * 512 + 64 * kb, 512, scr, F.lane); }
    }
}

__device__ __forceinline__ void small_gates_mfma(Frame& F, int l) {
    const int gw = F.vcu * NWAVES + F.wave, lane = F.lane, r = lane & 15, kg = lane >> 4;
    if (gw * 16 >= T) return;
    const bf16* __restrict__ A = (const bf16*)(F.ws + WS_XB) + (size_t)(gw * 16 + r) * D + 8 * kg; const bf16* __restrict__ B = (const bf16*)(F.ws + WS_WSM) + (size_t)r * D + 8 * kg;
    f32x4 acc = {0.f, 0.f, 0.f, 0.f};
#pragma unroll 8
    for (int ks = 0; ks < 32; ++ks) { const bf16x8 a = *(const GAS bf16x8*)(A + 32 * ks), b = *(const GAS bf16x8*)(B + 32 * ks); acc = __builtin_amdgcn_mfma_f32_16x16x32_bf16(a, b, acc, 0, 0, 0); }
    const float bias = F.ka->in[I_b_in][(size_t)l * INTOT + (r < 8 ? 2048 + r : 4104 + (r - 8))];
    float* sg = (float*)(F.ws + WS_SG) + (size_t)(gw * 16 + 4 * kg) * 16 + r;
#pragma unroll
    for (int i = 0; i < 4; ++i) sg[i * 16] = acc[i] + bias;
}
__device__ __forceinline__ void small_w_prep(Frame& F, int l) {
    const float* w = F.ka->in[I_w_in] + (size_t)l * D * INTOT; bf16* o = (bf16*)(F.ws + WS_WSM);
    for (int i = F.tid; i < 1024 * 16; i += 512) { const int k = i >> 4, j = i & 15; o[j * 1024 + k] = (bf16)f2bf(w[(size_t)k * INTOT + (j < 8 ? 2048 + j : 4104 + (j - 8))]); }
}

__device__ __forceinline__ void phase_p0(Frame& F) {
    if (F.vcu < NL * S5G) s5_build_group(F, F.vcu >> 5, F.vcu & 31);
    weight_prep(F, 0);
    const int gw = F.vcu * NWAVES + F.wave, NGW = F.G * NWAVES;
    f32x4 nv[4];
    { const GAS f32x4* x0 = (const GAS f32x4*)(F.ka->in[I_x] + (size_t)gw * D) + F.lane;
#pragma unroll
      for (int j = 0; j < 4; ++j) nv[j] = x0[64 * j]; }
    for (int m = gw; m < T; m += NGW) {
        f32x4 v[4];
#pragma unroll
        for (int j = 0; j < 4; ++j) v[j] = nv[j];
        if (m + NGW < T) { const GAS f32x4* xn = (const GAS f32x4*)(F.ka->in[I_x] + (size_t)(m + NGW) * D) + F.lane;
#pragma unroll
            for (int j = 0; j < 4; ++j) nv[j] = xn[64 * j]; }
        GAS v2u* o8 = (GAS v2u*)((bf16*)(F.ws + WS_XB) + (size_t)m * D) + F.lane;
#pragma unroll
        for (int j = 0; j < 4; ++j) { v2u o; o.x = pk2(v[j].x, v[j].y); o.y = pk2(v[j].z, v[j].w); o8[64 * j] = o; }
    }
    __syncthreads();
}

struct EpiInProj {
    static constexpr bool PERM = true;
    unsigned char* ws; const float* bias;
    __device__ __forceinline__ bool reset_after(const pg8::Unit&) const { return true; }
    __device__ __forceinline__ void operator()(pg8::f32x4 (&acc)[2][2][4][2], const pg8::Unit& u, int wr, int wc, int fr, int fq) const {
        using namespace pg8;
        const int pn = u.pn, row0 = u.pm * BM + wr * 64 + fr;
        int mode, pitch, cofs; size_t base;
        if (pn < 4) { mode = 0; base = WS_MQK; pitch = 1024; cofs = 0; }
        else if (pn < 6) { mode = 0; base = WS_MV; pitch = 512; cofs = 1024; }
        else if (pn < 8) { mode = 1; base = WS_MO; pitch = 512; cofs = 1536; }
        else if (pn < 10) { mode = 3; base = WS_S5A; pitch = 0; cofs = 2048; }
        else if (pn < 16) { mode = (pn < 12) ? 2 : 0; base = WS_AQKV; pitch = 1536; cofs = 2560; }
        else { mode = 4; base = WS_GATE; pitch = 3072; cofs = 4096; }
        bf16_t* O = (bf16_t*)(ws + base);
#pragma unroll
        for (int bj = 0; bj < 2; ++bj) {
            const int col0 = pn * BM + bj * HALF + wc * 32 + 8 * fq;
            const int sc = in_srccol(col0);
            const f32x4 b0 = *(const f32x4*)(bias + sc), b1 = *(const f32x4*)(bias + sc + 4);
            const int cl = col0 - cofs;
#pragma unroll
            for (int ai = 0; ai < 2; ++ai)
#pragma unroll
                for (int m = 0; m < 4; ++m) {
                    const int row = row0 + ai * HALF + m * 16;
                    f32x4 v0 = acc[ai][bj][m][0] + b0, v1 = acc[ai][bj][m][1] + b1;
                    if (mode == 1) {
#pragma unroll
                        for (int i = 0; i < 4; ++i) { v0[i] = 1.f / (1.f + __expf(-v0[i])); v1[i] = 1.f / (1.f + __expf(-v1[i])); }
                    } else if (mode == 2) { v0 = v0 * C2; v1 = v1 * C2; }
                    else if (mode == 4) {
#pragma unroll
                        for (int i = 0; i < 4; ++i) { v0[i] = __expf(fminf(fmaxf(-v0[i], -30.f), 30.f)); v1[i] = __expf(fminf(fmaxf(-v1[i], -30.f), 30.f)); }
                    }
                    u32x4 w; w.x = cvt_pk_bf16(v0[0], v0[1]); w.y = cvt_pk_bf16(v0[2], v0[3]); w.z = cvt_pk_bf16(v1[0], v1[1]); w.w = cvt_pk_bf16(v1[2], v1[3]);
                    size_t off;
                    if (mode == 3) { const int g = cl >> 4; off = ((size_t)(g * 1024 + (row >> 5)) * S5K) + (row & 31) * 16 + (cl & 15); }
                    else off = (size_t)row * pitch + cl;
                    *(u32x4*)(O + off) = w;
                }
        }
    }
};

__device__ __forceinline__ float wave_incl_scan_add(float v, int lane) {
#pragma unroll
    for (int o = 1; o < 64; o <<= 1) { const float t = lane_get(v, (lane - o) & 63); if (lane >= o) v += t; }
    return v;
}
__device__ __forceinline__ float wave_incl_scan_max(float v, int lane) {
#pragma unroll
    for (int o = 1; o < 64; o <<= 1) { const float t = lane_get(v, (lane - o) & 63); if (lane >= o) v = fmaxf(v, t); }
    return v;
}
__device__ __forceinline__ float lane63(float v) { return __int_as_float(__builtin_amdgcn_readlane(__float_as_int(v), 63)); }
__device__ __forceinline__ void phase_prep2(Frame& F, int l) {
    const int lane = F.lane;
    const float* __restrict__ SG = (const float*)(F.ws + WS_SG);
    LAS float* XS = (LAS float*)(F.lds);
    if (F.vcu < 64) {
        const int sq = F.vcu, b = sq >> 3, h = sq & 7, w = F.wave; float* __restrict__ FT = (float*)(F.ws + WS_FTAB) + (size_t)sq * SEQ;
        float x[8], c8[8];
#pragma unroll
        for (int i = 0; i < 8; ++i) x[i] = SG[(size_t)(b * SEQ + w * 512 + i * 64 + lane) * 16 + 8 + h];
        float carry = 0.f;
#pragma unroll
        for (int i = 0; i < 8; ++i) { const float c = wave_incl_scan_add(log_sigmoid(x[i]), lane) + carry; c8[i] = c; carry = lane63(c); }
        if (lane == 0) XS[w] = carry;
        __syncthreads();
        float pre = 0.f;
        for (int j = 0; j < w; ++j) pre += XS[j];
#pragma unroll
        for (int i = 0; i < 8; ++i) FT[w * 512 + i * 64 + lane] = (c8[i] + pre) * LOG2E;
        __syncthreads();
    } else if (F.vcu < 96) {
        const int bh = F.vcu - 64, b = bh >> 2, h = bh & 3, w = F.wave;
        float* __restrict__ MU = (float*)(F.ws + WS_MLU) + (size_t)bh * SEQ; float* __restrict__ MM = MU + (size_t)32 * SEQ; float* __restrict__ MB = MM + (size_t)32 * SEQ;
        float* __restrict__ MSC = (float*)(F.ws + WS_MSC) + bh * 64;
        float xi[8], xf[8], pm8[8];
#pragma unroll
        for (int i = 0; i < 8; ++i) { const float* sg = SG + (size_t)(b * SEQ + (w * 8 + i) * 64 + lane) * 16; xi[i] = sg[h]; xf[i] = sg[4 + h]; }
#pragma unroll
        for (int i = 0; i < 8; ++i) { const int c = w * 8 + i, s = c * 64 + lane;
            const float bc = wave_incl_scan_add(log_sigmoid(xf[i]), lane), u = xi[i] - bc, pm = wave_incl_scan_max(u, lane);
            MU[s] = u; MB[s] = bc; pm8[i] = pm;
            if (lane == 63) { XS[c] = pm; XS[64 + c] = bc; } }
        __syncthreads();
        float mprev = 0.f;
        for (int c = 0; c < w * 8; ++c) mprev = XS[64 + c] + fmaxf(mprev, XS[c]);
#pragma unroll
        for (int i = 0; i < 8; ++i) { const int c = w * 8 + i, s = c * 64 + lane; const float mloc = XS[c], blast = XS[64 + c];
            MM[s] = fmaxf(pm8[i], mprev);
            const float Mc = fmaxf(mprev, mloc);
            if (lane == 0) { MSC[c] = mprev; MSC[2048 + c] = mloc; MSC[4096 + c] = expf(mprev - Mc); MSC[6144 + c] = expf(mloc - Mc); }
            mprev = blast + Mc; }
        __syncthreads();
    }
    const bf16* __restrict__ RAW = (const bf16*)(F.ws + WS_MQK); bf16* __restrict__ QK = (bf16*)(F.ws + WS_QK);
    const float* cw = F.ka->in[I_m_conv_w] + (size_t)l * 4 * 1024; const float* cb = F.ka->in[I_m_conv_b] + (size_t)l * 1024;
    const int gt = F.vcu * 512 + F.tid, c0 = (gt & 127) * 8, run = gt >> 7;
    if (run < T / 32) {
        float w[4][8], bs[8];
#pragma unroll
        for (int j = 0; j < 4; ++j) { const f32x4 w0 = *(const f32x4*)(cw + j * 1024 + c0), w1 = *(const f32x4*)(cw + j * 1024 + c0 + 4); w[j][0] = w0.x; w[j][1] = w0.y; w[j][2] = w0.z; w[j][3] = w0.w; w[j][4] = w1.x; w[j][5] = w1.y; w[j][6] = w1.z; w[j][7] = w1.w; }
        { const f32x4 b0 = *(const f32x4*)(cb + c0), b1 = *(const f32x4*)(cb + c0 + 4); bs[0] = b0.x; bs[1] = b0.y; bs[2] = b0.z; bs[3] = b0.w; bs[4] = b1.x; bs[5] = b1.y; bs[6] = b1.z; bs[7] = b1.w; }
        const float sc = (c0 >= 512) ? 0.08838834764831845f : 1.f;
        const int tok0 = run * 32; const bool first = (tok0 & (SEQ - 1)) == 0;
        const bf16* rp = RAW + (size_t)tok0 * 1024 + c0; bf16* qp = QK + (size_t)tok0 * 1024 + c0;
        v4u win[3];
#pragma unroll
        for (int j = 0; j < 3; ++j) win[j] = first ? (v4u){0u, 0u, 0u, 0u} : *(const GAS v4u*)(rp - (size_t)(3 - j) * 1024);
#pragma unroll 1
        for (int t8 = 0; t8 < 32; t8 += 8) { v4u r[8];
#pragma unroll
            for (int i = 0; i < 8; ++i) r[i] = *(const GAS v4u*)(rp + (size_t)(t8 + i) * 1024);
#pragma unroll
            for (int i = 0; i < 8; ++i) { float a[8];
#pragma unroll
                for (int e = 0; e < 8; ++e) a[e] = bs[e];
#pragma unroll
                for (int j = 0; j < 4; ++j) { const v4u x = (j == 3) ? r[i] : ((i + j >= 3) ? r[i + j - 3 < 0 ? 0 : i + j - 3] : win[i + j]);
                    a[0] += w[j][0] * bflo(x.x); a[1] += w[j][1] * bfhi(x.x); a[2] += w[j][2] * bflo(x.y); a[3] += w[j][3] * bfhi(x.y);
                    a[4] += w[j][4] * bflo(x.z); a[5] += w[j][5] * bfhi(x.z); a[6] += w[j][6] * bflo(x.w); a[7] += w[j][7] * bfhi(x.w); }
#pragma unroll
                for (int e = 0; e < 8; ++e) a[e] = a[e] / (1.f + __expf(-a[e])) * sc;
                v4u o; o.x = pk2(a[0], a[1]); o.y = pk2(a[2], a[3]); o.z = pk2(a[4], a[5]); o.w = pk2(a[6], a[7]);
                *(GAS v4u*)(qp + (size_t)(t8 + i) * 1024) = o; }
            win[0] = r[5]; win[1] = r[6]; win[2] = r[7]; }
    }
}

typedef short v4i16_t __attribute__((ext_vector_type(4)));
__device__ __forceinline__ v2u tr_read4(const LAS bf16* tile, int P, int row0, int col0, int lane) {
    const int q = (lane & 15) >> 2, blk = (lane >> 4) & 1, p = lane & 3;
    return __builtin_bit_cast(v2u, __builtin_amdgcn_ds_read_tr16_b64_v4i16((LAS v4i16_t*)(tile + (row0 + q) * P + col0 + 16 * blk + 4 * p)));
}
struct P1Regs { v4u k[2], v[2]; float u[2], ml; };
__device__ __forceinline__ void mlstm_p1_load(Frame& F, int uu, P1Regs& R) {
    const int tid = F.tid, bh = uu >> 6, c = uu & 63, b = bh >> 2, h = bh & 3; const size_t tok0 = (size_t)b * SEQ + c * 64;
    const bf16* QK = (const bf16*)(F.ws + WS_QK); const bf16* MV = (const bf16*)(F.ws + WS_MV);
    const float ml = ((const float*)(F.ws + WS_MSC))[2048 + bh * 64 + c];
#pragma unroll
    for (int i = 0; i < 2; ++i) { const int p = tid + 512 * i, s = p >> 4, d0 = (p & 15) * 8;
        R.k[i] = *(const GAS v4u*)(QK + (tok0 + s) * 1024 + 512 + h * 128 + d0); R.v[i] = *(const GAS v4u*)(MV + (tok0 + s) * 512 + h * 128 + d0);
        R.u[i] = ((const float*)(F.ws + WS_MLU))[(size_t)bh * SEQ + c * 64 + s]; }
    R.ml = ml;
}
__device__ __forceinline__ void mlstm_pass1_all(Frame& F) {
    const int tid = F.tid, lane = F.lane, wid = F.wave, r = lane & 31, hh = lane >> 5;
    constexpr int PV = 160;
    LAS bf16* KW = (LAS bf16*)(F.lds); LAS bf16* VV = KW + 64 * PV;
    const int mt = wid >> 1, nt0 = (wid & 1) * 2;
    P1Regs R; mlstm_p1_load(F, F.vcu * 8, R);
    v2u pend[2][4]; float pend_n = 0.f;
#define P1_STORE(uu_) do { bf16* CT = (bf16*)(F.ws + WS_CST) + (size_t)(uu_) * 128 * 128; \
        _Pragma("unroll") for (int n = 0; n < 2; ++n) _Pragma("unroll") for (int g = 0; g < 4; ++g) *(GAS v2u*)(CT + (size_t)(32 * (nt0 + n) + r) * 128 + 32 * mt + 8 * g + 4 * hh) = pend[n][g]; \
        if (tid < 128) ((float*)(F.ws + WS_NST))[(size_t)(uu_) * 128 + tid] = pend_n; } while (0)
#pragma unroll 1
    for (int it = 0; it < 8; ++it) { const int uu = F.vcu * 8 + it;
#pragma unroll
        for (int i = 0; i < 2; ++i) { const int p = tid + 512 * i, s = p >> 4, d0 = (p & 15) * 8; const float w = expf(R.u[i] - R.ml);
            v4u kw; kw.x = pk2(bflo(R.k[i].x) * w, bfhi(R.k[i].x) * w); kw.y = pk2(bflo(R.k[i].y) * w, bfhi(R.k[i].y) * w); kw.z = pk2(bflo(R.k[i].z) * w, bfhi(R.k[i].z) * w); kw.w = pk2(bflo(R.k[i].w) * w, bfhi(R.k[i].w) * w);
            *(LAS v4u*)(KW + s * PV + d0) = kw; *(LAS v4u*)(VV + s * PV + d0) = R.v[i]; }
        if (it > 0) P1_STORE(uu - 1);
        if (it + 1 < 8) mlstm_p1_load(F, uu + 1, R);
        LDS_BARRIER();
        f32x16 acc[2]; acc[0] = f32x16{}; acc[1] = f32x16{};
#pragma unroll
        for (int ks = 0; ks < 4; ++ks) { const v2u a0 = tr_read4(KW, PV, 16 * ks + 8 * hh, 32 * mt, lane), a1 = tr_read4(KW, PV, 16 * ks + 8 * hh + 4, 32 * mt, lane);
            const v4u A = {a0.x, a0.y, a1.x, a1.y};
#pragma unroll
            for (int n = 0; n < 2; ++n) { const v2u b0 = tr_read4(VV, PV, 16 * ks + 8 * hh, 32 * (nt0 + n), lane), b1 = tr_read4(VV, PV, 16 * ks + 8 * hh + 4, 32 * (nt0 + n), lane);
                const v4u B = {b0.x, b0.y, b1.x, b1.y};
                acc[n] = __builtin_amdgcn_mfma_f32_32x32x16_bf16(__builtin_bit_cast(bf16x8, A), __builtin_bit_cast(bf16x8, B), acc[n], 0, 0, 0); } }
#pragma unroll
        for (int n = 0; n < 2; ++n)
#pragma unroll
            for (int g = 0; g < 4; ++g) { pend[n][g].x = pk2(acc[n][4 * g], acc[n][4 * g + 1]); pend[n][g].y = pk2(acc[n][4 * g + 2], acc[n][4 * g + 3]); }
        if (tid < 128) { float s = 0.f;
#pragma unroll 8
            for (int i = 0; i < 64; ++i) s += bf2f(KW[i * PV + tid]); pend_n = s; }
        LDS_BARRIER();
    }
    P1_STORE(F.vcu * 8 + 7);
#undef P1_STORE
}

struct P3Regs { v4u q[2], k[2], v[2], ct[4]; float a0, a1, a2, a3, np; };
__device__ __forceinline__ void mlstm_p3_load(Frame& F, int uu, P3Regs& R) {
    const int tid = F.tid, bh = uu >> 6, c = uu & 63, b = bh >> 2, h = bh & 3; const size_t tok0 = (size_t)b * SEQ + c * 64;
    const bf16* QKg = (const bf16*)(F.ws + WS_QK); const bf16* MVg = (const bf16*)(F.ws + WS_MV); const bf16* CTg = (const bf16*)(F.ws + WS_CST) + (size_t)uu * 128 * 128;
#pragma unroll
    for (int i = 0; i < 2; ++i) { const int p = tid + 512 * i, s = p >> 4, d0 = (p & 15) * 8;
        R.q[i] = *(const GAS v4u*)(QKg + (tok0 + s) * 1024 + h * 128 + d0); R.k[i] = *(const GAS v4u*)(QKg + (tok0 + s) * 1024 + 512 + h * 128 + d0); R.v[i] = *(const GAS v4u*)(MVg + (tok0 + s) * 512 + h * 128 + d0); }
#pragma unroll
    for (int i = 0; i < 4; ++i) { const int p = tid + 512 * i, dv = p >> 4, d0 = (p & 15) * 8; R.ct[i] = *(const GAS v4u*)(CTg + (size_t)dv * 128 + d0); }
    { const size_t o = (size_t)bh * SEQ + c * 64 + (tid & 63); const float* MLU = (const float*)(F.ws + WS_MLU);
      R.a0 = MLU[o]; R.a1 = MLU[(size_t)32 * SEQ + o]; R.a2 = MLU[(size_t)64 * SEQ + o]; R.a3 = ((const float*)(F.ws + WS_MSC))[bh * 64 + c];
      R.np = ((const float*)(F.ws + WS_NST))[(size_t)uu * 128 + ((tid + 64) & 127)]; }
}
__device__ __forceinline__ void mlstm_pass3_all(Frame& F, int l) {
    const int tid = F.tid, lane = F.lane, wid = F.wave, r = lane & 31, hh = lane >> 5;
    constexpr int PV = 160;
    LAS bf16* Q = (LAS bf16*)(F.lds); LAS bf16* Kk = Q + 64 * 136; LAS bf16* VV = Kk + 64 * 136; LAS bf16* CT = VV + 64 * PV;
    LAS float* HB = (LAS float*)(F.lds + 90112); LAS float* SM = (LAS float*)(F.lds + 123904);
    LAS float* U = SM, *MT = SM + 64, *WST = SM + 128, *FLO = SM + 192, *DEN = SM + 256, *NP = SM + 320, *QN = SM + 448;
    float nwv[16];
    { const int h0 = ((F.vcu * 8) >> 6) & 3; const float* nw = F.ka->in[I_m_norm_w] + (size_t)l * BW + h0 * 128 + (tid & 7) * 16;
#pragma unroll
      for (int i = 0; i < 16; ++i) nwv[i] = nw[i]; }
    P3Regs R; mlstm_p3_load(F, F.vcu * 8, R);
    v4u pend0 = {0u, 0u, 0u, 0u}, pend1 = pend0; size_t pend_off = 0;
#pragma unroll 1
    for (int it = 0; it < 8; ++it) { const int uu = F.vcu * 8 + it;
        const int bh = uu >> 6, c = uu & 63, b = bh >> 2, h = bh & 3; const size_t tok0 = (size_t)b * SEQ + c * 64;
        for (int dA = 0; dA < ((F.dup & 0x80) ? 2 : 1); ++dA) {
#pragma unroll
        for (int i = 0; i < 2; ++i) { const int p = tid + 512 * i, s = p >> 4, d0 = (p & 15) * 8;
            *(LAS v4u*)(Q + s * 136 + d0) = R.q[i]; *(LAS v4u*)(Kk + s * 136 + d0) = R.k[i]; *(LAS v4u*)(VV + s * PV + d0) = R.v[i]; }
#pragma unroll
        for (int i = 0; i < 4; ++i) { const int p = tid + 512 * i, dv = p >> 4, d0 = (p & 15) * 8; *(LAS v4u*)(CT + dv * 136 + d0) = R.ct[i]; }
        if (tid < 64) { U[tid] = R.a0; MT[tid] = R.a1; WST[tid] = expf(R.a3 - R.a1); FLO[tid] = expf(-R.a2 - R.a1); }
        else if (tid < 192) NP[tid - 64] = R.np;
        }
        if (it > 0) { bf16* yo = (bf16*)(F.ws + WS_YTALL) + pend_off; *(GAS v4u*)yo = pend0; *(GAS v4u*)(yo + 8) = pend1; }
        if (it + 1 < 8) mlstm_p3_load(F, uu + 1, R);
        const int tq = tid >> 3, part = tid & 7; const bf16* og = (const bf16*)(F.ws + WS_MO) + (tok0 + tq) * 512 + h * 128 + part * 16;
        const v4u o0 = *(const GAS v4u*)og, o1 = *(const GAS v4u*)(og + 8);
        LDS_BARRIER();
        { float s = 0.f;
#pragma unroll
            for (int i = 0; i < 16; ++i) s += bf2f(Q[tq * 136 + part * 16 + i]) * NP[part * 16 + i];
            s += shx<1>(s); s += shx<2>(s); s += shx<4>(s); if (part == 0) QN[tq] = s; }
        LDS_BARRIER();
        const int tt = wid >> 2, dt = wid & 3;
        f32x16 acc = f32x16{}; float denp = 0.f;
        for (int dB = 0; dB < ((F.dup & 0x20) ? 2 : 1); ++dB) {
        acc = f32x16{};
#pragma unroll
        for (int ks = 0; ks < 8; ++ks) { const bf16x8 A = *(const LAS bf16x8*)(Q + (32 * tt + r) * 136 + 16 * ks + 8 * hh); const bf16x8 B = *(const LAS bf16x8*)(CT + (32 * dt + r) * 136 + 16 * ks + 8 * hh);
            acc = __builtin_amdgcn_mfma_f32_32x32x16_bf16(A, B, acc, 0, 0, 0); }
#pragma unroll
        for (int g = 0; g < 16; ++g) acc[g] *= WST[32 * tt + (g & 3) + 8 * (g >> 2) + 4 * hh];
        denp = 0.f; const float Mt_l = MT[32 * tt + r];
        for (int st = 0; st <= tt; ++st) {
            f32x16 ST = f32x16{};
#pragma unroll
            for (int ks = 0; ks < 8; ++ks) { const bf16x8 A = *(const LAS bf16x8*)(Kk + (32 * st + r) * 136 + 16 * ks + 8 * hh); const bf16x8 B = *(const LAS bf16x8*)(Q + (32 * tt + r) * 136 + 16 * ks + 8 * hh);
                ST = __builtin_amdgcn_mfma_f32_32x32x16_bf16(A, B, ST, 0, 0, 0); }
#pragma unroll
            for (int g = 0; g < 16; ++g) { const int ri = (g & 3) + 8 * (g >> 2) + 4 * hh; float w = __expf(U[32 * st + ri] - Mt_l); if (st == tt && ri > r) w = 0.f; ST[g] *= w; denp += ST[g]; }
#pragma unroll
            for (int sp = 0; sp < 2; ++sp) {
                v4u pa; pa.x = pg8::cvt_pk_bf16(ST[8 * sp], ST[8 * sp + 1]); pa.y = pg8::cvt_pk_bf16(ST[8 * sp + 2], ST[8 * sp + 3]); pa.z = pg8::cvt_pk_bf16(ST[8 * sp + 4], ST[8 * sp + 5]); pa.w = pg8::cvt_pk_bf16(ST[8 * sp + 6], ST[8 * sp + 7]);
                const v2u lo = tr_read4(VV, PV, 32 * st + 16 * sp + 4 * hh, 32 * dt, lane), hi = tr_read4(VV, PV, 32 * st + 16 * sp + 8 + 4 * hh, 32 * dt, lane);
                v4u pb; pb.x = lo.x; pb.y = lo.y; pb.z = hi.x; pb.w = hi.y;
                acc = __builtin_amdgcn_mfma_f32_32x32x16_bf16(__builtin_bit_cast(bf16x8, pa), __builtin_bit_cast(bf16x8, pb), acc, 0, 0, 0); }
        }
        denp = half_swap_add(denp);
        if (dt == 0 && hh == 0) { const int t = 32 * tt + r; DEN[t] = denp + WST[t] * QN[t]; }
        }
        LDS_BARRIER();
#pragma unroll
        for (int g = 0; g < 16; ++g) { const int t = 32 * tt + (g & 3) + 8 * (g >> 2) + 4 * hh; HB[t * 132 + 32 * dt + r] = acc[g] / fmaxf(fabsf(DEN[t]), FLO[t]); }
        LDS_BARRIER();
        for (int dC = 0; dC < ((F.dup & 0x40) ? 2 : 1); ++dC)
        { float x[16]; float s = 0.f;
#pragma unroll
            for (int i = 0; i < 16; ++i) { x[i] = HB[tq * 132 + part * 16 + i]; s += x[i]; }
            s += shx<1>(s); s += shx<2>(s); s += shx<4>(s); const float mean = s * (1.f / 128.f); float q = 0.f;
#pragma unroll
            for (int i = 0; i < 16; ++i) { x[i] -= mean; q += x[i] * x[i]; }
            q += shx<1>(q); q += shx<2>(q); q += shx<4>(q); const float rstd = 1.f / sqrtf(q * (1.f / 128.f) + LN_EPS);
            const unsigned oa[8] = {o0.x, o0.y, o0.z, o0.w, o1.x, o1.y, o1.z, o1.w};
            unsigned ow[8];
#pragma unroll
            for (int i = 0; i < 8; ++i) ow[i] = pk2(x[2 * i] * rstd * nwv[2 * i] * bflo(oa[i]), x[2 * i + 1] * rstd * nwv[2 * i + 1] * bfhi(oa[i]));
            pend_off = (tok0 + tq) * 512 + h * 128 + part * 16; pend0 = (v4u){ow[0], ow[1], ow[2], ow[3]}; pend1 = (v4u){ow[4], ow[5], ow[6], ow[7]}; }
        LDS_BARRIER();
    }
    { bf16* yo = (bf16*)(F.ws + WS_YTALL) + pend_off; *(GAS v4u*)yo = pend0; *(GAS v4u*)(yo + 8) = pend1; }
}

__device__ __forceinline__ void phase_scans(Frame& F, int l, bool dry = false) {
    const int v = F.vcu, tid = F.tid, seg = F.wave, e = tid & 63;
    LAS float* LE = (LAS float*)(F.lds);
    LAS float* DS = LE + 8 * 64 * 8;
    { const int b = v >> 5, g = v & 31, p = e; const float* tab = (const float*)(F.ws + WS_S5TAB) + ((l * 32 + g) * 64 + p) * 2; const float ar = tab[0], ai = tab[1];
      bf16* A = (bf16*)(F.ws + (dry ? WS_AQKV : WS_S5A)); const float* E = (const float*)(F.ws + WS_EBUF);
      const size_t row0 = (size_t)g * 1024 + b * 128 + seg * 16; float er[16], ei[16];
#pragma unroll
      for (int j = 0; j < 16; ++j) { er[j] = E[(row0 + j) * 128 + p]; ei[j] = E[(row0 + j) * 128 + 64 + p]; }
      float hr = 0.f, hi = 0.f;
#pragma unroll
      for (int j = 0; j < 16; ++j) { const float nr = ar * hr - ai * hi + er[j], ni = ar * hi + ai * hr + ei[j]; hr = nr; hi = ni; }
      LE[(seg * 64 + p) * 2] = hr; LE[(seg * 64 + p) * 2 + 1] = hi;
      float pr = ar, pi = ai;
#pragma unroll
      for (int k = 0; k < 4; ++k) { const float nr = pr * pr - pi * pi, ni = 2.f * pr * pi; pr = nr; pi = ni; }
      LDS_BARRIER();
      hr = 0.f; hi = 0.f;
      for (int s = 0; s < seg; ++s) { const float lr = LE[(s * 64 + p) * 2], li = LE[(s * 64 + p) * 2 + 1]; const float nr = pr * hr - pi * hi + lr, ni = pr * hi + pi * hr + li; hr = nr; hi = ni; }
#pragma unroll
      for (int j = 0; j < 16; ++j) { A[(row0 + j) * S5K + 512 + p] = (bf16)f2bf(hr); A[(row0 + j) * S5K + 576 + p] = (bf16)f2bf(hi);
          const float nr = ar * hr - ai * hi + er[j], ni = ar * hi + ai * hr + ei[j]; hr = nr; hi = ni; }
      LDS_BARRIER(); }
    const float* MSC = (const float*)(F.ws + WS_MSC);
#pragma unroll 1
    for (int i = 0; i < 4; ++i) { const int uix = v * 4 + i, bh = uix >> 5, slice = uix & 31;
        bf16* p = (bf16*)(F.ws + (dry ? WS_MQK : WS_CST)) + ((size_t)bh * 64 + seg * 8) * 16384 + slice * 512 + e * 8;
        v4u lc[8]; float dec[8], sc[8];
#pragma unroll
        for (int j = 0; j < 8; ++j) { lc[j] = *(const GAS v4u*)(p + (size_t)j * 16384); dec[j] = MSC[4096 + bh * 64 + seg * 8 + j]; sc[j] = MSC[6144 + bh * 64 + seg * 8 + j]; }
        float S[8] = {0.f, 0.f, 0.f, 0.f, 0.f, 0.f, 0.f, 0.f}; float dp = 1.f;
#pragma unroll
        for (int j = 0; j < 8; ++j) { const float d = dec[j], s_ = sc[j]; dp *= d;
            S[0] = d * S[0] + s_ * bflo(lc[j].x); S[1] = d * S[1] + s_ * bfhi(lc[j].x); S[2] = d * S[2] + s_ * bflo(lc[j].y); S[3] = d * S[3] + s_ * bfhi(lc[j].y);
            S[4] = d * S[4] + s_ * bflo(lc[j].z); S[5] = d * S[5] + s_ * bfhi(lc[j].z); S[6] = d * S[6] + s_ * bflo(lc[j].w); S[7] = d * S[7] + s_ * bfhi(lc[j].w); }
#pragma unroll
        for (int k = 0; k < 8; ++k) LE[(seg * 64 + e) * 8 + k] = S[k];
        if (e == 0) DS[seg] = dp;
        LDS_BARRIER();
#pragma unroll
        for (int k = 0; k < 8; ++k) S[k] = 0.f;
        for (int s = 0; s < seg; ++s) { const float d = DS[s];
#pragma unroll
            for (int k = 0; k < 8; ++k) S[k] = d * S[k] + LE[(s * 64 + e) * 8 + k]; }
#pragma unroll
        for (int j = 0; j < 8; ++j) { v4u o; o.x = pk2(S[0], S[1]); o.y = pk2(S[2], S[3]); o.z = pk2(S[4], S[5]); o.w = pk2(S[6], S[7]); *(GAS v4u*)(p + (size_t)j * 16384) = o;
            const float d = dec[j], s_ = sc[j];
            S[0] = d * S[0] + s_ * bflo(lc[j].x); S[1] = d * S[1] + s_ * bfhi(lc[j].x); S[2] = d * S[2] + s_ * bflo(lc[j].y); S[3] = d * S[3] + s_ * bfhi(lc[j].y);
            S[4] = d * S[4] + s_ * bflo(lc[j].z); S[5] = d * S[5] + s_ * bfhi(lc[j].z); S[6] = d * S[6] + s_ * bflo(lc[j].w); S[7] = d * S[7] + s_ * bfhi(lc[j].w); }
        LDS_BARRIER(); }
    if (tid < 16) { const int gid = v * 16 + tid, bh = gid >> 7, dk = gid & 127; float* p = (float*)(F.ws + (dry ? WS_YTALL : WS_NST)) + (size_t)bh * 64 * 128 + dk; float lc[64];
#pragma unroll
        for (int c = 0; c < 64; ++c) lc[c] = p[c * 128];
        float n = 0.f;
#pragma unroll
        for (int c = 0; c < 64; ++c) { p[c * 128] = n; n = MSC[4096 + bh * 64 + c] * n + MSC[6144 + bh * 64 + c] * lc[c]; } }
}

struct SchedS5E { static constexpr bool GATHER = false; int c; __device__ __forceinline__ bool next(int i, pg8::Unit& u) const { if (i > 0 || c >= 128) return false; u.pm = c; u.pn = c >> 2; return true; } };
struct SchedS5Y { static constexpr bool GATHER = false; int c; __device__ __forceinline__ bool next(int i, pg8::Unit& u) const { if (i > 0 || c >= 256) return false; u.pm = c >> 1; u.pn = (c >> 3) * 2 + (c & 1); return true; } };
struct EpiS5E {
    static constexpr bool PERM = false;
    float* E;
    __device__ __forceinline__ bool reset_after(const pg8::Unit&) const { return true; }
    __device__ __forceinline__ void operator()(pg8::f32x4 (&acc)[2][2][4][2], const pg8::Unit& u, int wr, int wc, int fr, int fq) const {
        using namespace pg8;
        const int row0 = u.pm * BM + wr * 64 + fr, col0 = wc * 32 + 4 * fq;
#pragma unroll
        for (int ai = 0; ai < 2; ++ai)
#pragma unroll
            for (int m = 0; m < 4; ++m)
#pragma unroll
                for (int n = 0; n < 2; ++n) *(f32x4*)(E + (size_t)(row0 + ai * HALF + m * 16) * 128 + col0 + 16 * n) = acc[ai][0][m][n];
    }
};
__device__ __forceinline__ float gelu_tanh(float x) { const float z = 0.7978845608028654f * (x + 0.044715f * x * x * x); const float e = __expf(2.f * z); return 0.5f * x * (2.f - 2.f / (1.f + e)); }
struct EpiS5Y {
    static constexpr bool PERM = true;
    bf16* Y;
    __device__ __forceinline__ bool reset_after(const pg8::Unit&) const { return true; }
    __device__ __forceinline__ void operator()(pg8::f32x4 (&acc)[2][2][4][2], const pg8::Unit& u, int wr, int wc, int fr, int fq) const {
        using namespace pg8;
        const int row0 = u.pm * BM + wr * 64 + fr, ct = u.pn & 1;
#pragma unroll
        for (int bj = 0; bj < 2; ++bj) { const int cc = ct * 256 + bj * HALF + wc * 32 + 8 * fq, tq = cc >> 4, co = cc & 15;
#pragma unroll
            for (int ai = 0; ai < 2; ++ai)
#pragma unroll
                for (int m = 0; m < 4; ++m) { const int R = row0 + ai * HALF + m * 16, g = R >> 10, rr = R & 1023; const f32x4 v0 = acc[ai][bj][m][0], v1 = acc[ai][bj][m][1];
                    u32x4 w; w.x = cvt_pk_bf16(gelu_tanh(v0[0]), gelu_tanh(v0[1])); w.y = cvt_pk_bf16(gelu_tanh(v0[2]), gelu_tanh(v0[3])); w.z = cvt_pk_bf16(gelu_tanh(v1[0]), gelu_tanh(v1[1])); w.w = cvt_pk_bf16(gelu_tanh(v1[2]), gelu_tanh(v1[3]));
                    *(u32x4*)(Y + (size_t)(rr * 32 + tq) * 512 + 16 * g + co) = w; } }
    }
};
struct EpiGlu {
    static constexpr bool PERM = true;
    const bf16* Y1; bf16* YO; const float* bias;
    __device__ __forceinline__ bool reset_after(const pg8::Unit&) const { return true; }
    __device__ __forceinline__ void operator()(pg8::f32x4 (&acc)[2][2][4][2], const pg8::Unit& u, int wr, int wc, int fr, int fq) const {
        using namespace pg8;
        const int row0 = u.pm * BM + wr * 64 + fr;
#pragma unroll
        for (int bj = 0; bj < 2; ++bj) { const int col0 = u.pn * BM + bj * HALF + wc * 32 + 8 * fq; const f32x4 b0 = *(const f32x4*)(bias + col0), b1 = *(const f32x4*)(bias + col0 + 4);
            u32x4 yv[2][4];
#pragma unroll
            for (int ai = 0; ai < 2; ++ai)
#pragma unroll
                for (int m = 0; m < 4; ++m) yv[ai][m] = *(const u32x4*)(Y1 + (size_t)(row0 + ai * HALF + m * 16) * 512 + col0);
            asm volatile("" ::: "memory");
#pragma unroll
            for (int ai = 0; ai < 2; ++ai)
#pragma unroll
                for (int m = 0; m < 4; ++m) { const size_t off = (size_t)(row0 + ai * HALF + m * 16) * 512 + col0; const u32x4 y = yv[ai][m];
                    const f32x4 v0 = acc[ai][bj][m][0] + b0, v1 = acc[ai][bj][m][1] + b1;
                    u32x4 w; w.x = cvt_pk_bf16(bflo(y.x) * sigmoidf_(v0[0]), bfhi(y.x) * sigmoidf_(v0[1])); w.y = cvt_pk_bf16(bflo(y.y) * sigmoidf_(v0[2]), bfhi(y.y) * sigmoidf_(v0[3]));
                    w.z = cvt_pk_bf16(bflo(y.z) * sigmoidf_(v1[0]), bfhi(y.z) * sigmoidf_(v1[1])); w.w = cvt_pk_bf16(bflo(y.w) * sigmoidf_(v1[2]), bfhi(y.w) * sigmoidf_(v1[3]));
                    *(u32x4*)(YO + off) = w; }
            asm volatile("" ::: "memory"); }
    }
};
struct SchedMerge { static constexpr bool GATHER = false; int c, G; __device__ __forceinline__ bool next(int i, pg8::Unit& u) const { const int tl = (i / 3) * G + c, b = i % 3; if (tl >= 512) return false; u.pm = b * 128 + (tl >> 2); u.pn = b * 4 + (tl & 3); return true; } };
struct EpiMerge {
    static constexpr bool PERM = true;
    const bf16* GP; bf16* MX;
    __device__ __forceinline__ bool reset_after(const pg8::Unit& u) const { return u.pm >= 256; }
    __device__ __forceinline__ void operator()(pg8::f32x4 (&acc)[2][2][4][2], const pg8::Unit& u, int wr, int wc, int fr, int fq) const {
        using namespace pg8;
        const int b = u.pm >> 7, pm = u.pm & 127, pn = u.pn & 3, row0 = pm * BM + wr * 64 + fr;
#pragma unroll
        for (int bj = 0; bj < 2; ++bj) { const int col0 = pn * BM + bj * HALF + wc * 32 + 8 * fq;
#pragma unroll
            for (int ai = 0; ai < 2; ++ai) {
            u32x4 gav[4], gbv[4];
#pragma unroll
                for (int m = 0; m < 4; ++m) { const bf16* gp = GP + (size_t)(row0 + ai * HALF + m * 16) * 3072 + b * 1024 + col0; gav[m] = *(const u32x4*)gp; gbv[m] = (b < 2) ? *(const u32x4*)(gp + 1024) : (u32x4){0u, 0u, 0u, 0u}; }
            asm volatile("" ::: "memory");
#pragma unroll
                for (int m = 0; m < 4; ++m) { const int row = row0 + ai * HALF + m * 16;
                    const u32x4 ga = gav[m]; float f[8];
                    const unsigned gaa[4] = {ga.x, ga.y, ga.z, ga.w};
                    if (b < 2) { const u32x4 gb = gbv[m]; const unsigned gba[4] = {gb.x, gb.y, gb.z, gb.w};
#pragma unroll
                        for (int i = 0; i < 4; ++i) {
                            f[2 * i] = (1.f + bflo(gba[i])) * __builtin_amdgcn_rcpf(1.f + bflo(gaa[i])); f[2 * i + 1] = (1.f + bfhi(gba[i])) * __builtin_amdgcn_rcpf(1.f + bfhi(gaa[i])); }
                    } else {
#pragma unroll
                        for (int i = 0; i < 4; ++i) { f[2 * i] = __builtin_amdgcn_rcpf(1.f + bflo(gaa[i])); f[2 * i + 1] = __builtin_amdgcn_rcpf(1.f + bfhi(gaa[i])); }
                    }
                    f32x4& v0 = acc[ai][bj][m][0]; f32x4& v1 = acc[ai][bj][m][1];
                    v0[0] *= f[0]; v0[1] *= f[1]; v0[2] *= f[2]; v0[3] *= f[3]; v1[0] *= f[4]; v1[1] *= f[5]; v1[2] *= f[6]; v1[3] *= f[7];
                    if (b == 2) { u32x4 w; w.x = cvt_pk_bf16(v0[0], v0[1]); w.y = cvt_pk_bf16(v0[2], v0[3]); w.z = cvt_pk_bf16(v1[0], v1[1]); w.w = cvt_pk_bf16(v1[2], v1[3]);
                        *(u32x4*)(MX + (size_t)row * 1024 + col0) = w; } }
            asm volatile("" ::: "memory"); } }
    }
};
struct EpiOutProj {
    static constexpr bool PERM = false;
    const float* X; float* O;
    __device__ __forceinline__ bool reset_after(const pg8::Unit&) const { return true; }
    __device__ __forceinline__ void operator()(pg8::f32x4 (&acc)[2][2][4][2], const pg8::Unit& u, int wr, int wc, int fr, int fq) const {
        using namespace pg8;
        const int row0 = u.pm * BM + wr * 64 + fr, col0 = u.pn * BM + wc * 32 + 4 * fq;
#pragma unroll
        for (int ai = 0; ai < 2; ++ai) {
            f32x4 xv[4][2][2];
#pragma unroll
            for (int m = 0; m < 4; ++m) { const size_t off = (size_t)(row0 + ai * HALF + m * 16) * 1024 + col0;
#pragma unroll
                for (int bj = 0; bj < 2; ++bj)
#pragma unroll
                    for (int n = 0; n < 2; ++n) xv[m][bj][n] = *(const f32x4*)(X + off + bj * HALF + n * 16); }
            asm volatile("" ::: "memory");
#pragma unroll
            for (int m = 0; m < 4; ++m) { const size_t off = (size_t)(row0 + ai * HALF + m * 16) * 1024 + col0;
#pragma unroll
                for (int bj = 0; bj < 2; ++bj)
#pragma unroll
                    for (int n = 0; n < 2; ++n) *(f32x4*)(O + off + bj * HALF + n * 16) = xv[m][bj][n] * ALPHA + acc[ai][bj][m][n]; }
            asm volatile("" ::: "memory");
        }
    }
};

__device__ __forceinline__ void phase_ln1_route(Frame& F, int l, bool dry = false) {
    float* const STo = (float*)(F.ws + (dry ? WS_YB : WS_STAT)); bf16* const XBo = (bf16*)(F.ws + (dry ? WS_XG : WS_XB)); unsigned char* const RT = F.ws + (dry ? WS_HB : WS_ROUTE); int* const TPo = (int*)(F.ws + (dry ? WS_HB + 4 * MiB : WS_TOKPOS)); const int gl = dry ? l + 4 : l;
    constexpr int WP = 1028;
    LAS float* WRE = (LAS float*)(F.lds); LAS float* WRG = WRE + 32 * WP;
    LAS float* BR = WRG + 4 * WP; LAS unsigned* HIST = (LAS unsigned*)(BR + 64); LAS unsigned* BASE = HIST + 32;
    const float* wre = F.ka->in[I_w_re] + (size_t)l * 1024 * 32; const float* wrg = F.ka->in[I_w_rg] + (size_t)l * 1024 * 4;
    for (int i = F.tid; i < 1024 * 32; i += 512) WRE[(i & 31) * WP + (i >> 5)] = wre[i];
    for (int i = F.tid; i < 1024 * 4; i += 512) WRG[(i & 3) * WP + (i >> 2)] = wrg[i];
    if (F.tid < 32) { BR[F.tid] = F.ka->in[I_b_re][l * 32 + F.tid]; HIST[F.tid] = 0u; }
    if (F.tid < 4) BR[32 + F.tid] = F.ka->in[I_b_rg][l * 4 + F.tid];
    { int* tp = TPo; for (int i = F.vcu * 512 + F.tid; i < MOE_ROWS; i += F.G * 512) tp[i] = -1; }
    __syncthreads();
    const int gw = F.vcu * NWAVES + F.wave, NGW = F.G * NWAVES, lane = F.lane;
    const float* lg = F.ka->in[I_ln1_g] + (size_t)l * D; const float* lb = F.ka->in[I_ln1_b] + (size_t)l * D;
    int my_e0 = 0, my_e1 = 0, my_r0 = 0, my_r1 = 0, my_m = -1; float my_w0 = 0.f, my_w1 = 0.f; int it = 0;
    f32x4 nv[4], nv2[4];
    { const GAS f32x4* x0 = (const GAS f32x4*)(F.out + (size_t)gw * D) + lane; const GAS f32x4* x1 = (const GAS f32x4*)(F.out + (size_t)(gw + NGW) * D) + lane;
#pragma unroll
      for (int j = 0; j < 4; ++j) { nv[j] = x0[64 * j]; nv2[j] = x1[64 * j]; } }
    f32x4 g4[4], b4[4];
#pragma unroll
    for (int j = 0; j < 4; ++j) { g4[j] = *(const f32x4*)(lg + 256 * j + 4 * lane); b4[j] = *(const f32x4*)(lb + 256 * j + 4 * lane); }
    for (int m = gw; m < T; m += NGW, ++it) {
        f32x4 v[4]; float s = 0.f;
#pragma unroll
        for (int j = 0; j < 4; ++j) { v[j] = nv[j]; nv[j] = nv2[j]; s += (v[j].x + v[j].y) + (v[j].z + v[j].w); }
        if (m + 2 * NGW < T) { const GAS f32x4* xn = (const GAS f32x4*)(F.out + (size_t)(m + 2 * NGW) * D) + lane;
#pragma unroll
            for (int j = 0; j < 4; ++j) nv2[j] = xn[64 * j]; }
        const float mean = wave_sum(s) * (1.f / D); float s2 = 0.f;
#pragma unroll
        for (int j = 0; j < 4; ++j) { v[j] = v[j] - mean; s2 += (v[j].x * v[j].x + v[j].y * v[j].y) + (v[j].z * v[j].z + v[j].w * v[j].w); }
        const float rstd = 1.f / sqrtf(wave_sum(s2) * (1.f / D) + LN_EPS);
        if (lane == 0) { float* st = STo + 2 * (size_t)m; st[0] = mean; st[1] = rstd; }
        GAS v2u* o8 = (GAS v2u*)(XBo + (size_t)m * D) + lane;
#pragma unroll
        for (int j = 0; j < 4; ++j) {
            v[j] = v[j] * rstd * g4[j] + b4[j]; v2u o;     o.x = pk2(v[j].x, v[j].y); o.y = pk2(v[j].z, v[j].w); o8[64 * j] = o; }
        const bool b0 = (lane & 1) != 0, b1 = (lane & 2) != 0, b2 = (lane & 4) != 0;
        float gl[4];
        { float p[4];
#pragma unroll
          for (int o = 0; o < 4; ++o) { p[o] = 0.f;
#pragma unroll
            for (int j = 0; j < 4; ++j) { const f32x4 w = *(const LAS f32x4*)(WRG + o * WP + 256 * j + 4 * lane); p[o] += (v[j].x * w.x + v[j].y * w.y) + (v[j].z * w.z + v[j].w * w.w); } }
          JR_STEP(p, 2, 1, b0) JR_STEP(p, 1, 2, b1)
          float r = p[0]; r += shx<4>(r); r += shx<8>(r); r += shx<16>(r); r = half_swap_add(r);
          gl[0] = rdlane(r, 0) + BR[32]; gl[1] = rdlane(r, 2) + BR[33]; gl[2] = rdlane(r, 1) + BR[34]; gl[3] = rdlane(r, 3) + BR[35]; }
        int grp = 0; float gmax = gl[0];
#pragma unroll
        for (int o = 1; o < 4; ++o) if (gl[o] > gmax) { gmax = gl[o]; grp = o; }
        float gs = 0.f;
#pragma unroll
        for (int o = 0; o < 4; ++o) gs += __expf(gl[o] - gmax);
        const float pg = 1.f / gs;
        float el[8];
        { float p[8]; const LAS float* wr_ = WRE + grp * 8 * WP;
#pragma unroll
          for (int o = 0; o < 8; ++o) { p[o] = 0.f;
#pragma unroll
            for (int j = 0; j < 4; ++j) { const f32x4 w = *(const LAS f32x4*)(wr_ + o * WP + 256 * j + 4 * lane); p[o] += (v[j].x * w.x + v[j].y * w.y) + (v[j].z * w.z + v[j].w * w.w); } }
          JR_STEP(p, 4, 1, b0) JR_STEP(p, 2, 2, b1) JR_STEP(p, 1, 4, b2)
          float r = p[0]; r += shx<8>(r); r += shx<16>(r); r = half_swap_add(r);
          const LAS float* be = BR + grp * 8;
          el[0] = rdlane(r, 0) + be[0]; el[1] = rdlane(r, 4) + be[1]; el[2] = rdlane(r, 2) + be[2]; el[3] = rdlane(r, 6) + be[3];
          el[4] = rdlane(r, 1) + be[4]; el[5] = rdlane(r, 5) + be[5]; el[6] = rdlane(r, 3) + be[6]; el[7] = rdlane(r, 7) + be[7]; }
        int i0 = 0; float l0 = el[0];
#pragma unroll
        for (int o = 1; o < 8; ++o) if (el[o] > l0) { l0 = el[o]; i0 = o; }
        int i1 = -1; float l1 = -INFINITY;
#pragma unroll
        for (int o = 0; o < 8; ++o) if (o != i0 && el[o] > l1) { l1 = el[o]; i1 = o; }
        const float ex = __expf(l1 - l0), pe0 = 1.f / (1.f + ex), pe1 = ex / (1.f + ex);
        const int e0 = grp * 8 + i0, e1 = grp * 8 + i1;
        unsigned r0 = 0u, r1 = 0u;
        if (lane == 0) { r0 = __hip_atomic_fetch_add(&HIST[e0], 1u, __ATOMIC_RELAXED, __HIP_MEMORY_SCOPE_WORKGROUP); r1 = __hip_atomic_fetch_add(&HIST[e1], 1u, __ATOMIC_RELAXED, __HIP_MEMORY_SCOPE_WORKGROUP); }
        r0 = (unsigned)__builtin_amdgcn_readfirstlane((int)r0); r1 = (unsigned)__builtin_amdgcn_readfirstlane((int)r1);
        if (lane == it) { my_e0 = e0; my_e1 = e1; my_r0 = (int)r0; my_r1 = (int)r1; my_w0 = pg * pe0; my_w1 = pg * pe1; my_m = m; }
    }
    __syncthreads();
    if (F.tid < 32) BASE[F.tid] = __hip_atomic_fetch_add((unsigned*)(F.ctl + CW_GCNT + gl * 32 + F.tid), HIST[F.tid], RLX_AGENT);
    __syncthreads();
    if (my_m >= 0) { int* re = (int*)RT; float* rw = (float*)(RT + 262144); int* rp = (int*)(RT + 524288);
        re[2 * my_m] = my_e0; re[2 * my_m + 1] = my_e1; rw[2 * my_m] = my_w0; rw[2 * my_m + 1] = my_w1; rp[2 * my_m] = (int)BASE[my_e0] + my_r0; rp[2 * my_m + 1] = (int)BASE[my_e1] + my_r1; }
    __syncthreads();
}

__device__ __forceinline__ void moe_tables(Frame& F, int l) {
    LAS int* PST = (LAS int*)(F.lds + LDSX_OFF + 20480); LAS int* BLKE = PST + 64;
    if (F.tid == 0) { int acc = 0;
#pragma unroll 1
        for (int e = 0; e < NEXP; ++e) { const int cnt = (int)__hip_atomic_load(F.ctl + CW_GCNT + l * 32 + e, RLX_AGENT); PST[e] = acc; const int nb = (cnt + 255) >> 8;
#pragma unroll 1
            for (int j = 0; j < nb; ++j) BLKE[(acc >> 8) + j] = e; acc += nb << 8; } PST[32] = acc; PST[33] = acc >> 8; }
    __syncthreads();
}
__device__ __forceinline__ void phase_dispatch(Frame& F, int l) {
    moe_tables(F, l);
    const LAS int* PST = (const LAS int*)(F.lds + LDSX_OFF + 20480);
    const int* re = (const int*)(F.ws + WS_ROUTE); const float* rw = (const float*)(F.ws + WS_ROUTE + 262144); const int* rp = (const int*)(F.ws + WS_ROUTE + 524288);
    int* tp = (int*)(F.ws + WS_TOKPOS); float* wp = (float*)(F.ws + WS_TOKPOS + 524288);
    for (int t = F.vcu * 512 + F.tid; t < 2 * T; t += F.G * 512) { const int pos = PST[re[t]] + rp[t]; tp[pos] = t; wp[pos] = rw[t]; }
}
struct SchedMoe { static constexpr bool GATHER = false; const LAS int* PST; int c, G; __device__ __forceinline__ bool next(int i, pg8::Unit& u) const { const int L = i * G + c; const int nb = __builtin_amdgcn_readfirstlane(PST[33]); if (L >= nb * 4) return false; const int rb = L >> 2; u.pm = rb; u.pn = __builtin_amdgcn_readfirstlane(PST[64 + rb]) * 4 + (L & 3); return true; } };
struct SchedMoeG { static constexpr bool GATHER = true; const LAS int* PST; const LAS int* TOKL; int c, G;
    __device__ __forceinline__ bool next(int i, pg8::Unit& u) const { const int L = i * G + c; const int nb = __builtin_amdgcn_readfirstlane(PST[33]); if (L >= nb * 4) return false; const int rb = L >> 2; u.pm = rb; u.pn = __builtin_amdgcn_readfirstlane(PST[64 + rb]) * 4 + (L & 3); return true; }
    __device__ __forceinline__ unsigned row_byte_off(int ui, int r) const { return (unsigned)TOKL[ui * 256 + r] * 2048u; } };
__device__ __forceinline__ void moe_stage_rows(Frame& F) {
    const LAS int* PST = (const LAS int*)(F.lds + LDSX_OFF + 20480); LAS int* TOKL = (LAS int*)(F.lds + LDSX_OFF); const int* tp = (const int*)(F.ws + WS_TOKPOS);
    const int nb = PST[33];
    for (int i = F.tid; i < 5 * 256; i += 512) { const int ui = i >> 8, r = i & 255, L = ui * F.G + F.vcu; int tok = 0; if (L < nb * 4) { const int t = tp[(L >> 2) * 256 + r]; tok = t < 0 ? 0 : (t >> 1); } TOKL[i] = tok; }
    __syncthreads();
}
struct EpiGateUp {
    static constexpr bool PERM = true;
    bf16* H;
    __device__ __forceinline__ bool reset_after(const pg8::Unit&) const { return true; }
    __device__ __forceinline__ void operator()(pg8::f32x4 (&acc)[2][2][4][2], const pg8::Unit& u, int wr, int wc, int fr, int fq) const {
        using namespace pg8;
        const int row0 = u.pm * BM + wr * 64 + fr, col0 = (u.pn & 3) * HALF + wc * 32 + 8 * fq;
#pragma unroll
        for (int ai = 0; ai < 2; ++ai)
#pragma unroll
            for (int m = 0; m < 4; ++m) { float hv[8];
#pragma unroll
                for (int n = 0; n < 2; ++n)
#pragma unroll
                    for (int i = 0; i < 4; ++i) { const float g = acc[ai][0][m][n][i], up = acc[ai][1][m][n][i]; hv[4 * n + i] = g / (1.f + __expf(-g)) * up; }
                u32x4 w; w.x = cvt_pk_bf16(hv[0], hv[1]); w.y = cvt_pk_bf16(hv[2], hv[3]); w.z = cvt_pk_bf16(hv[4], hv[5]); w.w = cvt_pk_bf16(hv[6], hv[7]);
                *(u32x4*)(H + (size_t)(row0 + ai * HALF + m * 16) * 512 + col0) = w; }
    }
};
struct EpiDown {
    static constexpr bool PERM = true;
    bf16* YB; const int* TP; const float* WP;
    __device__ __forceinline__ bool reset_after(const pg8::Unit&) const { return true; }
    __device__ __forceinline__ void operator()(pg8::f32x4 (&acc)[2][2][4][2], const pg8::Unit& u, int wr, int wc, int fr, int fq) const {
        using namespace pg8;
        const int row0 = u.pm * BM + wr * 64 + fr, colb = (u.pn & 3) * BM + wc * 32 + 8 * fq;
        int tpa[2][4]; float wpa[2][4];
#pragma unroll
        for (int ai = 0; ai < 2; ++ai)
#pragma unroll
            for (int m = 0; m < 4; ++m) { tpa[ai][m] = TP[row0 + ai * HALF + m * 16]; wpa[ai][m] = WP[row0 + ai * HALF + m * 16]; }
        asm volatile("" ::: "memory");
#pragma unroll
        for (int ai = 0; ai < 2; ++ai)
#pragma unroll
            for (int m = 0; m < 4; ++m) { const int tpv = tpa[ai][m]; if (tpv < 0) continue; const float w_ = wpa[ai][m];
#pragma unroll
                for (int bj = 0; bj < 2; ++bj) { const f32x4 v0 = acc[ai][bj][m][0] * w_, v1 = acc[ai][bj][m][1] * w_;
                    u32x4 w; w.x = cvt_pk_bf16(v0[0], v0[1]); w.y = cvt_pk_bf16(v0[2], v0[3]); w.z = cvt_pk_bf16(v1[0], v1[1]); w.w = cvt_pk_bf16(v1[2], v1[3]);
                    *(u32x4*)(YB + (size_t)tpv * 1024 + colb + bj * HALF) = w; } }
    }
};
__device__ __forceinline__ void phase_ln2(Frame& F, int l, int sub) {
    const bool more = (l + 1 < NL); const bool dry = (sub & 0x10) != 0;
    float* const OUT = dry ? (float*)(F.ws + 560 * MiB) : F.out; bf16* const XBo = (bf16*)(F.ws + (dry ? WS_YTALL : WS_XB));
    const int gw = F.vcu * NWAVES + F.wave, NGW = F.G * NWAVES, lane = F.lane;
    const float* lg = F.ka->in[I_ln2_g] + (size_t)l * D; const float* lb = F.ka->in[I_ln2_b] + (size_t)l * D; const bf16* YB = (const bf16*)(F.ws + WS_YB);
    f32x4 g4[4], b4[4];
#pragma unroll
    for (int j = 0; j < 4; ++j) { g4[j] = *(const f32x4*)(lg + 256 * j + 4 * lane); b4[j] = *(const f32x4*)(lb + 256 * j + 4 * lane); }
    f32x4 g1[4], b1[4];
    { const float* lg1 = F.ka->in[I_ln1_g] + (size_t)l * D; const float* lb1 = F.ka->in[I_ln1_b] + (size_t)l * D;
#pragma unroll
      for (int j = 0; j < 4; ++j) { g1[j] = *(const f32x4*)(lg1 + 256 * j + 4 * lane); b1[j] = *(const f32x4*)(lb1 + 256 * j + 4 * lane); } }
    const float* ST = (const float*)(F.ws + WS_STAT);
    f32x4 nx[4]; v2u na[4], nb[4];
    if (sub & 1) { const GAS f32x4* xr = (const GAS f32x4*)(F.out + (size_t)gw * D) + lane; const GAS v2u* y0 = (const GAS v2u*)(YB + (size_t)(2 * gw) * D) + lane; const GAS v2u* y1 = y0 + D / 4;
#pragma unroll
        for (int j = 0; j < 4; ++j) { nx[j] = xr[64 * j]; na[j] = y0[64 * j]; nb[j] = y1[64 * j]; } }
    if (sub & 1) for (int m = gw; m < T; m += NGW) {
        GAS f32x4* xw = (GAS f32x4*)(OUT + (size_t)m * D) + lane;
        f32x4 v[4]; float s = 0.f; f32x4 cx[4]; v2u ca[4], cb_[4];
#pragma unroll
        for (int j = 0; j < 4; ++j) { cx[j] = nx[j]; ca[j] = na[j]; cb_[j] = nb[j]; }
        if (m + NGW < T) { const GAS f32x4* xr = (const GAS f32x4*)(F.out + (size_t)(m + NGW) * D) + lane; const GAS v2u* y0 = (const GAS v2u*)(YB + (size_t)(2 * (m + NGW)) * D) + lane; const GAS v2u* y1 = y0 + D / 4;
#pragma unroll
            for (int j = 0; j < 4; ++j) { nx[j] = xr[64 * j]; na[j] = y0[64 * j]; nb[j] = y1[64 * j]; } }
        const float mean1 = ST[2 * (size_t)m], rstd1 = ST[2 * (size_t)m + 1];
#pragma unroll
        for (int j = 0; j < 4; ++j) { const f32x4 x = (cx[j] - mean1) * rstd1 * g1[j] + b1[j]; const v2u a = ca[j], b = cb_[j];
            v[j].x = ALPHA * x.x + (bflo(a.x) + bflo(b.x)); v[j].y = ALPHA * x.y + (bfhi(a.x) + bfhi(b.x)); v[j].z = ALPHA * x.z + (bflo(a.y) + bflo(b.y)); v[j].w = ALPHA * x.w + (bfhi(a.y) + bfhi(b.y));
            s += (v[j].x + v[j].y) + (v[j].z + v[j].w); }
        const float mean = wave_sum(s) * (1.f / D); float s2 = 0.f;
#pragma unroll
        for (int j = 0; j < 4; ++j) { v[j] = v[j] - mean; s2 += (v[j].x * v[j].x + v[j].y * v[j].y) + (v[j].z * v[j].z + v[j].w * v[j].w); }
        const float rstd = 1.f / sqrtf(wave_sum(s2) * (1.f / D) + LN_EPS);
        GAS v2u* o8 = (GAS v2u*)(XBo + (size_t)m * D) + lane;
#pragma unroll
        for (int j = 0; j < 4; ++j) {
            v[j] = v[j] * rstd * g4[j] + b4[j]; xw[64 * j] = v[j]; v2u o; o.x = pk2(v[j].x, v[j].y); o.y = pk2(v[j].z, v[j].w); o8[64 * j] = o; }
    }
    __syncthreads();
    if (more && (sub & 2)) weight_prep(F, l + 1);
}

__device__ __forceinline__ void phase_attention(Frame& F, int l) {
    const attn_body::AttnTensors AT{(const attn_body::bf16*)(F.ws + WS_AQKV), (const attn_body::bf16*)(F.ws + WS_AQKV) + 512, (const attn_body::bf16*)(F.ws + WS_AQKV) + 1024,
                                    (attn_body::bf16*)(F.ws + WS_YTALL) + (size_t)2 * T * 512, (const float*)(F.ws + WS_FTAB)};
    volatile LAS unsigned* NEXT = (volatile LAS unsigned*)(F.lds + LDSCTL_OFF + 64);
    unsigned* head = (unsigned*)(F.ctl + CW_AQ + 64 * l);
    if (F.tid == 0) NEXT[0] = __hip_atomic_fetch_add(head, 1u, RLX_AGENT);
    __syncthreads();
    int idx = __builtin_amdgcn_readfirstlane((int)NEXT[0]);
#pragma unroll 1
    while (idx < 1024) {
        unsigned nxt = 0u;
        if (F.tid == 0) nxt = __hip_atomic_fetch_add(head, 1u, RLX_AGENT);
        const int qb = 15 - (idx >> 6), bh = idx & 63;
        attn_body::attn_unit<8>(bh >> 3, bh & 7, qb, AT.Q, AT.K, AT.V, AT.O, AT.F, (char*)F.ldsg, F.tid);
        if (F.tid == 0) NEXT[0] = nxt;
        __syncthreads();
        idx = __builtin_amdgcn_readfirstlane((int)NEXT[0]);
        __syncthreads();
    }
}

__global__ void __launch_bounds__(NWAVES * 64, 2) mega_fwd(Args args) {
    extern __shared__ __attribute__((aligned(16))) unsigned char lds[];
    Frame F;
    F.lds = (LAS unsigned char*)lds; F.ldsg = lds;
    const int wave_s = __builtin_amdgcn_readfirstlane((int)threadIdx.x >> 6);
    F.tid = wave_s * 64 + lane_id(); F.lane = F.tid & 63; F.wave = wave_s;
    const int G_s = gridDim.x, bx_s = blockIdx.x, vcu_s = (G_s % 8 == 0) ? (bx_s % 8) * (G_s / 8) + bx_s / 8 : bx_s;
    F.G = G_s; F.bx = bx_s; F.vcu = vcu_s;
    F.ws = args.ws; F.ctl = (gu32*)(args.ws + WS_CTL); F.out = args.out; F.ka = (KArgs)__builtin_amdgcn_kernarg_segment_ptr();
    volatile LAS unsigned* MISC = (volatile LAS unsigned*)(F.lds + MISC_OFF);
    for (int u = F.tid; u < (LDS_BYTES - LDSCTL_OFF) / 4; u += NWAVES * 64) ((LAS unsigned*)(F.lds + LDSCTL_OFF))[u] = 0u;
    __syncthreads();
    const int lo = args.ph_lo, hi = args.ph_hi, sub = args.sub; F.dup = sub & 0xE0;
    XcdBarrier bar; bar.bar = (unsigned*)(F.ctl + CW_BAR); bar.x = 0; bar.st = nullptr;
    if (hi - lo > 1) bar = xcd_barrier_post((unsigned*)(F.ctl + CW_BAR), MISC + 8, wave_s == 0 && lane_id() == 0);
#ifndef PH_MASK
#define PH_MASK 0x3fff
#endif
#define HAS(j) (((PH_MASK) >> (j)) & 1)

#define IN(k) (lo <= (k) && (k) < hi)
#define SEAM(k) do { if (IN(k) && IN((k) + 1)) { XcdBarrier b2_ = bar; asm volatile("" : "+s"(b2_.bar)); asm volatile("" : "+s"(b2_.x)); xcd_barrier(b2_, wave_s == 0 && lane_id() == 0); } } while (0)
#define FRESH() do { int t_ = wave_s * 64 + lane_id(); asm volatile("" : "+v"(t_)); F.tid = t_; F.lane = t_ & 63; F.wave = wave_s; \
        int g_ = G_s, b_ = bx_s, v_ = vcu_s; asm volatile("" : "+s"(g_), "+s"(b_), "+s"(v_)); F.G = g_; F.bx = b_; F.vcu = v_; \
        unsigned char* w_ = args.ws; asm volatile("" : "+s"(w_)); F.ws = w_; ws = w_; F.ctl = (gu32*)(w_ + WS_CTL); float* o_ = args.out; asm volatile("" : "+s"(o_)); F.out = o_; } while (0)
    unsigned char* ws = args.ws;
    if (HAS(13) && IN(0)) { FRESH(); phase_p0(F); SEAM(0); }
#pragma unroll 1
    for (int l = 0; l < NL; ++l) {
        const int pb = 1 + l * NPH_LAYER;
        if (HAS(0) && IN(pb + 0)) { FRESH(); small_gates_mfma(F, l);
            pg8::Gemm g{(const pg8::bf16_t*)(ws + WS_XB), (const pg8::bf16_t*)(ws + WS_WIN), 1024, 1024, 1024}; pg8::StaticOrder S; S.init(T, NIN, F.G, F.bx);
            EpiInProj E{ws, F.ka->in[I_b_in] + (size_t)l * INTOT};
            pg8::gemm_phase<EpiInProj, pg8::StaticOrder, true>(F.lds + RING_OFF, g, S, E, F.tid);
            SEAM(pb + 0);
        }
        if (HAS(1) && IN(pb + 1)) { FRESH(); phase_prep2(F, l); SEAM(pb + 1); }
        if (HAS(2) && IN(pb + 2)) { FRESH();
#ifndef P2_NO_A
            if (sub & 1) mlstm_pass1_all(F);
#endif
#ifndef P2_NO_B
            if (sub & 2) { pg8::Gemm g{(const pg8::bf16_t*)(ws + WS_S5A), (const pg8::bf16_t*)(ws + WS_S5ALL + (size_t)l * S5_LAYER_BYTES + 20 * MiB), 512, S5K, 512}; SchedS5E S{F.vcu}; EpiS5E E{(float*)(ws + WS_EBUF)};
              pg8::gemm_phase<EpiS5E, SchedS5E, true>(F.lds + RING_OFF, g, S, E, F.tid); }
            __syncthreads();
#endif
#ifndef P2_NO_C
            if (sub & 4) phase_attention(F, l);
#endif
            SEAM(pb + 2);
        }
        if (HAS(3) && IN(pb + 3)) { FRESH(); phase_scans(F, l, (sub & 0x10) != 0); SEAM(pb + 3); }
        if (HAS(4) && IN(pb + 4)) { FRESH();
            mlstm_pass3_all(F, l);
            { pg8::Gemm g{(const pg8::bf16_t*)(ws + WS_S5A), (const pg8::bf16_t*)(ws + WS_S5ALL + (size_t)l * S5_LAYER_BYTES), S5K, S5K, S5K}; SchedS5Y S{F.vcu}; EpiS5Y E{(bf16*)(ws + WS_YS1)};
              pg8::gemm_phase<EpiS5Y, SchedS5Y, true>(F.lds + RING_OFF, g, S, E, F.tid); }
            SEAM(pb + 4);
        }
        if (HAS(5) && IN(pb + 5)) { FRESH();            pg8::Gemm g{(const pg8::bf16_t*)(ws + WS_YS1), (const pg8::bf16_t*)(ws + WS_WGLU), 512, 512, 512}; pg8::StaticOrder S; S.init(T, 512, F.G, F.bx);
            EpiGlu E{(const bf16*)(ws + WS_YS1), (bf16*)(ws + WS_YTALL) + (size_t)T * 512, F.ka->in[I_s5_b_glu] + (size_t)l * 512};
            pg8::gemm_phase<EpiGlu, pg8::StaticOrder, true>(F.lds + RING_OFF, g, S, E, F.tid);
            SEAM(pb + 5);
        }
        if (HAS(6) && IN(pb + 6)) { FRESH();            pg8::Gemm g{(const pg8::bf16_t*)(ws + WS_YTALL), (const pg8::bf16_t*)(ws + WS_WBR), 512, 512, 512}; SchedMerge S{F.vcu, F.G};
            EpiMerge E{(const bf16*)(ws + WS_GATE), (bf16*)(ws + WS_MIXED)};
            pg8::gemm_phase<EpiMerge, SchedMerge, true>(F.lds + RING_OFF, g, S, E, F.tid);
            SEAM(pb + 6);
        }
        if (HAS(7) && IN(pb + 7)) { FRESH();
            pg8::Gemm g{(const pg8::bf16_t*)(ws + WS_MIXED), (const pg8::bf16_t*)(ws + WS_WOUT), 1024, 1024, 1024}; pg8::StaticOrder S; S.init(T, 1024, F.G, F.bx);
            EpiOutProj E{l == 0 ? F.ka->in[I_x] : (const float*)F.out, F.out};
            pg8::gemm_phase<EpiOutProj, pg8::StaticOrder, true>(F.lds + RING_OFF, g, S, E, F.tid);
            SEAM(pb + 7);
        }
        if (HAS(8) && IN(pb + 8)) { FRESH(); phase_ln1_route(F, l, (sub & 0x10) != 0); SEAM(pb + 8); }
        if (HAS(9) && IN(pb + 9)) { FRESH(); phase_dispatch(F, l); SEAM(pb + 9); }
        if (HAS(10) && IN(pb + 10)) { FRESH();moe_tables(F, l); moe_stage_rows(F);
            pg8::Gemm g{(const pg8::bf16_t*)(ws + WS_XB), (const pg8::bf16_t*)(ws + WS_WGU), 1024, 1024, 1024}; SchedMoeG S{(const LAS int*)(F.lds + LDSX_OFF + 20480), (const LAS int*)(F.lds + LDSX_OFF), F.vcu, F.G};
            EpiGateUp E{(bf16*)(ws + WS_HB)};
            pg8::gemm_phase<EpiGateUp, SchedMoeG, true>(F.lds + RING_OFF, g, S, E, F.tid);
            SEAM(pb + 10);
        }
        if (HAS(11) && IN(pb + 11)) { FRESH();            moe_tables(F, l);
            pg8::Gemm g{(const pg8::bf16_t*)(ws + WS_HB), (const pg8::bf16_t*)(ws + WS_WDN), 512, 512, 512}; SchedMoe S{(const LAS int*)(F.lds + LDSX_OFF + 20480), F.vcu, F.G};
            EpiDown E{(bf16*)(ws + WS_YB), (const int*)(ws + WS_TOKPOS), (const float*)(ws + WS_TOKPOS + 524288)};
            pg8::gemm_phase<EpiDown, SchedMoe, true>(F.lds + RING_OFF, g, S, E, F.tid);
            SEAM(pb + 11);
        }
        if (HAS(12) && IN(pb + 12)) { FRESH(); phase_ln2(F, l, sub); SEAM(pb + 12); }
    }
#undef IN
#undef SEAM
}

extern "C" void kernel_launch(void* const* d_in, const int* in_sizes, int n_in, void* d_out, int out_size, void* d_ws, size_t ws_size, hipStream_t stream) {
    static int grid = 0;
    if (grid == 0) {
        if (n_in != 29 || in_sizes[0] != T * D || out_size != T * D || ws_size < WS_END) { fprintf(stderr, "kernel_launch: unexpected shapes / workspace (n_in %d, ws %zu < %zu)\n", n_in, ws_size, (size_t)WS_END); grid = -1; return; }
        int dev = 0, cus = 0;
        if (hipGetDevice(&dev) != hipSuccess || hipDeviceGetAttribute(&cus, hipDeviceAttributeMultiprocessorCount, dev) != hipSuccess) { grid = -1; return; }
        if (hipFuncSetAttribute((const void*)mega_fwd, hipFuncAttributeMaxDynamicSharedMemorySize, LDS_BYTES) != hipSuccess) { fprintf(stderr, "kernel_launch: hipFuncSetAttribute failed\n"); grid = -1; return; }
        int per_cu = 0;
        (void)hipOccupancyMaxActiveBlocksPerMultiprocessor(&per_cu, (const void*)mega_fwd, NWAVES * 64, LDS_BYTES);
        (void)hipGetLastError();
        if (cus != 256 || per_cu < 1) { fprintf(stderr, "kernel_launch: needs 256 CUs with one resident workgroup each (cus %d, per_cu %d)\n", cus, per_cu); grid = -1; return; }
        grid = cus;
    }
    if (grid < 0) return;
    (void)hipMemsetAsync((char*)d_ws + WS_CTL, 0, CTL_ZERO_BYTES, stream);
    Args a{};
    for (int i = 0; i < 29; ++i) a.in[i] = (const float*)d_in[i];
    a.out = (float*)d_out; a.ws = (unsigned char*)d_ws;
    a.sub = 0xF; a.pad = 0;
#if MK_ONE_LAUNCH
    a.ph_lo = 0; a.ph_hi = NPHASES;
    hipLaunchKernelGGL(mega_fwd, dim3(grid), dim3(NWAVES * 64), LDS_BYTES, stream, a);
#else
#ifndef PROBE_KIND
#define PROBE_KIND -1
#endif
#ifndef PROBE_REPS
#define PROBE_REPS 1
#endif
#ifndef PROBE_SUB
#define PROBE_SUB -1
#endif
    for (int p = 0; p < NPHASES; ++p) { a.ph_lo = p; a.ph_hi = p + 1; a.sub = 0xF;
        const int kind = (p == 0) ? 13 : (p - 1) % NPH_LAYER;
        if (kind == PROBE_KIND && PROBE_SUB != -1 && (PROBE_SUB & 0x100)) {   }
        hipLaunchKernelGGL(mega_fwd, dim3(grid), dim3(NWAVES * 64), LDS_BYTES, stream, a);
        if (kind == PROBE_KIND) { a.sub = PROBE_SUB; for (int r = 0; r < PROBE_REPS; ++r) hipLaunchKernelGGL(mega_fwd, dim3(grid), dim3(NWAVES * 64), LDS_BYTES, stream, a); }
    }
#endif
}
```

```cpp
#include <hip/hip_runtime.h>
#include <hip/hip_bf16.h>
#include <cstdio>
#include <cstdint>
#include <cmath>

#ifndef MK_ONE_LAUNCH
#define MK_ONE_LAUNCH 1
#endif

namespace pg8 {
#define PG8_LAS __attribute__((address_space(3)))
typedef unsigned short bf16_t;
typedef short bf16x8 __attribute__((ext_vector_type(8)));
typedef float f32x4 __attribute__((ext_vector_type(4)));
typedef float f32x2 __attribute__((ext_vector_type(2)));
typedef unsigned u32x4 __attribute__((ext_vector_type(4)));
typedef unsigned u32x2 __attribute__((ext_vector_type(2)));
constexpr int BM = 256, BK = 64, HALF = 128, HTB = HALF * BK * 2  , STAGE_BYTES = 8 * HTB, NXCD = 8, WGM = 8;

__host__ __device__ __forceinline__ int lds_byte(int r, int c) { const int st = (r >> 4) * 2 + (c >> 5), rr = r & 15, cc = c & 31, ob = rr * 64 + cc * 2; return st * 1024 + (ob ^ (((ob >> 9) & 1) << 5)); }
__host__ __device__ __forceinline__ void stage_rc(int b, int& R, int& C) { const int st = b / 1024, sb = b % 1024, swz = sb ^ (((sb >> 9) & 1) << 5); R = (st >> 1) * 16 + swz / 64; C = (st & 1) * 32 + (swz % 64) / 2; }
__host__ __device__ __forceinline__ int perm32(int rho) { const int n = rho >> 4, i = rho & 15; return 8 * (i >> 2) + 4 * n + (i & 3); }

struct Unit { int pm, pn; };
struct Gemm { const bf16_t* A; const bf16_t* Bt; int K, lda, ldb; };

struct StaticOrder {
    static constexpr bool GATHER = false;
    int nM, nN, nwg, G, c;
    __host__ __device__ void init(int M, int N, int G_, int c_) { nM = M / BM; nN = N / BM; nwg = nM * nN; G = G_; c = c_; }
    __host__ __device__ bool next(int i, Unit& u) const {
        const long L = (long)i * G + c; if (L >= nwg) return false;
        int wgid = (int)L; { const int q = nwg / NXCD, r = nwg % NXCD, xcd = wgid % NXCD, off = wgid / NXCD; wgid = (xcd < r ? xcd * (q + 1) : r * (q + 1) + (xcd - r) * q) + off; }
        const int nig = WGM * nN, gid = wgid / nig, fm = gid * WGM, gsz = (nM - fm) < WGM ? (nM - fm) : WGM;
        u.pm = fm + ((wgid % nig) % gsz); u.pn = (wgid % nig) / gsz; return true;
    }
};

__device__ __forceinline__ unsigned cvt_pk_bf16(float lo, float hi) { unsigned r; asm volatile("v_cvt_pk_bf16_f32 %0, %1, %2" : "=v"(r) : "v"(lo), "v"(hi)); return r; }

template <class Epi, class Sched, bool ALIGN_EPI = true>
__device__ __forceinline__ void gemm_phase(PG8_LAS unsigned char* lds, const Gemm g, const Sched& S, const Epi& E, const int tid  ) {
    const int wid = __builtin_amdgcn_readfirstlane(tid >> 6), lane = tid & 63, wr = wid >> 2, wc = wid & 3, fr = lane & 15, fq = lane >> 4;
    const int K = g.K, nt = K / BK;
    unsigned voffA[2], voffB[2];
#pragma unroll
    for (int i = 0; i < 2; ++i) { int R, C; stage_rc(tid * 16 + i * 8192, R, C); const int Rb = Epi::PERM ? ((R & ~31) + perm32(R & 31)) : R;
        voffA[i] = (unsigned)(R * g.lda + C) * 2u; voffB[i] = (unsigned)(Rb * g.ldb + C) * 2u; }
    unsigned cvo[2][2] = {{0u, 0u}, {0u, 0u}}, nvo[2][2] = {{0u, 0u}, {0u, 0u}}; int gR[2] = {0, 0}; unsigned gC[2] = {0u, 0u};
    if constexpr (Sched::GATHER) {
#pragma unroll
        for (int i = 0; i < 2; ++i) { int R, C; stage_rc(tid * 16 + i * 8192, R, C); gR[i] = R; gC[i] = (unsigned)C * 2u; }
    }
    const size_t kstep = (size_t)(BK * 2);
    const size_t hstepA = (size_t)HALF * g.lda * 2, hstepB = (size_t)HALF * g.ldb * 2;
    const size_t tstepA = 2 * hstepA, tstepB = 2 * hstepB;
    const unsigned ldsw = (unsigned)wid * 1024u;
    const int aoff = lds_byte(wr * 64 + fr, fq * 8), boff = lds_byte(wc * 32 + fr, fq * 8);
#define PG8_SA(b, h) (((b) * 2 + (h)) * HTB)
#define PG8_SB(b, h) ((4 + (b) * 2 + (h)) * HTB)
#define PG8_STAGE(bufoff, gbase, voff) do { _Pragma("unroll") for (int _i = 0; _i < 2; ++_i) \
        __builtin_amdgcn_global_load_lds((const unsigned*)((const char*)(gbase) + (voff)[_i]), (PG8_LAS unsigned*)(lds + (bufoff) + ldsw + _i * 8192), 16, 0, 0); } while (0)
#define PG8_LDA(dst, b, h) do { _Pragma("unroll") for (int m = 0; m < 4; ++m) _Pragma("unroll") for (int k = 0; k < 2; ++k) dst[m][k] = *(const PG8_LAS bf16x8*)(lds + PG8_SA(b, h) + aoff + m * 2048 + k * 1024); } while (0)
#define PG8_LDB(dst, b, h) do { _Pragma("unroll") for (int n = 0; n < 2; ++n) _Pragma("unroll") for (int k = 0; k < 2; ++k) dst[n][k] = *(const PG8_LAS bf16x8*)(lds + PG8_SB(b, h) + boff + n * 2048 + k * 1024); } while (0)
#define PG8_MMA(ai, bj, At, Bt) do { __builtin_amdgcn_s_setprio(1); _Pragma("unroll") for (int m = 0; m < 4; ++m) _Pragma("unroll") for (int n = 0; n < 2; ++n) _Pragma("unroll") for (int k = 0; k < 2; ++k) \
        acc[ai][bj][m][n] = __builtin_amdgcn_mfma_f32_16x16x32_bf16(Bt[n][k], At[m][k], acc[ai][bj][m][n], 0, 0, 0); __builtin_amdgcn_s_setprio(0); } while (0)
#define PG8_WAIT_V(n) asm volatile("s_waitcnt vmcnt(" #n ")" ::: "memory")
#define PG8_WAIT_L(n) asm volatile("s_waitcnt lgkmcnt(" #n ")" ::: "memory")
#define PG8_BAR __builtin_amdgcn_s_barrier()
#define PG8_SCHED __builtin_amdgcn_sched_barrier(0)
    Unit cur, nxt; int ui = 0;
    if (!S.next(0, cur)) return;
    f32x4 acc[2][2][4][2];
    float zf = 0.f; asm volatile("" : "+v"(zf));
#pragma unroll
    for (int a = 0; a < 2; ++a)
#pragma unroll
        for (int b = 0; b < 2; ++b)
#pragma unroll
            for (int m = 0; m < 4; ++m)
#pragma unroll
                for (int n = 0; n < 2; ++n) acc[a][b][m][n] = (f32x4){zf, zf, zf, zf};
    bf16x8 At[4][2], B0[2][2], B1[2][2];
    const char* cA = Sched::GATHER ? (const char*)g.A : (const char*)g.A + (size_t)cur.pm * tstepA; const char* cB = (const char*)g.Bt + (size_t)cur.pn * tstepB;
    if constexpr (Sched::GATHER) {
#pragma unroll
        for (int h = 0; h < 2; ++h)
#pragma unroll
            for (int i = 0; i < 2; ++i) cvo[h][i] = S.row_byte_off(0, 128 * h + gR[i]) + gC[i];
    }
#define PG8_STAGE_A(bufoff, gbase, h, vo) do { if constexpr (Sched::GATHER) { PG8_STAGE(bufoff, gbase, (vo)[h]); } else { PG8_STAGE(bufoff, (gbase) + (h) * hstepA, voffA); } } while (0)
    PG8_STAGE(PG8_SB(0, 0), cB, voffB); PG8_STAGE(PG8_SB(0, 1), cB + hstepB, voffB); PG8_STAGE_A(PG8_SA(0, 0), cA, 0, cvo); PG8_STAGE_A(PG8_SA(0, 1), cA, 1, cvo);
    if (wr == 1) PG8_BAR;
    PG8_WAIT_V(2); PG8_BAR;
    PG8_STAGE(PG8_SB(1, 0), cB + kstep, voffB); PG8_STAGE_A(PG8_SA(1, 0), cA + kstep, 0, cvo); PG8_STAGE(PG8_SB(1, 1), cB + hstepB + kstep, voffB);
    PG8_WAIT_V(6); PG8_BAR;
    for (;;) {
        const bool has_next = S.next(ui + 1, nxt);
        const char* nA = (has_next && !Sched::GATHER) ? (const char*)g.A + (size_t)nxt.pm * tstepA : cA; const char* nB = has_next ? (const char*)g.Bt + (size_t)nxt.pn * tstepB : cB;
        if constexpr (Sched::GATHER) {
#pragma unroll
            for (int h = 0; h < 2; ++h)
#pragma unroll
                for (int i = 0; i < 2; ++i) nvo[h][i] = has_next ? S.row_byte_off(ui + 1, 128 * h + gR[i]) + gC[i] : cvo[h][i];
        }
        for (int t = 0; t < nt; t += 2) {
            const bool last = (t == nt - 2);
            const char* a1 = cA + (size_t)(t + 1) * kstep;
            const char* a2 = last ? nA : cA + (size_t)(t + 2) * kstep; const char* b2 = last ? nB : cB + (size_t)(t + 2) * kstep;
            const char* a3 = a2 + kstep; const char* b3 = b2 + kstep;
            unsigned vo2[2][2];
#pragma unroll
            for (int h = 0; h < 2; ++h)
#pragma unroll
                for (int i = 0; i < 2; ++i) vo2[h][i] = last ? nvo[h][i] : cvo[h][i];
            PG8_LDB(B0, 0, 0); PG8_LDB(B1, 0, 1); PG8_SCHED; PG8_LDA(At, 0, 0); PG8_STAGE_A(PG8_SA(1, 1), a1, 1, cvo);
            PG8_WAIT_V(8); PG8_WAIT_L(0); PG8_BAR; PG8_MMA(0, 0, At, B0); PG8_MMA(0, 1, At, B1); PG8_BAR; PG8_SCHED;
            PG8_LDA(At, 0, 1); PG8_STAGE(PG8_SB(0, 0), b2, voffB); PG8_STAGE(PG8_SB(0, 1), b2 + hstepB, voffB); PG8_STAGE_A(PG8_SA(0, 0), a2, 0, vo2);
            PG8_WAIT_V(8); PG8_WAIT_L(0); PG8_BAR; PG8_MMA(1, 0, At, B0); PG8_MMA(1, 1, At, B1); PG8_BAR; PG8_SCHED;
            PG8_LDB(B0, 1, 0); PG8_LDB(B1, 1, 1); PG8_SCHED; PG8_LDA(At, 1, 0); PG8_STAGE_A(PG8_SA(0, 1), a2, 1, vo2);
            PG8_WAIT_V(8); PG8_WAIT_L(0); PG8_BAR; PG8_MMA(0, 0, At, B0); PG8_MMA(0, 1, At, B1); PG8_BAR; PG8_SCHED;
            PG8_LDA(At, 1, 1); PG8_STAGE(PG8_SB(1, 0), b3, voffB); PG8_STAGE(PG8_SB(1, 1), b3 + hstepB, voffB); PG8_STAGE_A(PG8_SA(1, 0), a3, 0, vo2);
            PG8_WAIT_V(8); PG8_WAIT_L(0); PG8_BAR; PG8_MMA(1, 0, At, B0); PG8_MMA(1, 1, At, B1); PG8_BAR; PG8_SCHED;
        }
        if constexpr (ALIGN_EPI) { if (wr == 0) PG8_BAR; }
        E(acc, cur, wr, wc, fr, fq);
        if (!has_next) break;
        if (E.reset_after(cur)) {
#pragma unroll
        for (int a = 0; a < 2; ++a)
#pragma unroll
            for (int b = 0; b < 2; ++b)
#pragma unroll
                for (int m = 0; m < 4; ++m)
#pragma unroll
                    for (int n = 0; n < 2; ++n) acc[a][b][m][n] = (f32x4){zf, zf, zf, zf};
        }
        cur = nxt; cA = nA; cB = nB; ++ui;
        if constexpr (Sched::GATHER) {
#pragma unroll
            for (int h = 0; h < 2; ++h)
#pragma unroll
                for (int i = 0; i < 2; ++i) cvo[h][i] = nvo[h][i];
        }
        if constexpr (ALIGN_EPI) { if (wr == 1) PG8_BAR; }
    }
    PG8_WAIT_V(0);
    if constexpr (!ALIGN_EPI) { if (wr == 0) PG8_BAR; }
    PG8_BAR;
#undef PG8_SA
#undef PG8_SB
#undef PG8_STAGE
#undef PG8_STAGE_A
#undef PG8_LDA
#undef PG8_LDB
#undef PG8_MMA
#undef PG8_WAIT_V
#undef PG8_WAIT_L
#undef PG8_BAR
#undef PG8_SCHED
}
}

#include <hip/hip_bf16.h>
#include <cmath>
namespace attn_body {
using bf16=__hip_bfloat16;
using bf16x8=__attribute__((ext_vector_type(8)))short;
using s16x4=__attribute__((ext_vector_type(4)))short;
using f32x16=__attribute__((ext_vector_type(16)))float;
using u32x4=__attribute__((ext_vector_type(4)))unsigned;
using f32x4v=__attribute__((ext_vector_type(4)))float;
constexpr int BATCH=8,NHEAD=8,SEQ=4096,D=64,DM=1536,DMO=512;
constexpr int NW=8,QBLK=32,QB=QBLK*NW,KVBLK=64,NQB=SEQ/QB;
constexpr int ATTN_PITCH=DM, ATTN_UNIT_ROWS=QB;
__device__ __forceinline__ int crow(int r,int hi){return (r&3)+8*(r>>2)+4*hi;}
#define SBAR() __builtin_amdgcn_sched_barrier(0)
__device__ __forceinline__ void cmask(f32x16&p0,f32x16&p1,int jb,int qrel,int hi){
  const float NEG=-INFINITY; int kb=64*jb+4*hi;
  #pragma unroll
  for(int r=0;r<16;++r){int kv=kb+(r&3)+8*(r>>2); if(kv>qrel)p0[r]=NEG; if(kv+32>qrel)p1[r]=NEG;}
}

constexpr int NSLOT=3, SLOTB=8192;
constexpr int LDS_K=0, LDS_V=NSLOT*SLOTB, LDS_WS=2*NSLOT*SLOTB, LDS_OST=LDS_WS+NW*64*4, LDS_F=LDS_OST+NW*4096, LDS_Q=LDS_F+SEQ*4, LDS_BYTES=LDS_Q+NW*4096;
constexpr float PRUNE2=64.f;
constexpr float C2=0.125f*1.4426950408889634f;
__device__ __forceinline__ void glds16(const void*gsrc,unsigned lds_dst){unsigned keep;
  asm volatile("s_mov_b32 %0, m0\n\ts_mov_b32 m0, %2\n\ts_nop 0\n\tglobal_load_lds_dwordx4 %1, off\n\ts_mov_b32 m0, %0":"=&s"(keep):"v"(gsrc),"s"(lds_dst):"memory");}
__device__ __forceinline__ void glds16s(const void*sbase,unsigned voff,unsigned lds_dst){unsigned keep;
  asm volatile("s_mov_b32 %0, m0\n\ts_mov_b32 m0, %3\n\ts_nop 0\n\tglobal_load_lds_dwordx4 %1, %2\n\ts_mov_b32 m0, %0":"=&s"(keep):"v"(voff),"s"(sbase),"s"(lds_dst):"memory");}
__device__ __forceinline__ float max3f(float a,float b,float c){float r;asm("v_max3_f32 %0, %1, %2, %3":"=v"(r):"v"(a),"v"(b),"v"(c));return r;}
__device__ __forceinline__ float max2f(float a,float b){float r;asm("v_max_f32_e32 %0, %1, %2":"=v"(r):"v"(a),"v"(b));return r;}
__device__ __forceinline__ float fadd_s(float a,float b){float r;asm("v_add_f32_e32 %0, %1, %2":"=v"(r):"v"(a),"v"(b));return r;}
__device__ __forceinline__ float fsub_s(float a,float b){float r;asm("v_sub_f32_e32 %0, %1, %2":"=v"(r):"v"(a),"v"(b));return r;}
typedef float f32x2_t __attribute__((ext_vector_type(2))); typedef __bf16 bf16x2_t __attribute__((ext_vector_type(2)));
__device__ __forceinline__ unsigned cvtpk_s(float lo,float hi){f32x2_t v={lo,hi};bf16x2_t b=__builtin_convertvector(v,bf16x2_t);return __builtin_bit_cast(unsigned,b);}
#define WAIT_BAR(N) asm volatile("s_waitcnt vmcnt(" #N ") lgkmcnt(0)\n\ts_barrier":::"memory")

__device__ __forceinline__ void qkt(f32x16&p0,f32x16&p1,const char*Kslot,const bf16x8*qr,int r32,int hi){
  const char*kb=Kslot+hi*1024+r32*16;
  #pragma unroll
  for(int d0=0;d0<4;++d0){
    const bf16x8 b0=*reinterpret_cast<const bf16x8*>(kb+d0*2048);
    const bf16x8 b1=*reinterpret_cast<const bf16x8*>(kb+d0*2048+512);
    {p0=__builtin_amdgcn_mfma_f32_32x32x16_bf16(b0,qr[d0],p0,0,0,0);p1=__builtin_amdgcn_mfma_f32_32x32x16_bf16(b1,qr[d0],p1,0,0,0);}}
}
typedef __attribute__((address_space(3))) const char* lds_cptr;
typedef short v4i16_t __attribute__((ext_vector_type(4)));
__device__ __forceinline__ void kload8(bf16x8*kf,lds_cptr kp){
  kf[0]=*(const __attribute__((address_space(3))) bf16x8*)(kp);      kf[1]=*(const __attribute__((address_space(3))) bf16x8*)(kp+512);
  kf[2]=*(const __attribute__((address_space(3))) bf16x8*)(kp+2048); kf[3]=*(const __attribute__((address_space(3))) bf16x8*)(kp+2560);
  kf[4]=*(const __attribute__((address_space(3))) bf16x8*)(kp+4096); kf[5]=*(const __attribute__((address_space(3))) bf16x8*)(kp+4608);
  kf[6]=*(const __attribute__((address_space(3))) bf16x8*)(kp+6144); kf[7]=*(const __attribute__((address_space(3))) bf16x8*)(kp+6656);
}
__device__ __forceinline__ void kload2(bf16x8*kf,lds_cptr kp,int j){ kf[2*j]=*(const __attribute__((address_space(3))) bf16x8*)(kp+j*2048); kf[2*j+1]=*(const __attribute__((address_space(3))) bf16x8*)(kp+j*2048+512); }
__device__ __forceinline__ s16x4 vtr(lds_cptr p){ return __builtin_bit_cast(s16x4,__builtin_amdgcn_ds_read_tr16_b64_v4i16((__attribute__((address_space(3))) v4i16_t*)p)); }
__device__ __forceinline__ float rowmax(const f32x16&p0,const f32x16&p1){
  float a=max3f(p0[0],p0[1],p1[0]),b=max3f(p0[2],p0[3],p1[1]);a=max3f(a,p1[2],p1[3]);
  #pragma unroll
  for(int r=4;r<16;r+=4){a=max3f(a,p0[r],p0[r+1]);b=max3f(b,p0[r+2],p0[r+3]);a=max3f(a,p1[r],p1[r+1]);b=max3f(b,p1[r+2],p1[r+3]);}
  const float m=max2f(a,b);
  auto rr=__builtin_amdgcn_permlane32_swap(__float_as_uint(m),__float_as_uint(m),false,false);
  return max2f(__uint_as_float(rr[0]),__uint_as_float(rr[1]));
}
__device__ __forceinline__ void pv(f32x16*o,int vb,bf16x8 pa0,bf16x8 pa1,bf16x8 pa2,bf16x8 pa3){
  #pragma unroll
  for(int d0=0;d0<2;++d0){s16x4 lo[4],hi[4];
    #pragma unroll
    for(int ks=0;ks<4;++ks){
      asm volatile("ds_read_b64_tr_b16 %0,%1 offset:%c2":"=&v"(lo[ks]):"v"(vb),"i"(d0*4096+ks*1024):"memory");
      asm volatile("ds_read_b64_tr_b16 %0,%1 offset:%c2":"=&v"(hi[ks]):"v"(vb),"i"(d0*4096+ks*1024+512):"memory");}
    asm volatile("s_waitcnt lgkmcnt(0)":::"memory");SBAR();
    #define PK(k) (bf16x8){lo[k][0],lo[k][1],lo[k][2],lo[k][3],hi[k][0],hi[k][1],hi[k][2],hi[k][3]}
    o[d0]=__builtin_amdgcn_mfma_f32_32x32x16_bf16(pa0,PK(0),o[d0],0,0,0);
    o[d0]=__builtin_amdgcn_mfma_f32_32x32x16_bf16(pa1,PK(1),o[d0],0,0,0);
    o[d0]=__builtin_amdgcn_mfma_f32_32x32x16_bf16(pa2,PK(2),o[d0],0,0,0);
    o[d0]=__builtin_amdgcn_mfma_f32_32x32x16_bf16(pa3,PK(3),o[d0],0,0,0);
    #undef PK
  }
}

#ifndef ATTN_STORE16
#define ATTN_STORE16(p,v) (*(u32x4*)(p)=(v))
#endif
template<int THRL> __device__ __forceinline__ void attn_unit(int b,int h,int qb,const bf16*Q,const bf16*__restrict__ K,const bf16*__restrict__ V,bf16*O,const float*__restrict__ Ftab,char*shm,const int tid){
  const int lane=tid&63,r32=lane&31,hi=lane>>5; const int wid=__builtin_amdgcn_readfirstlane(tid>>6);
  const long rowbase=(long)b*SEQ; const int q0=qb*QB;
  const bf16*Qw=Q+(rowbase+q0+wid*QBLK)*DM+h*D;
  const float*Fh=Ftab+(long)(b*NHEAD+h)*SEQ;
  int ts=0;
  { const int NT0=(q0+QB)/KVBLK; const float fq0=Fh[q0]; const float fk=Fh[(lane<NT0?lane:NT0-1)*KVBLK+KVBLK-1];
    const unsigned long long mk=__ballot(lane<NT0&&(fq0-fk>=-PRUNE2)); const int first=mk?(int)__builtin_ctzll(mk):0; ts=first&~1; if(ts>NT0-4)ts=NT0-4; ts=__builtin_amdgcn_readfirstlane(ts); }
  const bf16*Kh=K+(rowbase+(long)ts*KVBLK)*DM+h*D,*Vh=V+(rowbase+(long)ts*KVBLK)*DM+h*D;
  const unsigned lds0=(unsigned)(uintptr_t)shm;
  float*wsf=(float*)(shm+LDS_WS)+wid*64;
  const unsigned koff=(unsigned)(lane*DM+wid*8)*2u;
  const unsigned voff=(unsigned)((16*(wid&3)+(lane>>2))*DM+(wid>>2)*32+(lane&3)*8)*2u;
  const unsigned kdst=lds0+LDS_K+wid*1024, vdst=lds0+LDS_V+wid*1024;
  #define DMA_K(t,slot) glds16s(Kh+(long)(t)*KVBLK*DM,koff,(unsigned)__builtin_amdgcn_readfirstlane(kdst+(slot)))
  #define DMA_V(t,slot) glds16s(Vh+(long)(t)*KVBLK*DM,voff,(unsigned)__builtin_amdgcn_readfirstlane(vdst+(slot)))
  const int vb0=(int)(lds0+LDS_V)+((lane>>4)&1)*32+(lane&3)*8+(4*hi+((lane&15)>>2))*64;
  const char*Kbase=shm+LDS_K; bf16x8 kf[8];
  const lds_cptr shm3=(lds_cptr)shm; const lds_cptr kp0=shm3+LDS_K+hi*1024+r32*16; const lds_cptr vp0=shm3+LDS_V+((lane>>4)&1)*32+(lane&3)*8+(4*hi+((lane&15)>>2))*64;
  const int NT=(q0+QB)/KVBLK-ts;
  { glds16s(Fh,(unsigned)(lane*16+wid*1024),(unsigned)__builtin_amdgcn_readfirstlane(lds0+LDS_F+wid*1024));
    glds16s(Fh,(unsigned)(lane*16+(wid+8)*1024),(unsigned)__builtin_amdgcn_readfirstlane(lds0+LDS_F+(wid+8)*1024)); }
  const float fq2=Fh[q0+wid*QBLK+r32];
  DMA_K(0,0);DMA_V(0,0);DMA_K(1,SLOTB);
  const lds_cptr qs=(lds_cptr)shm+LDS_Q+wid*4096+(hi*32+r32)*16;
  #pragma unroll
  for(int d0=0;d0<4;++d0)*(__attribute__((address_space(3))) bf16x8*)(qs+d0*1024)=*reinterpret_cast<const bf16x8*>(&Qw[(long)r32*DM+d0*16+hi*8]);
  #define QF(k) (*(const __attribute__((address_space(3))) bf16x8*)(qs+(k)*1024))
  float mhat=-fq2,nm=fq2,l_reg=0.f;f32x16 o[2];o[0]=f32x16{};o[1]=f32x16{};
  const lds_cptr fl0=(lds_cptr)shm+LDS_F+hi*16+ts*256;
  #define FINIT1(C0,t,o_) do{ const __attribute__((address_space(3))) f32x4v* fp_=(const __attribute__((address_space(3))) f32x4v*)(fl0+(t)*256+(o_)); \
    _Pragma("unroll") for(int j_=0;j_<4;++j_){ const f32x4v a_=fp_[2*j_]; \
      C0[4*j_]=nm-a_[0]; C0[4*j_+1]=nm-a_[1]; C0[4*j_+2]=nm-a_[2]; C0[4*j_+3]=nm-a_[3]; } }while(0)
  #define FINIT(C0,C1,t) do{ FINIT1(C0,t,0); FINIT1(C1,t,128); }while(0)
  const int qrel=wid*QBLK+r32;
  #define CMASK(P0,P1,t) do{int jb_=(t)-(NT-4); if(jb_>=0)cmask(P0,P1,jb_,qrel,hi);}while(0)
  bool resc=false;
  #define START(P0,P1) do{ const float rm=rowmax(P0,P1); resc=false; \
    { const float dl=rm; mhat=fadd_s(mhat,dl); \
      _Pragma("unroll") for(int r=0;r<16;++r){P0[r]=fsub_s(P0[r],dl);P1[r]=fsub_s(P1[r],dl);} \
      nm=-mhat; } \
    _Pragma("unroll") for(int r=0;r<16;++r)P0[r]=__builtin_amdgcn_exp2f(P0[r]); }while(0)
  #define RESC() do{ if(resc){ asm volatile("s_waitcnt lgkmcnt(0)":::"memory"); \
      _Pragma("unroll") for(int d_=0;d_<2;++d_) _Pragma("unroll") for(int r=0;r<16;++r)o[d_][r]*=wsf[crow(r,hi)]; } }while(0)
  f32x16 pA0,pA1,pB0,pB1;
  int sl_prev=0,sl_cur=0,sl_next=SLOTB;
  #define ROT() do{sl_prev=sl_cur;sl_cur=sl_next;sl_next=(sl_next==(NSLOT-1)*SLOTB)?0:sl_next+SLOTB;}while(0)
  DMA_K(2,2*SLOTB);
  WAIT_BAR(3);
  { bf16x8 qr[4]; qr[0]=QF(0);qr[1]=QF(1);qr[2]=QF(2);qr[3]=QF(3); FINIT(pA0,pA1,0); qkt(pA0,pA1,Kbase,qr,r32,hi); }asm volatile("s_nop 15\n\ts_nop 7":"+v"(pA0),"+v"(pA1));CMASK(pA0,pA1,0);
  START(pA0,pA1);
  _Pragma("unroll") for(int r=0;r<16;++r)pA1[r]=__builtin_amdgcn_exp2f(pA1[r]);
  WAIT_BAR(0);
  DMA_K(3,0);DMA_V(1,SLOTB);
  ROT();
  kload8(kf,kp0+sl_cur);
  WAIT_BAR(2);
  s16x4 vlo[8],vhi[8]; u32x4 pw0,pw1,pw2,pw3;
  #define PKW(P,B) cvtpk_s(P[B],P[B+1])
  #define PAF(k) __builtin_bit_cast(bf16x8,pw##k)
  #define VFR(i) (bf16x8){vlo[i][0],vlo[i][1],vlo[i][2],vlo[i][3],vhi[i][0],vhi[i][1],vhi[i][2],vhi[i][3]}
  #define PIN(x) asm volatile("":"+v"(x))
  #define MX3(a,b,c) __builtin_fmaxf(__builtin_fmaxf((a),(b)),(c))
  #define GAPA(MF,A0,A1,A2,A3,W0,W1,PW) do{ MF; sacc+=A0; sacc+=A1; sacc+=A2; sacc+=A3; PIN(sacc); W0; W1; PIN(PW); SBAR(); }while(0)
  #define EX(v) __builtin_amdgcn_exp2f(v)
  #define GAPB(MF,X,B) do{ MF; X[B]=EX(X[B]); X[B+1]=EX(X[B+1]); X[B+2]=EX(X[B+2]); X[B+3]=EX(X[B+3]); PIN(X); SBAR(); }while(0)
  #define VRD(i) do{ vlo[i]=vtr(vp_+(((i)>>2)*4096+((i)&3)*1024)); vhi[i]=vtr(vp_+(((i)>>2)*4096+((i)&3)*1024+512)); }while(0)
  #define KRD(G,j) do{ if(G){ kload2(kf,kp0+sl_next,j); SBAR(); } }while(0)
  #define STEP(C0,C1,P0,P1,t,GK,GV,GL) do{ SBAR(); FINIT1(C0,t,0); bf16x8 qA_=QF(0),qB_=QF(1); SBAR(); \
    const lds_cptr vp_=vp0+sl_prev; \
    VRD(0); SBAR(); float sacc=(P0[0]+P0[1]); \
    GAPA(C0=__builtin_amdgcn_mfma_f32_32x32x16_bf16(kf[0],qA_,C0,0,0,0), P0[2],P0[3],P0[4],P0[5],     pw0[0]=PKW(P0,0), pw0[1]=PKW(P0,2), pw0); \
    FINIT1(C1,t,128); SBAR(); VRD(4); SBAR(); GAPA(C1=__builtin_amdgcn_mfma_f32_32x32x16_bf16(kf[1],qA_,C1,0,0,0), P0[6],P0[7],P0[8],P0[9],     pw0[2]=PKW(P0,4), pw0[3]=PKW(P0,6), pw0); \
    qA_=QF(2); VRD(1); SBAR(); GAPA(C0=__builtin_amdgcn_mfma_f32_32x32x16_bf16(kf[2],qB_,C0,0,0,0),   P0[10],P0[11],P0[12],P0[13], pw1[0]=PKW(P0,8), pw1[1]=PKW(P0,10), pw1); \
    VRD(5); SBAR(); GAPA(C1=__builtin_amdgcn_mfma_f32_32x32x16_bf16(kf[3],qB_,C1,0,0,0),   P0[14],P0[15],P1[0],P1[1],   pw1[2]=PKW(P0,12),pw1[3]=PKW(P0,14), pw1); \
    qB_=QF(3); VRD(2); SBAR(); GAPA(C0=__builtin_amdgcn_mfma_f32_32x32x16_bf16(kf[4],qA_,C0,0,0,0),   P1[2],P1[3],P1[4],P1[5],     pw2[0]=PKW(P1,0), pw2[1]=PKW(P1,2), pw2); \
    VRD(6); SBAR(); GAPA(C1=__builtin_amdgcn_mfma_f32_32x32x16_bf16(kf[5],qA_,C1,0,0,0),   P1[6],P1[7],P1[8],P1[9],     pw2[2]=PKW(P1,4), pw2[3]=PKW(P1,6), pw2); \
    VRD(3); SBAR(); GAPA(C0=__builtin_amdgcn_mfma_f32_32x32x16_bf16(kf[6],qB_,C0,0,0,0),   P1[10],P1[11],P1[12],P1[13], pw3[0]=PKW(P1,8), pw3[1]=PKW(P1,10), pw3); \
    VRD(7); SBAR(); GAPA(C1=__builtin_amdgcn_mfma_f32_32x32x16_bf16(kf[7],qB_,C1,0,0,0),   P1[14],P1[15],0.f,0.f,       pw3[2]=PKW(P1,12),pw3[3]=PKW(P1,14), pw3); \
    l_reg+=sacc; \
    if(GK){DMA_K((t)+3,sl_cur);} if(GV){DMA_V((t)+1,sl_next);} \
    CMASK(C0,C1,t); \
    { float a=MX3(C0[0],C0[1],C1[0]),b=MX3(C0[2],C0[3],C1[1]); a=MX3(a,C1[2],C1[3]); \
      _Pragma("unroll") for(int r=4;r<16;r+=4){a=MX3(a,C0[r],C0[r+1]);b=MX3(b,C0[r+2],C0[r+3]);a=MX3(a,C1[r],C1[r+1]);b=MX3(b,C1[r+2],C1[r+3]);} \
      float rm=__builtin_fmaxf(a,b); { auto rr=__builtin_amdgcn_permlane32_swap(__float_as_uint(rm),__float_as_uint(rm),false,false); rm=__builtin_fmaxf(__uint_as_float(rr[0]),__uint_as_float(rr[1])); } \
      resc=false; \
      if(__builtin_expect(__any(rm>(float)THRL),0)){ const float dl=__builtin_fmaxf(rm,0.f); mhat+=dl; \
        _Pragma("unroll") for(int r=0;r<16;++r){C0[r]-=dl;C1[r]-=dl;} \
        nm=-mhat; \
        const float f=__builtin_amdgcn_exp2f(-dl); l_reg*=f; if(hi==0)wsf[r32]=f; resc=true; } } \
    SBAR(); \
    GAPB(o[0]=__builtin_amdgcn_mfma_f32_32x32x16_bf16(PAF(0),VFR(0),o[0],0,0,0), C0,0); \
    GAPB(o[1]=__builtin_amdgcn_mfma_f32_32x32x16_bf16(PAF(0),VFR(4),o[1],0,0,0), C0,4); \
    KRD(GL,0); GAPB(o[0]=__builtin_amdgcn_mfma_f32_32x32x16_bf16(PAF(1),VFR(1),o[0],0,0,0), C0,8); \
    KRD(GL,1); GAPB(o[1]=__builtin_amdgcn_mfma_f32_32x32x16_bf16(PAF(1),VFR(5),o[1],0,0,0), C0,12); \
    KRD(GL,2); GAPB(o[0]=__builtin_amdgcn_mfma_f32_32x32x16_bf16(PAF(2),VFR(2),o[0],0,0,0), C1,0); \
    KRD(GL,3); GAPB(o[1]=__builtin_amdgcn_mfma_f32_32x32x16_bf16(PAF(2),VFR(6),o[1],0,0,0), C1,4); \
    GAPB(o[0]=__builtin_amdgcn_mfma_f32_32x32x16_bf16(PAF(3),VFR(3),o[0],0,0,0), C1,8); \
    GAPB(o[1]=__builtin_amdgcn_mfma_f32_32x32x16_bf16(PAF(3),VFR(7),o[1],0,0,0), C1,12); \
    }while(0)
  int t=1;
  #undef CMASK
  #define CMASK(P0,P1,t) do{}while(0)
  for(;t+5<NT;t+=2){
    STEP(pB0,pB1,pA0,pA1,t,true,true,true);     WAIT_BAR(2); RESC(); ROT();
    STEP(pA0,pA1,pB0,pB1,t+1,true,true,true);   WAIT_BAR(2); RESC(); ROT();
  }
  #undef CMASK
  #define CMASK(P0,P1,t) do{int jb_=(t)-(NT-4); if(jb_>=0)cmask(P0,P1,jb_,qrel,hi);}while(0)
  #define ENDW(tt) do{ if((tt)+3<NT){WAIT_BAR(2);} else if((tt)+2<NT){WAIT_BAR(1);} else {WAIT_BAR(0);} }while(0)
  for(;t+1<NT;t+=2){
    STEP(pB0,pB1,pA0,pA1,t,(t+3<NT),(t+1<NT),(t+1<NT));       ENDW(t);   RESC(); ROT();
    STEP(pA0,pA1,pB0,pB1,t+1,(t+4<NT),(t+2<NT),(t+2<NT));     ENDW(t+1); RESC(); ROT();
  }
  STEP(pB0,pB1,pA0,pA1,NT-1,false,false,false); RESC();
  { float sacc=pB0[0]+pB0[1]; _Pragma("unroll") for(int r=2;r<16;++r)sacc+=pB0[r]; _Pragma("unroll") for(int r=0;r<16;++r)sacc+=pB1[r]; l_reg+=sacc;
    pw0=(u32x4){PKW(pB0,0),PKW(pB0,2),PKW(pB0,4),PKW(pB0,6)};pw1=(u32x4){PKW(pB0,8),PKW(pB0,10),PKW(pB0,12),PKW(pB0,14)};pw2=(u32x4){PKW(pB1,0),PKW(pB1,2),PKW(pB1,4),PKW(pB1,6)};pw3=(u32x4){PKW(pB1,8),PKW(pB1,10),PKW(pB1,12),PKW(pB1,14)};
    SBAR(); pv(o,vb0+sl_cur,PAF(0),PAF(1),PAF(2),PAF(3)); }
  #undef PKW
  #undef PAF
  #undef VFR
  #undef PIN
  #undef MX3
  #undef GAPA
  #undef GAPB
  #undef EX
  #undef VRD
  #undef KRD
  #undef STEP
  #undef ENDW
  {auto rr=__builtin_amdgcn_permlane32_swap(__float_as_uint(l_reg),__float_as_uint(l_reg),false,false);l_reg=__uint_as_float(rr[0])+__uint_as_float(rr[1]);}
  if(hi==0)wsf[32+r32]=l_reg;asm volatile("s_waitcnt lgkmcnt(0)":::"memory");
  float rli[16];
  #pragma unroll
  for(int r=0;r<16;++r)rli[r]=__builtin_amdgcn_rcpf(wsf[32+crow(r,hi)]);
  bf16*Ow=O+(rowbase+q0+wid*QBLK)*DMO+h*D;
  { bf16*stg=(bf16*)(shm+LDS_OST)+wid*2048;
    #pragma unroll
    for(int r=0;r<16;++r){const int orow=crow(r,hi);
      #pragma unroll
      for(int d0=0;d0<2;++d0)stg[orow*64+d0*32+r32]=__float2bfloat16(o[d0][r]*rli[r]);}
    asm volatile("s_waitcnt lgkmcnt(0)":::"memory");
    #pragma unroll
    for(int i=0;i<4;++i){const int row=i*8+(lane>>3),ch=lane&7; const u32x4 v=*(const u32x4*)(stg+row*64+ch*8); ATTN_STORE16(Ow+(long)row*DMO+ch*8,v);} }
  asm volatile("s_waitcnt lgkmcnt(0)\n\ts_barrier":::"memory");
  #undef DMA_K
  #undef DMA_V
  #undef CMASK
  #undef START
  #undef RESC
  #undef FINIT
  #undef QF
  #undef FINIT1
  #undef ROT
}
constexpr int ATTN_LDS_BYTES=LDS_BYTES;
struct AttnTensors { const bf16* Q; const bf16* K; const bf16* V; bf16* O; const float* F; };
#undef SBAR
#undef WAIT_BAR
}

constexpr int NWAVES = 8;
constexpr int BATCH = 8, SEQ = 4096, D = 1024, T = BATCH * SEQ, NL = 4;
constexpr int BW = 512, INTOT = 7184, NIN = 7168;
constexpr int MH = 4, MDH = 128, AH = 8, ADH = 64, S5G = 32, S5C = 16, S5P = 64, S5L = 32  , S5K = 640;
constexpr int NEXP = 32, EH = 512, MOE_ROWS = 73728  , MOE_NBLK_MAX = 288;
constexpr float LN_EPS = 1e-5f;
constexpr float ALPHA = 1.6817928305074290f;
constexpr float C2 = 0.125f * 1.4426950408889634f;
constexpr float LOG2E = 1.4426950408889634f;
constexpr int NPH_LAYER = 13, NPHASES = 1 + NL * NPH_LAYER;

constexpr size_t MiB = 1u << 20;
constexpr size_t WS_CTL = 0, CTL_ZERO_BYTES = 65536;
constexpr size_t WS_S5TAB = 2 * MiB;
constexpr size_t WS_MSC = 2 * MiB + 65536;
constexpr size_t WS_WSM = 2 * MiB + 131072;
constexpr size_t WS_NST = 3 * MiB;
constexpr size_t WS_WIN = 4 * MiB, WS_WGLU = 18 * MiB, WS_WBR = 19 * MiB, WS_WOUT = 22 * MiB, WS_WGU = 24 * MiB, WS_WDN = 88 * MiB;
constexpr size_t WS_XB = 148 * MiB;
constexpr size_t WS_MQK = 212 * MiB, WS_QK = 276 * MiB, WS_MV = 340 * MiB, WS_MO = 372 * MiB, WS_S5A = 404 * MiB, WS_AQKV = 444 * MiB, WS_GATE = 540 * MiB;
constexpr size_t WS_YS1 = WS_MQK, WS_MIXED = WS_QK;
constexpr size_t WS_XG = 212 * MiB, WS_HB = 356 * MiB, WS_YB = 428 * MiB;
constexpr size_t WS_YTALL = 732 * MiB, WS_CST = 828 * MiB, WS_EBUF = 892 * MiB, WS_SG = 908 * MiB, WS_FTAB = 910 * MiB, WS_MLU = 911 * MiB, WS_STAT = 912 * MiB + 524288  , WS_ROUTE = 913 * MiB, WS_TOKPOS = 914 * MiB, WS_S5ALL = 916 * MiB  , S5_LAYER_BYTES = 28 * MiB, WS_END = 1028 * MiB;
static_assert(WS_XG + (size_t)MOE_ROWS * 1024 * 2 <= WS_HB && WS_HB + (size_t)MOE_ROWS * 512 * 2 <= WS_YB && WS_YB + (size_t)2 * T * 1024 * 2 <= WS_YTALL, "moe overlay");
static_assert(WS_S5A + (size_t)32 * 1024 * 640 * 2 <= WS_AQKV && WS_GATE + (size_t)T * 3072 * 2 <= WS_YTALL, "region A");
constexpr int CW_TMO = 0, CW_CODE = 1, CW_BAR = 4096, CW_GCNT = 8192, CW_AQ = 8704;

constexpr int RING_OFF = 0, RING_BYTES = 131072;
constexpr int LDS_BYTES = 163840;
constexpr int LDSX_OFF = RING_BYTES;
constexpr int LDSCTL_OFF = 162816, MISC_OFF = LDSCTL_OFF + 320;

#define GAS __attribute__((address_space(1)))
#define LAS __attribute__((address_space(3)))
typedef unsigned short bf16;
typedef unsigned v4u __attribute__((ext_vector_type(4)));
typedef unsigned v2u __attribute__((ext_vector_type(2)));
typedef float f32x4 __attribute__((ext_vector_type(4)));
typedef float f32x16 __attribute__((ext_vector_type(16)));
typedef short bf16x8 __attribute__((ext_vector_type(8)));
typedef GAS unsigned gu32;
#define RLX_AGENT __ATOMIC_RELAXED, __HIP_MEMORY_SCOPE_AGENT
#define LDS_WAIT() asm volatile("s_waitcnt lgkmcnt(0)" ::: "memory")
#define LDS_BARRIER() asm volatile("s_waitcnt lgkmcnt(0)\n\ts_barrier" ::: "memory")
#define VM_WAIT() asm volatile("s_waitcnt vmcnt(0)" ::: "memory")
__device__ __forceinline__ unsigned f2bf(float f) { unsigned u = __builtin_bit_cast(unsigned, f); return (u + 0x7fffu + ((u >> 16) & 1u)) >> 16; }
typedef float f32x2_t_ __attribute__((ext_vector_type(2))); typedef __bf16 bf16x2_t_ __attribute__((ext_vector_type(2)));
__device__ __forceinline__ unsigned pk2(float lo, float hi) { const f32x2_t_ v = {lo, hi}; return __builtin_bit_cast(unsigned, __builtin_convertvector(v, bf16x2_t_)); }
__device__ __forceinline__ float bflo(unsigned u) { return __uint_as_float(u << 16); }
__device__ __forceinline__ float bfhi(unsigned u) { return __uint_as_float(u & 0xffff0000u); }
__device__ __forceinline__ float bf2f(bf16 v) { return __uint_as_float((unsigned)v << 16); }
__device__ __forceinline__ float sigmoidf_(float x) { return 1.f / (1.f + __expf(-x)); }

__device__ __forceinline__ int lane_id() { int l; asm volatile("v_mbcnt_lo_u32_b32 %0, -1, 0\n\tv_mbcnt_hi_u32_b32 %0, -1, %0" : "=v"(l)); return l; }
#define XB_TMO      128
#define XB_XCNT(j)  (256  + 64 * (j))
#define XB_XSUB(j)  (1280 + 64 * (j))
#define XB_XGEN(j)  (2304 + 64 * (j))
#define XB_TOP      3328
#define XB_TOPGEN   3392
#define XCD_BAR_WORDS 3456
#define XB_SPIN_CAP (1u << 18)
__device__ __forceinline__ unsigned xb_ld(unsigned* p)              { return __hip_atomic_load(p, __ATOMIC_RELAXED, __HIP_MEMORY_SCOPE_AGENT); }
__device__ __forceinline__ unsigned xb_add(unsigned* p, unsigned v) { return __hip_atomic_fetch_add(p, v, __ATOMIC_RELAXED, __HIP_MEMORY_SCOPE_AGENT); }
__device__ __forceinline__ unsigned xb_xcc_id() { return (unsigned)__builtin_amdgcn_s_getreg((3 << 11) | 20) & 0xFu; }
#define XB_SPIN(cond, bar) do { unsigned _sp = 0; while (cond) { __builtin_amdgcn_s_sleep(1); \
    if ((++_sp & 255u) == 0u) { if (xb_ld(&(bar)[XB_TMO])) break; if (_sp > XB_SPIN_CAP) { atomicAdd(&(bar)[XB_TMO], 1u); break; } } } } while (0)
struct XcdBarrier { unsigned* bar; unsigned x; volatile LAS unsigned* st; };
__device__ __forceinline__ XcdBarrier xcd_barrier_post(unsigned* bar, volatile LAS unsigned* st, bool leader) {
    XcdBarrier b; b.bar = bar; b.x = xb_xcc_id(); b.st = st;
    if (leader) (void)xb_add(&bar[XB_XCNT(b.x)], 1u);
    return b;
}
__device__ __forceinline__ void xcd_barrier_complete(unsigned* bar, unsigned x, unsigned& nloc, unsigned& nx) {
    const unsigned G = gridDim.x * gridDim.y * gridDim.z;
    unsigned sum, cnt, mine, sp = 0u;
    for (;;) {
        sum = 0u; cnt = 0u; mine = 0u;
#pragma unroll
        for (unsigned j = 0; j < 16; ++j) { const unsigned c = xb_ld(&bar[XB_XCNT(j)]); sum += c; cnt += (c > 0u) ? 1u : 0u; mine = (j == x) ? c : mine; }
        if (sum == G) break;
        __builtin_amdgcn_s_sleep(1);
        if ((++sp & 255u) == 0u) { if (xb_ld(&bar[XB_TMO])) break; if (sp > XB_SPIN_CAP) { atomicAdd(&bar[XB_TMO], 1u); break; } }
    }
    nloc = mine > 0u ? mine : 1u; nx = cnt > 0u ? cnt : 1u;
}
__device__ __forceinline__ void xcd_barrier(const XcdBarrier& b, bool leader) {
    asm volatile("s_waitcnt vmcnt(0)" ::: "memory");
    __syncthreads();
    if (leader) {
        unsigned* bar = b.bar;
        __builtin_amdgcn_s_waitcnt(0);
        unsigned nloc = b.st[0], nx = b.st[1];
        if (nloc == 0u) { xcd_barrier_complete(bar, b.x, nloc, nx); b.st[0] = nloc; b.st[1] = nx; }
        const unsigned old = xb_add(&bar[XB_XSUB(b.x)], 1u);
        const unsigned gen = old / nloc;
        if (old + 1u == (gen + 1u) * nloc) {
            __builtin_amdgcn_fence(__ATOMIC_RELEASE, "agent");
            asm volatile("s_waitcnt vmcnt(0)" ::: "memory");
            const unsigned og = xb_add(&bar[XB_TOP], 1u);
            const unsigned tg = og / nx;
            if (og + 1u == (tg + 1u) * nx) xb_add(&bar[XB_TOPGEN], 1u);
            else XB_SPIN(xb_ld(&bar[XB_TOPGEN]) == tg, bar);
            __builtin_amdgcn_fence(__ATOMIC_ACQUIRE, "agent");
            xb_add(&bar[XB_XGEN(b.x)], 1u);
            asm volatile("s_waitcnt vmcnt(0)" ::: "memory");
        } else {
            XB_SPIN(xb_ld(&bar[XB_XGEN(b.x)]) == gen, bar);
            __builtin_amdgcn_fence(__ATOMIC_ACQUIRE, "agent");
            asm volatile("s_waitcnt vmcnt(0)" ::: "memory");
        }
    }
    __syncthreads();
}

enum InIdx { I_x, I_w_in, I_b_in, I_m_conv_w, I_m_conv_b, I_m_norm_w, I_s5_lam_re, I_s5_lam_im, I_s5_log_dt, I_s5_b_re, I_s5_b_im, I_s5_c_re, I_s5_c_im, I_s5_d, I_s5_w_glu, I_s5_b_glu, I_w_branch, I_w_out, I_ln1_g, I_ln1_b, I_w_rg, I_b_rg, I_w_re, I_b_re, I_moe_wg, I_moe_wu, I_moe_wd, I_ln2_g, I_ln2_b };
struct Args { const float* in[29]; float* out; unsigned char* ws; int ph_lo, ph_hi, sub, pad; };
typedef const __attribute__((address_space(4))) Args* KArgs;
struct Frame {
    LAS unsigned char* lds; unsigned char* ldsg;
    gu32* ctl;
    unsigned char* ws;
    int tid, lane, wave, vcu, G, bx, dup;
    float* out;
    KArgs ka;
};
template <int O> __device__ __forceinline__ float shx(float v) { static_assert(O >= 1 && O < 32, "xor mask inside a 32-lane half"); return __int_as_float(__builtin_amdgcn_ds_swizzle(__float_as_int(v), (O << 10) | 0x1f)); }
__device__ __forceinline__ float half_swap_add(float v) { auto rr = __builtin_amdgcn_permlane32_swap(__float_as_uint(v), __float_as_uint(v), false, false); return __uint_as_float(rr[0]) + __uint_as_float(rr[1]); }
__device__ __forceinline__ float half_swap_max(float v) { auto rr = __builtin_amdgcn_permlane32_swap(__float_as_uint(v), __float_as_uint(v), false, false); return fmaxf(__uint_as_float(rr[0]), __uint_as_float(rr[1])); }
__device__ __forceinline__ float wave_sum(float v) { v += shx<1>(v); v += shx<2>(v); v += shx<4>(v); v += shx<8>(v); v += shx<16>(v); return half_swap_add(v); }
__device__ __forceinline__ float wave_max(float v) { v = fmaxf(v, shx<1>(v)); v = fmaxf(v, shx<2>(v)); v = fmaxf(v, shx<4>(v)); v = fmaxf(v, shx<8>(v)); v = fmaxf(v, shx<16>(v)); return half_swap_max(v); }
#define JR_STEP(p, NH, M, bit) _Pragma("unroll") for (int i_ = 0; i_ < (NH); ++i_) { const float send_ = (bit) ? p[i_] : p[i_ + (NH)]; const float keep_ = (bit) ? p[i_ + (NH)] : p[i_]; p[i_] = keep_ + shx<M>(send_); }
__device__ __forceinline__ float rdlane(float v, int l) { return __int_as_float(__builtin_amdgcn_readlane(__float_as_int(v), l)); }
__device__ __forceinline__ float lane_get(float v, int srclane) { return __int_as_float(__builtin_amdgcn_ds_bpermute(srclane << 2, __float_as_int(v))); }
__device__ __forceinline__ float log_sigmoid(float x) { return fminf(x, 0.f) - log1pf(expf(-fabsf(x))); }

__device__ __forceinline__ void transpose_item(const float* Wsrc, int ldw, bf16* WTdst, int ldt, LAS float* scr, int lane) {
    float tv[32];
#pragma unroll
    for (int i = 0; i < 32; ++i) tv[i] = __builtin_nontemporal_load(Wsrc + (size_t)(2 * i + (lane >> 5)) * ldw + (lane & 31));
#pragma unroll
    for (int i = 0; i < 32; ++i) scr[(2 * i + (lane >> 5)) * 33 + (lane & 31)] = tv[i];
    LDS_WAIT(); asm volatile("" ::: "memory");
    const int c = lane & 7;
#pragma unroll
    for (int j = 0; j < 4; ++j) { const int n = (lane >> 3) + 8 * j; const LAS float* s = scr + (8 * c) * 33 + n;
        v4u o; o.x = pk2(s[0 * 33], s[1 * 33]); o.y = pk2(s[2 * 33], s[3 * 33]); o.z = pk2(s[4 * 33], s[5 * 33]); o.w = pk2(s[6 * 33], s[7 * 33]);
        *(GAS v4u*)(WTdst + (size_t)n * ldt + 8 * c) = o; }
    LDS_WAIT(); asm volatile("" ::: "memory");
}
__device__ __forceinline__ int in_srccol(int c) { return c + (c >= 4096 ? 16 : (c >= 2048 ? 8 : 0)); }

__device__ __forceinline__ void sincos_d(double ang, float& s, float& c) {
    double inv2pi = 0.15915494309189535, twopi = 6.283185307179586476925; asm volatile("" : "+v"(inv2pi), "+v"(twopi));
    const double k = rint(ang * inv2pi); const float r = (float)(ang - k * twopi);
    const float q = rintf(r * 0.6366197723675814f); float y = fmaf(q, -1.57079637050628662109375f, r); y = fmaf(q, 4.371139000186241e-8f, y); const float y2 = y * y;
    float sp = 2.7557319e-6f; sp = sp * y2 - 1.9841270e-4f; sp = sp * y2 + 8.3333333e-3f; sp = sp * y2 - 1.6666667e-1f; sp = y + y * y2 * sp;
    float cp = -2.7557319e-7f; cp = cp * y2 + 2.4801587e-5f; cp = cp * y2 - 1.3888889e-3f; cp = cp * y2 + 4.1666667e-2f; cp = cp * y2 - 0.5f; cp = 1.f + y2 * cp;
    const int qi = ((int)q) & 3; s = (qi == 0) ? sp : (qi == 1) ? cp : (qi == 2) ? -sp : -cp; c = (qi == 0) ? cp : (qi == 1) ? -sp : (qi == 2) ? -cp : sp;
}
__device__ __forceinline__ void s5_build_group(Frame& F, int l, int g) {
    LAS float* AP = (LAS float*)(F.lds);
    LAS float* BB = AP + 33 * 64 * 2;
    LAS float* CC = BB + 64 * 16 * 2;
    LAS float* KT = CC + 16 * 64 * 2;
    LAS float* DD = KT + 32 * 256;
    const int tid = F.tid;
    const float* lre = F.ka->in[I_s5_lam_re] + ((size_t)l * S5G + g) * S5P; const float* lim = F.ka->in[I_s5_lam_im] + ((size_t)l * S5G + g) * S5P;
    const double dt = (double)expf(F.ka->in[I_s5_log_dt][l * S5G + g]);
    for (int i = tid; i < 33 * 64; i += 512) { const int tau = i >> 6, p = i & 63; const double lr = lre[p], li = lim[p];
        const float mag = expf((float)(lr * dt * tau)); float sn, cs; sincos_d(li * dt * tau, sn, cs); AP[i * 2] = mag * cs; AP[i * 2 + 1] = mag * sn; }
    for (int i = tid; i < 64 * 16; i += 512) { const int p = i >> 4, ci = i & 15; const double lr = lre[p], li = lim[p];
        float sn, cs; sincos_d(li * dt, sn, cs); const double mag = (double)expf((float)(lr * dt)), ar = mag * cs, ai = mag * sn, den = lr * lr + li * li, nr = ar - 1.0, ni = ai;
        const double zr = (nr * lr + ni * li) / den, zi = (ni * lr - nr * li) / den;
        const size_t bi = (((size_t)l * S5G + g) * S5P + p) * S5C + ci; const double br = F.ka->in[I_s5_b_re][bi], bim = F.ka->in[I_s5_b_im][bi];
        BB[i * 2] = (float)(zr * br - zi * bim); BB[i * 2 + 1] = (float)(zr * bim + zi * br); }
    for (int i = tid; i < 16 * 64; i += 512) { const size_t ci_ = ((size_t)l * S5G + g) * S5C * S5P + i; CC[i * 2] = F.ka->in[I_s5_c_re][ci_]; CC[i * 2 + 1] = F.ka->in[I_s5_c_im][ci_]; }
    if (tid < 16) DD[tid] = F.ka->in[I_s5_d][(l * S5G + g) * S5C + tid];
    __syncthreads();
    for (int i = tid; i < 32 * 256; i += 512) { const int tau = i >> 8, co = (i >> 4) & 15, ci = i & 15; float s = 0.f;
        for (int p = 0; p < 64; ++p) { const float cr = CC[(co * 64 + p) * 2], cim = CC[(co * 64 + p) * 2 + 1], ar = AP[(tau * 64 + p) * 2], ai = AP[(tau * 64 + p) * 2 + 1];
            const float xr = cr * ar - cim * ai, xi = cr * ai + cim * ar; s += xr * BB[(p * 16 + ci) * 2] - xi * BB[(p * 16 + ci) * 2 + 1]; }
        KT[i] = s; }
    if (tid < 64) { float* tab = (float*)(F.ws + WS_S5TAB) + ((l * 32 + g) * 64 + tid) * 2; tab[0] = AP[(32 * 64 + tid) * 2]; tab[1] = AP[(32 * 64 + tid) * 2 + 1]; }
    __syncthreads();
    bf16* MP = (bf16*)(F.ws + WS_S5ALL + (size_t)l * S5_LAYER_BYTES) + (size_t)g * 512 * S5K;
    for (int i = tid; i < 512 * (S5K / 8); i += 512) { const int n = i / (S5K / 8), k0 = (i % (S5K / 8)) * 8, tq = n >> 4, co = n & 15; float v[8];
#pragma unroll
        for (int j = 0; j < 8; ++j) { const int k = k0 + j; float x;
            if (k < 512) { const int sq = k >> 4, ci = k & 15; x = (tq >= sq) ? KT[((tq - sq) * 16 + co) * 16 + ci] : 0.f; if (tq == sq && co == ci) x += DD[co]; }
            else { const int p = (k - 512) & 63; const float cr = CC[(co * 64 + p) * 2], cim = CC[(co * 64 + p) * 2 + 1], ar = AP[((tq + 1) * 64 + p) * 2], ai = AP[((tq + 1) * 64 + p) * 2 + 1];
                x = (k < 576) ? (cr * ar - cim * ai) : -(cr * ai + cim * ar); }
            v[j] = x; }
        v4u o; o.x = pk2(v[0], v[1]); o.y = pk2(v[2], v[3]); o.z = pk2(v[4], v[5]); o.w = pk2(v[6], v[7]);
        *(GAS v4u*)(MP + (size_t)n * S5K + k0) = o; }
    bf16* GG = (bf16*)(F.ws + WS_S5ALL + (size_t)l * S5_LAYER_BYTES + 20 * MiB) + (size_t)g * 256 * 512;
    for (int i = tid; i < 256 * 64; i += 512) { const int n = i >> 6, k0 = (i & 63) * 8; float v[8];
#pragma unroll
        for (int j = 0; j < 8; ++j) { const int k = k0 + j, sq = k >> 4, ci = k & 15; float x = 0.f;
            if (n < 128) { const int p = n & 63; const float ar = AP[((31 - sq) * 64 + p) * 2], ai = AP[((31 - sq) * 64 + p) * 2 + 1], br = BB[(p * 16 + ci) * 2], bim = BB[(p * 16 + ci) * 2 + 1];
                x = (n < 64) ? (ar * br - ai * bim) : (ar * bim + ai * br); }
            v[j] = x; }
        v4u o; o.x = pk2(v[0], v[1]); o.y = pk2(v[2], v[3]); o.z = pk2(v[4], v[5]); o.w = pk2(v[6], v[7]);
        *(GAS v4u*)(GG + (size_t)n * 512 + k0) = o; }
    __syncthreads();
}

__device__ __forceinline__ void small_w_prep(Frame& F, int l);
__device__ __forceinline__ void weight_prep(Frame& F, int l) {
    if (F.vcu == F.G - 1) small_w_prep(F, l);
    LAS float* scr = (LAS float*)(F.lds + RING_OFF + F.wave * 16384);
    const int gw = F.vcu * NWAVES + F.wave, NGW = F.G * NWAVES;
    constexpr int I_IN = (NIN / 32) * 16, I_GLU = 16 * 8, I_BR = 3 * 32 * 8, I_OUT = 32 * 16, I_G = NEXP * 16 * 16, I_D = NEXP * 32 * 8;
    constexpr int NITEMS = I_IN + I_GLU + I_BR + I_OUT + 2 * I_G + I_D;
    for (int it = gw; it < NITEMS; it += NGW) {
        int r = it;
        if (r < I_IN) { const int nb = r >> 4, kb = r & 15; transpose_item(F.ka->in[I_w_in] + (size_t)l * D * INTOT + (size_t)(64 * kb) * INTOT + in_srccol(32 * nb), INTOT, (bf16*)(F.ws + WS_WIN) + (size_t)(32 * nb) * 1024 + 64 * kb, 1024, scr, F.lane); continue; } r -= I_IN;
        if (r < I_GLU) { const int nb = r >> 3, kb = r & 7; transpose_item(F.ka->in[I_s5_w_glu] + (size_t)l * 512 * 512 + (size_t)(64 * kb) * 512 + 32 * nb, 512, (bf16*)(F.ws + WS_WGLU) + (size_t)(32 * nb) * 512 + 64 * kb, 512, scr, F.lane); continue; } r -= I_GLU;
        if (r < I_BR) { const int br = r >> 8, nb = (r >> 3) & 31, kb = r & 7; transpose_item(F.ka->in[I_w_branch] + ((size_t)l * 3 + br) * 512 * 1024 + (size_t)(64 * kb) * 1024 + 32 * nb, 1024, (bf16*)(F.ws + WS_WBR) + (size_t)(br * 1024 + 32 * nb) * 512 + 64 * kb, 512, scr, F.lane); continue; } r -= I_BR;
        if (r < I_OUT) { const int nb = r >> 4, kb = r & 15; transpose_item(F.ka->in[I_w_out] + (size_t)l * 1024 * 1024 + (size_t)(64 * kb) * 1024 + 32 * nb, 1024, (bf16*)(F.ws + WS_WOUT) + (size_t)(32 * nb) * 1024 + 64 * kb, 1024, scr, F.lane); continue; } r -= I_OUT;
        if (r < 2 * I_G) { const int up = r >= I_G; if (up) r -= I_G; const int e = r >> 8, nb = (r >> 4) & 15, kb = r & 15;
            const float* src = (up ? F.ka->in[I_moe_wu] : F.ka->in[I_moe_wg]) + ((size_t)l * NEXP + e) * 1024 * 512 + (size_t)(64 * kb) * 512 + 32 * nb; const int n0 = 32 * nb;
            transpose_item(src, 512, (bf16*)(F.ws + WS_WGU) + (size_t)(e * 1024 + (n0 >> 7) * 256 + up * 128 + (n0 & 127)) * 1024 + 64 * kb, 1024, scr, F.lane); continue; } r -= 2 * I_G;
        { const int e = r >> 8, nb = (r >> 3) & 31, kb = r & 7;
            transpose_item(F.ka->in[I_moe_wd] + ((size_t)l * NEXP + e) * 512 * 1024 + (size_t)(64 * kb) * 1024 + 32 * nb, 1024, (bf16*)(F.ws + WS_WDN) + (size_t)(e * 1024 + 32 * nb) * 512 + 64 * kb, 512, scr, F.lane); }
    }
}

__device__ __forceinline__ void small_gates_mfma(Frame& F, int l) {
    const int gw = F.vcu * NWAVES + F.wave, lane = F.lane, r = lane & 15, kg = lane >> 4;
    if (gw * 16 >= T) return;
    const bf16* __restrict__ A = (const bf16*)(F.ws + WS_XB) + (size_t)(gw * 16 + r) * D + 8 * kg; const bf16* __restrict__ B = (const bf16*)(F.ws + WS_WSM) + (size_t)r * D + 8 * kg;
    f32x4 acc = {0.f, 0.f, 0.f, 0.f};
#pragma unroll 8
    for (int ks = 0; ks < 32; ++ks) { const bf16x8 a = *(const GAS bf16x8*)(A + 32 * ks), b = *(const GAS bf16x8*)(B + 32 * ks); acc = __builtin_amdgcn_mfma_f32_16x16x32_bf16(a, b, acc, 0, 0, 0); }
    const float bias = F.ka->in[I_b_in][(size_t)l * INTOT + (r < 8 ? 2048 + r : 4104 + (r - 8))];
    float* sg = (float*)(F.ws + WS_SG) + (size_t)(gw * 16 + 4 * kg) * 16 + r;
#pragma unroll
    for (int i = 0; i < 4; ++i) sg[i * 16] = acc[i] + bias;
}
__device__ __forceinline__ void small_w_prep(Frame& F, int l) {
    const float* w = F.ka->in[I_w_in] + (size_t)l * D * INTOT; bf16* o = (bf16*)(F.ws + WS_WSM);
    for (int i = F.tid; i < 1024 * 16; i += 512) { const int k = i >> 4, j = i & 15; o[j * 1024 + k] = (bf16)f2bf(w[(size_t)k * INTOT + (j < 8 ? 2048 + j : 4104 + (j - 8))]); }
}

__device__ __forceinline__ void phase_p0(Frame& F) {
    const bool s5cu = F.vcu < NL * S5G;
    if (s5cu) s5_build_group(F, F.vcu >> 5, F.vcu & 31);
    weight_prep(F, 0);
    const int widx = (s5cu ? F.vcu : F.vcu - NL * S5G) * NWAVES + F.wave, nrow = s5cu ? 8 : 24, row0 = s5cu ? widx * 8 : 8192 + widx * 24;
    f32x4 nv[4];
    { const GAS f32x4* x0 = (const GAS f32x4*)(F.ka->in[I_x] + (size_t)row0 * D) + F.lane;
#pragma unroll
      for (int j = 0; j < 4; ++j) nv[j] = x0[64 * j]; }
    for (int i = 0; i < nrow; ++i) { const int m = row0 + i;
        f32x4 v[4];
#pragma unroll
        for (int j = 0; j < 4; ++j) v[j] = nv[j];
        { const GAS f32x4* xn = (const GAS f32x4*)(F.ka->in[I_x] + (size_t)((i + 1 < nrow) ? m + 1 : m) * D) + F.lane;
#pragma unroll
            for (int j = 0; j < 4; ++j) nv[j] = xn[64 * j]; }
        GAS v2u* o8 = (GAS v2u*)((bf16*)(F.ws + WS_XB) + (size_t)m * D) + F.lane;
#pragma unroll
        for (int j = 0; j < 4; ++j) { v2u o; o.x = pk2(v[j].x, v[j].y); o.y = pk2(v[j].z, v[j].w); o8[64 * j] = o; }
    }
    __syncthreads();
}

struct EpiInProj {
    static constexpr bool PERM = true;
    unsigned char* ws; const float* bias;
    __device__ __forceinline__ bool reset_after(const pg8::Unit&) const { return true; }
    __device__ __forceinline__ void operator()(pg8::f32x4 (&acc)[2][2][4][2], const pg8::Unit& u, int wr, int wc, int fr, int fq) const {
        using namespace pg8;
        const int pn = u.pn, row0 = u.pm * BM + wr * 64 + fr;
        int mode, pitch, cofs; size_t base;
        if (pn < 4) { mode = 0; base = WS_MQK; pitch = 1024; cofs = 0; }
        else if (pn < 6) { mode = 0; base = WS_MV; pitch = 512; cofs = 1024; }
        else if (pn < 8) { mode = 1; base = WS_MO; pitch = 512; cofs = 1536; }
        else if (pn < 10) { mode = 3; base = WS_S5A; pitch = 0; cofs = 2048; }
        else if (pn < 16) { mode = (pn < 12) ? 2 : 0; base = WS_AQKV; pitch = 1536; cofs = 2560; }
        else { mode = 4; base = WS_GATE; pitch = 3072; cofs = 4096; }
        bf16_t* O = (bf16_t*)(ws + base);
#pragma unroll
        for (int bj = 0; bj < 2; ++bj) {
            const int col0 = pn * BM + bj * HALF + wc * 32 + 8 * fq;
            const int sc = in_srccol(col0);
            const f32x4 b0 = *(const f32x4*)(bias + sc), b1 = *(const f32x4*)(bias + sc + 4);
            const int cl = col0 - cofs;
#pragma unroll
            for (int ai = 0; ai < 2; ++ai)
#pragma unroll
                for (int m = 0; m < 4; ++m) {
                    const int row = row0 + ai * HALF + m * 16;
                    f32x4 v0 = acc[ai][bj][m][0] + b0, v1 = acc[ai][bj][m][1] + b1;
                    if (mode == 1) {
#pragma unroll
                        for (int i = 0; i < 4; ++i) { v0[i] = 1.f / (1.f + __expf(-v0[i])); v1[i] = 1.f / (1.f + __expf(-v1[i])); }
                    } else if (mode == 2) { v0 = v0 * C2; v1 = v1 * C2; }
                    else if (mode == 4) {
#pragma unroll
                        for (int i = 0; i < 4; ++i) { v0[i] = __expf(fminf(fmaxf(-v0[i], -30.f), 30.f)); v1[i] = __expf(fminf(fmaxf(-v1[i], -30.f), 30.f)); }
                    }
                    u32x4 w; w.x = cvt_pk_bf16(v0[0], v0[1]); w.y = cvt_pk_bf16(v0[2], v0[3]); w.z = cvt_pk_bf16(v1[0], v1[1]); w.w = cvt_pk_bf16(v1[2], v1[3]);
                    size_t off;
                    if (mode == 3) { const int g = cl >> 4; off = ((size_t)(g * 1024 + (row >> 5)) * S5K) + (row & 31) * 16 + (cl & 15); }
                    else off = (size_t)row * pitch + cl;
                    *(u32x4*)(O + off) = w;
                }
        }
    }
};

__device__ __forceinline__ float wave_incl_scan_add(float v, int lane) {
#pragma unroll
    for (int o = 1; o < 64; o <<= 1) { const float t = lane_get(v, (lane - o) & 63); if (lane >= o) v += t; }
    return v;
}
__device__ __forceinline__ float wave_incl_scan_max(float v, int lane) {
#pragma unroll
    for (int o = 1; o < 64; o <<= 1) { const float t = lane_get(v, (lane - o) & 63); if (lane >= o) v = fmaxf(v, t); }
    return v;
}
__device__ __forceinline__ float lane63(float v) { return __int_as_float(__builtin_amdgcn_readlane(__float_as_int(v), 63)); }
__device__ __forceinline__ void phase_prep2(Frame& F, int l) {
    const int lane = F.lane;
    const float* __restrict__ SG = (const float*)(F.ws + WS_SG);
    LAS float* XS = (LAS float*)(F.lds);
    if (F.vcu < 64) {
        const int sq = F.vcu, b = sq >> 3, h = sq & 7, w = F.wave; float* __restrict__ FT = (float*)(F.ws + WS_FTAB) + (size_t)sq * SEQ;
        float x[8], c8[8];
#pragma unroll
        for (int i = 0; i < 8; ++i) x[i] = SG[(size_t)(b * SEQ + w * 512 + i * 64 + lane) * 16 + 8 + h];
        float carry = 0.f;
#pragma unroll
        for (int i = 0; i < 8; ++i) { const float c = wave_incl_scan_add(log_sigmoid(x[i]), lane) + carry; c8[i] = c; carry = lane63(c); }
        if (lane == 0) XS[w] = carry;
        __syncthreads();
        float pre = 0.f;
        for (int j = 0; j < w; ++j) pre += XS[j];
#pragma unroll
        for (int i = 0; i < 8; ++i) FT[w * 512 + i * 64 + lane] = (c8[i] + pre) * LOG2E;
        __syncthreads();
    } else if (F.vcu < 96) {
        const int bh = F.vcu - 64, b = bh >> 2, h = bh & 3, w = F.wave;
        float* __restrict__ MU = (float*)(F.ws + WS_MLU) + (size_t)bh * SEQ; float* __restrict__ MM = MU + (size_t)32 * SEQ; float* __restrict__ MB = MM + (size_t)32 * SEQ;
        float* __restrict__ MSC = (float*)(F.ws + WS_MSC) + bh * 64;
        float xi[8], xf[8], pm8[8];
#pragma unroll
        for (int i = 0; i < 8; ++i) { const float* sg = SG + (size_t)(b * SEQ + (w * 8 + i) * 64 + lane) * 16; xi[i] = sg[h]; xf[i] = sg[4 + h]; }
#pragma unroll
        for (int i = 0; i < 8; ++i) { const int c = w * 8 + i, s = c * 64 + lane;
            const float bc = wave_incl_scan_add(log_sigmoid(xf[i]), lane), u = xi[i] - bc, pm = wave_incl_scan_max(u, lane);
            MU[s] = u; MB[s] = bc; pm8[i] = pm;
            if (lane == 63) { XS[c] = pm; XS[64 + c] = bc; } }
        __syncthreads();
        float mprev = 0.f;
        for (int c = 0; c < w * 8; ++c) mprev = XS[64 + c] + fmaxf(mprev, XS[c]);
#pragma unroll
        for (int i = 0; i < 8; ++i) { const int c = w * 8 + i, s = c * 64 + lane; const float mloc = XS[c], blast = XS[64 + c];
            MM[s] = fmaxf(pm8[i], mprev);
            const float Mc = fmaxf(mprev, mloc);
            if (lane == 0) { MSC[c] = mprev; MSC[2048 + c] = mloc; MSC[4096 + c] = expf(mprev - Mc); MSC[6144 + c] = expf(mloc - Mc); }
            mprev = blast + Mc; }
        __syncthreads();
    }
    const bf16* __restrict__ RAW = (const bf16*)(F.ws + WS_MQK); bf16* __restrict__ QK = (bf16*)(F.ws + WS_QK);
    const float* cw = F.ka->in[I_m_conv_w] + (size_t)l * 4 * 1024; const float* cb = F.ka->in[I_m_conv_b] + (size_t)l * 1024;
    const int gt = F.vcu * 512 + F.tid, c0 = (gt & 127) * 8, run = gt >> 7;
    if (run < T / 32) {
        float w[4][8], bs[8];
#pragma unroll
        for (int j = 0; j < 4; ++j) { const f32x4 w0 = *(const f32x4*)(cw + j * 1024 + c0), w1 = *(const f32x4*)(cw + j * 1024 + c0 + 4); w[j][0] = w0.x; w[j][1] = w0.y; w[j][2] = w0.z; w[j][3] = w0.w; w[j][4] = w1.x; w[j][5] = w1.y; w[j][6] = w1.z; w[j][7] = w1.w; }
        { const f32x4 b0 = *(const f32x4*)(cb + c0), b1 = *(const f32x4*)(cb + c0 + 4); bs[0] = b0.x; bs[1] = b0.y; bs[2] = b0.z; bs[3] = b0.w; bs[4] = b1.x; bs[5] = b1.y; bs[6] = b1.z; bs[7] = b1.w; }
        const float sc = (c0 >= 512) ? 0.08838834764831845f : 1.f;
        const int tok0 = run * 32; const bool first = (tok0 & (SEQ - 1)) == 0;
        const bf16* rp = RAW + (size_t)tok0 * 1024 + c0; bf16* qp = QK + (size_t)tok0 * 1024 + c0;
        v4u win[3];
#pragma unroll
        for (int j = 0; j < 3; ++j) win[j] = first ? (v4u){0u, 0u, 0u, 0u} : *(const GAS v4u*)(rp - (size_t)(3 - j) * 1024);
#pragma unroll 1
        for (int t8 = 0; t8 < 32; t8 += 8) { v4u r[8];
#pragma unroll
            for (int i = 0; i < 8; ++i) r[i] = *(const GAS v4u*)(rp + (size_t)(t8 + i) * 1024);
#pragma unroll
            for (int i = 0; i < 8; ++i) { float a[8];
#pragma unroll
                for (int e = 0; e < 8; ++e) a[e] = bs[e];
#pragma unroll
                for (int j = 0; j < 4; ++j) { const v4u x = (j == 3) ? r[i] : ((i + j >= 3) ? r[i + j - 3 < 0 ? 0 : i + j - 3] : win[i + j]);
                    a[0] += w[j][0] * bflo(x.x); a[1] += w[j][1] * bfhi(x.x); a[2] += w[j][2] * bflo(x.y); a[3] += w[j][3] * bfhi(x.y);
                    a[4] += w[j][4] * bflo(x.z); a[5] += w[j][5] * bfhi(x.z); a[6] += w[j][6] * bflo(x.w); a[7] += w[j][7] * bfhi(x.w); }
#pragma unroll
                for (int e = 0; e < 8; ++e) a[e] = a[e] / (1.f + __expf(-a[e])) * sc;
                v4u o; o.x = pk2(a[0], a[1]); o.y = pk2(a[2], a[3]); o.z = pk2(a[4], a[5]); o.w = pk2(a[6], a[7]);
                *(GAS v4u*)(qp + (size_t)(t8 + i) * 1024) = o; }
            win[0] = r[5]; win[1] = r[6]; win[2] = r[7]; }
    }
}

typedef short v4i16_t __attribute__((ext_vector_type(4)));
__device__ __forceinline__ v2u tr_read4(const LAS bf16* tile, int P, int row0, int col0, int lane) {
    const int q = (lane & 15) >> 2, blk = (lane >> 4) & 1, p = lane & 3;
    return __builtin_bit_cast(v2u, __builtin_amdgcn_ds_read_tr16_b64_v4i16((LAS v4i16_t*)(tile + (row0 + q) * P + col0 + 16 * blk + 4 * p)));
}
struct P1Regs { v4u k[2], v[2]; float u[2], ml; };
__device__ __forceinline__ void mlstm_p1_load(Frame& F, int uu, P1Regs& R) {
    const int tid = F.tid, bh = uu >> 6, c = uu & 63, b = bh >> 2, h = bh & 3; const size_t tok0 = (size_t)b * SEQ + c * 64;
    const bf16* QK = (const bf16*)(F.ws + WS_QK); const bf16* MV = (const bf16*)(F.ws + WS_MV);
    const float ml = ((const float*)(F.ws + WS_MSC))[2048 + bh * 64 + c];
#pragma unroll
    for (int i = 0; i < 2; ++i) { const int p = tid + 512 * i, s = p >> 4, d0 = (p & 15) * 8;
        R.k[i] = *(const GAS v4u*)(QK + (tok0 + s) * 1024 + 512 + h * 128 + d0); R.v[i] = *(const GAS v4u*)(MV + (tok0 + s) * 512 + h * 128 + d0);
        R.u[i] = ((const float*)(F.ws + WS_MLU))[(size_t)bh * SEQ + c * 64 + s]; }
    R.ml = ml;
}
__device__ __forceinline__ void mlstm_pass1_all(Frame& F) {
    const int tid = F.tid, lane = F.lane, wid = F.wave, r = lane & 31, hh = lane >> 5;
    constexpr int PV = 160;
    LAS bf16* KW = (LAS bf16*)(F.lds); LAS bf16* VV = KW + 64 * PV;
    const int mt = wid >> 1, nt0 = (wid & 1) * 2;
    P1Regs R; mlstm_p1_load(F, F.vcu * 8, R);
    v2u pend[2][4]; float pend_n = 0.f;
#define P1_STORE(uu_) do { bf16* CT = (bf16*)(F.ws + WS_CST) + (size_t)(uu_) * 128 * 128; \
        _Pragma("unroll") for (int n = 0; n < 2; ++n) _Pragma("unroll") for (int g = 0; g < 4; ++g) *(GAS v2u*)(CT + (size_t)(32 * (nt0 + n) + r) * 128 + 32 * mt + 8 * g + 4 * hh) = pend[n][g]; \
        if (tid < 128) ((float*)(F.ws + WS_NST))[(size_t)(uu_) * 128 + tid] = pend_n; } while (0)
#pragma unroll 1
    for (int it = 0; it < 8; ++it) { const int uu = F.vcu * 8 + it;
#pragma unroll
        for (int i = 0; i < 2; ++i) { const int p = tid + 512 * i, s = p >> 4, d0 = (p & 15) * 8; const float w = expf(R.u[i] - R.ml);
            v4u kw; kw.x = pk2(bflo(R.k[i].x) * w, bfhi(R.k[i].x) * w); kw.y = pk2(bflo(R.k[i].y) * w, bfhi(R.k[i].y) * w); kw.z = pk2(bflo(R.k[i].z) * w, bfhi(R.k[i].z) * w); kw.w = pk2(bflo(R.k[i].w) * w, bfhi(R.k[i].w) * w);
            *(LAS v4u*)(KW + s * PV + d0) = kw; *(LAS v4u*)(VV + s * PV + d0) = R.v[i]; }
        if (it > 0) P1_STORE(uu - 1);
        mlstm_p1_load(F, (it + 1 < 8) ? uu + 1 : uu, R);
        LDS_BARRIER();
        f32x16 acc[2]; acc[0] = f32x16{}; acc[1] = f32x16{};
#pragma unroll
        for (int ks = 0; ks < 4; ++ks) { const v2u a0 = tr_read4(KW, PV, 16 * ks + 8 * hh, 32 * mt, lane), a1 = tr_read4(KW, PV, 16 * ks + 8 * hh + 4, 32 * mt, lane);
            const v4u A = {a0.x, a0.y, a1.x, a1.y};
#pragma unroll
            for (int n = 0; n < 2; ++n) { const v2u b0 = tr_read4(VV, PV, 16 * ks + 8 * hh, 32 * (nt0 + n), lane), b1 = tr_read4(VV, PV, 16 * ks + 8 * hh + 4, 32 * (nt0 + n), lane);
                const v4u B = {b0.x, b0.y, b1.x, b1.y};
                acc[n] = __builtin_amdgcn_mfma_f32_32x32x16_bf16(__builtin_bit_cast(bf16x8, A), __builtin_bit_cast(bf16x8, B), acc[n], 0, 0, 0); } }
#pragma unroll
        for (int n = 0; n < 2; ++n)
#pragma unroll
            for (int g = 0; g < 4; ++g) { pend[n][g].x = pk2(acc[n][4 * g], acc[n][4 * g + 1]); pend[n][g].y = pk2(acc[n][4 * g + 2], acc[n][4 * g + 3]); }
        if (tid < 128) { float s = 0.f;
#pragma unroll 8
            for (int i = 0; i < 64; ++i) s += bf2f(KW[i * PV + tid]); pend_n = s; }
        LDS_BARRIER();
    }
    P1_STORE(F.vcu * 8 + 7);
#undef P1_STORE
}

struct P3Regs { v4u q[2], k[2], v[2], ct[4]; float a0, a1, a2, a3, np; };
__device__ __forceinline__ void mlstm_p3_load(Frame& F, int uu, P3Regs& R) {
    const int tid = F.tid, bh = uu >> 6, c = uu & 63, b = bh >> 2, h = bh & 3; const size_t tok0 = (size_t)b * SEQ + c * 64;
    const bf16* QKg = (const bf16*)(F.ws + WS_QK); const bf16* MVg = (const bf16*)(F.ws + WS_MV); const bf16* CTg = (const bf16*)(F.ws + WS_CST) + (size_t)uu * 128 * 128;
#pragma unroll
    for (int i = 0; i < 2; ++i) { const int p = tid + 512 * i, s = p >> 4, d0 = (p & 15) * 8;
        R.q[i] = *(const GAS v4u*)(QKg + (tok0 + s) * 1024 + h * 128 + d0); R.k[i] = *(const GAS v4u*)(QKg + (tok0 + s) * 1024 + 512 + h * 128 + d0); R.v[i] = *(const GAS v4u*)(MVg + (tok0 + s) * 512 + h * 128 + d0); }
#pragma unroll
    for (int i = 0; i < 4; ++i) { const int p = tid + 512 * i, dv = p >> 4, d0 = (p & 15) * 8; R.ct[i] = *(const GAS v4u*)(CTg + (size_t)dv * 128 + d0); }
    { const size_t o = (size_t)bh * SEQ + c * 64 + (tid & 63); const float* MLU = (const float*)(F.ws + WS_MLU);
      R.a0 = MLU[o]; R.a1 = MLU[(size_t)32 * SEQ + o]; R.a2 = MLU[(size_t)64 * SEQ + o]; R.a3 = ((const float*)(F.ws + WS_MSC))[bh * 64 + c];
      R.np = ((const float*)(F.ws + WS_NST))[(size_t)uu * 128 + ((tid + 64) & 127)]; }
}
__device__ __forceinline__ void mlstm_pass3_all(Frame& F, int l) {
    const int tid = F.tid, lane = F.lane, wid = F.wave, r = lane & 31, hh = lane >> 5;
    constexpr int PV = 160;
    LAS bf16* Q = (LAS bf16*)(F.lds); LAS bf16* Kk = Q + 64 * 136; LAS bf16* VV = Kk + 64 * 136; LAS bf16* CT = VV + 64 * PV;
    LAS float* HB = (LAS float*)(F.lds + 90112); LAS float* SM = (LAS float*)(F.lds + 123904);
    LAS float* U = SM, *MT = SM + 64, *WST = SM + 128, *FLO = SM + 192, *DEN = SM + 256, *NP = SM + 320, *QN = SM + 448;
    float nwv[16];
    { const int h0 = ((F.vcu * 8) >> 6) & 3; const float* nw = F.ka->in[I_m_norm_w] + (size_t)l * BW + h0 * 128 + (tid & 7) * 16;
#pragma unroll
      for (int i = 0; i < 16; ++i) nwv[i] = nw[i]; }
    P3Regs R; mlstm_p3_load(F, F.vcu * 8, R);
    v4u pend0 = {0u, 0u, 0u, 0u}, pend1 = pend0; size_t pend_off = 0;
#pragma unroll 1
    for (int it = 0; it < 8; ++it) { const int uu = F.vcu * 8 + it;
        const int bh = uu >> 6, c = uu & 63, b = bh >> 2, h = bh & 3; const size_t tok0 = (size_t)b * SEQ + c * 64;
        for (int dA = 0; dA < ((F.dup & 0x80) ? 2 : 1); ++dA) {
#pragma unroll
        for (int i = 0; i < 2; ++i) { const int p = tid + 512 * i, s = p >> 4, d0 = (p & 15) * 8;
            *(LAS v4u*)(Q + s * 136 + d0) = R.q[i]; *(LAS v4u*)(Kk + s * 136 + d0) = R.k[i]; *(LAS v4u*)(VV + s * PV + d0) = R.v[i]; }
#pragma unroll
        for (int i = 0; i < 4; ++i) { const int p = tid + 512 * i, dv = p >> 4, d0 = (p & 15) * 8; *(LAS v4u*)(CT + dv * 136 + d0) = R.ct[i]; }
        if (tid < 64) { U[tid] = R.a0; MT[tid] = R.a1; WST[tid] = expf(R.a3 - R.a1); FLO[tid] = expf(-R.a2 - R.a1); }
        else if (tid < 192) NP[tid - 64] = R.np;
        }
        if (it > 0) { bf16* yo = (bf16*)(F.ws + WS_YTALL) + pend_off; *(GAS v4u*)yo = pend0; *(GAS v4u*)(yo + 8) = pend1; }
        mlstm_p3_load(F, (it + 1 < 8) ? uu + 1 : uu, R);
        const int tq = tid >> 3, part = tid & 7; const bf16* og = (const bf16*)(F.ws + WS_MO) + (tok0 + tq) * 512 + h * 128 + part * 16;
        const v4u o0 = *(const GAS v4u*)og, o1 = *(const GAS v4u*)(og + 8);
        LDS_BARRIER();
        { float s = 0.f;
#pragma unroll
            for (int i = 0; i < 16; ++i) s += bf2f(Q[tq * 136 + part * 16 + i]) * NP[part * 16 + i];
            s += shx<1>(s); s += shx<2>(s); s += shx<4>(s); if (part == 0) QN[tq] = s; }
        LDS_BARRIER();
        const int tt = wid >> 2, dt = wid & 3;
        f32x16 acc = f32x16{}; float denp = 0.f;
        for (int dB = 0; dB < ((F.dup & 0x20) ? 2 : 1); ++dB) {
        acc = f32x16{};
#pragma unroll
        for (int ks = 0; ks < 8; ++ks) { const bf16x8 A = *(const LAS bf16x8*)(Q + (32 * tt + r) * 136 + 16 * ks + 8 * hh); const bf16x8 B = *(const LAS bf16x8*)(CT + (32 * dt + r) * 136 + 16 * ks + 8 * hh);
            acc = __builtin_amdgcn_mfma_f32_32x32x16_bf16(A, B, acc, 0, 0, 0); }
#pragma unroll
        for (int g = 0; g < 16; ++g) acc[g] *= WST[32 * tt + (g & 3) + 8 * (g >> 2) + 4 * hh];
        denp = 0.f; const float Mt_l = MT[32 * tt + r];
        for (int st = 0; st <= tt; ++st) {
            f32x16 ST = f32x16{};
#pragma unroll
            for (int ks = 0; ks < 8; ++ks) { const bf16x8 A = *(const LAS bf16x8*)(Kk + (32 * st + r) * 136 + 16 * ks + 8 * hh); const bf16x8 B = *(const LAS bf16x8*)(Q + (32 * tt + r) * 136 + 16 * ks + 8 * hh);
                ST = __builtin_amdgcn_mfma_f32_32x32x16_bf16(A, B, ST, 0, 0, 0); }
#pragma unroll
            for (int g = 0; g < 16; ++g) { const int ri = (g & 3) + 8 * (g >> 2) + 4 * hh; float w = __expf(U[32 * st + ri] - Mt_l); if (st == tt && ri > r) w = 0.f; ST[g] *= w; denp += ST[g]; }
#pragma unroll
            for (int sp = 0; sp < 2; ++sp) {
                v4u pa; pa.x = pg8::cvt_pk_bf16(ST[8 * sp], ST[8 * sp + 1]); pa.y = pg8::cvt_pk_bf16(ST[8 * sp + 2], ST[8 * sp + 3]); pa.z = pg8::cvt_pk_bf16(ST[8 * sp + 4], ST[8 * sp + 5]); pa.w = pg8::cvt_pk_bf16(ST[8 * sp + 6], ST[8 * sp + 7]);
                const v2u lo = tr_read4(VV, PV, 32 * st + 16 * sp + 4 * hh, 32 * dt, lane), hi = tr_read4(VV, PV, 32 * st + 16 * sp + 8 + 4 * hh, 32 * dt, lane);
                v4u pb; pb.x = lo.x; pb.y = lo.y; pb.z = hi.x; pb.w = hi.y;
                acc = __builtin_amdgcn_mfma_f32_32x32x16_bf16(__builtin_bit_cast(bf16x8, pa), __builtin_bit_cast(bf16x8, pb), acc, 0, 0, 0); }
        }
        denp = half_swap_add(denp);
        if (dt == 0 && hh == 0) { const int t = 32 * tt + r; DEN[t] = denp + WST[t] * QN[t]; }
        }
        LDS_BARRIER();
#pragma unroll
        for (int g = 0; g < 16; ++g) { const int t = 32 * tt + (g & 3) + 8 * (g >> 2) + 4 * hh; HB[t * 132 + 32 * dt + r] = acc[g] / fmaxf(fabsf(DEN[t]), FLO[t]); }
        LDS_BARRIER();
        for (int dC = 0; dC < ((F.dup & 0x40) ? 2 : 1); ++dC)
        { float x[16]; float s = 0.f;
#pragma unroll
            for (int i = 0; i < 16; ++i) { x[i] = HB[tq * 132 + part * 16 + i]; s += x[i]; }
            s += shx<1>(s); s += shx<2>(s); s += shx<4>(s); const float mean = s * (1.f / 128.f); float q = 0.f;
#pragma unroll
            for (int i = 0; i < 16; ++i) { x[i] -= mean; q += x[i] * x[i]; }
            q += shx<1>(q); q += shx<2>(q); q += shx<4>(q); const float rstd = 1.f / sqrtf(q * (1.f / 128.f) + LN_EPS);
            const unsigned oa[8] = {o0.x, o0.y, o0.z, o0.w, o1.x, o1.y, o1.z, o1.w};
            unsigned ow[8];
#pragma unroll
            for (int i = 0; i < 8; ++i) ow[i] = pk2(x[2 * i] * rstd * nwv[2 * i] * bflo(oa[i]), x[2 * i + 1] * rstd * nwv[2 * i + 1] * bfhi(oa[i]));
            pend_off = (tok0 + tq) * 512 + h * 128 + part * 16; pend0 = (v4u){ow[0], ow[1], ow[2], ow[3]}; pend1 = (v4u){ow[4], ow[5], ow[6], ow[7]}; }
        LDS_BARRIER();
    }
    { bf16* yo = (bf16*)(F.ws + WS_YTALL) + pend_off; *(GAS v4u*)yo = pend0; *(GAS v4u*)(yo + 8) = pend1; }
}

__device__ __forceinline__ void phase_scans(Frame& F, int l, bool dry = false) {
    const int v = F.vcu, tid = F.tid, seg = F.wave, e = tid & 63;
    LAS float* LE = (LAS float*)(F.lds);
    LAS float* DS = LE + 8 * 64 * 8;
    { const int b = v >> 5, g = v & 31, p = e; const float* tab = (const float*)(F.ws + WS_S5TAB) + ((l * 32 + g) * 64 + p) * 2; const float ar = tab[0], ai = tab[1];
      bf16* A = (bf16*)(F.ws + (dry ? WS_AQKV : WS_S5A)); const float* E = (const float*)(F.ws + WS_EBUF);
      const size_t row0 = (size_t)g * 1024 + b * 128 + seg * 16; float er[16], ei[16];
#pragma unroll
      for (int j = 0; j < 16; ++j) { er[j] = E[(row0 + j) * 128 + p]; ei[j] = E[(row0 + j) * 128 + 64 + p]; }
      float hr = 0.f, hi = 0.f;
#pragma unroll
      for (int j = 0; j < 16; ++j) { const float nr = ar * hr - ai * hi + er[j], ni = ar * hi + ai * hr + ei[j]; hr = nr; hi = ni; }
      LE[(seg * 64 + p) * 2] = hr; LE[(seg * 64 + p) * 2 + 1] = hi;
      float pr = ar, pi = ai;
#pragma unroll
      for (int k = 0; k < 4; ++k) { const float nr = pr * pr - pi * pi, ni = 2.f * pr * pi; pr = nr; pi = ni; }
      LDS_BARRIER();
      hr = 0.f; hi = 0.f;
      for (int s = 0; s < seg; ++s) { const float lr = LE[(s * 64 + p) * 2], li = LE[(s * 64 + p) * 2 + 1]; const float nr = pr * hr - pi * hi + lr, ni = pr * hi + pi * hr + li; hr = nr; hi = ni; }
#pragma unroll
      for (int j = 0; j < 16; ++j) { A[(row0 + j) * S5K + 512 + p] = (bf16)f2bf(hr); A[(row0 + j) * S5K + 576 + p] = (bf16)f2bf(hi);
          const float nr = ar * hr - ai * hi + er[j], ni = ar * hi + ai * hr + ei[j]; hr = nr; hi = ni; }
      LDS_BARRIER(); }
    const float* MSC = (const float*)(F.ws + WS_MSC);
#pragma unroll 1
    for (int i = 0; i < 4; ++i) { const int uix = v * 4 + i, bh = uix >> 5, slice = uix & 31;
        bf16* p = (bf16*)(F.ws + (dry ? WS_MQK : WS_CST)) + ((size_t)bh * 64 + seg * 8) * 16384 + slice * 512 + e * 8;
        v4u lc[8]; float dec[8], sc[8];
#pragma unroll
        for (int j = 0; j < 8; ++j) { lc[j] = *(const GAS v4u*)(p + (size_t)j * 16384); dec[j] = MSC[4096 + bh * 64 + seg * 8 + j]; sc[j] = MSC[6144 + bh * 64 + seg * 8 + j]; }
        float S[8] = {0.f, 0.f, 0.f, 0.f, 0.f, 0.f, 0.f, 0.f}; float dp = 1.f;
#pragma unroll
        for (int j = 0; j < 8; ++j) { const float d = dec[j], s_ = sc[j]; dp *= d;
            S[0] = d * S[0] + s_ * bflo(lc[j].x); S[1] = d * S[1] + s_ * bfhi(lc[j].x); S[2] = d * S[2] + s_ * bflo(lc[j].y); S[3] = d * S[3] + s_ * bfhi(lc[j].y);
            S[4] = d * S[4] + s_ * bflo(lc[j].z); S[5] = d * S[5] + s_ * bfhi(lc[j].z); S[6] = d * S[6] + s_ * bflo(lc[j].w); S[7] = d * S[7] + s_ * bfhi(lc[j].w); }
#pragma unroll
        for (int k = 0; k < 8; ++k) LE[(seg * 64 + e) * 8 + k] = S[k];
        if (e == 0) DS[seg] = dp;
        LDS_BARRIER();
#pragma unroll
        for (int k = 0; k < 8; ++k) S[k] = 0.f;
        for (int s = 0; s < seg; ++s) { const float d = DS[s];
#pragma unroll
            for (int k = 0; k < 8; ++k) S[k] = d * S[k] + LE[(s * 64 + e) * 8 + k]; }
#pragma unroll
        for (int j = 0; j < 8; ++j) { v4u o; o.x = pk2(S[0], S[1]); o.y = pk2(S[2], S[3]); o.z = pk2(S[4], S[5]); o.w = pk2(S[6], S[7]); *(GAS v4u*)(p + (size_t)j * 16384) = o;
            const float d = dec[j], s_ = sc[j];
            S[0] = d * S[0] + s_ * bflo(lc[j].x); S[1] = d * S[1] + s_ * bfhi(lc[j].x); S[2] = d * S[2] + s_ * bflo(lc[j].y); S[3] = d * S[3] + s_ * bfhi(lc[j].y);
            S[4] = d * S[4] + s_ * bflo(lc[j].z); S[5] = d * S[5] + s_ * bfhi(lc[j].z); S[6] = d * S[6] + s_ * bflo(lc[j].w); S[7] = d * S[7] + s_ * bfhi(lc[j].w); }
        LDS_BARRIER(); }
    if (tid < 16) { const int gid = v * 16 + tid, bh = gid >> 7, dk = gid & 127; float* p = (float*)(F.ws + (dry ? WS_YTALL : WS_NST)) + (size_t)bh * 64 * 128 + dk; float lc[64];
#pragma unroll
        for (int c = 0; c < 64; ++c) lc[c] = p[c * 128];
        float n = 0.f;
#pragma unroll
        for (int c = 0; c < 64; ++c) { p[c * 128] = n; n = MSC[4096 + bh * 64 + c] * n + MSC[6144 + bh * 64 + c] * lc[c]; } }
}

struct SchedS5E { static constexpr bool GATHER = false; int c; __device__ __forceinline__ bool next(int i, pg8::Unit& u) const { if (i > 0 || c >= 128) return false; u.pm = c; u.pn = c >> 2; return true; } };
struct SchedS5Y { static constexpr bool GATHER = false; int c; __device__ __forceinline__ bool next(int i, pg8::Unit& u) const { if (i > 0 || c >= 256) return false; u.pm = c >> 1; u.pn = (c >> 3) * 2 + (c & 1); return true; } };
struct EpiS5E {
    static constexpr bool PERM = false;
    float* E;
    __device__ __forceinline__ bool reset_after(const pg8::Unit&) const { return true; }
    __device__ __forceinline__ void operator()(pg8::f32x4 (&acc)[2][2][4][2], const pg8::Unit& u, int wr, int wc, int fr, int fq) const {
        using namespace pg8;
        const int row0 = u.pm * BM + wr * 64 + fr, col0 = wc * 32 + 4 * fq;
#pragma unroll
        for (int ai = 0; ai < 2; ++ai)
#pragma unroll
            for (int m = 0; m < 4; ++m)
#pragma unroll
                for (int n = 0; n < 2; ++n) *(f32x4*)(E + (size_t)(row0 + ai * HALF + m * 16) * 128 + col0 + 16 * n) = acc[ai][0][m][n];
    }
};
__device__ __forceinline__ float gelu_tanh(float x) { const float z = 0.7978845608028654f * (x + 0.044715f * x * x * x); const float e = __expf(2.f * z); return 0.5f * x * (2.f - 2.f / (1.f + e)); }
struct EpiS5Y {
    static constexpr bool PERM = true;
    bf16* Y;
    __device__ __forceinline__ bool reset_after(const pg8::Unit&) const { return true; }
    __device__ __forceinline__ void operator()(pg8::f32x4 (&acc)[2][2][4][2], const pg8::Unit& u, int wr, int wc, int fr, int fq) const {
        using namespace pg8;
        const int row0 = u.pm * BM + wr * 64 + fr, ct = u.pn & 1;
#pragma unroll
        for (int bj = 0; bj < 2; ++bj) { const int cc = ct * 256 + bj * HALF + wc * 32 + 8 * fq, tq = cc >> 4, co = cc & 15;
#pragma unroll
            for (int ai = 0; ai < 2; ++ai)
#pragma unroll
                for (int m = 0; m < 4; ++m) { const int R = row0 + ai * HALF + m * 16, g = R >> 10, rr = R & 1023; const f32x4 v0 = acc[ai][bj][m][0], v1 = acc[ai][bj][m][1];
                    u32x4 w; w.x = cvt_pk_bf16(gelu_tanh(v0[0]), gelu_tanh(v0[1])); w.y = cvt_pk_bf16(gelu_tanh(v0[2]), gelu_tanh(v0[3])); w.z = cvt_pk_bf16(gelu_tanh(v1[0]), gelu_tanh(v1[1])); w.w = cvt_pk_bf16(gelu_tanh(v1[2]), gelu_tanh(v1[3]));
                    *(u32x4*)(Y + (size_t)(rr * 32 + tq) * 512 + 16 * g + co) = w; } }
    }
};
struct EpiGlu {
    static constexpr bool PERM = true;
    const bf16* Y1; bf16* YO; const float* bias;
    __device__ __forceinline__ bool reset_after(const pg8::Unit&) const { return true; }
    __device__ __forceinline__ void operator()(pg8::f32x4 (&acc)[2][2][4][2], const pg8::Unit& u, int wr, int wc, int fr, int fq) const {
        using namespace pg8;
        const int row0 = u.pm * BM + wr * 64 + fr;
#pragma unroll
        for (int bj = 0; bj < 2; ++bj) { const int col0 = u.pn * BM + bj * HALF + wc * 32 + 8 * fq; const f32x4 b0 = *(const f32x4*)(bias + col0), b1 = *(const f32x4*)(bias + col0 + 4);
            u32x4 yv[2][4];
#pragma unroll
            for (int ai = 0; ai < 2; ++ai)
#pragma unroll
                for (int m = 0; m < 4; ++m) yv[ai][m] = *(const u32x4*)(Y1 + (size_t)(row0 + ai * HALF + m * 16) * 512 + col0);
            asm volatile("" ::: "memory");
#pragma unroll
            for (int ai = 0; ai < 2; ++ai)
#pragma unroll
                for (int m = 0; m < 4; ++m) { const size_t off = (size_t)(row0 + ai * HALF + m * 16) * 512 + col0; const u32x4 y = yv[ai][m];
                    const f32x4 v0 = acc[ai][bj][m][0] + b0, v1 = acc[ai][bj][m][1] + b1;
                    u32x4 w; w.x = cvt_pk_bf16(bflo(y.x) * sigmoidf_(v0[0]), bfhi(y.x) * sigmoidf_(v0[1])); w.y = cvt_pk_bf16(bflo(y.y) * sigmoidf_(v0[2]), bfhi(y.y) * sigmoidf_(v0[3]));
                    w.z = cvt_pk_bf16(bflo(y.z) * sigmoidf_(v1[0]), bfhi(y.z) * sigmoidf_(v1[1])); w.w = cvt_pk_bf16(bflo(y.w) * sigmoidf_(v1[2]), bfhi(y.w) * sigmoidf_(v1[3]));
                    *(u32x4*)(YO + off) = w; }
            asm volatile("" ::: "memory"); }
    }
};
struct SchedMerge { static constexpr bool GATHER = false; int c, G; __device__ __forceinline__ bool next(int i, pg8::Unit& u) const { const int tl = (i / 3) * G + c, b = i % 3; if (tl >= 512) return false; u.pm = b * 128 + (tl >> 2); u.pn = b * 4 + (tl & 3); return true; } };
struct EpiMerge {
    static constexpr bool PERM = true;
    const bf16* GP; bf16* MX;
    __device__ __forceinline__ bool reset_after(const pg8::Unit& u) const { return u.pm >= 256; }
    __device__ __forceinline__ void operator()(pg8::f32x4 (&acc)[2][2][4][2], const pg8::Unit& u, int wr, int wc, int fr, int fq) const {
        using namespace pg8;
        const int b = u.pm >> 7, pm = u.pm & 127, pn = u.pn & 3, row0 = pm * BM + wr * 64 + fr;
#pragma unroll
        for (int bj = 0; bj < 2; ++bj) { const int col0 = pn * BM + bj * HALF + wc * 32 + 8 * fq;
#pragma unroll
            for (int ai = 0; ai < 2; ++ai) {
            u32x4 gav[4], gbv[4];
#pragma unroll
                for (int m = 0; m < 4; ++m) { const bf16* gp = GP + (size_t)(row0 + ai * HALF + m * 16) * 3072 + b * 1024 + col0; gav[m] = *(const u32x4*)gp; gbv[m] = (b < 2) ? *(const u32x4*)(gp + 1024) : (u32x4){0u, 0u, 0u, 0u}; }
            asm volatile("" ::: "memory");
#pragma unroll
                for (int m = 0; m < 4; ++m) { const int row = row0 + ai * HALF + m * 16;
                    const u32x4 ga = gav[m]; float f[8];
                    const unsigned gaa[4] = {ga.x, ga.y, ga.z, ga.w};
                    if (b < 2) { const u32x4 gb = gbv[m]; const unsigned gba[4] = {gb.x, gb.y, gb.z, gb.w};
#pragma unroll
                        for (int i = 0; i < 4; ++i) {
                            f[2 * i] = (1.f + bflo(gba[i])) * __builtin_amdgcn_rcpf(1.f + bflo(gaa[i])); f[2 * i + 1] = (1.f + bfhi(gba[i])) * __builtin_amdgcn_rcpf(1.f + bfhi(gaa[i])); }
                    } else {
#pragma unroll
                        for (int i = 0; i < 4; ++i) { f[2 * i] = __builtin_amdgcn_rcpf(1.f + bflo(gaa[i])); f[2 * i + 1] = __builtin_amdgcn_rcpf(1.f + bfhi(gaa[i])); }
                    }
                    f32x4& v0 = acc[ai][bj][m][0]; f32x4& v1 = acc[ai][bj][m][1];
                    v0[0] *= f[0]; v0[1] *= f[1]; v0[2] *= f[2]; v0[3] *= f[3]; v1[0] *= f[4]; v1[1] *= f[5]; v1[2] *= f[6]; v1[3] *= f[7];
                    if (b == 2) { u32x4 w; w.x = cvt_pk_bf16(v0[0], v0[1]); w.y = cvt_pk_bf16(v0[2], v0[3]); w.z = cvt_pk_bf16(v1[0], v1[1]); w.w = cvt_pk_bf16(v1[2], v1[3]);
                        *(u32x4*)(MX + (size_t)row * 1024 + col0) = w; } }
            asm volatile("" ::: "memory"); } }
    }
};
struct EpiOutProj {
    static constexpr bool PERM = false;
    const float* X; float* O;
    __device__ __forceinline__ bool reset_after(const pg8::Unit&) const { return true; }
    __device__ __forceinline__ void operator()(pg8::f32x4 (&acc)[2][2][4][2], const pg8::Unit& u, int wr, int wc, int fr, int fq) const {
        using namespace pg8;
        const int row0 = u.pm * BM + wr * 64 + fr, col0 = u.pn * BM + wc * 32 + 4 * fq;
#pragma unroll
        for (int ai = 0; ai < 2; ++ai) {
            f32x4 xv[4][2][2];
#pragma unroll
            for (int m = 0; m < 4; ++m) { const size_t off = (size_t)(row0 + ai * HALF + m * 16) * 1024 + col0;
#pragma unroll
                for (int bj = 0; bj < 2; ++bj)
#pragma unroll
                    for (int n = 0; n < 2; ++n) xv[m][bj][n] = *(const f32x4*)(X + off + bj * HALF + n * 16); }
            asm volatile("" ::: "memory");
#pragma unroll
            for (int m = 0; m < 4; ++m) { const size_t off = (size_t)(row0 + ai * HALF + m * 16) * 1024 + col0;
#pragma unroll
                for (int bj = 0; bj < 2; ++bj)
#pragma unroll
                    for (int n = 0; n < 2; ++n) *(f32x4*)(O + off + bj * HALF + n * 16) = xv[m][bj][n] * ALPHA + acc[ai][bj][m][n]; }
            asm volatile("" ::: "memory");
        }
    }
};

__device__ __forceinline__ void phase_ln1_route(Frame& F, int l, bool dry = false) {
    float* const STo = (float*)(F.ws + (dry ? WS_YB : WS_STAT)); bf16* const XBo = (bf16*)(F.ws + (dry ? WS_XG : WS_XB)); unsigned char* const RT = F.ws + (dry ? WS_HB : WS_ROUTE); int* const TPo = (int*)(F.ws + (dry ? WS_HB + 4 * MiB : WS_TOKPOS)); const int gl = dry ? l + 4 : l;
    constexpr int WP = 1028;
    LAS float* WRE = (LAS float*)(F.lds); LAS float* WRG = WRE + 32 * WP;
    LAS float* BR = WRG + 4 * WP; LAS unsigned* HIST = (LAS unsigned*)(BR + 64); LAS unsigned* BASE = HIST + 32;
    const int gw = F.vcu * NWAVES + F.wave, NGW = F.G * NWAVES, lane = F.lane;
    f32x4 nv[4], nv2[4];
    { const GAS f32x4* x0 = (const GAS f32x4*)(F.out + (size_t)gw * D) + lane; const GAS f32x4* x1 = (const GAS f32x4*)(F.out + (size_t)(gw + NGW) * D) + lane;
#pragma unroll
      for (int j = 0; j < 4; ++j) { nv[j] = x0[64 * j]; nv2[j] = x1[64 * j]; } }
    const float* wre = F.ka->in[I_w_re] + (size_t)l * 1024 * 32; const float* wrg = F.ka->in[I_w_rg] + (size_t)l * 1024 * 4;
    {
        f32x4 we[16], wg[2];
#pragma unroll
        for (int j = 0; j < 16; ++j) we[j] = *(const f32x4*)(wre + 4 * (F.tid + 512 * j));
#pragma unroll
        for (int j = 0; j < 2; ++j) wg[j] = *(const f32x4*)(wrg + 4 * (F.tid + 512 * j));
#pragma unroll
        for (int j = 0; j < 16; ++j) { const int i = 4 * (F.tid + 512 * j), k = i >> 5, e = i & 31; WRE[e * WP + k] = we[j].x; WRE[(e + 1) * WP + k] = we[j].y; WRE[(e + 2) * WP + k] = we[j].z; WRE[(e + 3) * WP + k] = we[j].w; }
#pragma unroll
        for (int j = 0; j < 2; ++j) { const int k = F.tid + 512 * j; WRG[k] = wg[j].x; WRG[WP + k] = wg[j].y; WRG[2 * WP + k] = wg[j].z; WRG[3 * WP + k] = wg[j].w; }
    }
    if (F.tid < 32) { BR[F.tid] = F.ka->in[I_b_re][l * 32 + F.tid]; HIST[F.tid] = 0u; }
    if (F.tid < 4) BR[32 + F.tid] = F.ka->in[I_b_rg][l * 4 + F.tid];
    { int* tp = TPo; for (int i = F.vcu * 512 + F.tid; i < MOE_ROWS; i += F.G * 512) tp[i] = -1; }
    __syncthreads();
    const float* lg = F.ka->in[I_ln1_g] + (size_t)l * D; const float* lb = F.ka->in[I_ln1_b] + (size_t)l * D;
    int my_e0 = 0, my_e1 = 0, my_r0 = 0, my_r1 = 0, my_m = -1; float my_w0 = 0.f, my_w1 = 0.f; int it = 0;
    f32x4 g4[4], b4[4];
#pragma unroll
    for (int j = 0; j < 4; ++j) { g4[j] = *(const f32x4*)(lg + 256 * j + 4 * lane); b4[j] = *(const f32x4*)(lb + 256 * j + 4 * lane); }
    v2u pend[4] = {{0u, 0u}, {0u, 0u}, {0u, 0u}, {0u, 0u}}; float pend_s = 0.f; int pend_m = -1;
#define LN1_FLUSH() do { if (pend_m >= 0) { GAS v2u* o8_ = (GAS v2u*)(XBo + (size_t)pend_m * D) + lane; _Pragma("unroll") for (int j = 0; j < 4; ++j) o8_[64 * j] = pend[j]; STo[2 * (size_t)pend_m + (lane & 1)] = pend_s; } } while (0)
    for (int m = gw; m < T; m += NGW, ++it) {
        f32x4 v[4]; float s = 0.f;
#pragma unroll
        for (int j = 0; j < 4; ++j) { v[j] = nv[j]; nv[j] = nv2[j]; s += (v[j].x + v[j].y) + (v[j].z + v[j].w); }
        LN1_FLUSH();
        { const int mn = (m + 2 * NGW < T) ? m + 2 * NGW : m;
          const GAS f32x4* xn = (const GAS f32x4*)(F.out + (size_t)mn * D) + lane;
#pragma unroll
            for (int j = 0; j < 4; ++j) nv2[j] = xn[64 * j]; }
        const float mean = wave_sum(s) * (1.f / D); float s2 = 0.f;
#pragma unroll
        for (int j = 0; j < 4; ++j) { v[j] = v[j] - mean; s2 += (v[j].x * v[j].x + v[j].y * v[j].y) + (v[j].z * v[j].z + v[j].w * v[j].w); }
        const float rstd = 1.f / sqrtf(wave_sum(s2) * (1.f / D) + LN_EPS);
        pend_s = (lane & 1) ? rstd : mean; pend_m = m;
#pragma unroll
        for (int j = 0; j < 4; ++j) {
            v[j] = v[j] * rstd * g4[j] + b4[j]; v2u o;     o.x = pk2(v[j].x, v[j].y); o.y = pk2(v[j].z, v[j].w); pend[j] = o; }
        const bool b0 = (lane & 1) != 0, b1 = (lane & 2) != 0, b2 = (lane & 4) != 0;
        float gl[4];
        { float p[4];
#pragma unroll
          for (int o = 0; o < 4; ++o) { p[o] = 0.f;
#pragma unroll
            for (int j = 0; j < 4; ++j) { const f32x4 w = *(const LAS f32x4*)(WRG + o * WP + 256 * j + 4 * lane); p[o] += (v[j].x * w.x + v[j].y * w.y) + (v[j].z * w.z + v[j].w * w.w); } }
          JR_STEP(p, 2, 1, b0) JR_STEP(p, 1, 2, b1)
          float r = p[0]; r += shx<4>(r); r += shx<8>(r); r += shx<16>(r); r = half_swap_add(r);
          gl[0] = rdlane(r, 0) + BR[32]; gl[1] = rdlane(r, 2) + BR[33]; gl[2] = rdlane(r, 1) + BR[34]; gl[3] = rdlane(r, 3) + BR[35]; }
        int grp = 0; float gmax = gl[0];
#pragma unroll
        for (int o = 1; o < 4; ++o) if (gl[o] > gmax) { gmax = gl[o]; grp = o; }
        float gs = 0.f;
#pragma unroll
        for (int o = 0; o < 4; ++o) gs += __expf(gl[o] - gmax);
        const float pg = 1.f / gs;
        float el[8];
        { float p[8]; const LAS float* wr_ = WRE + grp * 8 * WP;
#pragma unroll
          for (int o = 0; o < 8; ++o) { p[o] = 0.f;
#pragma unroll
            for (int j = 0; j < 4; ++j) { const f32x4 w = *(const LAS f32x4*)(wr_ + o * WP + 256 * j + 4 * lane); p[o] += (v[j].x * w.x + v[j].y * w.y) + (v[j].z * w.z + v[j].w * w.w); } }
          JR_STEP(p, 4, 1, b0) JR_STEP(p, 2, 2, b1) JR_STEP(p, 1, 4, b2)
          float r = p[0]; r += shx<8>(r); r += shx<16>(r); r = half_swap_add(r);
          const LAS float* be = BR + grp * 8;
          el[0] = rdlane(r, 0) + be[0]; el[1] = rdlane(r, 4) + be[1]; el[2] = rdlane(r, 2) + be[2]; el[3] = rdlane(r, 6) + be[3];
          el[4] = rdlane(r, 1) + be[4]; el[5] = rdlane(r, 5) + be[5]; el[6] = rdlane(r, 3) + be[6]; el[7] = rdlane(r, 7) + be[7]; }
        int i0 = 0; float l0 = el[0];
#pragma unroll
        for (int o = 1; o < 8; ++o) if (el[o] > l0) { l0 = el[o]; i0 = o; }
        int i1 = -1; float l1 = -INFINITY;
#pragma unroll
        for (int o = 0; o < 8; ++o) if (o != i0 && el[o] > l1) { l1 = el[o]; i1 = o; }
        const float ex = __expf(l1 - l0), pe0 = 1.f / (1.f + ex), pe1 = ex / (1.f + ex);
        const int e0 = grp * 8 + i0, e1 = grp * 8 + i1;
        unsigned r0 = 0u, r1 = 0u;
        if (lane == 0) { r0 = __hip_atomic_fetch_add(&HIST[e0], 1u, __ATOMIC_RELAXED, __HIP_MEMORY_SCOPE_WORKGROUP); r1 = __hip_atomic_fetch_add(&HIST[e1], 1u, __ATOMIC_RELAXED, __HIP_MEMORY_SCOPE_WORKGROUP); }
        r0 = (unsigned)__builtin_amdgcn_readfirstlane((int)r0); r1 = (unsigned)__builtin_amdgcn_readfirstlane((int)r1);
        if (lane == it) { my_e0 = e0; my_e1 = e1; my_r0 = (int)r0; my_r1 = (int)r1; my_w0 = pg * pe0; my_w1 = pg * pe1; my_m = m; }
    }
    LN1_FLUSH();
#undef LN1_FLUSH
    __syncthreads();
    if (F.tid < 32) BASE[F.tid] = __hip_atomic_fetch_add((unsigned*)(F.ctl + CW_GCNT + gl * 32 + F.tid), HIST[F.tid], RLX_AGENT);
    __syncthreads();
    if (my_m >= 0) { int* re = (int*)RT; float* rw = (float*)(RT + 262144); int* rp = (int*)(RT + 524288);
        re[2 * my_m] = my_e0; re[2 * my_m + 1] = my_e1; rw[2 * my_m] = my_w0; rw[2 * my_m + 1] = my_w1; rp[2 * my_m] = (int)BASE[my_e0] + my_r0; rp[2 * my_m + 1] = (int)BASE[my_e1] + my_r1; }
    __syncthreads();
}

__device__ __forceinline__ void moe_tables(Frame& F, int l) {
    LAS int* PST = (LAS int*)(F.lds + LDSX_OFF + 20480); LAS int* BLKE = PST + 64; LAS int* CNT = PST + 384;
    if (F.tid < NEXP) CNT[F.tid] = (int)__hip_atomic_load(F.ctl + CW_GCNT + l * 32 + F.tid, RLX_AGENT);
    __syncthreads();
    if (F.tid == 0) { int acc = 0;
#pragma unroll 1
        for (int e = 0; e < NEXP; ++e) { const int cnt = CNT[e]; PST[e] = acc; const int nb = (cnt + 255) >> 8;
#pragma unroll 1
            for (int j = 0; j < nb; ++j) BLKE[(acc >> 8) + j] = e; acc += nb << 8; } PST[32] = acc; PST[33] = acc >> 8; }
    __syncthreads();
}
__device__ __forceinline__ void phase_dispatch(Frame& F, int l) {
    moe_tables(F, l);
    const LAS int* PST = (const LAS int*)(F.lds + LDSX_OFF + 20480);
    const int* re = (const int*)(F.ws + WS_ROUTE); const float* rw = (const float*)(F.ws + WS_ROUTE + 262144); const int* rp = (const int*)(F.ws + WS_ROUTE + 524288);
    int* tp = (int*)(F.ws + WS_TOKPOS); float* wp = (float*)(F.ws + WS_TOKPOS + 524288);
    for (int t = F.vcu * 512 + F.tid; t < 2 * T; t += F.G * 512) { const int pos = PST[re[t]] + rp[t]; tp[pos] = t; wp[pos] = rw[t]; }
}
struct SchedMoe { static constexpr bool GATHER = false; const LAS int* PST; int c, G; __device__ __forceinline__ bool next(int i, pg8::Unit& u) const { const int L = i * G + c; const int nb = __builtin_amdgcn_readfirstlane(PST[33]); if (L >= nb * 4) return false; const int rb = L >> 2; u.pm = rb; u.pn = __builtin_amdgcn_readfirstlane(PST[64 + rb]) * 4 + (L & 3); return true; } };
struct SchedMoeG { static constexpr bool GATHER = true; const LAS int* PST; const LAS int* TOKL; int c, G;
    __device__ __forceinline__ bool next(int i, pg8::Unit& u) const { const int L = i * G + c; const int nb = __builtin_amdgcn_readfirstlane(PST[33]); if (L >= nb * 4) return false; const int rb = L >> 2; u.pm = rb; u.pn = __builtin_amdgcn_readfirstlane(PST[64 + rb]) * 4 + (L & 3); return true; }
    __device__ __forceinline__ unsigned row_byte_off(int ui, int r) const { return (unsigned)TOKL[ui * 256 + r] * 2048u; } };
__device__ __forceinline__ void moe_stage_rows(Frame& F) {
    const LAS int* PST = (const LAS int*)(F.lds + LDSX_OFF + 20480); LAS int* TOKL = (LAS int*)(F.lds + LDSX_OFF); const int* tp = (const int*)(F.ws + WS_TOKPOS);
    const int nb = PST[33];
    for (int i = F.tid; i < 5 * 256; i += 512) { const int ui = i >> 8, r = i & 255, L = ui * F.G + F.vcu; int tok = 0; if (L < nb * 4) { const int t = tp[(L >> 2) * 256 + r]; tok = t < 0 ? 0 : (t >> 1); } TOKL[i] = tok; }
    __syncthreads();
}
struct EpiGateUp {
    static constexpr bool PERM = true;
    bf16* H;
    __device__ __forceinline__ bool reset_after(const pg8::Unit&) const { return true; }
    __device__ __forceinline__ void operator()(pg8::f32x4 (&acc)[2][2][4][2], const pg8::Unit& u, int wr, int wc, int fr, int fq) const {
        using namespace pg8;
        const int row0 = u.pm * BM + wr * 64 + fr, col0 = (u.pn & 3) * HALF + wc * 32 + 8 * fq;
#pragma unroll
        for (int ai = 0; ai < 2; ++ai)
#pragma unroll
            for (int m = 0; m < 4; ++m) { float hv[8];
#pragma unroll
                for (int n = 0; n < 2; ++n)
#pragma unroll
                    for (int i = 0; i < 4; ++i) { const float g = acc[ai][0][m][n][i], up = acc[ai][1][m][n][i]; hv[4 * n + i] = g / (1.f + __expf(-g)) * up; }
                u32x4 w; w.x = cvt_pk_bf16(hv[0], hv[1]); w.y = cvt_pk_bf16(hv[2], hv[3]); w.z = cvt_pk_bf16(hv[4], hv[5]); w.w = cvt_pk_bf16(hv[6], hv[7]);
                *(u32x4*)(H + (size_t)(row0 + ai * HALF + m * 16) * 512 + col0) = w; }
    }
};
struct EpiDown {
    static constexpr bool PERM = true;
    bf16* YB; const int* TP; const float* WP;
    __device__ __forceinline__ bool reset_after(const pg8::Unit&) const { return true; }
    __device__ __forceinline__ void operator()(pg8::f32x4 (&acc)[2][2][4][2], const pg8::Unit& u, int wr, int wc, int fr, int fq) const {
        using namespace pg8;
        const int row0 = u.pm * BM + wr * 64 + fr, colb = (u.pn & 3) * BM + wc * 32 + 8 * fq;
        int tpa[2][4]; float wpa[2][4];
#pragma unroll
        for (int ai = 0; ai < 2; ++ai)
#pragma unroll
            for (int m = 0; m < 4; ++m) { tpa[ai][m] = TP[row0 + ai * HALF + m * 16]; wpa[ai][m] = WP[row0 + ai * HALF + m * 16]; }
        asm volatile("" ::: "memory");
#pragma unroll
        for (int ai = 0; ai < 2; ++ai)
#pragma unroll
            for (int m = 0; m < 4; ++m) { const int tpv = tpa[ai][m]; if (tpv < 0) continue; const float w_ = wpa[ai][m];
#pragma unroll
                for (int bj = 0; bj < 2; ++bj) { const f32x4 v0 = acc[ai][bj][m][0] * w_, v1 = acc[ai][bj][m][1] * w_;
                    u32x4 w; w.x = cvt_pk_bf16(v0[0], v0[1]); w.y = cvt_pk_bf16(v0[2], v0[3]); w.z = cvt_pk_bf16(v1[0], v1[1]); w.w = cvt_pk_bf16(v1[2], v1[3]);
                    *(u32x4*)(YB + (size_t)tpv * 1024 + colb + bj * HALF) = w; } }
    }
};
__device__ __forceinline__ void phase_ln2(Frame& F, int l, int sub) {
    const bool more = (l + 1 < NL); const bool dry = (sub & 0x10) != 0;
    float* const OUT = dry ? (float*)(F.ws + 560 * MiB) : F.out; bf16* const XBo = (bf16*)(F.ws + (dry ? WS_YTALL : WS_XB));
    const int gw = F.vcu * NWAVES + F.wave, NGW = F.G * NWAVES, lane = F.lane;
    const float* lg = F.ka->in[I_ln2_g] + (size_t)l * D; const float* lb = F.ka->in[I_ln2_b] + (size_t)l * D; const bf16* YB = (const bf16*)(F.ws + WS_YB);
    f32x4 g4[4], b4[4];
#pragma unroll
    for (int j = 0; j < 4; ++j) { g4[j] = *(const f32x4*)(lg + 256 * j + 4 * lane); b4[j] = *(const f32x4*)(lb + 256 * j + 4 * lane); }
    f32x4 g1[4], b1[4];
    { const float* lg1 = F.ka->in[I_ln1_g] + (size_t)l * D; const float* lb1 = F.ka->in[I_ln1_b] + (size_t)l * D;
#pragma unroll
      for (int j = 0; j < 4; ++j) { g1[j] = *(const f32x4*)(lg1 + 256 * j + 4 * lane); b1[j] = *(const f32x4*)(lb1 + 256 * j + 4 * lane); } }
    const float* ST = (const float*)(F.ws + WS_STAT);
    f32x4 nx[4]; v2u na[4], nb[4];
    if (sub & 1) { const GAS f32x4* xr = (const GAS f32x4*)(F.out + (size_t)gw * D) + lane; const GAS v2u* y0 = (const GAS v2u*)(YB + (size_t)(2 * gw) * D) + lane; const GAS v2u* y1 = y0 + D / 4;
#pragma unroll
        for (int j = 0; j < 4; ++j) { nx[j] = xr[64 * j]; na[j] = y0[64 * j]; nb[j] = y1[64 * j]; } }
    if (sub & 1) for (int m = gw; m < T; m += NGW) {
        GAS f32x4* xw = (GAS f32x4*)(OUT + (size_t)m * D) + lane;
        f32x4 v[4]; float s = 0.f; f32x4 cx[4]; v2u ca[4], cb_[4];
#pragma unroll
        for (int j = 0; j < 4; ++j) { cx[j] = nx[j]; ca[j] = na[j]; cb_[j] = nb[j]; }
        { const int mn = (m + NGW < T) ? m + NGW : m;
          const GAS f32x4* xr = (const GAS f32x4*)(F.out + (size_t)mn * D) + lane; const GAS v2u* y0 = (const GAS v2u*)(YB + (size_t)(2 * mn) * D) + lane; const GAS v2u* y1 = y0 + D / 4;
#pragma unroll
            for (int j = 0; j < 4; ++j) { nx[j] = xr[64 * j]; na[j] = y0[64 * j]; nb[j] = y1[64 * j]; } }
        const float mean1 = ST[2 * (size_t)m], rstd1 = ST[2 * (size_t)m + 1];
#pragma unroll
        for (int j = 0; j < 4; ++j) { const f32x4 x = (cx[j] - mean1) * rstd1 * g1[j] + b1[j]; const v2u a = ca[j], b = cb_[j];
            v[j].x = ALPHA * x.x + (bflo(a.x) + bflo(b.x)); v[j].y = ALPHA * x.y + (bfhi(a.x) + bfhi(b.x)); v[j].z = ALPHA * x.z + (bflo(a.y) + bflo(b.y)); v[j].w = ALPHA * x.w + (bfhi(a.y) + bfhi(b.y));
            s += (v[j].x + v[j].y) + (v[j].z + v[j].w); }
        const float mean = wave_sum(s) * (1.f / D); float s2 = 0.f;
#pragma unroll
        for (int j = 0; j < 4; ++j) { v[j] = v[j] - mean; s2 += (v[j].x * v[j].x + v[j].y * v[j].y) + (v[j].z * v[j].z + v[j].w * v[j].w); }
        const float rstd = 1.f / sqrtf(wave_sum(s2) * (1.f / D) + LN_EPS);
        GAS v2u* o8 = (GAS v2u*)(XBo + (size_t)m * D) + lane;
#pragma unroll
        for (int j = 0; j < 4; ++j) {
            v[j] = v[j] * rstd * g4[j] + b4[j]; __builtin_nontemporal_store(v[j], (f32x4*)(xw + 64 * j)); v2u o; o.x = pk2(v[j].x, v[j].y); o.y = pk2(v[j].z, v[j].w); o8[64 * j] = o; }
    }
    __syncthreads();
    if (more && (sub & 2)) weight_prep(F, l + 1);
}

__device__ __forceinline__ void phase_attention(Frame& F, int l) {
    const attn_body::AttnTensors AT{(const attn_body::bf16*)(F.ws + WS_AQKV), (const attn_body::bf16*)(F.ws + WS_AQKV) + 512, (const attn_body::bf16*)(F.ws + WS_AQKV) + 1024,
                                    (attn_body::bf16*)(F.ws + WS_YTALL) + (size_t)2 * T * 512, (const float*)(F.ws + WS_FTAB)};
    volatile LAS unsigned* NEXT = (volatile LAS unsigned*)(F.lds + LDSCTL_OFF + 64);
    unsigned* head = (unsigned*)(F.ctl + CW_AQ + 64 * l);
    if (F.tid == 0) NEXT[0] = __hip_atomic_fetch_add(head, 1u, RLX_AGENT);
    __syncthreads();
    int idx = __builtin_amdgcn_readfirstlane((int)NEXT[0]);
#pragma unroll 1
    while (idx < 1024) {
        unsigned nxt = 0u;
        if (F.tid == 0) nxt = __hip_atomic_fetch_add(head, 1u, RLX_AGENT);
        const int qb = 15 - (idx >> 6), bh = idx & 63;
        attn_body::attn_unit<8>(bh >> 3, bh & 7, qb, AT.Q, AT.K, AT.V, AT.O, AT.F, (char*)F.ldsg, F.tid);
        if (F.tid == 0) NEXT[0] = nxt;
        __syncthreads();
        idx = __builtin_amdgcn_readfirstlane((int)NEXT[0]);
        __syncthreads();
    }
}

__global__ void __launch_bounds__(NWAVES * 64, 2) mega_fwd(Args args) {
    extern __shared__ __attribute__((aligned(16))) unsigned char lds[];
    Frame F;
    F.lds = (LAS unsigned char*)lds; F.ldsg = lds;
    const int wave_s = __builtin_amdgcn_readfirstlane((int)threadIdx.x >> 6);
    F.tid = wave_s * 64 + lane_id(); F.lane = F.tid & 63; F.wave = wave_s;
    const int G_s = gridDim.x, bx_s = blockIdx.x, vcu_s = (G_s % 8 == 0) ? (bx_s % 8) * (G_s / 8) + bx_s / 8 : bx_s;
    F.G = G_s; F.bx = bx_s; F.vcu = vcu_s;
    F.ws = args.ws; F.ctl = (gu32*)(args.ws + WS_CTL); F.out = args.out; F.ka = (KArgs)__builtin_amdgcn_kernarg_segment_ptr();
    volatile LAS unsigned* MISC = (volatile LAS unsigned*)(F.lds + MISC_OFF);
    for (int u = F.tid; u < (LDS_BYTES - LDSCTL_OFF) / 4; u += NWAVES * 64) ((LAS unsigned*)(F.lds + LDSCTL_OFF))[u] = 0u;
    __syncthreads();
    const int lo = args.ph_lo, hi = args.ph_hi, sub = args.sub; F.dup = sub & 0xE0;
    XcdBarrier bar; bar.bar = (unsigned*)(F.ctl + CW_BAR); bar.x = 0; bar.st = nullptr;
    if (hi - lo > 1) bar = xcd_barrier_post((unsigned*)(F.ctl + CW_BAR), MISC + 8, wave_s == 0 && lane_id() == 0);
#ifndef PH_MASK
#define PH_MASK 0x3fff
#endif
#define HAS(j) (((PH_MASK) >> (j)) & 1)
#ifndef DOUBLE_BAR
#define DOUBLE_BAR 0
#endif

#define IN(k) (lo <= (k) && (k) < hi)
#define SEAM(k) do { if (IN(k) && IN((k) + 1)) { XcdBarrier b2_ = bar; asm volatile("" : "+s"(b2_.bar)); asm volatile("" : "+s"(b2_.x)); xcd_barrier(b2_, wave_s == 0 && lane_id() == 0); if (DOUBLE_BAR) xcd_barrier(b2_, wave_s == 0 && lane_id() == 0); } } while (0)
#define FRESH() do { int t_ = wave_s * 64 + lane_id(); asm volatile("" : "+v"(t_)); F.tid = t_; F.lane = t_ & 63; F.wave = wave_s; \
        int g_ = G_s, b_ = bx_s, v_ = vcu_s; asm volatile("" : "+s"(g_), "+s"(b_), "+s"(v_)); F.G = g_; F.bx = b_; F.vcu = v_; \
        unsigned char* w_ = args.ws; asm volatile("" : "+s"(w_)); F.ws = w_; ws = w_; F.ctl = (gu32*)(w_ + WS_CTL); float* o_ = args.out; asm volatile("" : "+s"(o_)); F.out = o_; } while (0)
    unsigned char* ws = args.ws;
    if (HAS(13) && IN(0)) { FRESH(); phase_p0(F); SEAM(0); }
#pragma unroll 1
    for (int l = 0; l < NL; ++l) {
        const int pb = 1 + l * NPH_LAYER;
        if (HAS(0) && IN(pb + 0)) { FRESH(); small_gates_mfma(F, l);
            pg8::Gemm g{(const pg8::bf16_t*)(ws + WS_XB), (const pg8::bf16_t*)(ws + WS_WIN), 1024, 1024, 1024}; pg8::StaticOrder S; S.init(T, NIN, F.G, F.bx);
            EpiInProj E{ws, F.ka->in[I_b_in] + (size_t)l * INTOT};
            pg8::gemm_phase<EpiInProj, pg8::StaticOrder, true>(F.lds + RING_OFF, g, S, E, F.tid);
            SEAM(pb + 0);
        }
        if (HAS(1) && IN(pb + 1)) { FRESH(); phase_prep2(F, l); SEAM(pb + 1); }
        if (HAS(2) && IN(pb + 2)) { FRESH();
#ifndef P2_NO_A
            if (sub & 1) mlstm_pass1_all(F);
#endif
#ifndef P2_NO_B
            if (sub & 2) { pg8::Gemm g{(const pg8::bf16_t*)(ws + WS_S5A), (const pg8::bf16_t*)(ws + WS_S5ALL + (size_t)l * S5_LAYER_BYTES + 20 * MiB), 512, S5K, 512}; SchedS5E S{F.vcu}; EpiS5E E{(float*)(ws + WS_EBUF)};
              pg8::gemm_phase<EpiS5E, SchedS5E, true>(F.lds + RING_OFF, g, S, E, F.tid); }
            __syncthreads();
#endif
#ifndef P2_NO_C
            if (sub & 4) phase_attention(F, l);
#endif
            SEAM(pb + 2);
        }
        if (HAS(3) && IN(pb + 3)) { FRESH(); phase_scans(F, l, (sub & 0x10) != 0); SEAM(pb + 3); }
        if (HAS(4) && IN(pb + 4)) { FRESH();
            mlstm_pass3_all(F, l);
            { pg8::Gemm g{(const pg8::bf16_t*)(ws + WS_S5A), (const pg8::bf16_t*)(ws + WS_S5ALL + (size_t)l * S5_LAYER_BYTES), S5K, S5K, S5K}; SchedS5Y S{F.vcu}; EpiS5Y E{(bf16*)(ws + WS_YS1)};
              pg8::gemm_phase<EpiS5Y, SchedS5Y, true>(F.lds + RING_OFF, g, S, E, F.tid); }
            SEAM(pb + 4);
        }
        if (HAS(5) && IN(pb + 5)) { FRESH();            pg8::Gemm g{(const pg8::bf16_t*)(ws + WS_YS1), (const pg8::bf16_t*)(ws + WS_WGLU), 512, 512, 512}; pg8::StaticOrder S; S.init(T, 512, F.G, F.bx);
            EpiGlu E{(const bf16*)(ws + WS_YS1), (bf16*)(ws + WS_YTALL) + (size_t)T * 512, F.ka->in[I_s5_b_glu] + (size_t)l * 512};
            pg8::gemm_phase<EpiGlu, pg8::StaticOrder, true>(F.lds + RING_OFF, g, S, E, F.tid);
            SEAM(pb + 5);
        }
        if (HAS(6) && IN(pb + 6)) { FRESH();            pg8::Gemm g{(const pg8::bf16_t*)(ws + WS_YTALL), (const pg8::bf16_t*)(ws + WS_WBR), 512, 512, 512}; SchedMerge S{F.vcu, F.G};
            EpiMerge E{(const bf16*)(ws + WS_GATE), (bf16*)(ws + WS_MIXED)};
            pg8::gemm_phase<EpiMerge, SchedMerge, true>(F.lds + RING_OFF, g, S, E, F.tid);
            SEAM(pb + 6);
        }
        if (HAS(7) && IN(pb + 7)) { FRESH();
            pg8::Gemm g{(const pg8::bf16_t*)(ws + WS_MIXED), (const pg8::bf16_t*)(ws + WS_WOUT), 1024, 1024, 1024}; pg8::StaticOrder S; S.init(T, 1024, F.G, F.bx);
            EpiOutProj E{l == 0 ? F.ka->in[I_x] : (const float*)F.out, F.out};
            pg8::gemm_phase<EpiOutProj, pg8::StaticOrder, true>(F.lds + RING_OFF, g, S, E, F.tid);
            SEAM(pb + 7);
        }
        if (HAS(8) && IN(pb + 8)) { FRESH(); phase_ln1_route(F, l, (sub & 0x10) != 0); SEAM(pb + 8); }
        if (HAS(9) && IN(pb + 9)) { FRESH(); phase_dispatch(F, l); SEAM(pb + 9); }
        if (HAS(10) && IN(pb + 10)) { FRESH();moe_tables(F, l); moe_stage_rows(F);
            pg8::Gemm g{(const pg8::bf16_t*)(ws + WS_XB), (const pg8::bf16_t*)(ws + WS_WGU), 1024, 1024, 1024}; SchedMoeG S{(const LAS int*)(F.lds + LDSX_OFF + 20480), (const LAS int*)(F.lds + LDSX_OFF), F.vcu, F.G};
            EpiGateUp E{(bf16*)(ws + WS_HB)};
            pg8::gemm_phase<EpiGateUp, SchedMoeG, true>(F.lds + RING_OFF, g, S, E, F.tid);
            SEAM(pb + 10);
        }
        if (HAS(11) && IN(pb + 11)) { FRESH();            moe_tables(F, l);
            pg8::Gemm g{(const pg8::bf16_t*)(ws + WS_HB), (const pg8::bf16_t*)(ws + WS_WDN), 512, 512, 512}; SchedMoe S{(const LAS int*)(F.lds + LDSX_OFF + 20480), F.vcu, F.G};
            EpiDown E{(bf16*)(ws + WS_YB), (const int*)(ws + WS_TOKPOS), (const float*)(ws + WS_TOKPOS + 524288)};
            pg8::gemm_phase<EpiDown, SchedMoe, true>(F.lds + RING_OFF, g, S, E, F.tid);
            SEAM(pb + 11);
        }
        if (HAS(12) && IN(pb + 12)) { FRESH(); phase_ln2(F, l, sub); SEAM(pb + 12); }
    }
#undef IN
#undef SEAM
}

extern "C" void kernel_launch(void* const* d_in, const int* in_sizes, int n_in, void* d_out, int out_size, void* d_ws, size_t ws_size, hipStream_t stream) {
    static int grid = 0;
    if (grid == 0) {
        if (n_in != 29 || in_sizes[0] != T * D || out_size != T * D || ws_size < WS_END) { fprintf(stderr, "kernel_launch: unexpected shapes / workspace (n_in %d, ws %zu < %zu)\n", n_in, ws_size, (size_t)WS_END); grid = -1; return; }
        int dev = 0, cus = 0;
        if (hipGetDevice(&dev) != hipSuccess || hipDeviceGetAttribute(&cus, hipDeviceAttributeMultiprocessorCount, dev) != hipSuccess) { grid = -1; return; }
        if (hipFuncSetAttribute((const void*)mega_fwd, hipFuncAttributeMaxDynamicSharedMemorySize, LDS_BYTES) != hipSuccess) { fprintf(stderr, "kernel_launch: hipFuncSetAttribute failed\n"); grid = -1; return; }
        int per_cu = 0;
        (void)hipOccupancyMaxActiveBlocksPerMultiprocessor(&per_cu, (const void*)mega_fwd, NWAVES * 64, LDS_BYTES);
        (void)hipGetLastError();
        if (cus != 256 || per_cu < 1) { fprintf(stderr, "kernel_launch: needs 256 CUs with one resident workgroup each (cus %d, per_cu %d)\n", cus, per_cu); grid = -1; return; }
        grid = cus;
    }
    if (grid < 0) return;
    (void)hipMemsetAsync((char*)d_ws + WS_CTL, 0, CTL_ZERO_BYTES, stream);
    Args a{};
    for (int i = 0; i < 29; ++i) a.in[i] = (const float*)d_in[i];
    a.out = (float*)d_out; a.ws = (unsigned char*)d_ws;
    a.sub = 0xF; a.pad = 0;
#if MK_ONE_LAUNCH
    a.ph_lo = 0; a.ph_hi = NPHASES;
    hipLaunchKernelGGL(mega_fwd, dim3(grid), dim3(NWAVES * 64), LDS_BYTES, stream, a);
#else
#ifndef PROBE_KIND
#define PROBE_KIND -1
#endif
#ifndef PROBE_REPS
#define PROBE_REPS 1
#endif
#ifndef PROBE_SUB
#define PROBE_SUB -1
#endif
    for (int p = 0; p < NPHASES; ++p) { a.ph_lo = p; a.ph_hi = p + 1; a.sub = 0xF;
        const int kind = (p == 0) ? 13 : (p - 1) % NPH_LAYER;
        if (kind == PROBE_KIND && PROBE_SUB != -1 && (PROBE_SUB & 0x100)) {   }
        hipLaunchKernelGGL(mega_fwd, dim3(grid), dim3(NWAVES * 64), LDS_BYTES, stream, a);
        if (kind == PROBE_KIND) { a.sub = PROBE_SUB; for (int r = 0; r < PROBE_REPS; ++r) hipLaunchKernelGGL(mega_fwd, dim3(grid), dim3(NWAVES * 64), LDS_BYTES, stream, a); }
    }
#endif
}
```

```cpp
#include <hip/hip_runtime.h>
#include <hip/hip_bf16.h>
#include <cstdio>
#include <cstdint>
#include <cmath>

#ifndef MK_ONE_LAUNCH
#define MK_ONE_LAUNCH 1
#endif

namespace pg8 {
#define PG8_LAS __attribute__((address_space(3)))
typedef unsigned short bf16_t;
typedef short bf16x8 __attribute__((ext_vector_type(8)));
typedef float f32x4 __attribute__((ext_vector_type(4)));
typedef float f32x2 __attribute__((ext_vector_type(2)));
typedef unsigned u32x4 __attribute__((ext_vector_type(4)));
typedef unsigned u32x2 __attribute__((ext_vector_type(2)));
constexpr int BM = 256, BK = 64, HALF = 128, HTB = HALF * BK * 2  , STAGE_BYTES = 8 * HTB, NXCD = 8, WGM = 8;

__host__ __device__ __forceinline__ int lds_byte(int r, int c) { const int st = (r >> 4) * 2 + (c >> 5), rr = r & 15, cc = c & 31, ob = rr * 64 + cc * 2; return st * 1024 + (ob ^ (((ob >> 9) & 1) << 5)); }
__host__ __device__ __forceinline__ void stage_rc(int b, int& R, int& C) { const int st = b / 1024, sb = b % 1024, swz = sb ^ (((sb >> 9) & 1) << 5); R = (st >> 1) * 16 + swz / 64; C = (st & 1) * 32 + (swz % 64) / 2; }
__host__ __device__ __forceinline__ int perm32(int rho) { const int n = rho >> 4, i = rho & 15; return 8 * (i >> 2) + 4 * n + (i & 3); }

struct Unit { int pm, pn; };
struct Gemm { const bf16_t* A; const bf16_t* Bt; int K, lda, ldb; };

struct StaticOrder {
    static constexpr bool GATHER = false;
    int nM, nN, nwg, G, c;
    __host__ __device__ void init(int M, int N, int G_, int c_) { nM = M / BM; nN = N / BM; nwg = nM * nN; G = G_; c = c_; }
    __host__ __device__ bool next(int i, Unit& u) const {
        const long L = (long)i * G + c; if (L >= nwg) return false;
        int wgid = (int)L; { const int q = nwg / NXCD, r = nwg % NXCD, xcd = wgid % NXCD, off = wgid / NXCD; wgid = (xcd < r ? xcd * (q + 1) : r * (q + 1) + (xcd - r) * q) + off; }
        const int nig = WGM * nN, gid = wgid / nig, fm = gid * WGM, gsz = (nM - fm) < WGM ? (nM - fm) : WGM;
        u.pm = fm + ((wgid % nig) % gsz); u.pn = (wgid % nig) / gsz; return true;
    }
};

__device__ __forceinline__ unsigned cvt_pk_bf16(float lo, float hi) { unsigned r; asm volatile("v_cvt_pk_bf16_f32 %0, %1, %2" : "=v"(r) : "v"(lo), "v"(hi)); return r; }

template <class Epi, class Sched, bool ALIGN_EPI = true>
__device__ __forceinline__ void gemm_phase(PG8_LAS unsigned char* lds, const Gemm g, const Sched& S, const Epi& E, const int tid  ) {
    const int wid = __builtin_amdgcn_readfirstlane(tid >> 6), lane = tid & 63, wr = wid >> 2, wc = wid & 3, fr = lane & 15, fq = lane >> 4;
    const int K = g.K, nt = K / BK;
    unsigned voffA[2], voffB[2];
#pragma unroll
    for (int i = 0; i < 2; ++i) { int R, C; stage_rc(tid * 16 + i * 8192, R, C); const int Rb = Epi::PERM ? ((R & ~31) + perm32(R & 31)) : R;
        voffA[i] = (unsigned)(R * g.lda + C) * 2u; voffB[i] = (unsigned)(Rb * g.ldb + C) * 2u; }
    unsigned cvo[2][2] = {{0u, 0u}, {0u, 0u}}, nvo[2][2] = {{0u, 0u}, {0u, 0u}}; int gR[2] = {0, 0}; unsigned gC[2] = {0u, 0u};
    if constexpr (Sched::GATHER) {
#pragma unroll
        for (int i = 0; i < 2; ++i) { int R, C; stage_rc(tid * 16 + i * 8192, R, C); gR[i] = R; gC[i] = (unsigned)C * 2u; }
    }
    const size_t kstep = (size_t)(BK * 2);
    const size_t hstepA = (size_t)HALF * g.lda * 2, hstepB = (size_t)HALF * g.ldb * 2;
    const size_t tstepA = 2 * hstepA, tstepB = 2 * hstepB;
    const unsigned ldsw = (unsigned)wid * 1024u;
    const int aoff = lds_byte(wr * 64 + fr, fq * 8), boff = lds_byte(wc * 32 + fr, fq * 8);
#define PG8_SA(b, h) (((b) * 2 + (h)) * HTB)
#define PG8_SB(b, h) ((4 + (b) * 2 + (h)) * HTB)
#define PG8_STAGE(bufoff, gbase, voff) do { _Pragma("unroll") for (int _i = 0; _i < 2; ++_i) \
        __builtin_amdgcn_global_load_lds((const unsigned*)((const char*)(gbase) + (voff)[_i]), (PG8_LAS unsigned*)(lds + (bufoff) + ldsw + _i * 8192), 16, 0, 0); } while (0)
#define PG8_LDA(dst, b, h) do { _Pragma("unroll") for (int m = 0; m < 4; ++m) _Pragma("unroll") for (int k = 0; k < 2; ++k) dst[m][k] = *(const PG8_LAS bf16x8*)(lds + PG8_SA(b, h) + aoff + m * 2048 + k * 1024); } while (0)
#define PG8_LDB(dst, b, h) do { _Pragma("unroll") for (int n = 0; n < 2; ++n) _Pragma("unroll") for (int k = 0; k < 2; ++k) dst[n][k] = *(const PG8_LAS bf16x8*)(lds + PG8_SB(b, h) + boff + n * 2048 + k * 1024); } while (0)
#define PG8_MMA(ai, bj, At, Bt) do { __builtin_amdgcn_s_setprio(1); _Pragma("unroll") for (int m = 0; m < 4; ++m) _Pragma("unroll") for (int n = 0; n < 2; ++n) _Pragma("unroll") for (int k = 0; k < 2; ++k) \
        acc[ai][bj][m][n] = __builtin_amdgcn_mfma_f32_16x16x32_bf16(Bt[n][k], At[m][k], acc[ai][bj][m][n], 0, 0, 0); __builtin_amdgcn_s_setprio(0); } while (0)
#define PG8_WAIT_V(n) asm volatile("s_waitcnt vmcnt(" #n ")" ::: "memory")
#define PG8_WAIT_L(n) asm volatile("s_waitcnt lgkmcnt(" #n ")" ::: "memory")
#define PG8_BAR __builtin_amdgcn_s_barrier()
#define PG8_SCHED __builtin_amdgcn_sched_barrier(0)
    Unit cur, nxt; int ui = 0;
    if (!S.next(0, cur)) return;
    f32x4 acc[2][2][4][2];
    float zf = 0.f; asm volatile("" : "+v"(zf));
#pragma unroll
    for (int a = 0; a < 2; ++a)
#pragma unroll
        for (int b = 0; b < 2; ++b)
#pragma unroll
            for (int m = 0; m < 4; ++m)
#pragma unroll
                for (int n = 0; n < 2; ++n) acc[a][b][m][n] = (f32x4){zf, zf, zf, zf};
    bf16x8 At[4][2], B0[2][2], B1[2][2];
    const char* cA = Sched::GATHER ? (const char*)g.A : (const char*)g.A + (size_t)cur.pm * tstepA; const char* cB = (const char*)g.Bt + (size_t)cur.pn * tstepB;
    if constexpr (Sched::GATHER) {
#pragma unroll
        for (int h = 0; h < 2; ++h)
#pragma unroll
            for (int i = 0; i < 2; ++i) cvo[h][i] = S.row_byte_off(0, 128 * h + gR[i]) + gC[i];
    }
#define PG8_STAGE_A(bufoff, gbase, h, vo) do { if constexpr (Sched::GATHER) { PG8_STAGE(bufoff, gbase, (vo)[h]); } else { PG8_STAGE(bufoff, (gbase) + (h) * hstepA, voffA); } } while (0)
    PG8_STAGE(PG8_SB(0, 0), cB, voffB); PG8_STAGE(PG8_SB(0, 1), cB + hstepB, voffB); PG8_STAGE_A(PG8_SA(0, 0), cA, 0, cvo); PG8_STAGE_A(PG8_SA(0, 1), cA, 1, cvo);
    if (wr == 1) PG8_BAR;
    PG8_WAIT_V(2); PG8_BAR;
    PG8_STAGE(PG8_SB(1, 0), cB + kstep, voffB); PG8_STAGE_A(PG8_SA(1, 0), cA + kstep, 0, cvo); PG8_STAGE(PG8_SB(1, 1), cB + hstepB + kstep, voffB);
    PG8_WAIT_V(6); PG8_BAR;
    for (;;) {
        const bool has_next = S.next(ui + 1, nxt);
        const char* nA = (has_next && !Sched::GATHER) ? (const char*)g.A + (size_t)nxt.pm * tstepA : cA; const char* nB = has_next ? (const char*)g.Bt + (size_t)nxt.pn * tstepB : cB;
        if constexpr (Sched::GATHER) {
#pragma unroll
            for (int h = 0; h < 2; ++h)
#pragma unroll
                for (int i = 0; i < 2; ++i) nvo[h][i] = has_next ? S.row_byte_off(ui + 1, 128 * h + gR[i]) + gC[i] : cvo[h][i];
        }
        for (int t = 0; t < nt; t += 2) {
            const bool last = (t == nt - 2);
            const char* a1 = cA + (size_t)(t + 1) * kstep;
            const char* a2 = last ? nA : cA + (size_t)(t + 2) * kstep; const char* b2 = last ? nB : cB + (size_t)(t + 2) * kstep;
            const char* a3 = a2 + kstep; const char* b3 = b2 + kstep;
            unsigned vo2[2][2];
#pragma unroll
            for (int h = 0; h < 2; ++h)
#pragma unroll
                for (int i = 0; i < 2; ++i) vo2[h][i] = last ? nvo[h][i] : cvo[h][i];
            PG8_LDB(B0, 0, 0); PG8_LDB(B1, 0, 1); PG8_SCHED; PG8_LDA(At, 0, 0); PG8_STAGE_A(PG8_SA(1, 1), a1, 1, cvo);
            PG8_WAIT_V(8); PG8_WAIT_L(0); PG8_BAR; PG8_MMA(0, 0, At, B0); PG8_MMA(0, 1, At, B1); PG8_BAR; PG8_SCHED;
            PG8_LDA(At, 0, 1); PG8_STAGE(PG8_SB(0, 0), b2, voffB); PG8_STAGE(PG8_SB(0, 1), b2 + hstepB, voffB); PG8_STAGE_A(PG8_SA(0, 0), a2, 0, vo2);
            PG8_WAIT_V(8); PG8_WAIT_L(0); PG8_BAR; PG8_MMA(1, 0, At, B0); PG8_MMA(1, 1, At, B1); PG8_BAR; PG8_SCHED;
            PG8_LDB(B0, 1, 0); PG8_LDB(B1, 1, 1); PG8_SCHED; PG8_LDA(At, 1, 0); PG8_STAGE_A(PG8_SA(0, 1), a2, 1, vo2);
            PG8_WAIT_V(8); PG8_WAIT_L(0); PG8_BAR; PG8_MMA(0, 0, At, B0); PG8_MMA(0, 1, At, B1); PG8_BAR; PG8_SCHED;
            PG8_LDA(At, 1, 1); PG8_STAGE(PG8_SB(1, 0), b3, voffB); PG8_STAGE(PG8_SB(1, 1), b3 + hstepB, voffB); PG8_STAGE_A(PG8_SA(1, 0), a3, 0, vo2);
            PG8_WAIT_V(8); PG8_WAIT_L(0); PG8_BAR; PG8_MMA(1, 0, At, B0); PG8_MMA(1, 1, At, B1); PG8_BAR; PG8_SCHED;
        }
        if constexpr (ALIGN_EPI) { if (wr == 0) PG8_BAR; }
        E(acc, cur, wr, wc, fr, fq);
        if (!has_next) break;
        if (E.reset_after(cur)) {
#pragma unroll
        for (int a = 0; a < 2; ++a)
#pragma unroll
            for (int b = 0; b < 2; ++b)
#pragma unroll
                for (int m = 0; m < 4; ++m)
#pragma unroll
                    for (int n = 0; n < 2; ++n) acc[a][b][m][n] = (f32x4){zf, zf, zf, zf};
        }
        cur = nxt; cA = nA; cB = nB; ++ui;
        if constexpr (Sched::GATHER) {
#pragma unroll
            for (int h = 0; h < 2; ++h)
#pragma unroll
                for (int i = 0; i < 2; ++i) cvo[h][i] = nvo[h][i];
        }
        if constexpr (ALIGN_EPI) { if (wr == 1) PG8_BAR; }
    }
    PG8_WAIT_V(0);
    if constexpr (!ALIGN_EPI) { if (wr == 0) PG8_BAR; }
    PG8_BAR;
#undef PG8_SA
#undef PG8_SB
#undef PG8_STAGE
#undef PG8_STAGE_A
#undef PG8_LDA
#undef PG8_LDB
#undef PG8_MMA
#undef PG8_WAIT_V
#undef PG8_WAIT_L
#undef PG8_BAR
#undef PG8_SCHED
}
}

#include <hip/hip_bf16.h>
#include <cmath>
namespace attn_body {
using bf16=__hip_bfloat16;
using bf16x8=__attribute__((ext_vector_type(8)))short;
using s16x4=__attribute__((ext_vector_type(4)))short;
using f32x16=__attribute__((ext_vector_type(16)))float;
using u32x4=__attribute__((ext_vector_type(4)))unsigned;
using f32x4v=__attribute__((ext_vector_type(4)))float;
constexpr int BATCH=8,NHEAD=8,SEQ=4096,D=64,DM=1536,DMO=512;
constexpr int NW=8,QBLK=32,QB=QBLK*NW,KVBLK=64,NQB=SEQ/QB;
constexpr int ATTN_PITCH=DM, ATTN_UNIT_ROWS=QB;
__device__ __forceinline__ int crow(int r,int hi){return (r&3)+8*(r>>2)+4*hi;}
#define SBAR() __builtin_amdgcn_sched_barrier(0)
__device__ __forceinline__ void cmask(f32x16&p0,f32x16&p1,int jb,int qrel,int hi){
  const float NEG=-INFINITY; int kb=64*jb+4*hi;
  #pragma unroll
  for(int r=0;r<16;++r){int kv=kb+(r&3)+8*(r>>2); if(kv>qrel)p0[r]=NEG; if(kv+32>qrel)p1[r]=NEG;}
}

constexpr int NSLOT=3, SLOTB=8192;
constexpr int LDS_K=0, LDS_V=NSLOT*SLOTB, LDS_WS=2*NSLOT*SLOTB, LDS_OST=LDS_WS+NW*64*4, LDS_F=LDS_OST+NW*4096, LDS_Q=LDS_F+SEQ*4, LDS_BYTES=LDS_Q+NW*4096;
constexpr float PRUNE2=64.f;
constexpr float C2=0.125f*1.4426950408889634f;
__device__ __forceinline__ void glds16(const void*gsrc,unsigned lds_dst){unsigned keep;
  asm volatile("s_mov_b32 %0, m0\n\ts_mov_b32 m0, %2\n\ts_nop 0\n\tglobal_load_lds_dwordx4 %1, off\n\ts_mov_b32 m0, %0":"=&s"(keep):"v"(gsrc),"s"(lds_dst):"memory");}
__device__ __forceinline__ void glds16s(const void*sbase,unsigned voff,unsigned lds_dst){unsigned keep;
  asm volatile("s_mov_b32 %0, m0\n\ts_mov_b32 m0, %3\n\ts_nop 0\n\tglobal_load_lds_dwordx4 %1, %2\n\ts_mov_b32 m0, %0":"=&s"(keep):"v"(voff),"s"(sbase),"s"(lds_dst):"memory");}
__device__ __forceinline__ float max3f(float a,float b,float c){float r;asm("v_max3_f32 %0, %1, %2, %3":"=v"(r):"v"(a),"v"(b),"v"(c));return r;}
__device__ __forceinline__ float max2f(float a,float b){float r;asm("v_max_f32_e32 %0, %1, %2":"=v"(r):"v"(a),"v"(b));return r;}
__device__ __forceinline__ float fadd_s(float a,float b){float r;asm("v_add_f32_e32 %0, %1, %2":"=v"(r):"v"(a),"v"(b));return r;}
__device__ __forceinline__ float fsub_s(float a,float b){float r;asm("v_sub_f32_e32 %0, %1, %2":"=v"(r):"v"(a),"v"(b));return r;}
typedef float f32x2_t __attribute__((ext_vector_type(2))); typedef __bf16 bf16x2_t __attribute__((ext_vector_type(2)));
__device__ __forceinline__ unsigned cvtpk_s(float lo,float hi){f32x2_t v={lo,hi};bf16x2_t b=__builtin_convertvector(v,bf16x2_t);return __builtin_bit_cast(unsigned,b);}
#define WAIT_BAR(N) asm volatile("s_waitcnt vmcnt(" #N ") lgkmcnt(0)\n\ts_barrier":::"memory")

__device__ __forceinline__ void qkt(f32x16&p0,f32x16&p1,const char*Kslot,const bf16x8*qr,int r32,int hi){
  const char*kb=Kslot+hi*1024+r32*16;
  #pragma unroll
  for(int d0=0;d0<4;++d0){
    const bf16x8 b0=*reinterpret_cast<const bf16x8*>(kb+d0*2048);
    const bf16x8 b1=*reinterpret_cast<const bf16x8*>(kb+d0*2048+512);
    {p0=__builtin_amdgcn_mfma_f32_32x32x16_bf16(b0,qr[d0],p0,0,0,0);p1=__builtin_amdgcn_mfma_f32_32x32x16_bf16(b1,qr[d0],p1,0,0,0);}}
}
typedef __attribute__((address_space(3))) const char* lds_cptr;
typedef short v4i16_t __attribute__((ext_vector_type(4)));
__device__ __forceinline__ void kload8(bf16x8*kf,lds_cptr kp){
  kf[0]=*(const __attribute__((address_space(3))) bf16x8*)(kp);      kf[1]=*(const __attribute__((address_space(3))) bf16x8*)(kp+512);
  kf[2]=*(const __attribute__((address_space(3))) bf16x8*)(kp+2048); kf[3]=*(const __attribute__((address_space(3))) bf16x8*)(kp+2560);
  kf[4]=*(const __attribute__((address_space(3))) bf16x8*)(kp+4096); kf[5]=*(const __attribute__((address_space(3))) bf16x8*)(kp+4608);
  kf[6]=*(const __attribute__((address_space(3))) bf16x8*)(kp+6144); kf[7]=*(const __attribute__((address_space(3))) bf16x8*)(kp+6656);
}
__device__ __forceinline__ void kload2(bf16x8*kf,lds_cptr kp,int j){ kf[2*j]=*(const __attribute__((address_space(3))) bf16x8*)(kp+j*2048); kf[2*j+1]=*(const __attribute__((address_space(3))) bf16x8*)(kp+j*2048+512); }
__device__ __forceinline__ s16x4 vtr(lds_cptr p){ return __builtin_bit_cast(s16x4,__builtin_amdgcn_ds_read_tr16_b64_v4i16((__attribute__((address_space(3))) v4i16_t*)p)); }
__device__ __forceinline__ float rowmax(const f32x16&p0,const f32x16&p1){
  float a=max3f(p0[0],p0[1],p1[0]),b=max3f(p0[2],p0[3],p1[1]);a=max3f(a,p1[2],p1[3]);
  #pragma unroll
  for(int r=4;r<16;r+=4){a=max3f(a,p0[r],p0[r+1]);b=max3f(b,p0[r+2],p0[r+3]);a=max3f(a,p1[r],p1[r+1]);b=max3f(b,p1[r+2],p1[r+3]);}
  const float m=max2f(a,b);
  auto rr=__builtin_amdgcn_permlane32_swap(__float_as_uint(m),__float_as_uint(m),false,false);
  return max2f(__uint_as_float(rr[0]),__uint_as_float(rr[1]));
}
__device__ __forceinline__ void pv(f32x16*o,int vb,bf16x8 pa0,bf16x8 pa1,bf16x8 pa2,bf16x8 pa3){
  #pragma unroll
  for(int d0=0;d0<2;++d0){s16x4 lo[4],hi[4];
    #pragma unroll
    for(int ks=0;ks<4;++ks){
      asm volatile("ds_read_b64_tr_b16 %0,%1 offset:%c2":"=&v"(lo[ks]):"v"(vb),"i"(d0*4096+ks*1024):"memory");
      asm volatile("ds_read_b64_tr_b16 %0,%1 offset:%c2":"=&v"(hi[ks]):"v"(vb),"i"(d0*4096+ks*1024+512):"memory");}
    asm volatile("s_waitcnt lgkmcnt(0)":::"memory");SBAR();
    #define PK(k) (bf16x8){lo[k][0],lo[k][1],lo[k][2],lo[k][3],hi[k][0],hi[k][1],hi[k][2],hi[k][3]}
    o[d0]=__builtin_amdgcn_mfma_f32_32x32x16_bf16(pa0,PK(0),o[d0],0,0,0);
    o[d0]=__builtin_amdgcn_mfma_f32_32x32x16_bf16(pa1,PK(1),o[d0],0,0,0);
    o[d0]=__builtin_amdgcn_mfma_f32_32x32x16_bf16(pa2,PK(2),o[d0],0,0,0);
    o[d0]=__builtin_amdgcn_mfma_f32_32x32x16_bf16(pa3,PK(3),o[d0],0,0,0);
    #undef PK
  }
}

#ifndef ATTN_STORE16
#define ATTN_STORE16(p,v) (*(u32x4*)(p)=(v))
#endif
template<int THRL> __device__ __forceinline__ void attn_unit(int b,int h,int qb,const bf16*Q,const bf16*__restrict__ K,const bf16*__restrict__ V,bf16*O,const float*__restrict__ Ftab,char*shm,const int tid){
  const int lane=tid&63,r32=lane&31,hi=lane>>5; const int wid=__builtin_amdgcn_readfirstlane(tid>>6);
  const long rowbase=(long)b*SEQ; const int q0=qb*QB;
  const bf16*Qw=Q+(rowbase+q0+wid*QBLK)*DM+h*D;
  const float*Fh=Ftab+(long)(b*NHEAD+h)*SEQ;
  int ts=0;
  { const int NT0=(q0+QB)/KVBLK; const float fq0=Fh[q0]; const float fk=Fh[(lane<NT0?lane:NT0-1)*KVBLK+KVBLK-1];
    const unsigned long long mk=__ballot(lane<NT0&&(fq0-fk>=-PRUNE2)); const int first=mk?(int)__builtin_ctzll(mk):0; ts=first&~1; if(ts>NT0-4)ts=NT0-4; ts=__builtin_amdgcn_readfirstlane(ts); }
  const bf16*Kh=K+(rowbase+(long)ts*KVBLK)*DM+h*D,*Vh=V+(rowbase+(long)ts*KVBLK)*DM+h*D;
  const unsigned lds0=(unsigned)(uintptr_t)shm;
  float*wsf=(float*)(shm+LDS_WS)+wid*64;
  const unsigned koff=(unsigned)(lane*DM+wid*8)*2u;
  const unsigned voff=(unsigned)((16*(wid&3)+(lane>>2))*DM+(wid>>2)*32+(lane&3)*8)*2u;
  const unsigned kdst=lds0+LDS_K+wid*1024, vdst=lds0+LDS_V+wid*1024;
  #define DMA_K(t,slot) glds16s(Kh+(long)(t)*KVBLK*DM,koff,(unsigned)__builtin_amdgcn_readfirstlane(kdst+(slot)))
  #define DMA_V(t,slot) glds16s(Vh+(long)(t)*KVBLK*DM,voff,(unsigned)__builtin_amdgcn_readfirstlane(vdst+(slot)))
  const int vb0=(int)(lds0+LDS_V)+((lane>>4)&1)*32+(lane&3)*8+(4*hi+((lane&15)>>2))*64;
  const char*Kbase=shm+LDS_K; bf16x8 kf[8];
  const lds_cptr shm3=(lds_cptr)shm; const lds_cptr kp0=shm3+LDS_K+hi*1024+r32*16; const lds_cptr vp0=shm3+LDS_V+((lane>>4)&1)*32+(lane&3)*8+(4*hi+((lane&15)>>2))*64;
  const int NT=(q0+QB)/KVBLK-ts;
  { glds16s(Fh,(unsigned)(lane*16+wid*1024),(unsigned)__builtin_amdgcn_readfirstlane(lds0+LDS_F+wid*1024));
    glds16s(Fh,(unsigned)(lane*16+(wid+8)*1024),(unsigned)__builtin_amdgcn_readfirstlane(lds0+LDS_F+(wid+8)*1024)); }
  const float fq2=Fh[q0+wid*QBLK+r32];
  DMA_K(0,0);DMA_V(0,0);DMA_K(1,SLOTB);
  const lds_cptr qs=(lds_cptr)shm+LDS_Q+wid*4096+(hi*32+r32)*16;
  #pragma unroll
  for(int d0=0;d0<4;++d0)*(__attribute__((address_space(3))) bf16x8*)(qs+d0*1024)=*reinterpret_cast<const bf16x8*>(&Qw[(long)r32*DM+d0*16+hi*8]);
  #define QF(k) (*(const __attribute__((address_space(3))) bf16x8*)(qs+(k)*1024))
  float mhat=-fq2,nm=fq2,l_reg=0.f;f32x16 o[2];o[0]=f32x16{};o[1]=f32x16{};
  const lds_cptr fl0=(lds_cptr)shm+LDS_F+hi*16+ts*256;
  #define FINIT1(C0,t,o_) do{ const __attribute__((address_space(3))) f32x4v* fp_=(const __attribute__((address_space(3))) f32x4v*)(fl0+(t)*256+(o_)); \
    _Pragma("unroll") for(int j_=0;j_<4;++j_){ const f32x4v a_=fp_[2*j_]; \
      C0[4*j_]=nm-a_[0]; C0[4*j_+1]=nm-a_[1]; C0[4*j_+2]=nm-a_[2]; C0[4*j_+3]=nm-a_[3]; } }while(0)
  #define FINIT(C0,C1,t) do{ FINIT1(C0,t,0); FINIT1(C1,t,128); }while(0)
  const int qrel=wid*QBLK+r32;
  #define CMASK(P0,P1,t) do{int jb_=(t)-(NT-4); if(jb_>=0)cmask(P0,P1,jb_,qrel,hi);}while(0)
  bool resc=false;
  #define START(P0,P1) do{ const float rm=rowmax(P0,P1); resc=false; \
    { const float dl=rm; mhat=fadd_s(mhat,dl); \
      _Pragma("unroll") for(int r=0;r<16;++r){P0[r]=fsub_s(P0[r],dl);P1[r]=fsub_s(P1[r],dl);} \
      nm=-mhat; } \
    _Pragma("unroll") for(int r=0;r<16;++r)P0[r]=__builtin_amdgcn_exp2f(P0[r]); }while(0)
  #define RESC() do{ if(resc){ asm volatile("s_waitcnt lgkmcnt(0)":::"memory"); \
      _Pragma("unroll") for(int d_=0;d_<2;++d_) _Pragma("unroll") for(int r=0;r<16;++r)o[d_][r]*=wsf[crow(r,hi)]; } }while(0)
  f32x16 pA0,pA1,pB0,pB1;
  int sl_prev=0,sl_cur=0,sl_next=SLOTB;
  #define ROT() do{sl_prev=sl_cur;sl_cur=sl_next;sl_next=(sl_next==(NSLOT-1)*SLOTB)?0:sl_next+SLOTB;}while(0)
  DMA_K(2,2*SLOTB);
  WAIT_BAR(3);
  { bf16x8 qr[4]; qr[0]=QF(0);qr[1]=QF(1);qr[2]=QF(2);qr[3]=QF(3); FINIT(pA0,pA1,0); qkt(pA0,pA1,Kbase,qr,r32,hi); }asm volatile("s_nop 15\n\ts_nop 7":"+v"(pA0),"+v"(pA1));CMASK(pA0,pA1,0);
  START(pA0,pA1);
  _Pragma("unroll") for(int r=0;r<16;++r)pA1[r]=__builtin_amdgcn_exp2f(pA1[r]);
  WAIT_BAR(0);
  DMA_K(3,0);DMA_V(1,SLOTB);
  ROT();
  kload8(kf,kp0+sl_cur);
  WAIT_BAR(2);
  s16x4 vlo[8],vhi[8]; u32x4 pw0,pw1,pw2,pw3;
  #define PKW(P,B) cvtpk_s(P[B],P[B+1])
  #define PAF(k) __builtin_bit_cast(bf16x8,pw##k)
  #define VFR(i) (bf16x8){vlo[i][0],vlo[i][1],vlo[i][2],vlo[i][3],vhi[i][0],vhi[i][1],vhi[i][2],vhi[i][3]}
  #define PIN(x) asm volatile("":"+v"(x))
  #define MX3(a,b,c) __builtin_fmaxf(__builtin_fmaxf((a),(b)),(c))
  #define GAPA(MF,A0,A1,A2,A3,W0,W1,PW) do{ MF; sacc+=A0; sacc+=A1; sacc+=A2; sacc+=A3; PIN(sacc); W0; W1; PIN(PW); SBAR(); }while(0)
  #define EX(v) __builtin_amdgcn_exp2f(v)
  #define GAPB(MF,X,B) do{ MF; X[B]=EX(X[B]); X[B+1]=EX(X[B+1]); X[B+2]=EX(X[B+2]); X[B+3]=EX(X[B+3]); PIN(X); SBAR(); }while(0)
  #define VRD(i) do{ vlo[i]=vtr(vp_+(((i)>>2)*4096+((i)&3)*1024)); vhi[i]=vtr(vp_+(((i)>>2)*4096+((i)&3)*1024+512)); }while(0)
  #define KRD(G,j) do{ if(G){ kload2(kf,kp0+sl_next,j); SBAR(); } }while(0)
  #define STEP(C0,C1,P0,P1,t,GK,GV,GL) do{ SBAR(); FINIT1(C0,t,0); bf16x8 qA_=QF(0),qB_=QF(1); SBAR(); \
    const lds_cptr vp_=vp0+sl_prev; \
    VRD(0); SBAR(); float sacc=(P0[0]+P0[1]); \
    GAPA(C0=__builtin_amdgcn_mfma_f32_32x32x16_bf16(kf[0],qA_,C0,0,0,0), P0[2],P0[3],P0[4],P0[5],     pw0[0]=PKW(P0,0), pw0[1]=PKW(P0,2), pw0); \
    FINIT1(C1,t,128); SBAR(); VRD(4); SBAR(); GAPA(C1=__builtin_amdgcn_mfma_f32_32x32x16_bf16(kf[1],qA_,C1,0,0,0), P0[6],P0[7],P0[8],P0[9],     pw0[2]=PKW(P0,4), pw0[3]=PKW(P0,6), pw0); \
    qA_=QF(2); VRD(1); SBAR(); GAPA(C0=__builtin_amdgcn_mfma_f32_32x32x16_bf16(kf[2],qB_,C0,0,0,0),   P0[10],P0[11],P0[12],P0[13], pw1[0]=PKW(P0,8), pw1[1]=PKW(P0,10), pw1); \
    VRD(5); SBAR(); GAPA(C1=__builtin_amdgcn_mfma_f32_32x32x16_bf16(kf[3],qB_,C1,0,0,0),   P0[14],P0[15],P1[0],P1[1],   pw1[2]=PKW(P0,12),pw1[3]=PKW(P0,14), pw1); \
    qB_=QF(3); VRD(2); SBAR(); GAPA(C0=__builtin_amdgcn_mfma_f32_32x32x16_bf16(kf[4],qA_,C0,0,0,0),   P1[2],P1[3],P1[4],P1[5],     pw2[0]=PKW(P1,0), pw2[1]=PKW(P1,2), pw2); \
    VRD(6); SBAR(); GAPA(C1=__builtin_amdgcn_mfma_f32_32x32x16_bf16(kf[5],qA_,C1,0,0,0),   P1[6],P1[7],P1[8],P1[9],     pw2[2]=PKW(P1,4), pw2[3]=PKW(P1,6), pw2); \
    VRD(3); SBAR(); GAPA(C0=__builtin_amdgcn_mfma_f32_32x32x16_bf16(kf[6],qB_,C0,0,0,0),   P1[10],P1[11],P1[12],P1[13], pw3[0]=PKW(P1,8), pw3[1]=PKW(P1,10), pw3); \
    VRD(7); SBAR(); GAPA(C1=__builtin_amdgcn_mfma_f32_32x32x16_bf16(kf[7],qB_,C1,0,0,0),   P1[14],P1[15],0.f,0.f,       pw3[2]=PKW(P1,12),pw3[3]=PKW(P1,14), pw3); \
    l_reg+=sacc; \
    if(GK){DMA_K((t)+3,sl_cur);} if(GV){DMA_V((t)+1,sl_next);} \
    CMASK(C0,C1,t); \
    { float a=MX3(C0[0],C0[1],C1[0]),b=MX3(C0[2],C0[3],C1[1]); a=MX3(a,C1[2],C1[3]); \
      _Pragma("unroll") for(int r=4;r<16;r+=4){a=MX3(a,C0[r],C0[r+1]);b=MX3(b,C0[r+2],C0[r+3]);a=MX3(a,C1[r],C1[r+1]);b=MX3(b,C1[r+2],C1[r+3]);} \
      float rm=__builtin_fmaxf(a,b); { auto rr=__builtin_amdgcn_permlane32_swap(__float_as_uint(rm),__float_as_uint(rm),false,false); rm=__builtin_fmaxf(__uint_as_float(rr[0]),__uint_as_float(rr[1])); } \
      resc=false; \
      if(__builtin_expect(__any(rm>(float)THRL),0)){ const float dl=__builtin_fmaxf(rm,0.f); mhat+=dl; \
        _Pragma("unroll") for(int r=0;r<16;++r){C0[r]-=dl;C1[r]-=dl;} \
        nm=-mhat; \
        const float f=__builtin_amdgcn_exp2f(-dl); l_reg*=f; if(hi==0)wsf[r32]=f; resc=true; } } \
    SBAR(); \
    GAPB(o[0]=__builtin_amdgcn_mfma_f32_32x32x16_bf16(PAF(0),VFR(0),o[0],0,0,0), C0,0); \
    GAPB(o[1]=__builtin_amdgcn_mfma_f32_32x32x16_bf16(PAF(0),VFR(4),o[1],0,0,0), C0,4); \
    KRD(GL,0); GAPB(o[0]=__builtin_amdgcn_mfma_f32_32x32x16_bf16(PAF(1),VFR(1),o[0],0,0,0), C0,8); \
    KRD(GL,1); GAPB(o[1]=__builtin_amdgcn_mfma_f32_32x32x16_bf16(PAF(1),VFR(5),o[1],0,0,0), C0,12); \
    KRD(GL,2); GAPB(o[0]=__builtin_amdgcn_mfma_f32_32x32x16_bf16(PAF(2),VFR(2),o[0],0,0,0), C1,0); \
    KRD(GL,3); GAPB(o[1]=__builtin_amdgcn_mfma_f32_32x32x16_bf16(PAF(2),VFR(6),o[1],0,0,0), C1,4); \
    GAPB(o[0]=__builtin_amdgcn_mfma_f32_32x32x16_bf16(PAF(3),VFR(3),o[0],0,0,0), C1,8); \
    GAPB(o[1]=__builtin_amdgcn_mfma_f32_32x32x16_bf16(PAF(3),VFR(7),o[1],0,0,0), C1,12); \
    }while(0)
  int t=1;
  #undef CMASK
  #define CMASK(P0,P1,t) do{}while(0)
  for(;t+5<NT;t+=2){
    STEP(pB0,pB1,pA0,pA1,t,true,true,true);     WAIT_BAR(2); RESC(); ROT();
    STEP(pA0,pA1,pB0,pB1,t+1,true,true,true);   WAIT_BAR(2); RESC(); ROT();
  }
  #undef CMASK
  #define CMASK(P0,P1,t) do{int jb_=(t)-(NT-4); if(jb_>=0)cmask(P0,P1,jb_,qrel,hi);}while(0)
  #define ENDW(tt) do{ if((tt)+3<NT){WAIT_BAR(2);} else if((tt)+2<NT){WAIT_BAR(1);} else {WAIT_BAR(0);} }while(0)
  for(;t+1<NT;t+=2){
    STEP(pB0,pB1,pA0,pA1,t,(t+3<NT),(t+1<NT),(t+1<NT));       ENDW(t);   RESC(); ROT();
    STEP(pA0,pA1,pB0,pB1,t+1,(t+4<NT),(t+2<NT),(t+2<NT));     ENDW(t+1); RESC(); ROT();
  }
  STEP(pB0,pB1,pA0,pA1,NT-1,false,false,false); RESC();
  { float sacc=pB0[0]+pB0[1]; _Pragma("unroll") for(int r=2;r<16;++r)sacc+=pB0[r]; _Pragma("unroll") for(int r=0;r<16;++r)sacc+=pB1[r]; l_reg+=sacc;
    pw0=(u32x4){PKW(pB0,0),PKW(pB0,2),PKW(pB0,4),PKW(pB0,6)};pw1=(u32x4){PKW(pB0,8),PKW(pB0,10),PKW(pB0,12),PKW(pB0,14)};pw2=(u32x4){PKW(pB1,0),PKW(pB1,2),PKW(pB1,4),PKW(pB1,6)};pw3=(u32x4){PKW(pB1,8),PKW(pB1,10),PKW(pB1,12),PKW(pB1,14)};
    SBAR(); pv(o,vb0+sl_cur,PAF(0),PAF(1),PAF(2),PAF(3)); }
  #undef PKW
  #undef PAF
  #undef VFR
  #undef PIN
  #undef MX3
  #undef GAPA
  #undef GAPB
  #undef EX
  #undef VRD
  #undef KRD
  #undef STEP
  #undef ENDW
  {auto rr=__builtin_amdgcn_permlane32_swap(__float_as_uint(l_reg),__float_as_uint(l_reg),false,false);l_reg=__uint_as_float(rr[0])+__uint_as_float(rr[1]);}
  if(hi==0)wsf[32+r32]=l_reg;asm volatile("s_waitcnt lgkmcnt(0)":::"memory");
  float rli[16];
  #pragma unroll
  for(int r=0;r<16;++r)rli[r]=__builtin_amdgcn_rcpf(wsf[32+crow(r,hi)]);
  bf16*Ow=O+(rowbase+q0+wid*QBLK)*DMO+h*D;
  { bf16*stg=(bf16*)(shm+LDS_OST)+wid*2048;
    #pragma unroll
    for(int r=0;r<16;++r){const int orow=crow(r,hi);
      #pragma unroll
      for(int d0=0;d0<2;++d0)stg[orow*64+d0*32+r32]=__float2bfloat16(o[d0][r]*rli[r]);}
    asm volatile("s_waitcnt lgkmcnt(0)":::"memory");
    #pragma unroll
    for(int i=0;i<4;++i){const int row=i*8+(lane>>3),ch=lane&7; const u32x4 v=*(const u32x4*)(stg+row*64+ch*8); ATTN_STORE16(Ow+(long)row*DMO+ch*8,v);} }
  asm volatile("s_waitcnt lgkmcnt(0)\n\ts_barrier":::"memory");
  #undef DMA_K
  #undef DMA_V
  #undef CMASK
  #undef START
  #undef RESC
  #undef FINIT
  #undef QF
  #undef FINIT1
  #undef ROT
}
constexpr int ATTN_LDS_BYTES=LDS_BYTES;
struct AttnTensors { const bf16* Q; const bf16* K; const bf16* V; bf16* O; const float* F; };
#undef SBAR
#undef WAIT_BAR
}

constexpr int NWAVES = 8;
constexpr int BATCH = 8, SEQ = 4096, D = 1024, T = BATCH * SEQ, NL = 4;
constexpr int BW = 512, INTOT = 7184, NIN = 7168;
constexpr int MH = 4, MDH = 128, AH = 8, ADH = 64, S5G = 32, S5C = 16, S5P = 64, S5L = 32  , S5K = 640;
constexpr int NEXP = 32, EH = 512, MOE_ROWS = 73728  , MOE_NBLK_MAX = 288;
constexpr float LN_EPS = 1e-5f;
constexpr float ALPHA = 1.6817928305074290f;
constexpr float C2 = 0.125f * 1.4426950408889634f;
constexpr float LOG2E = 1.4426950408889634f;
constexpr int NPH_LAYER = 12, NPHASES = 1 + NL * NPH_LAYER;

constexpr size_t MiB = 1u << 20;
constexpr size_t WS_CTL = 0, CTL_ZERO_BYTES = 65536;
constexpr size_t WS_S5TAB = 2 * MiB;
constexpr size_t WS_MSC = 2 * MiB + 65536;
constexpr size_t WS_WSM = 2 * MiB + 131072;
constexpr size_t WS_NST = 3 * MiB;
constexpr size_t WS_WIN = 4 * MiB, WS_WGLU = 18 * MiB, WS_WBR = 19 * MiB, WS_WOUT = 22 * MiB, WS_WGU = 24 * MiB, WS_WDN = 88 * MiB;
constexpr size_t WS_XB = 148 * MiB;
constexpr size_t WS_MQK = 212 * MiB, WS_QK = 276 * MiB, WS_MV = 340 * MiB, WS_MO = 372 * MiB, WS_S5A = 404 * MiB, WS_AQKV = 444 * MiB, WS_GATE = 540 * MiB;
constexpr size_t WS_KC = WS_QK  , WS_YS1 = WS_QK + 32 * MiB, WS_MIXED = WS_QK;
constexpr size_t WS_TPF = WS_MQK, WS_WPF = WS_MQK + 4 * MiB;
constexpr size_t WS_XG = 212 * MiB, WS_HB = 356 * MiB, WS_YB = 428 * MiB;
constexpr size_t WS_YTALL = 732 * MiB, WS_CST = 828 * MiB, WS_EBUF = 892 * MiB, WS_SG = 908 * MiB, WS_FTAB = 910 * MiB, WS_MLU = 911 * MiB, WS_STAT = 912 * MiB + 524288  , WS_ROUTE = 913 * MiB, WS_TOKPOS = 914 * MiB, WS_S5ALL = 916 * MiB  , S5_LAYER_BYTES = 28 * MiB, WS_END = 1028 * MiB;
static_assert(WS_XG + (size_t)MOE_ROWS * 1024 * 2 <= WS_HB && WS_HB + (size_t)MOE_ROWS * 512 * 2 <= WS_YB && WS_YB + (size_t)2 * T * 1024 * 2 <= WS_YTALL, "moe overlay");
static_assert(WS_S5A + (size_t)32 * 1024 * 640 * 2 <= WS_AQKV && WS_GATE + (size_t)T * 3072 * 2 <= WS_YTALL, "region A");
constexpr int CW_TMO = 0, CW_CODE = 1, CW_BAR = 4096, CW_GCNT = 8192, CW_AQ = 8704;

constexpr int RING_OFF = 0, RING_BYTES = 131072;
constexpr int LDS_BYTES = 163840;
constexpr int LDSX_OFF = RING_BYTES;
constexpr int LDSCTL_OFF = 162816, MISC_OFF = LDSCTL_OFF + 320;

#define GAS __attribute__((address_space(1)))
#define LAS __attribute__((address_space(3)))
typedef unsigned short bf16;
typedef unsigned v4u __attribute__((ext_vector_type(4)));
typedef unsigned v2u __attribute__((ext_vector_type(2)));
typedef float f32x4 __attribute__((ext_vector_type(4)));
typedef float f32x16 __attribute__((ext_vector_type(16)));
typedef short bf16x8 __attribute__((ext_vector_type(8)));
typedef GAS unsigned gu32;
#define RLX_AGENT __ATOMIC_RELAXED, __HIP_MEMORY_SCOPE_AGENT
#define LDS_WAIT() asm volatile("s_waitcnt lgkmcnt(0)" ::: "memory")
#define LDS_BARRIER() asm volatile("s_waitcnt lgkmcnt(0)\n\ts_barrier" ::: "memory")
#define VM_WAIT() asm volatile("s_waitcnt vmcnt(0)" ::: "memory")
__device__ __forceinline__ unsigned f2bf(float f) { unsigned u = __builtin_bit_cast(unsigned, f); return (u + 0x7fffu + ((u >> 16) & 1u)) >> 16; }
typedef float f32x2_t_ __attribute__((ext_vector_type(2))); typedef __bf16 bf16x2_t_ __attribute__((ext_vector_type(2)));
__device__ __forceinline__ unsigned pk2(float lo, float hi) { const f32x2_t_ v = {lo, hi}; return __builtin_bit_cast(unsigned, __builtin_convertvector(v, bf16x2_t_)); }
__device__ __forceinline__ float bflo(unsigned u) { return __uint_as_float(u << 16); }
__device__ __forceinline__ float bfhi(unsigned u) { return __uint_as_float(u & 0xffff0000u); }
__device__ __forceinline__ float bf2f(bf16 v) { return __uint_as_float((unsigned)v << 16); }
__device__ __forceinline__ float sigmoidf_(float x) { return 1.f / (1.f + __expf(-x)); }

__device__ __forceinline__ int lane_id() { int l; asm volatile("v_mbcnt_lo_u32_b32 %0, -1, 0\n\tv_mbcnt_hi_u32_b32 %0, -1, %0" : "=v"(l)); return l; }
#define XB_TMO      128
#define XB_XCNT(j)  (256  + 64 * (j))
#define XB_XSUB(j)  (1280 + 64 * (j))
#define XB_XGEN(j)  (2304 + 64 * (j))
#define XB_TOP      3328
#define XB_TOPGEN   3392
#define XCD_BAR_WORDS 3456
#define XB_SPIN_CAP (1u << 18)
__device__ __forceinline__ unsigned xb_ld(unsigned* p)              { return __hip_atomic_load(p, __ATOMIC_RELAXED, __HIP_MEMORY_SCOPE_AGENT); }
__device__ __forceinline__ unsigned xb_add(unsigned* p, unsigned v) { return __hip_atomic_fetch_add(p, v, __ATOMIC_RELAXED, __HIP_MEMORY_SCOPE_AGENT); }
__device__ __forceinline__ unsigned xb_xcc_id() { return (unsigned)__builtin_amdgcn_s_getreg((3 << 11) | 20) & 0xFu; }
#define XB_SPIN(cond, bar) do { unsigned _sp = 0; while (cond) { __builtin_amdgcn_s_sleep(1); \
    if ((++_sp & 255u) == 0u) { if (xb_ld(&(bar)[XB_TMO])) break; if (_sp > XB_SPIN_CAP) { atomicAdd(&(bar)[XB_TMO], 1u); break; } } } } while (0)
struct XcdBarrier { unsigned* bar; unsigned x; volatile LAS unsigned* st; };
__device__ __forceinline__ XcdBarrier xcd_barrier_post(unsigned* bar, volatile LAS unsigned* st, bool leader) {
    XcdBarrier b; b.bar = bar; b.x = xb_xcc_id(); b.st = st;
    if (leader) (void)xb_add(&bar[XB_XCNT(b.x)], 1u);
    return b;
}
__device__ __forceinline__ void xcd_barrier_complete(unsigned* bar, unsigned x, unsigned& nloc, unsigned& nx) {
    const unsigned G = gridDim.x * gridDim.y * gridDim.z;
    unsigned sum, cnt, mine, sp = 0u;
    for (;;) {
        sum = 0u; cnt = 0u; mine = 0u;
#pragma unroll
        for (unsigned j = 0; j < 16; ++j) { const unsigned c = xb_ld(&bar[XB_XCNT(j)]); sum += c; cnt += (c > 0u) ? 1u : 0u; mine = (j == x) ? c : mine; }
        if (sum == G) break;
        __builtin_amdgcn_s_sleep(1);
        if ((++sp & 255u) == 0u) { if (xb_ld(&bar[XB_TMO])) break; if (sp > XB_SPIN_CAP) { atomicAdd(&bar[XB_TMO], 1u); break; } }
    }
    nloc = mine > 0u ? mine : 1u; nx = cnt > 0u ? cnt : 1u;
}
__device__ __forceinline__ void xcd_barrier(const XcdBarrier& b, bool leader) {
    asm volatile("s_waitcnt vmcnt(0)" ::: "memory");
    __syncthreads();
    if (leader) {
        unsigned* bar = b.bar;
        __builtin_amdgcn_s_waitcnt(0);
        unsigned nloc = b.st[0], nx = b.st[1];
        if (nloc == 0u) { xcd_barrier_complete(bar, b.x, nloc, nx); b.st[0] = nloc; b.st[1] = nx; }
        const unsigned old = xb_add(&bar[XB_XSUB(b.x)], 1u);
        const unsigned gen = old / nloc;
        if (old + 1u == (gen + 1u) * nloc) {
            __builtin_amdgcn_fence(__ATOMIC_RELEASE, "agent");
            asm volatile("s_waitcnt vmcnt(0)" ::: "memory");
            const unsigned og = xb_add(&bar[XB_TOP], 1u);
            const unsigned tg = og / nx;
            if (og + 1u == (tg + 1u) * nx) xb_add(&bar[XB_TOPGEN], 1u);
            else XB_SPIN(xb_ld(&bar[XB_TOPGEN]) == tg, bar);
            __builtin_amdgcn_fence(__ATOMIC_ACQUIRE, "agent");
            xb_add(&bar[XB_XGEN(b.x)], 1u);
            asm volatile("s_waitcnt vmcnt(0)" ::: "memory");
        } else {
            XB_SPIN(xb_ld(&bar[XB_XGEN(b.x)]) == gen, bar);
            __builtin_amdgcn_fence(__ATOMIC_ACQUIRE, "agent");
            asm volatile("s_waitcnt vmcnt(0)" ::: "memory");
        }
    }
    __syncthreads();
}

enum InIdx { I_x, I_w_in, I_b_in, I_m_conv_w, I_m_conv_b, I_m_norm_w, I_s5_lam_re, I_s5_lam_im, I_s5_log_dt, I_s5_b_re, I_s5_b_im, I_s5_c_re, I_s5_c_im, I_s5_d, I_s5_w_glu, I_s5_b_glu, I_w_branch, I_w_out, I_ln1_g, I_ln1_b, I_w_rg, I_b_rg, I_w_re, I_b_re, I_moe_wg, I_moe_wu, I_moe_wd, I_ln2_g, I_ln2_b };
struct Args { const float* in[29]; float* out; unsigned char* ws; int ph_lo, ph_hi, sub, pad; };
typedef const __attribute__((address_space(4))) Args* KArgs;
struct Frame {
    LAS unsigned char* lds; unsigned char* ldsg;
    gu32* ctl;
    unsigned char* ws;
    int tid, lane, wave, vcu, G, bx, dup;
    float* out;
    KArgs ka;
};
template <int O> __device__ __forceinline__ float shx(float v) { static_assert(O >= 1 && O < 32, "xor mask inside a 32-lane half"); return __int_as_float(__builtin_amdgcn_ds_swizzle(__float_as_int(v), (O << 10) | 0x1f)); }
__device__ __forceinline__ float half_swap_add(float v) { auto rr = __builtin_amdgcn_permlane32_swap(__float_as_uint(v), __float_as_uint(v), false, false); return __uint_as_float(rr[0]) + __uint_as_float(rr[1]); }
__device__ __forceinline__ float half_swap_max(float v) { auto rr = __builtin_amdgcn_permlane32_swap(__float_as_uint(v), __float_as_uint(v), false, false); return fmaxf(__uint_as_float(rr[0]), __uint_as_float(rr[1])); }
__device__ __forceinline__ float wave_sum(float v) { v += shx<1>(v); v += shx<2>(v); v += shx<4>(v); v += shx<8>(v); v += shx<16>(v); return half_swap_add(v); }
__device__ __forceinline__ float wave_max(float v) { v = fmaxf(v, shx<1>(v)); v = fmaxf(v, shx<2>(v)); v = fmaxf(v, shx<4>(v)); v = fmaxf(v, shx<8>(v)); v = fmaxf(v, shx<16>(v)); return half_swap_max(v); }
#define JR_STEP(p, NH, M, bit) _Pragma("unroll") for (int i_ = 0; i_ < (NH); ++i_) { const float send_ = (bit) ? p[i_] : p[i_ + (NH)]; const float keep_ = (bit) ? p[i_ + (NH)] : p[i_]; p[i_] = keep_ + shx<M>(send_); }
__device__ __forceinline__ float rdlane(float v, int l) { return __int_as_float(__builtin_amdgcn_readlane(__float_as_int(v), l)); }
__device__ __forceinline__ float lane_get(float v, int srclane) { return __int_as_float(__builtin_amdgcn_ds_bpermute(srclane << 2, __float_as_int(v))); }
__device__ __forceinline__ float log_sigmoid(float x) { return fminf(x, 0.f) - log1pf(expf(-fabsf(x))); }

__device__ __forceinline__ void transpose_item(const float* Wsrc, int ldw, bf16* WTdst, int ldt, LAS float* scr, int lane) {
    float tv[32];
#pragma unroll
    for (int i = 0; i < 32; ++i) tv[i] = __builtin_nontemporal_load(Wsrc + (size_t)(2 * i + (lane >> 5)) * ldw + (lane & 31));
#pragma unroll
    for (int i = 0; i < 32; ++i) scr[(2 * i + (lane >> 5)) * 33 + (lane & 31)] = tv[i];
    LDS_WAIT(); asm volatile("" ::: "memory");
    const int c = lane & 7;
#pragma unroll
    for (int j = 0; j < 4; ++j) { const int n = (lane >> 3) + 8 * j; const LAS float* s = scr + (8 * c) * 33 + n;
        v4u o; o.x = pk2(s[0 * 33], s[1 * 33]); o.y = pk2(s[2 * 33], s[3 * 33]); o.z = pk2(s[4 * 33], s[5 * 33]); o.w = pk2(s[6 * 33], s[7 * 33]);
        *(GAS v4u*)(WTdst + (size_t)n * ldt + 8 * c) = o; }
    LDS_WAIT(); asm volatile("" ::: "memory");
}
__device__ __forceinline__ int in_srccol(int c) { return c + (c >= 4096 ? 16 : (c >= 2048 ? 8 : 0)); }

__device__ __forceinline__ void sincos_d(double ang, float& s, float& c) {
    double inv2pi = 0.15915494309189535, twopi = 6.283185307179586476925; asm volatile("" : "+v"(inv2pi), "+v"(twopi));
    const double k = rint(ang * inv2pi); const float r = (float)(ang - k * twopi);
    const float q = rintf(r * 0.6366197723675814f); float y = fmaf(q, -1.57079637050628662109375f, r); y = fmaf(q, 4.371139000186241e-8f, y); const float y2 = y * y;
    float sp = 2.7557319e-6f; sp = sp * y2 - 1.9841270e-4f; sp = sp * y2 + 8.3333333e-3f; sp = sp * y2 - 1.6666667e-1f; sp = y + y * y2 * sp;
    float cp = -2.7557319e-7f; cp = cp * y2 + 2.4801587e-5f; cp = cp * y2 - 1.3888889e-3f; cp = cp * y2 + 4.1666667e-2f; cp = cp * y2 - 0.5f; cp = 1.f + y2 * cp;
    const int qi = ((int)q) & 3; s = (qi == 0) ? sp : (qi == 1) ? cp : (qi == 2) ? -sp : -cp; c = (qi == 0) ? cp : (qi == 1) ? -sp : (qi == 2) ? -cp : sp;
}
__device__ __forceinline__ void s5_build_group(Frame& F, int l, int g) {
    LAS float* AP = (LAS float*)(F.lds);
    LAS float* BB = AP + 33 * 64 * 2;
    LAS float* CC = BB + 64 * 16 * 2;
    LAS float* KT = CC + 16 * 64 * 2;
    LAS float* DD = KT + 32 * 256;
    const int tid = F.tid;
    const float* lre = F.ka->in[I_s5_lam_re] + ((size_t)l * S5G + g) * S5P; const float* lim = F.ka->in[I_s5_lam_im] + ((size_t)l * S5G + g) * S5P;
    const double dt = (double)expf(F.ka->in[I_s5_log_dt][l * S5G + g]);
    for (int i = tid; i < 33 * 64; i += 512) { const int tau = i >> 6, p = i & 63; const double lr = lre[p], li = lim[p];
        const float mag = expf((float)(lr * dt * tau)); float sn, cs; sincos_d(li * dt * tau, sn, cs); AP[i * 2] = mag * cs; AP[i * 2 + 1] = mag * sn; }
    for (int i = tid; i < 64 * 16; i += 512) { const int p = i >> 4, ci = i & 15; const double lr = lre[p], li = lim[p];
        float sn, cs; sincos_d(li * dt, sn, cs); const double mag = (double)expf((float)(lr * dt)), ar = mag * cs, ai = mag * sn, den = lr * lr + li * li, nr = ar - 1.0, ni = ai;
        const double zr = (nr * lr + ni * li) / den, zi = (ni * lr - nr * li) / den;
        const size_t bi = (((size_t)l * S5G + g) * S5P + p) * S5C + ci; const double br = F.ka->in[I_s5_b_re][bi], bim = F.ka->in[I_s5_b_im][bi];
        BB[i * 2] = (float)(zr * br - zi * bim); BB[i * 2 + 1] = (float)(zr * bim + zi * br); }
    for (int i = tid; i < 16 * 64; i += 512) { const size_t ci_ = ((size_t)l * S5G + g) * S5C * S5P + i; CC[i * 2] = F.ka->in[I_s5_c_re][ci_]; CC[i * 2 + 1] = F.ka->in[I_s5_c_im][ci_]; }
    if (tid < 16) DD[tid] = F.ka->in[I_s5_d][(l * S5G + g) * S5C + tid];
    __syncthreads();
    for (int i = tid; i < 32 * 256; i += 512) { const int tau = i >> 8, co = (i >> 4) & 15, ci = i & 15; float s = 0.f;
        for (int p = 0; p < 64; ++p) { const float cr = CC[(co * 64 + p) * 2], cim = CC[(co * 64 + p) * 2 + 1], ar = AP[(tau * 64 + p) * 2], ai = AP[(tau * 64 + p) * 2 + 1];
            const float xr = cr * ar - cim * ai, xi = cr * ai + cim * ar; s += xr * BB[(p * 16 + ci) * 2] - xi * BB[(p * 16 + ci) * 2 + 1]; }
        KT[i] = s; }
    if (tid < 64) { float* tab = (float*)(F.ws + WS_S5TAB) + ((l * 32 + g) * 64 + tid) * 2; tab[0] = AP[(32 * 64 + tid) * 2]; tab[1] = AP[(32 * 64 + tid) * 2 + 1]; }
    __syncthreads();
    bf16* MP = (bf16*)(F.ws + WS_S5ALL + (size_t)l * S5_LAYER_BYTES) + (size_t)g * 512 * S5K;
    for (int i = tid; i < 512 * (S5K / 8); i += 512) { const int n = i / (S5K / 8), k0 = (i % (S5K / 8)) * 8, tq = n >> 4, co = n & 15; float v[8];
#pragma unroll
        for (int j = 0; j < 8; ++j) { const int k = k0 + j; float x;
            if (k < 512) { const int sq = k >> 4, ci = k & 15; x = (tq >= sq) ? KT[((tq - sq) * 16 + co) * 16 + ci] : 0.f; if (tq == sq && co == ci) x += DD[co]; }
            else { const int p = (k - 512) & 63; const float cr = CC[(co * 64 + p) * 2], cim = CC[(co * 64 + p) * 2 + 1], ar = AP[((tq + 1) * 64 + p) * 2], ai = AP[((tq + 1) * 64 + p) * 2 + 1];
                x = (k < 576) ? (cr * ar - cim * ai) : -(cr * ai + cim * ar); }
            v[j] = x; }
        v4u o; o.x = pk2(v[0], v[1]); o.y = pk2(v[2], v[3]); o.z = pk2(v[4], v[5]); o.w = pk2(v[6], v[7]);
        *(GAS v4u*)(MP + (size_t)n * S5K + k0) = o; }
    bf16* GG = (bf16*)(F.ws + WS_S5ALL + (size_t)l * S5_LAYER_BYTES + 20 * MiB) + (size_t)g * 256 * 512;
    for (int i = tid; i < 256 * 64; i += 512) { const int n = i >> 6, k0 = (i & 63) * 8; float v[8];
#pragma unroll
        for (int j = 0; j < 8; ++j) { const int k = k0 + j, sq = k >> 4, ci = k & 15; float x = 0.f;
            if (n < 128) { const int p = n & 63; const float ar = AP[((31 - sq) * 64 + p) * 2], ai = AP[((31 - sq) * 64 + p) * 2 + 1], br = BB[(p * 16 + ci) * 2], bim = BB[(p * 16 + ci) * 2 + 1];
                x = (n < 64) ? (ar * br - ai * bim) : (ar * bim + ai * br); }
            v[j] = x; }
        v4u o; o.x = pk2(v[0], v[1]); o.y = pk2(v[2], v[3]); o.z = pk2(v[4], v[5]); o.w = pk2(v[6], v[7]);
        *(GAS v4u*)(GG + (size_t)n * 512 + k0) = o; }
    __syncthreads();
}

__device__ __forceinline__ void small_w_prep(Frame& F, int l);
constexpr int WI_IN = (NIN / 32) * 16, WI_GLU = 16 * 8, WI_BR = 3 * 32 * 8, WI_OUT = 32 * 16, WI_G = NEXP * 16 * 16, WI_D = NEXP * 32 * 8;
constexpr int W_DENSE_ITEMS = WI_IN + WI_GLU + WI_BR + WI_OUT;
constexpr int W_MOE_ITEMS = 2 * WI_G + WI_D, W_MOE_CHUNK = 64, W_MOE_CHUNKS = W_MOE_ITEMS / W_MOE_CHUNK;
__device__ __forceinline__ void weight_items(Frame& F, int l, int first, int count, int w, int nw) {
    LAS float* scr = (LAS float*)(F.lds + RING_OFF + F.wave * 16384);
    constexpr int I_IN = WI_IN, I_GLU = WI_GLU, I_BR = WI_BR, I_OUT = WI_OUT, I_G = WI_G;
    for (int it = first + w; it < first + count; it += nw) {
        int r = it;
        if (r < I_IN) { const int nb = r >> 4, kb = r & 15; transpose_item(F.ka->in[I_w_in] + (size_t)l * D * INTOT + (size_t)(64 * kb) * INTOT + in_srccol(32 * nb), INTOT, (bf16*)(F.ws + WS_WIN) + (size_t)(32 * nb) * 1024 + 64 * kb, 1024, scr, F.lane); continue; } r -= I_IN;
        if (r < I_GLU) { const int nb = r >> 3, kb = r & 7; transpose_item(F.ka->in[I_s5_w_glu] + (size_t)l * 512 * 512 + (size_t)(64 * kb) * 512 + 32 * nb, 512, (bf16*)(F.ws + WS_WGLU) + (size_t)(32 * nb) * 512 + 64 * kb, 512, scr, F.lane); continue; } r -= I_GLU;
        if (r < I_BR) { const int br = r >> 8, nb = (r >> 3) & 31, kb = r & 7; transpose_item(F.ka->in[I_w_branch] + ((size_t)l * 3 + br) * 512 * 1024 + (size_t)(64 * kb) * 1024 + 32 * nb, 1024, (bf16*)(F.ws + WS_WBR) + (size_t)(br * 1024 + 32 * nb) * 512 + 64 * kb, 512, scr, F.lane); continue; } r -= I_BR;
        if (r < I_OUT) { const int nb = r >> 4, kb = r & 15; transpose_item(F.ka->in[I_w_out] + (size_t)l * 1024 * 1024 + (size_t)(64 * kb) * 1024 + 32 * nb, 1024, (bf16*)(F.ws + WS_WOUT) + (size_t)(32 * nb) * 1024 + 64 * kb, 1024, scr, F.lane); continue; } r -= I_OUT;
        if (r < 2 * I_G) { const int up = r >= I_G; if (up) r -= I_G; const int e = r >> 8, nb = (r >> 4) & 15, kb = r & 15;
            const float* src = (up ? F.ka->in[I_moe_wu] : F.ka->in[I_moe_wg]) + ((size_t)l * NEXP + e) * 1024 * 512 + (size_t)(64 * kb) * 512 + 32 * nb; const int n0 = 32 * nb;
            transpose_item(src, 512, (bf16*)(F.ws + WS_WGU) + (size_t)(e * 1024 + (n0 >> 7) * 256 + up * 128 + (n0 & 127)) * 1024 + 64 * kb, 1024, scr, F.lane); continue; } r -= 2 * I_G;
        { const int e = r >> 8, nb = (r >> 3) & 31, kb = r & 7;
            transpose_item(F.ka->in[I_moe_wd] + ((size_t)l * NEXP + e) * 512 * 1024 + (size_t)(64 * kb) * 1024 + 32 * nb, 1024, (bf16*)(F.ws + WS_WDN) + (size_t)(e * 1024 + 32 * nb) * 512 + 64 * kb, 512, scr, F.lane); }
    }
}
__device__ __forceinline__ void weight_prep(Frame& F, int l) {
    if (F.vcu == F.G - 1) small_w_prep(F, l);
    weight_items(F, l, 0, W_DENSE_ITEMS, F.vcu * NWAVES + F.wave, F.G * NWAVES);
}

__device__ __forceinline__ void small_gates_mfma(Frame& F, int l) {
    const int gw = F.vcu * NWAVES + F.wave, lane = F.lane, r = lane & 15, kg = lane >> 4;
    if (gw * 16 >= T) return;
    const bf16* __restrict__ A = (const bf16*)(F.ws + WS_XB) + (size_t)(gw * 16 + r) * D + 8 * kg; const bf16* __restrict__ B = (const bf16*)(F.ws + WS_WSM) + (size_t)r * D + 8 * kg;
    f32x4 acc = {0.f, 0.f, 0.f, 0.f};
    bf16x8 av[32];
#pragma unroll
    for (int ks = 0; ks < 32; ++ks) av[ks] = *(const GAS bf16x8*)(A + 32 * ks);
#pragma unroll
    for (int ks = 0; ks < 32; ++ks) { const bf16x8 b = *(const GAS bf16x8*)(B + 32 * ks); acc = __builtin_amdgcn_mfma_f32_16x16x32_bf16(av[ks], b, acc, 0, 0, 0); }
    const float bias = F.ka->in[I_b_in][(size_t)l * INTOT + (r < 8 ? 2048 + r : 4104 + (r - 8))];
    float* sg = (float*)(F.ws + WS_SG) + (size_t)(gw * 16 + 4 * kg) * 16 + r;
#pragma unroll
    for (int i = 0; i < 4; ++i) sg[i * 16] = acc[i] + bias;
}
__device__ __forceinline__ void small_w_prep(Frame& F, int l) {
    const float* w = F.ka->in[I_w_in] + (size_t)l * D * INTOT; bf16* o = (bf16*)(F.ws + WS_WSM);
    for (int i = F.tid; i < 1024 * 16; i += 512) { const int k = i >> 4, j = i & 15; o[j * 1024 + k] = (bf16)f2bf(w[(size_t)k * INTOT + (j < 8 ? 2048 + j : 4104 + (j - 8))]); }
}

__device__ __forceinline__ void phase_p0(Frame& F) {
    const bool s5cu = F.vcu < NL * S5G;
    if (s5cu) s5_build_group(F, F.vcu >> 5, F.vcu & 31);
    weight_prep(F, 0);
    const int widx = (s5cu ? F.vcu : F.vcu - NL * S5G) * NWAVES + F.wave, nrow = s5cu ? 8 : 24, row0 = s5cu ? widx * 8 : 8192 + widx * 24;
    f32x4 nv[4];
    { const GAS f32x4* x0 = (const GAS f32x4*)(F.ka->in[I_x] + (size_t)row0 * D) + F.lane;
#pragma unroll
      for (int j = 0; j < 4; ++j) nv[j] = x0[64 * j]; }
    for (int i = 0; i < nrow; ++i) { const int m = row0 + i;
        f32x4 v[4];
#pragma unroll
        for (int j = 0; j < 4; ++j) v[j] = nv[j];
        { const GAS f32x4* xn = (const GAS f32x4*)(F.ka->in[I_x] + (size_t)((i + 1 < nrow) ? m + 1 : m) * D) + F.lane;
#pragma unroll
            for (int j = 0; j < 4; ++j) nv[j] = xn[64 * j]; }
        GAS v2u* o8 = (GAS v2u*)((bf16*)(F.ws + WS_XB) + (size_t)m * D) + F.lane;
#pragma unroll
        for (int j = 0; j < 4; ++j) { v2u o; o.x = pk2(v[j].x, v[j].y); o.y = pk2(v[j].z, v[j].w); o8[64 * j] = o; }
    }
    __syncthreads();
}

struct EpiInProj {
    static constexpr bool PERM = true;
    unsigned char* ws; const LAS float* bias;
    __device__ __forceinline__ bool reset_after(const pg8::Unit&) const { return true; }
    __device__ __forceinline__ void operator()(pg8::f32x4 (&acc)[2][2][4][2], const pg8::Unit& u, int wr, int wc, int fr, int fq) const {
        using namespace pg8;
        const int pn = u.pn, row0 = u.pm * BM + wr * 64 + fr;
        int mode, pitch, cofs; size_t base;
        if (pn < 4) { mode = 0; base = WS_MQK; pitch = 1024; cofs = 0; }
        else if (pn < 6) { mode = 0; base = WS_MV; pitch = 512; cofs = 1024; }
        else if (pn < 8) { mode = 1; base = WS_MO; pitch = 512; cofs = 1536; }
        else if (pn < 10) { mode = 3; base = WS_S5A; pitch = 0; cofs = 2048; }
        else if (pn < 16) { mode = (pn < 12) ? 2 : 0; base = WS_AQKV; pitch = 1536; cofs = 2560; }
        else { mode = 4; base = WS_GATE; pitch = 3072; cofs = 4096; }
        bf16_t* O = (bf16_t*)(ws + base);
#pragma unroll
        for (int bj = 0; bj < 2; ++bj) {
            const int col0 = pn * BM + bj * HALF + wc * 32 + 8 * fq;
            const int sc = in_srccol(col0);
            const f32x4 b0 = *(const LAS f32x4*)(bias + sc), b1 = *(const LAS f32x4*)(bias + sc + 4);
            const int cl = col0 - cofs;
#pragma unroll
            for (int ai = 0; ai < 2; ++ai)
#pragma unroll
                for (int m = 0; m < 4; ++m) {
                    const int row = row0 + ai * HALF + m * 16;
                    f32x4 v0 = acc[ai][bj][m][0] + b0, v1 = acc[ai][bj][m][1] + b1;
                    if (mode == 1) {
#pragma unroll
                        for (int i = 0; i < 4; ++i) { v0[i] = 1.f / (1.f + __expf(-v0[i])); v1[i] = 1.f / (1.f + __expf(-v1[i])); }
                    } else if (mode == 2) { v0 = v0 * C2; v1 = v1 * C2; }
                    else if (mode == 4) {
#pragma unroll
                        for (int i = 0; i < 4; ++i) { v0[i] = __expf(fminf(fmaxf(-v0[i], -30.f), 30.f)); v1[i] = __expf(fminf(fmaxf(-v1[i], -30.f), 30.f)); }
                    }
                    u32x4 w; w.x = cvt_pk_bf16(v0[0], v0[1]); w.y = cvt_pk_bf16(v0[2], v0[3]); w.z = cvt_pk_bf16(v1[0], v1[1]); w.w = cvt_pk_bf16(v1[2], v1[3]);
                    size_t off;
                    if (mode == 3) { const int g = cl >> 4; off = ((size_t)(g * 1024 + (row >> 5)) * S5K) + (row & 31) * 16 + (cl & 15); }
                    else off = (size_t)row * pitch + cl;
                    *(u32x4*)(O + off) = w;
                }
        }
    }
};

__device__ __forceinline__ float wave_incl_scan_add(float v, int lane) {
#pragma unroll
    for (int o = 1; o < 64; o <<= 1) { const float t = lane_get(v, (lane - o) & 63); if (lane >= o) v += t; }
    return v;
}
__device__ __forceinline__ float wave_incl_scan_max(float v, int lane) {
#pragma unroll
    for (int o = 1; o < 64; o <<= 1) { const float t = lane_get(v, (lane - o) & 63); if (lane >= o) v = fmaxf(v, t); }
    return v;
}
__device__ __forceinline__ float lane63(float v) { return __int_as_float(__builtin_amdgcn_readlane(__float_as_int(v), 63)); }
__device__ __forceinline__ void phase_prep2(Frame& F, int l) {
    const int lane = F.lane;
    const float* __restrict__ SG = (const float*)(F.ws + WS_SG);
    LAS float* XS = (LAS float*)(F.lds);
    if (F.vcu < 64) {
        const int sq = F.vcu, b = sq >> 3, h = sq & 7, w = F.wave; float* __restrict__ FT = (float*)(F.ws + WS_FTAB) + (size_t)sq * SEQ;
        float x[8], c8[8];
#pragma unroll
        for (int i = 0; i < 8; ++i) x[i] = SG[(size_t)(b * SEQ + w * 512 + i * 64 + lane) * 16 + 8 + h];
        float carry = 0.f;
#pragma unroll
        for (int i = 0; i < 8; ++i) { const float c = wave_incl_scan_add(log_sigmoid(x[i]), lane) + carry; c8[i] = c; carry = lane63(c); }
        if (lane == 0) XS[w] = carry;
        __syncthreads();
        float pre = 0.f;
        for (int j = 0; j < w; ++j) pre += XS[j];
#pragma unroll
        for (int i = 0; i < 8; ++i) FT[w * 512 + i * 64 + lane] = (c8[i] + pre) * LOG2E;
        __syncthreads();
    } else if (F.vcu < 96) {
        const int bh = F.vcu - 64, b = bh >> 2, h = bh & 3, w = F.wave;
        float* __restrict__ MU = (float*)(F.ws + WS_MLU) + (size_t)bh * SEQ; float* __restrict__ MM = MU + (size_t)32 * SEQ; float* __restrict__ MB = MM + (size_t)32 * SEQ;
        float* __restrict__ MSC = (float*)(F.ws + WS_MSC) + bh * 64;
        float xi[8], xf[8], pm8[8];
#pragma unroll
        for (int i = 0; i < 8; ++i) { const float* sg = SG + (size_t)(b * SEQ + (w * 8 + i) * 64 + lane) * 16; xi[i] = sg[h]; xf[i] = sg[4 + h]; }
#pragma unroll
        for (int i = 0; i < 8; ++i) { const int c = w * 8 + i, s = c * 64 + lane;
            const float bc = wave_incl_scan_add(log_sigmoid(xf[i]), lane), u = xi[i] - bc, pm = wave_incl_scan_max(u, lane);
            MU[s] = u; MB[s] = bc; pm8[i] = pm;
            if (lane == 63) { XS[c] = pm; XS[64 + c] = bc; } }
        __syncthreads();
        float mprev = 0.f;
        for (int c = 0; c < w * 8; ++c) mprev = XS[64 + c] + fmaxf(mprev, XS[c]);
#pragma unroll
        for (int i = 0; i < 8; ++i) { const int c = w * 8 + i, s = c * 64 + lane; const float mloc = XS[c], blast = XS[64 + c];
            MM[s] = fmaxf(pm8[i], mprev);
            const float Mc = fmaxf(mprev, mloc);
            if (lane == 0) { MSC[c] = mprev; MSC[2048 + c] = mloc; MSC[4096 + c] = expf(mprev - Mc); MSC[6144 + c] = expf(mloc - Mc); }
            mprev = blast + Mc; }
        __syncthreads();
    }
}

typedef short v4i16_t __attribute__((ext_vector_type(4)));
__device__ __forceinline__ v2u tr_read4(const LAS bf16* tile, int P, int row0, int col0, int lane) {
    const int q = (lane & 15) >> 2, blk = (lane >> 4) & 1, p = lane & 3;
    return __builtin_bit_cast(v2u, __builtin_amdgcn_ds_read_tr16_b64_v4i16((LAS v4i16_t*)(tile + (row0 + q) * P + col0 + 16 * blk + 4 * p)));
}
constexpr int CWT_OFF = 126976;
__device__ __forceinline__ void conv_table_load(Frame& F, int l, int h) {
    LAS float* CWT = (LAS float*)(F.lds + CWT_OFF); const float* cw = F.ka->in[I_m_conv_w] + (size_t)l * 4 * 1024; const float* cb = F.ka->in[I_m_conv_b] + (size_t)l * 1024;
    for (int i = F.tid; i < 1024; i += 512) { const int qk = i >> 9, tap = (i >> 7) & 3, d = i & 127; CWT[i] = cw[tap * 1024 + qk * 512 + h * 128 + d]; }
    if (F.tid < 256) CWT[1024 + F.tid] = cb[(F.tid >> 7) * 512 + h * 128 + (F.tid & 127)];
    if (F.tid < 128) CWT[1280 + F.tid] = F.ka->in[I_m_norm_w][(size_t)l * BW + h * 128 + F.tid];
}
__device__ __forceinline__ void conv8(const LAS float* CWT, const v4u (&raw)[4], int first_valid, int qk, int d0, float scale, float (&o)[8]) {
    { const f32x4 b0 = *(const LAS f32x4*)(CWT + 1024 + qk * 128 + d0), b1 = *(const LAS f32x4*)(CWT + 1024 + qk * 128 + d0 + 4); o[0] = b0.x; o[1] = b0.y; o[2] = b0.z; o[3] = b0.w; o[4] = b1.x; o[5] = b1.y; o[6] = b1.z; o[7] = b1.w; }
#pragma unroll
    for (int j = 0; j < 4; ++j) { const f32x4 w0 = *(const LAS f32x4*)(CWT + (qk * 4 + j) * 128 + d0), w1 = *(const LAS f32x4*)(CWT + (qk * 4 + j) * 128 + d0 + 4); const v4u r = raw[j]; const float m = (j >= first_valid) ? 1.f : 0.f;
        o[0] += m * w0.x * bflo(r.x); o[1] += m * w0.y * bfhi(r.x); o[2] += m * w0.z * bflo(r.y); o[3] += m * w0.w * bfhi(r.y);
        o[4] += m * w1.x * bflo(r.z); o[5] += m * w1.y * bfhi(r.z); o[6] += m * w1.z * bflo(r.w); o[7] += m * w1.w * bfhi(r.w); }
#pragma unroll
    for (int e = 0; e < 8; ++e) o[e] = o[e] / (1.f + __expf(-o[e])) * scale;
}
struct P1Regs { v4u kr[5], v[2]; float u[2], ml; };
__device__ __forceinline__ void mlstm_p1_load(Frame& F, int uu, P1Regs& R) {
    const int tid = F.tid, bh = uu >> 6, c = uu & 63, b = bh >> 2, h = bh & 3; const size_t tok0 = (size_t)b * SEQ + c * 64;
    const bf16* RAW = (const bf16*)(F.ws + WS_MQK); const bf16* MV = (const bf16*)(F.ws + WS_MV);
    const float ml = ((const float*)(F.ws + WS_MSC))[2048 + bh * 64 + c];
    const int sp = tid >> 4, d0 = (tid & 15) * 8;
#pragma unroll
    for (int j = 0; j < 5; ++j) { int t = 2 * sp - 3 + j; if (c == 0 && t < 0) t = 0;
        R.kr[j] = *(const GAS v4u*)(RAW + (size_t)((long)tok0 + t) * 1024 + 512 + h * 128 + d0); }
#pragma unroll
    for (int i = 0; i < 2; ++i) { const int s = 2 * sp + i;
        R.v[i] = *(const GAS v4u*)(MV + (tok0 + s) * 512 + h * 128 + d0);
        R.u[i] = ((const float*)(F.ws + WS_MLU))[(size_t)bh * SEQ + c * 64 + s]; }
    R.ml = ml;
}
__device__ __forceinline__ void mlstm_pass1_all(Frame& F, int l) {
    const int tid = F.tid, lane = F.lane, wid = F.wave, r = lane & 31, hh = lane >> 5;
    constexpr int PV = 160;
    LAS bf16* KW = (LAS bf16*)(F.lds); LAS bf16* VV = KW + 64 * PV; const LAS float* CWT = (const LAS float*)(F.lds + CWT_OFF);
    const int mt = wid >> 1, nt0 = (wid & 1) * 2;
    conv_table_load(F, l, ((F.vcu * 8) >> 6) & 3);
    P1Regs R; mlstm_p1_load(F, F.vcu * 8, R);
    LDS_BARRIER();
    v2u pend[2][4]; float pend_n = 0.f;
#define P1_STORE(uu_) do { bf16* CT = (bf16*)(F.ws + WS_CST) + (size_t)(uu_) * 128 * 128; \
        _Pragma("unroll") for (int n = 0; n < 2; ++n) _Pragma("unroll") for (int g = 0; g < 4; ++g) *(GAS v2u*)(CT + (size_t)(32 * (nt0 + n) + r) * 128 + 32 * mt + 8 * g + 4 * hh) = pend[n][g]; \
        if (tid < 128) ((float*)(F.ws + WS_NST))[(size_t)(uu_) * 128 + tid] = pend_n; } while (0)
#pragma unroll 1
    for (int it = 0; it < 8; ++it) { const int uu = F.vcu * 8 + it;
#pragma unroll
        for (int i = 0; i < 2; ++i) { const int s = 2 * (tid >> 4) + i, d0 = (tid & 15) * 8; const float w = expf(R.u[i] - R.ml); const v4u win[4] = {R.kr[i], R.kr[i + 1], R.kr[i + 2], R.kr[i + 3]};
            float kc[8]; conv8(CWT, win, ((uu & 63) == 0) ? 3 - s : 0, 1, d0, 0.08838834764831845f, kc);
            v4u kb; kb.x = pk2(kc[0], kc[1]); kb.y = pk2(kc[2], kc[3]); kb.z = pk2(kc[4], kc[5]); kb.w = pk2(kc[6], kc[7]);
            { const int bh_ = uu >> 6; *(GAS v4u*)((bf16*)(F.ws + WS_KC) + ((size_t)(bh_ >> 2) * SEQ + (uu & 63) * 64 + s) * 512 + (bh_ & 3) * 128 + d0) = kb; }
            v4u kw; kw.x = pk2(bflo(kb.x) * w, bfhi(kb.x) * w); kw.y = pk2(bflo(kb.y) * w, bfhi(kb.y) * w); kw.z = pk2(bflo(kb.z) * w, bfhi(kb.z) * w); kw.w = pk2(bflo(kb.w) * w, bfhi(kb.w) * w);
            *(LAS v4u*)(KW + s * PV + d0) = kw; *(LAS v4u*)(VV + s * PV + d0) = R.v[i]; }
        if (it > 0) P1_STORE(uu - 1);
        mlstm_p1_load(F, (it + 1 < 8) ? uu + 1 : uu, R);
        LDS_BARRIER();
        f32x16 acc[2]; acc[0] = f32x16{}; acc[1] = f32x16{};
#pragma unroll
        for (int ks = 0; ks < 4; ++ks) { const v2u a0 = tr_read4(KW, PV, 16 * ks + 8 * hh, 32 * mt, lane), a1 = tr_read4(KW, PV, 16 * ks + 8 * hh + 4, 32 * mt, lane);
            const v4u A = {a0.x, a0.y, a1.x, a1.y};
#pragma unroll
            for (int n = 0; n < 2; ++n) { const v2u b0 = tr_read4(VV, PV, 16 * ks + 8 * hh, 32 * (nt0 + n), lane), b1 = tr_read4(VV, PV, 16 * ks + 8 * hh + 4, 32 * (nt0 + n), lane);
                const v4u B = {b0.x, b0.y, b1.x, b1.y};
                acc[n] = __builtin_amdgcn_mfma_f32_32x32x16_bf16(__builtin_bit_cast(bf16x8, A), __builtin_bit_cast(bf16x8, B), acc[n], 0, 0, 0); } }
#pragma unroll
        for (int n = 0; n < 2; ++n)
#pragma unroll
            for (int g = 0; g < 4; ++g) { pend[n][g].x = pk2(acc[n][4 * g], acc[n][4 * g + 1]); pend[n][g].y = pk2(acc[n][4 * g + 2], acc[n][4 * g + 3]); }
        if (tid < 128) { float s = 0.f;
#pragma unroll 8
            for (int i = 0; i < 64; ++i) s += bf2f(KW[i * PV + tid]); pend_n = s; }
        LDS_BARRIER();
    }
    P1_STORE(F.vcu * 8 + 7);
#undef P1_STORE
}

struct P3Regs { v4u qr[5], k[2], v[2], ct[4]; float a0, a1, a2, a3, np; };
__device__ __forceinline__ void mlstm_p3_load(Frame& F, int uu, P3Regs& R) {
    const int tid = F.tid, bh = uu >> 6, c = uu & 63, b = bh >> 2, h = bh & 3; const size_t tok0 = (size_t)b * SEQ + c * 64;
    const bf16* RAW = (const bf16*)(F.ws + WS_MQK); const bf16* KCg = (const bf16*)(F.ws + WS_KC); const bf16* MVg = (const bf16*)(F.ws + WS_MV); const bf16* CTg = (const bf16*)(F.ws + WS_CST) + (size_t)uu * 128 * 128;
#pragma unroll
    for (int i = 0; i < 2; ++i) { const int p = tid + 512 * i, s = p >> 4, d0 = (p & 15) * 8;
        R.k[i] = *(const GAS v4u*)(KCg + (tok0 + s) * 512 + h * 128 + d0); R.v[i] = *(const GAS v4u*)(MVg + (tok0 + s) * 512 + h * 128 + d0); }
    { const int sp = tid >> 4, d0 = (tid & 15) * 8;
#pragma unroll
      for (int j = 0; j < 5; ++j) { int t = 2 * sp - 3 + j; if (c == 0 && t < 0) t = 0; R.qr[j] = *(const GAS v4u*)(RAW + (size_t)((long)tok0 + t) * 1024 + h * 128 + d0); } }
#pragma unroll
    for (int i = 0; i < 4; ++i) { const int p = tid + 512 * i, dv = p >> 4, d0 = (p & 15) * 8; R.ct[i] = *(const GAS v4u*)(CTg + (size_t)dv * 128 + d0); }
    { const size_t o = (size_t)bh * SEQ + c * 64 + (tid & 63); const float* MLU = (const float*)(F.ws + WS_MLU);
      R.a0 = MLU[o]; R.a1 = MLU[(size_t)32 * SEQ + o]; R.a2 = MLU[(size_t)64 * SEQ + o]; R.a3 = ((const float*)(F.ws + WS_MSC))[bh * 64 + c];
      R.np = ((const float*)(F.ws + WS_NST))[(size_t)uu * 128 + ((tid + 64) & 127)]; }
}
__device__ __forceinline__ void mlstm_pass3_all(Frame& F, int l) {
    const int tid = F.tid, lane = F.lane, wid = F.wave, r = lane & 31, hh = lane >> 5;
    constexpr int PV = 160;
    LAS bf16* Q = (LAS bf16*)(F.lds); LAS bf16* Kk = Q + 64 * 136; LAS bf16* VV = Kk + 64 * 136; LAS bf16* CT = VV + 64 * PV;
    LAS float* HB = (LAS float*)(F.lds + 90112); LAS float* SM = (LAS float*)(F.lds + 123904);
    LAS float* U = SM, *MT = SM + 64, *WST = SM + 128, *FLO = SM + 192, *DEN = SM + 256, *NP = SM + 320, *QN = SM + 448;
    const LAS float* CWT = (const LAS float*)(F.lds + CWT_OFF);
    conv_table_load(F, l, ((F.vcu * 8) >> 6) & 3);
    P3Regs R; mlstm_p3_load(F, F.vcu * 8, R);
    LDS_BARRIER();
#pragma unroll 1
    for (int it = 0; it < 8; ++it) { const int uu = F.vcu * 8 + it;
        const int bh = uu >> 6, c = uu & 63, b = bh >> 2, h = bh & 3; const size_t tok0 = (size_t)b * SEQ + c * 64;
        for (int dA = 0; dA < ((F.dup & 0x80) ? 2 : 1); ++dA) {
#pragma unroll
        for (int i = 0; i < 2; ++i) { const int p = tid + 512 * i, s = p >> 4, d0 = (p & 15) * 8;
            *(LAS v4u*)(Kk + s * 136 + d0) = R.k[i]; *(LAS v4u*)(VV + s * PV + d0) = R.v[i]; }
        { const int sp = tid >> 4, d0 = (tid & 15) * 8;
#pragma unroll
          for (int i = 0; i < 2; ++i) { const int s = 2 * sp + i; const v4u win[4] = {R.qr[i], R.qr[i + 1], R.qr[i + 2], R.qr[i + 3]};
              float qc[8]; conv8(CWT, win, (c == 0) ? 3 - s : 0, 0, d0, 1.f, qc);
              v4u qb; qb.x = pk2(qc[0], qc[1]); qb.y = pk2(qc[2], qc[3]); qb.z = pk2(qc[4], qc[5]); qb.w = pk2(qc[6], qc[7]);
              *(LAS v4u*)(Q + s * 136 + d0) = qb; } }
#pragma unroll
        for (int i = 0; i < 4; ++i) { const int p = tid + 512 * i, dv = p >> 4, d0 = (p & 15) * 8; *(LAS v4u*)(CT + dv * 136 + d0) = R.ct[i]; }
        if (tid < 64) { U[tid] = R.a0; MT[tid] = R.a1; WST[tid] = expf(R.a3 - R.a1); FLO[tid] = expf(-R.a2 - R.a1); }
        else if (tid < 192) NP[tid - 64] = R.np;
        }
        mlstm_p3_load(F, (it + 1 < 8) ? uu + 1 : uu, R);
        const int tq = tid >> 3, part = tid & 7; const bf16* og = (const bf16*)(F.ws + WS_MO) + (tok0 + tq) * 512 + h * 128 + part * 16;
        const v4u o0 = *(const GAS v4u*)og, o1 = *(const GAS v4u*)(og + 8);
        LDS_BARRIER();
        { float s = 0.f;
#pragma unroll
            for (int i = 0; i < 16; ++i) s += bf2f(Q[tq * 136 + part * 16 + i]) * NP[part * 16 + i];
            s += shx<1>(s); s += shx<2>(s); s += shx<4>(s); if (part == 0) QN[tq] = s; }
        LDS_BARRIER();
        const int tt = wid >> 2, dt = wid & 3;
        f32x16 acc = f32x16{}; float denp = 0.f;
        for (int dB = 0; dB < ((F.dup & 0x20) ? 2 : 1); ++dB) {
        acc = f32x16{};
#pragma unroll
        for (int ks = 0; ks < 8; ++ks) { const bf16x8 A = *(const LAS bf16x8*)(Q + (32 * tt + r) * 136 + 16 * ks + 8 * hh); const bf16x8 B = *(const LAS bf16x8*)(CT + (32 * dt + r) * 136 + 16 * ks + 8 * hh);
            acc = __builtin_amdgcn_mfma_f32_32x32x16_bf16(A, B, acc, 0, 0, 0); }
#pragma unroll
        for (int g = 0; g < 16; ++g) acc[g] *= WST[32 * tt + (g & 3) + 8 * (g >> 2) + 4 * hh];
        denp = 0.f; const float Mt_l = MT[32 * tt + r];
        for (int st = 0; st <= tt; ++st) {
            f32x16 ST = f32x16{};
#pragma unroll
            for (int ks = 0; ks < 8; ++ks) { const bf16x8 A = *(const LAS bf16x8*)(Kk + (32 * st + r) * 136 + 16 * ks + 8 * hh); const bf16x8 B = *(const LAS bf16x8*)(Q + (32 * tt + r) * 136 + 16 * ks + 8 * hh);
                ST = __builtin_amdgcn_mfma_f32_32x32x16_bf16(A, B, ST, 0, 0, 0); }
#pragma unroll
            for (int g = 0; g < 16; ++g) { const int ri = (g & 3) + 8 * (g >> 2) + 4 * hh; float w = __expf(U[32 * st + ri] - Mt_l); if (st == tt && ri > r) w = 0.f; ST[g] *= w; denp += ST[g]; }
#pragma unroll
            for (int sp = 0; sp < 2; ++sp) {
                v4u pa; pa.x = pg8::cvt_pk_bf16(ST[8 * sp], ST[8 * sp + 1]); pa.y = pg8::cvt_pk_bf16(ST[8 * sp + 2], ST[8 * sp + 3]); pa.z = pg8::cvt_pk_bf16(ST[8 * sp + 4], ST[8 * sp + 5]); pa.w = pg8::cvt_pk_bf16(ST[8 * sp + 6], ST[8 * sp + 7]);
                const v2u lo = tr_read4(VV, PV, 32 * st + 16 * sp + 4 * hh, 32 * dt, lane), hi = tr_read4(VV, PV, 32 * st + 16 * sp + 8 + 4 * hh, 32 * dt, lane);
                v4u pb; pb.x = lo.x; pb.y = lo.y; pb.z = hi.x; pb.w = hi.y;
                acc = __builtin_amdgcn_mfma_f32_32x32x16_bf16(__builtin_bit_cast(bf16x8, pa), __builtin_bit_cast(bf16x8, pb), acc, 0, 0, 0); }
        }
        denp = half_swap_add(denp);
        if (dt == 0 && hh == 0) { const int t = 32 * tt + r; DEN[t] = denp + WST[t] * QN[t]; }
        }
        LDS_BARRIER();
#pragma unroll
        for (int g = 0; g < 16; ++g) { const int t = 32 * tt + (g & 3) + 8 * (g >> 2) + 4 * hh; HB[t * 132 + 32 * dt + r] = acc[g] / fmaxf(fabsf(DEN[t]), FLO[t]); }
        LDS_BARRIER();
        for (int dC = 0; dC < ((F.dup & 0x40) ? 2 : 1); ++dC)
        { float x[16]; float s = 0.f;
#pragma unroll
            for (int i = 0; i < 16; ++i) { x[i] = HB[tq * 132 + part * 16 + i]; s += x[i]; }
            s += shx<1>(s); s += shx<2>(s); s += shx<4>(s); const float mean = s * (1.f / 128.f); float q = 0.f;
#pragma unroll
            for (int i = 0; i < 16; ++i) { x[i] -= mean; q += x[i] * x[i]; }
            q += shx<1>(q); q += shx<2>(q); q += shx<4>(q); const float rstd = 1.f / sqrtf(q * (1.f / 128.f) + LN_EPS);
            const unsigned oa[8] = {o0.x, o0.y, o0.z, o0.w, o1.x, o1.y, o1.z, o1.w};
            unsigned ow[8];
#pragma unroll
            for (int i = 0; i < 8; ++i) ow[i] = pk2(x[2 * i] * rstd * CWT[1280 + part * 16 + 2 * i] * bflo(oa[i]), x[2 * i + 1] * rstd * CWT[1280 + part * 16 + 2 * i + 1] * bfhi(oa[i]));
            bf16* yo = (bf16*)(F.ws + WS_YTALL) + (tok0 + tq) * 512 + h * 128 + part * 16; *(GAS v4u*)yo = (v4u){ow[0], ow[1], ow[2], ow[3]}; *(GAS v4u*)(yo + 8) = (v4u){ow[4], ow[5], ow[6], ow[7]}; }
        LDS_BARRIER();
    }
}

__device__ __forceinline__ void phase_scans(Frame& F, int l, bool dry = false) {
    const int v = F.vcu, tid = F.tid, seg = F.wave, e = tid & 63;
    LAS float* LE = (LAS float*)(F.lds);
    LAS float* DS = LE + 8 * 64 * 8;
    { const int b = v >> 5, g = v & 31, p = e; const float* tab = (const float*)(F.ws + WS_S5TAB) + ((l * 32 + g) * 64 + p) * 2; const float ar = tab[0], ai = tab[1];
      bf16* A = (bf16*)(F.ws + (dry ? WS_AQKV : WS_S5A)); const float* E = (const float*)(F.ws + WS_EBUF);
      const size_t row0 = (size_t)g * 1024 + b * 128 + seg * 16; float er[16], ei[16];
#pragma unroll
      for (int j = 0; j < 16; ++j) { er[j] = E[(row0 + j) * 128 + p]; ei[j] = E[(row0 + j) * 128 + 64 + p]; }
      float hr = 0.f, hi = 0.f;
#pragma unroll
      for (int j = 0; j < 16; ++j) { const float nr = ar * hr - ai * hi + er[j], ni = ar * hi + ai * hr + ei[j]; hr = nr; hi = ni; }
      LE[(seg * 64 + p) * 2] = hr; LE[(seg * 64 + p) * 2 + 1] = hi;
      float pr = ar, pi = ai;
#pragma unroll
      for (int k = 0; k < 4; ++k) { const float nr = pr * pr - pi * pi, ni = 2.f * pr * pi; pr = nr; pi = ni; }
      LDS_BARRIER();
      hr = 0.f; hi = 0.f;
      for (int s = 0; s < seg; ++s) { const float lr = LE[(s * 64 + p) * 2], li = LE[(s * 64 + p) * 2 + 1]; const float nr = pr * hr - pi * hi + lr, ni = pr * hi + pi * hr + li; hr = nr; hi = ni; }
#pragma unroll
      for (int j = 0; j < 16; ++j) { A[(row0 + j) * S5K + 512 + p] = (bf16)f2bf(hr); A[(row0 + j) * S5K + 576 + p] = (bf16)f2bf(hi);
          const float nr = ar * hr - ai * hi + er[j], ni = ar * hi + ai * hr + ei[j]; hr = nr; hi = ni; }
      LDS_BARRIER(); }
    const float* MSC = (const float*)(F.ws + WS_MSC);
#pragma unroll 1
    for (int i = 0; i < 4; ++i) { const int uix = v * 4 + i, bh = uix >> 5, slice = uix & 31;
        bf16* p = (bf16*)(F.ws + (dry ? WS_MQK : WS_CST)) + ((size_t)bh * 64 + seg * 8) * 16384 + slice * 512 + e * 8;
        v4u lc[8]; float dec[8], sc[8];
#pragma unroll
        for (int j = 0; j < 8; ++j) { lc[j] = *(const GAS v4u*)(p + (size_t)j * 16384); dec[j] = MSC[4096 + bh * 64 + seg * 8 + j]; sc[j] = MSC[6144 + bh * 64 + seg * 8 + j]; }
        float S[8] = {0.f, 0.f, 0.f, 0.f, 0.f, 0.f, 0.f, 0.f}; float dp = 1.f;
#pragma unroll
        for (int j = 0; j < 8; ++j) { const float d = dec[j], s_ = sc[j]; dp *= d;
            S[0] = d * S[0] + s_ * bflo(lc[j].x); S[1] = d * S[1] + s_ * bfhi(lc[j].x); S[2] = d * S[2] + s_ * bflo(lc[j].y); S[3] = d * S[3] + s_ * bfhi(lc[j].y);
            S[4] = d * S[4] + s_ * bflo(lc[j].z); S[5] = d * S[5] + s_ * bfhi(lc[j].z); S[6] = d * S[6] + s_ * bflo(lc[j].w); S[7] = d * S[7] + s_ * bfhi(lc[j].w); }
#pragma unroll
        for (int k = 0; k < 8; ++k) LE[(seg * 64 + e) * 8 + k] = S[k];
        if (e == 0) DS[seg] = dp;
        LDS_BARRIER();
#pragma unroll
        for (int k = 0; k < 8; ++k) S[k] = 0.f;
        for (int s = 0; s < seg; ++s) { const float d = DS[s];
#pragma unroll
            for (int k = 0; k < 8; ++k) S[k] = d * S[k] + LE[(s * 64 + e) * 8 + k]; }
#pragma unroll
        for (int j = 0; j < 8; ++j) { v4u o; o.x = pk2(S[0], S[1]); o.y = pk2(S[2], S[3]); o.z = pk2(S[4], S[5]); o.w = pk2(S[6], S[7]); *(GAS v4u*)(p + (size_t)j * 16384) = o;
            const float d = dec[j], s_ = sc[j];
            S[0] = d * S[0] + s_ * bflo(lc[j].x); S[1] = d * S[1] + s_ * bfhi(lc[j].x); S[2] = d * S[2] + s_ * bflo(lc[j].y); S[3] = d * S[3] + s_ * bfhi(lc[j].y);
            S[4] = d * S[4] + s_ * bflo(lc[j].z); S[5] = d * S[5] + s_ * bfhi(lc[j].z); S[6] = d * S[6] + s_ * bflo(lc[j].w); S[7] = d * S[7] + s_ * bfhi(lc[j].w); }
        LDS_BARRIER(); }
    if (tid < 16) { const int gid = v * 16 + tid, bh = gid >> 7, dk = gid & 127; float* p = (float*)(F.ws + (dry ? WS_YTALL : WS_NST)) + (size_t)bh * 64 * 128 + dk; float lc[64];
#pragma unroll
        for (int c = 0; c < 64; ++c) lc[c] = p[c * 128];
        float n = 0.f;
#pragma unroll
        for (int c = 0; c < 64; ++c) { p[c * 128] = n; n = MSC[4096 + bh * 64 + c] * n + MSC[6144 + bh * 64 + c] * lc[c]; } }
}

struct SchedS5E { static constexpr bool GATHER = false; int c; __device__ __forceinline__ bool next(int i, pg8::Unit& u) const { if (i > 0 || c >= 128) return false; u.pm = c; u.pn = c >> 2; return true; } };
struct SchedS5Y { static constexpr bool GATHER = false; int c; __device__ __forceinline__ bool next(int i, pg8::Unit& u) const { if (i > 0 || c >= 256) return false; u.pm = c >> 1; u.pn = (c >> 3) * 2 + (c & 1); return true; } };
struct EpiS5E {
    static constexpr bool PERM = false;
    float* E;
    __device__ __forceinline__ bool reset_after(const pg8::Unit&) const { return true; }
    __device__ __forceinline__ void operator()(pg8::f32x4 (&acc)[2][2][4][2], const pg8::Unit& u, int wr, int wc, int fr, int fq) const {
        using namespace pg8;
        const int row0 = u.pm * BM + wr * 64 + fr, col0 = wc * 32 + 4 * fq;
#pragma unroll
        for (int ai = 0; ai < 2; ++ai)
#pragma unroll
            for (int m = 0; m < 4; ++m)
#pragma unroll
                for (int n = 0; n < 2; ++n) *(f32x4*)(E + (size_t)(row0 + ai * HALF + m * 16) * 128 + col0 + 16 * n) = acc[ai][0][m][n];
    }
};
__device__ __forceinline__ float gelu_tanh(float x) { const float z = 0.7978845608028654f * (x + 0.044715f * x * x * x); const float e = __expf(2.f * z); return 0.5f * x * (2.f - 2.f / (1.f + e)); }
struct EpiS5Y {
    static constexpr bool PERM = true;
    bf16* Y;
    __device__ __forceinline__ bool reset_after(const pg8::Unit&) const { return true; }
    __device__ __forceinline__ void operator()(pg8::f32x4 (&acc)[2][2][4][2], const pg8::Unit& u, int wr, int wc, int fr, int fq) const {
        using namespace pg8;
        const int row0 = u.pm * BM + wr * 64 + fr, ct = u.pn & 1;
#pragma unroll
        for (int bj = 0; bj < 2; ++bj) { const int cc = ct * 256 + bj * HALF + wc * 32 + 8 * fq, tq = cc >> 4, co = cc & 15;
#pragma unroll
            for (int ai = 0; ai < 2; ++ai)
#pragma unroll
                for (int m = 0; m < 4; ++m) { const int R = row0 + ai * HALF + m * 16, g = R >> 10, rr = R & 1023; const f32x4 v0 = acc[ai][bj][m][0], v1 = acc[ai][bj][m][1];
                    u32x4 w; w.x = cvt_pk_bf16(gelu_tanh(v0[0]), gelu_tanh(v0[1])); w.y = cvt_pk_bf16(gelu_tanh(v0[2]), gelu_tanh(v0[3])); w.z = cvt_pk_bf16(gelu_tanh(v1[0]), gelu_tanh(v1[1])); w.w = cvt_pk_bf16(gelu_tanh(v1[2]), gelu_tanh(v1[3]));
                    *(u32x4*)(Y + (size_t)(rr * 32 + tq) * 512 + 16 * g + co) = w; } }
    }
};
struct EpiGlu {
    static constexpr bool PERM = true;
    const bf16* Y1; bf16* YO; const float* bias;
    __device__ __forceinline__ bool reset_after(const pg8::Unit&) const { return true; }
    __device__ __forceinline__ void operator()(pg8::f32x4 (&acc)[2][2][4][2], const pg8::Unit& u, int wr, int wc, int fr, int fq) const {
        using namespace pg8;
        const int row0 = u.pm * BM + wr * 64 + fr;
#pragma unroll
        for (int bj = 0; bj < 2; ++bj) { const int col0 = u.pn * BM + bj * HALF + wc * 32 + 8 * fq; const f32x4 b0 = *(const f32x4*)(bias + col0), b1 = *(const f32x4*)(bias + col0 + 4);
            u32x4 yv[2][4];
#pragma unroll
            for (int ai = 0; ai < 2; ++ai)
#pragma unroll
                for (int m = 0; m < 4; ++m) yv[ai][m] = *(const u32x4*)(Y1 + (size_t)(row0 + ai * HALF + m * 16) * 512 + col0);
            asm volatile("" ::: "memory");
#pragma unroll
            for (int ai = 0; ai < 2; ++ai)
#pragma unroll
                for (int m = 0; m < 4; ++m) { const size_t off = (size_t)(row0 + ai * HALF + m * 16) * 512 + col0; const u32x4 y = yv[ai][m];
                    const f32x4 v0 = acc[ai][bj][m][0] + b0, v1 = acc[ai][bj][m][1] + b1;
                    u32x4 w; w.x = cvt_pk_bf16(bflo(y.x) * sigmoidf_(v0[0]), bfhi(y.x) * sigmoidf_(v0[1])); w.y = cvt_pk_bf16(bflo(y.y) * sigmoidf_(v0[2]), bfhi(y.y) * sigmoidf_(v0[3]));
                    w.z = cvt_pk_bf16(bflo(y.z) * sigmoidf_(v1[0]), bfhi(y.z) * sigmoidf_(v1[1])); w.w = cvt_pk_bf16(bflo(y.w) * sigmoidf_(v1[2]), bfhi(y.w) * sigmoidf_(v1[3]));
                    *(u32x4*)(YO + off) = w; }
            asm volatile("" ::: "memory"); }
    }
};
struct SchedMerge { static constexpr bool GATHER = false; int c, G; __device__ __forceinline__ bool next(int i, pg8::Unit& u) const { const int tl = (i / 3) * G + c, b = i % 3; if (tl >= 512) return false; u.pm = b * 128 + (tl >> 2); u.pn = b * 4 + (tl & 3); return true; } };
struct EpiMerge {
    static constexpr bool PERM = true;
    const bf16* GP; bf16* MX;
    __device__ __forceinline__ bool reset_after(const pg8::Unit& u) const { return u.pm >= 256; }
    __device__ __forceinline__ void operator()(pg8::f32x4 (&acc)[2][2][4][2], const pg8::Unit& u, int wr, int wc, int fr, int fq) const {
        using namespace pg8;
        const int b = u.pm >> 7, pm = u.pm & 127, pn = u.pn & 3, row0 = pm * BM + wr * 64 + fr;
#pragma unroll
        for (int bj = 0; bj < 2; ++bj) { const int col0 = pn * BM + bj * HALF + wc * 32 + 8 * fq;
#pragma unroll
            for (int ai = 0; ai < 2; ++ai) {
            u32x4 gav[4], gbv[4];
#pragma unroll
                for (int m = 0; m < 4; ++m) { const bf16* gp = GP + (size_t)(row0 + ai * HALF + m * 16) * 3072 + b * 1024 + col0; gav[m] = *(const u32x4*)gp; gbv[m] = (b < 2) ? *(const u32x4*)(gp + 1024) : (u32x4){0u, 0u, 0u, 0u}; }
            asm volatile("" ::: "memory");
#pragma unroll
                for (int m = 0; m < 4; ++m) { const int row = row0 + ai * HALF + m * 16;
                    const u32x4 ga = gav[m]; float f[8];
                    const unsigned gaa[4] = {ga.x, ga.y, ga.z, ga.w};
                    if (b < 2) { const u32x4 gb = gbv[m]; const unsigned gba[4] = {gb.x, gb.y, gb.z, gb.w};
#pragma unroll
                        for (int i = 0; i < 4; ++i) {
                            f[2 * i] = (1.f + bflo(gba[i])) * __builtin_amdgcn_rcpf(1.f + bflo(gaa[i])); f[2 * i + 1] = (1.f + bfhi(gba[i])) * __builtin_amdgcn_rcpf(1.f + bfhi(gaa[i])); }
                    } else {
#pragma unroll
                        for (int i = 0; i < 4; ++i) { f[2 * i] = __builtin_amdgcn_rcpf(1.f + bflo(gaa[i])); f[2 * i + 1] = __builtin_amdgcn_rcpf(1.f + bfhi(gaa[i])); }
                    }
                    f32x4& v0 = acc[ai][bj][m][0]; f32x4& v1 = acc[ai][bj][m][1];
                    v0[0] *= f[0]; v0[1] *= f[1]; v0[2] *= f[2]; v0[3] *= f[3]; v1[0] *= f[4]; v1[1] *= f[5]; v1[2] *= f[6]; v1[3] *= f[7];
                    if (b == 2) { u32x4 w; w.x = cvt_pk_bf16(v0[0], v0[1]); w.y = cvt_pk_bf16(v0[2], v0[3]); w.z = cvt_pk_bf16(v1[0], v1[1]); w.w = cvt_pk_bf16(v1[2], v1[3]);
                        *(u32x4*)(MX + (size_t)row * 1024 + col0) = w; } }
            asm volatile("" ::: "memory"); } }
    }
};
struct EpiOutProj {
    static constexpr bool PERM = false;
    const float* X; float* O;
    __device__ __forceinline__ bool reset_after(const pg8::Unit&) const { return true; }
    __device__ __forceinline__ void operator()(pg8::f32x4 (&acc)[2][2][4][2], const pg8::Unit& u, int wr, int wc, int fr, int fq) const {
        using namespace pg8;
        const int row0 = u.pm * BM + wr * 64 + fr, col0 = u.pn * BM + wc * 32 + 4 * fq;
#pragma unroll
        for (int ai = 0; ai < 2; ++ai) {
            f32x4 xv[4][2][2];
#pragma unroll
            for (int m = 0; m < 4; ++m) { const size_t off = (size_t)(row0 + ai * HALF + m * 16) * 1024 + col0;
#pragma unroll
                for (int bj = 0; bj < 2; ++bj)
#pragma unroll
                    for (int n = 0; n < 2; ++n) xv[m][bj][n] = *(const f32x4*)(X + off + bj * HALF + n * 16); }
            asm volatile("" ::: "memory");
#pragma unroll
            for (int m = 0; m < 4; ++m) { const size_t off = (size_t)(row0 + ai * HALF + m * 16) * 1024 + col0;
#pragma unroll
                for (int bj = 0; bj < 2; ++bj)
#pragma unroll
                    for (int n = 0; n < 2; ++n) *(f32x4*)(O + off + bj * HALF + n * 16) = xv[m][bj][n] * ALPHA + acc[ai][bj][m][n]; }
            asm volatile("" ::: "memory");
        }
    }
};

__device__ __forceinline__ void phase_ln1_route(Frame& F, int l, bool dry = false) {
    float* const STo = (float*)(F.ws + (dry ? WS_YB : WS_STAT)); bf16* const XBo = (bf16*)(F.ws + (dry ? WS_XG : WS_XB)); int* const TPF = (int*)(F.ws + (dry ? WS_HB : WS_TPF)); float* const WPF = (float*)(F.ws + (dry ? WS_HB + 4 * MiB : WS_WPF)); const int gl = dry ? l + 4 : l;
    constexpr int WP = 1028;
    LAS float* WRE = (LAS float*)(F.lds); LAS float* WRG = WRE + 32 * WP;
    LAS float* BR = WRG + 4 * WP; LAS unsigned* HIST = (LAS unsigned*)(BR + 64); LAS unsigned* BASE = HIST + 32;
    const int gw = F.vcu * NWAVES + F.wave, NGW = F.G * NWAVES, lane = F.lane;
    f32x4 nv[4], nv2[4];
    { const GAS f32x4* x0 = (const GAS f32x4*)(F.out + (size_t)gw * D) + lane; const GAS f32x4* x1 = (const GAS f32x4*)(F.out + (size_t)(gw + NGW) * D) + lane;
#pragma unroll
      for (int j = 0; j < 4; ++j) { nv[j] = x0[64 * j]; nv2[j] = x1[64 * j]; } }
    const float* wre = F.ka->in[I_w_re] + (size_t)l * 1024 * 32; const float* wrg = F.ka->in[I_w_rg] + (size_t)l * 1024 * 4;
    {
        f32x4 we[16], wg[2];
#pragma unroll
        for (int j = 0; j < 16; ++j) we[j] = *(const f32x4*)(wre + 4 * (F.tid + 512 * j));
#pragma unroll
        for (int j = 0; j < 2; ++j) wg[j] = *(const f32x4*)(wrg + 4 * (F.tid + 512 * j));
#pragma unroll
        for (int j = 0; j < 16; ++j) { const int i = 4 * (F.tid + 512 * j), k = i >> 5, e = i & 31; WRE[e * WP + k] = we[j].x; WRE[(e + 1) * WP + k] = we[j].y; WRE[(e + 2) * WP + k] = we[j].z; WRE[(e + 3) * WP + k] = we[j].w; }
#pragma unroll
        for (int j = 0; j < 2; ++j) { const int k = F.tid + 512 * j; WRG[k] = wg[j].x; WRG[WP + k] = wg[j].y; WRG[2 * WP + k] = wg[j].z; WRG[3 * WP + k] = wg[j].w; }
    }
    if (F.tid < 32) { BR[F.tid] = F.ka->in[I_b_re][l * 32 + F.tid]; HIST[F.tid] = 0u; }
    if (F.tid < 4) BR[32 + F.tid] = F.ka->in[I_b_rg][l * 4 + F.tid];
    __syncthreads();
    const float* lg = F.ka->in[I_ln1_g] + (size_t)l * D; const float* lb = F.ka->in[I_ln1_b] + (size_t)l * D;
    int my_e0 = 0, my_e1 = 0, my_r0 = 0, my_r1 = 0, my_m = -1; float my_w0 = 0.f, my_w1 = 0.f; int it = 0;
    f32x4 g4[4], b4[4];
#pragma unroll
    for (int j = 0; j < 4; ++j) { g4[j] = *(const f32x4*)(lg + 256 * j + 4 * lane); b4[j] = *(const f32x4*)(lb + 256 * j + 4 * lane); }
    v2u pend[4] = {{0u, 0u}, {0u, 0u}, {0u, 0u}, {0u, 0u}}; float pend_s = 0.f; int pend_m = -1;
#define LN1_FLUSH() do { if (pend_m >= 0) { GAS v2u* o8_ = (GAS v2u*)(XBo + (size_t)pend_m * D) + lane; _Pragma("unroll") for (int j = 0; j < 4; ++j) o8_[64 * j] = pend[j]; STo[2 * (size_t)pend_m + (lane & 1)] = pend_s; } } while (0)
    for (int m = gw; m < T; m += NGW, ++it) {
        f32x4 v[4]; float s = 0.f;
#pragma unroll
        for (int j = 0; j < 4; ++j) { v[j] = nv[j]; nv[j] = nv2[j]; s += (v[j].x + v[j].y) + (v[j].z + v[j].w); }
        LN1_FLUSH();
        { const int mn = (m + 2 * NGW < T) ? m + 2 * NGW : m;
          const GAS f32x4* xn = (const GAS f32x4*)(F.out + (size_t)mn * D) + lane;
#pragma unroll
            for (int j = 0; j < 4; ++j) nv2[j] = xn[64 * j]; }
        const float mean = wave_sum(s) * (1.f / D); float s2 = 0.f;
#pragma unroll
        for (int j = 0; j < 4; ++j) { v[j] = v[j] - mean; s2 += (v[j].x * v[j].x + v[j].y * v[j].y) + (v[j].z * v[j].z + v[j].w * v[j].w); }
        const float rstd = 1.f / sqrtf(wave_sum(s2) * (1.f / D) + LN_EPS);
        pend_s = (lane & 1) ? rstd : mean; pend_m = m;
#pragma unroll
        for (int j = 0; j < 4; ++j) {
            v[j] = v[j] * rstd * g4[j] + b4[j]; v2u o;     o.x = pk2(v[j].x, v[j].y); o.y = pk2(v[j].z, v[j].w); pend[j] = o; }
        const bool b0 = (lane & 1) != 0, b1 = (lane & 2) != 0, b2 = (lane & 4) != 0;
        float gl[4];
        { float p[4];
#pragma unroll
          for (int o = 0; o < 4; ++o) { p[o] = 0.f;
#pragma unroll
            for (int j = 0; j < 4; ++j) { const f32x4 w = *(const LAS f32x4*)(WRG + o * WP + 256 * j + 4 * lane); p[o] += (v[j].x * w.x + v[j].y * w.y) + (v[j].z * w.z + v[j].w * w.w); } }
          JR_STEP(p, 2, 1, b0) JR_STEP(p, 1, 2, b1)
          float r = p[0]; r += shx<4>(r); r += shx<8>(r); r += shx<16>(r); r = half_swap_add(r);
          gl[0] = rdlane(r, 0) + BR[32]; gl[1] = rdlane(r, 2) + BR[33]; gl[2] = rdlane(r, 1) + BR[34]; gl[3] = rdlane(r, 3) + BR[35]; }
        int grp = 0; float gmax = gl[0];
#pragma unroll
        for (int o = 1; o < 4; ++o) if (gl[o] > gmax) { gmax = gl[o]; grp = o; }
        float gs = 0.f;
#pragma unroll
        for (int o = 0; o < 4; ++o) gs += __expf(gl[o] - gmax);
        const float pg = 1.f / gs;
        float el[8];
        { float p[8]; const LAS float* wr_ = WRE + grp * 8 * WP;
#pragma unroll
          for (int o = 0; o < 8; ++o) { p[o] = 0.f;
#pragma unroll
            for (int j = 0; j < 4; ++j) { const f32x4 w = *(const LAS f32x4*)(wr_ + o * WP + 256 * j + 4 * lane); p[o] += (v[j].x * w.x + v[j].y * w.y) + (v[j].z * w.z + v[j].w * w.w); } }
          JR_STEP(p, 4, 1, b0) JR_STEP(p, 2, 2, b1) JR_STEP(p, 1, 4, b2)
          float r = p[0]; r += shx<8>(r); r += shx<16>(r); r = half_swap_add(r);
          const LAS float* be = BR + grp * 8;
          el[0] = rdlane(r, 0) + be[0]; el[1] = rdlane(r, 4) + be[1]; el[2] = rdlane(r, 2) + be[2]; el[3] = rdlane(r, 6) + be[3];
          el[4] = rdlane(r, 1) + be[4]; el[5] = rdlane(r, 5) + be[5]; el[6] = rdlane(r, 3) + be[6]; el[7] = rdlane(r, 7) + be[7]; }
        int i0 = 0; float l0 = el[0];
#pragma unroll
        for (int o = 1; o < 8; ++o) if (el[o] > l0) { l0 = el[o]; i0 = o; }
        int i1 = -1; float l1 = -INFINITY;
#pragma unroll
        for (int o = 0; o < 8; ++o) if (o != i0 && el[o] > l1) { l1 = el[o]; i1 = o; }
        const float ex = __expf(l1 - l0), pe0 = 1.f / (1.f + ex), pe1 = ex / (1.f + ex);
        const int e0 = grp * 8 + i0, e1 = grp * 8 + i1;
        unsigned r0 = 0u, r1 = 0u;
        if (lane == 0) { r0 = __hip_atomic_fetch_add(&HIST[e0], 1u, __ATOMIC_RELAXED, __HIP_MEMORY_SCOPE_WORKGROUP); r1 = __hip_atomic_fetch_add(&HIST[e1], 1u, __ATOMIC_RELAXED, __HIP_MEMORY_SCOPE_WORKGROUP); }
        r0 = (unsigned)__builtin_amdgcn_readfirstlane((int)r0); r1 = (unsigned)__builtin_amdgcn_readfirstlane((int)r1);
        if (lane == it) { my_e0 = e0; my_e1 = e1; my_r0 = (int)r0; my_r1 = (int)r1; my_w0 = pg * pe0; my_w1 = pg * pe1; my_m = m; }
    }
    LN1_FLUSH();
#undef LN1_FLUSH
    __syncthreads();
    if (F.tid < 32) BASE[F.tid] = __hip_atomic_fetch_add((unsigned*)(F.ctl + CW_GCNT + gl * 32 + F.tid), HIST[F.tid], RLX_AGENT);
    __syncthreads();
    if (my_m >= 0) {
        const size_t i0 = (size_t)my_e0 * 32768 + BASE[my_e0] + my_r0, i1 = (size_t)my_e1 * 32768 + BASE[my_e1] + my_r1;
        TPF[i0] = 2 * my_m; WPF[i0] = my_w0; TPF[i1] = 2 * my_m + 1; WPF[i1] = my_w1; }
    __syncthreads();
}

__device__ __forceinline__ void moe_tables(Frame& F, int l) {
    LAS int* PST = (LAS int*)(F.lds + LDSX_OFF + 20480); LAS int* BLKE = PST + 64; LAS int* CNT = PST + 384;
    if (F.tid < NEXP) CNT[F.tid] = (int)__hip_atomic_load(F.ctl + CW_GCNT + l * 32 + F.tid, RLX_AGENT);
    __syncthreads();
    if (F.tid == 0) { int acc = 0;
#pragma unroll 1
        for (int e = 0; e < NEXP; ++e) { const int cnt = CNT[e]; PST[e] = acc; const int nb = (cnt + 255) >> 8;
#pragma unroll 1
            for (int j = 0; j < nb; ++j) BLKE[(acc >> 8) + j] = e; acc += nb << 8; } PST[32] = acc; PST[33] = acc >> 8; }
    __syncthreads();
}
struct SchedMoe { static constexpr bool GATHER = false; const LAS int* PST; int c, G; __device__ __forceinline__ bool next(int i, pg8::Unit& u) const { const int L = i * G + c; const int nb = __builtin_amdgcn_readfirstlane(PST[33]); if (L >= nb * 4) return false; const int rb = L >> 2; u.pm = rb; u.pn = __builtin_amdgcn_readfirstlane(PST[64 + rb]) * 4 + (L & 3); return true; } };
struct SchedMoeG { static constexpr bool GATHER = true; const LAS int* PST; const LAS int* TOKL; int c, G;
    __device__ __forceinline__ bool next(int i, pg8::Unit& u) const { const int L = i * G + c; const int nb = __builtin_amdgcn_readfirstlane(PST[33]); if (L >= nb * 4) return false; const int rb = L >> 2; u.pm = rb; u.pn = __builtin_amdgcn_readfirstlane(PST[64 + rb]) * 4 + (L & 3); return true; }
    __device__ __forceinline__ unsigned row_byte_off(int ui, int r) const { return (unsigned)TOKL[ui * 256 + r] * 2048u; } };
__device__ __forceinline__ void moe_stage_rows(Frame& F) {
    const LAS int* PST = (const LAS int*)(F.lds + LDSX_OFF + 20480); const LAS int* BLKE = PST + 64; const LAS int* CNT = PST + 384; LAS int* TOKL = (LAS int*)(F.lds + LDSX_OFF); const int* tpf = (const int*)(F.ws + WS_TPF);
    const int nb = PST[33];
    for (int i = F.tid; i < 5 * 256; i += 512) { const int ui = i >> 8, r = i & 255, L = ui * F.G + F.vcu; int tok = 0;
        if (L < nb * 4) { const int rb = L >> 2, e = BLKE[rb], local = rb * 256 - PST[e] + r; if (local < CNT[e]) tok = tpf[(size_t)e * 32768 + local] >> 1; }
        TOKL[i] = tok; }
    __syncthreads();
}
struct EpiGateUp {
    static constexpr bool PERM = true;
    bf16* H;
    __device__ __forceinline__ bool reset_after(const pg8::Unit&) const { return true; }
    __device__ __forceinline__ void operator()(pg8::f32x4 (&acc)[2][2][4][2], const pg8::Unit& u, int wr, int wc, int fr, int fq) const {
        using namespace pg8;
        const int row0 = u.pm * BM + wr * 64 + fr, col0 = (u.pn & 3) * HALF + wc * 32 + 8 * fq;
#pragma unroll
        for (int ai = 0; ai < 2; ++ai)
#pragma unroll
            for (int m = 0; m < 4; ++m) { float hv[8];
#pragma unroll
                for (int n = 0; n < 2; ++n)
#pragma unroll
                    for (int i = 0; i < 4; ++i) { const float g = acc[ai][0][m][n][i], up = acc[ai][1][m][n][i]; hv[4 * n + i] = g / (1.f + __expf(-g)) * up; }
                u32x4 w; w.x = cvt_pk_bf16(hv[0], hv[1]); w.y = cvt_pk_bf16(hv[2], hv[3]); w.z = cvt_pk_bf16(hv[4], hv[5]); w.w = cvt_pk_bf16(hv[6], hv[7]);
                *(u32x4*)(H + (size_t)(row0 + ai * HALF + m * 16) * 512 + col0) = w; }
    }
};
struct EpiDown {
    static constexpr bool PERM = true;
    bf16* YB; const int* TPF; const float* WPF; const LAS int* PST;
    __device__ __forceinline__ bool reset_after(const pg8::Unit&) const { return true; }
    __device__ __forceinline__ void operator()(pg8::f32x4 (&acc)[2][2][4][2], const pg8::Unit& u, int wr, int wc, int fr, int fq) const {
        using namespace pg8;
        const int e = u.pn >> 2, cnt = PST[384 + e], loc0 = u.pm * BM - PST[e] + wr * 64 + fr, colb = (u.pn & 3) * BM + wc * 32 + 8 * fq;
        const size_t tb = (size_t)e * 32768;
        int tpa[2][4]; float wpa[2][4];
#pragma unroll
        for (int ai = 0; ai < 2; ++ai)
#pragma unroll
            for (int m = 0; m < 4; ++m) { const int lc = loc0 + ai * HALF + m * 16; const bool ok = lc < cnt; const int li = ok ? lc : 0; const int t = TPF[tb + li]; tpa[ai][m] = ok ? t : -1; wpa[ai][m] = WPF[tb + li]; }
        asm volatile("" ::: "memory");
#pragma unroll
        for (int ai = 0; ai < 2; ++ai)
#pragma unroll
            for (int m = 0; m < 4; ++m) { const int tpv = tpa[ai][m]; if (tpv < 0) continue; const float w_ = wpa[ai][m];
#pragma unroll
                for (int bj = 0; bj < 2; ++bj) { const f32x4 v0 = acc[ai][bj][m][0] * w_, v1 = acc[ai][bj][m][1] * w_;
                    u32x4 w; w.x = cvt_pk_bf16(v0[0], v0[1]); w.y = cvt_pk_bf16(v0[2], v0[3]); w.z = cvt_pk_bf16(v1[0], v1[1]); w.w = cvt_pk_bf16(v1[2], v1[3]);
                    *(u32x4*)(YB + (size_t)tpv * 1024 + colb + bj * HALF) = w; } }
    }
};
__device__ __forceinline__ void phase_ln2(Frame& F, int l, int sub) {
    const bool more = (l + 1 < NL); const bool dry = (sub & 0x10) != 0;
    float* const OUT = dry ? (float*)(F.ws + 560 * MiB) : F.out; bf16* const XBo = (bf16*)(F.ws + (dry ? WS_YTALL : WS_XB));
    const int gw = F.vcu * NWAVES + F.wave, NGW = F.G * NWAVES, lane = F.lane;
    const float* lg = F.ka->in[I_ln2_g] + (size_t)l * D; const float* lb = F.ka->in[I_ln2_b] + (size_t)l * D; const bf16* YB = (const bf16*)(F.ws + WS_YB);
    f32x4 g4[4], b4[4];
#pragma unroll
    for (int j = 0; j < 4; ++j) { g4[j] = *(const f32x4*)(lg + 256 * j + 4 * lane); b4[j] = *(const f32x4*)(lb + 256 * j + 4 * lane); }
    f32x4 g1[4], b1[4];
    { const float* lg1 = F.ka->in[I_ln1_g] + (size_t)l * D; const float* lb1 = F.ka->in[I_ln1_b] + (size_t)l * D;
#pragma unroll
      for (int j = 0; j < 4; ++j) { g1[j] = *(const f32x4*)(lg1 + 256 * j + 4 * lane); b1[j] = *(const f32x4*)(lb1 + 256 * j + 4 * lane); } }
    const float* ST = (const float*)(F.ws + WS_STAT);
    f32x4 nx[4]; v2u na[4], nb[4];
    if (sub & 1) { const GAS f32x4* xr = (const GAS f32x4*)(F.out + (size_t)gw * D) + lane; const GAS v2u* y0 = (const GAS v2u*)(YB + (size_t)(2 * gw) * D) + lane; const GAS v2u* y1 = y0 + D / 4;
#pragma unroll
        for (int j = 0; j < 4; ++j) { nx[j] = xr[64 * j]; na[j] = y0[64 * j]; nb[j] = y1[64 * j]; } }
    if (sub & 1) for (int m = gw; m < T; m += NGW) {
        GAS f32x4* xw = (GAS f32x4*)(OUT + (size_t)m * D) + lane;
        f32x4 v[4]; float s = 0.f; f32x4 cx[4]; v2u ca[4], cb_[4];
#pragma unroll
        for (int j = 0; j < 4; ++j) { cx[j] = nx[j]; ca[j] = na[j]; cb_[j] = nb[j]; }
        { const int mn = (m + NGW < T) ? m + NGW : m;
          const GAS f32x4* xr = (const GAS f32x4*)(F.out + (size_t)mn * D) + lane; const GAS v2u* y0 = (const GAS v2u*)(YB + (size_t)(2 * mn) * D) + lane; const GAS v2u* y1 = y0 + D / 4;
#pragma unroll
            for (int j = 0; j < 4; ++j) { nx[j] = xr[64 * j]; na[j] = y0[64 * j]; nb[j] = y1[64 * j]; } }
        const float mean1 = ST[2 * (size_t)m], rstd1 = ST[2 * (size_t)m + 1];
#pragma unroll
        for (int j = 0; j < 4; ++j) { const f32x4 x = (cx[j] - mean1) * rstd1 * g1[j] + b1[j]; const v2u a = ca[j], b = cb_[j];
            v[j].x = ALPHA * x.x + (bflo(a.x) + bflo(b.x)); v[j].y = ALPHA * x.y + (bfhi(a.x) + bfhi(b.x)); v[j].z = ALPHA * x.z + (bflo(a.y) + bflo(b.y)); v[j].w = ALPHA * x.w + (bfhi(a.y) + bfhi(b.y));
            s += (v[j].x + v[j].y) + (v[j].z + v[j].w); }
        const float mean = wave_sum(s) * (1.f / D); float s2 = 0.f;
#pragma unroll
        for (int j = 0; j < 4; ++j) { v[j] = v[j] - mean; s2 += (v[j].x * v[j].x + v[j].y * v[j].y) + (v[j].z * v[j].z + v[j].w * v[j].w); }
        const float rstd = 1.f / sqrtf(wave_sum(s2) * (1.f / D) + LN_EPS);
        GAS v2u* o8 = (GAS v2u*)(XBo + (size_t)m * D) + lane;
#pragma unroll
        for (int j = 0; j < 4; ++j) {
            v[j] = v[j] * rstd * g4[j] + b4[j]; __builtin_nontemporal_store(v[j], (f32x4*)(xw + 64 * j)); v2u o; o.x = pk2(v[j].x, v[j].y); o.y = pk2(v[j].z, v[j].w); o8[64 * j] = o; }
    }
    __syncthreads();
    if (more && (sub & 2)) weight_prep(F, l + 1);
}

__device__ __forceinline__ void phase_attention(Frame& F, int l) {
    const attn_body::AttnTensors AT{(const attn_body::bf16*)(F.ws + WS_AQKV), (const attn_body::bf16*)(F.ws + WS_AQKV) + 512, (const attn_body::bf16*)(F.ws + WS_AQKV) + 1024,
                                    (attn_body::bf16*)(F.ws + WS_YTALL) + (size_t)2 * T * 512, (const float*)(F.ws + WS_FTAB)};
    volatile LAS unsigned* NEXT = (volatile LAS unsigned*)(F.lds + LDSCTL_OFF + 64);
    unsigned* head = (unsigned*)(F.ctl + CW_AQ + 64 * l);
    if (F.tid == 0) NEXT[0] = __hip_atomic_fetch_add(head, 1u, RLX_AGENT);
    __syncthreads();
    int idx = __builtin_amdgcn_readfirstlane((int)NEXT[0]);
#pragma unroll 1
    while (idx < 1024) {
        unsigned nxt = 0u;
        if (F.tid == 0) nxt = __hip_atomic_fetch_add(head, 1u, RLX_AGENT);
        const int qb = 15 - (idx >> 6), bh = idx & 63;
        attn_body::attn_unit<8>(bh >> 3, bh & 7, qb, AT.Q, AT.K, AT.V, AT.O, AT.F, (char*)F.ldsg, F.tid);
        if (F.tid == 0) NEXT[0] = nxt;
        __syncthreads();
        idx = __builtin_amdgcn_readfirstlane((int)NEXT[0]);
        __syncthreads();
    }
#pragma unroll 1
    while (idx < 1024 + W_MOE_CHUNKS) {
        weight_items(F, l, W_DENSE_ITEMS + (idx - 1024) * W_MOE_CHUNK, W_MOE_CHUNK, F.wave, NWAVES);
        __syncthreads();
        if (F.tid == 0) NEXT[0] = __hip_atomic_fetch_add(head, 1u, RLX_AGENT);
        __syncthreads();
        idx = __builtin_amdgcn_readfirstlane((int)NEXT[0]);
        __syncthreads();
    }
}

__global__ void __launch_bounds__(NWAVES * 64, 2) mega_fwd(Args args) {
    extern __shared__ __attribute__((aligned(16))) unsigned char lds[];
    Frame F;
    F.lds = (LAS unsigned char*)lds; F.ldsg = lds;
    const int wave_s = __builtin_amdgcn_readfirstlane((int)threadIdx.x >> 6);
    F.tid = wave_s * 64 + lane_id(); F.lane = F.tid & 63; F.wave = wave_s;
    const int G_s = gridDim.x, bx_s = blockIdx.x, vcu_s = (G_s % 8 == 0) ? (bx_s % 8) * (G_s / 8) + bx_s / 8 : bx_s;
    F.G = G_s; F.bx = bx_s; F.vcu = vcu_s;
    F.ws = args.ws; F.ctl = (gu32*)(args.ws + WS_CTL); F.out = args.out; F.ka = (KArgs)__builtin_amdgcn_kernarg_segment_ptr();
    volatile LAS unsigned* MISC = (volatile LAS unsigned*)(F.lds + MISC_OFF);
    for (int u = F.tid; u < (LDS_BYTES - LDSCTL_OFF) / 4; u += NWAVES * 64) ((LAS unsigned*)(F.lds + LDSCTL_OFF))[u] = 0u;
    __syncthreads();
    const int lo = args.ph_lo, hi = args.ph_hi, sub = args.sub; F.dup = sub & 0xE0;
    XcdBarrier bar; bar.bar = (unsigned*)(F.ctl + CW_BAR); bar.x = 0; bar.st = nullptr;
    if (hi - lo > 1) bar = xcd_barrier_post((unsigned*)(F.ctl + CW_BAR), MISC + 8, wave_s == 0 && lane_id() == 0);
#ifndef PH_MASK
#define PH_MASK 0x3fff
#endif
#define HAS(j) (((PH_MASK) >> (j)) & 1)
#ifndef DOUBLE_BAR
#define DOUBLE_BAR 0
#endif

#define IN(k) (lo <= (k) && (k) < hi)
#define SEAM(k) do { if (IN(k) && IN((k) + 1)) { XcdBarrier b2_ = bar; asm volatile("" : "+s"(b2_.bar)); asm volatile("" : "+s"(b2_.x)); xcd_barrier(b2_, wave_s == 0 && lane_id() == 0); if (DOUBLE_BAR) xcd_barrier(b2_, wave_s == 0 && lane_id() == 0); } } while (0)
#define FRESH() do { int t_ = wave_s * 64 + lane_id(); asm volatile("" : "+v"(t_)); F.tid = t_; F.lane = t_ & 63; F.wave = wave_s; \
        int g_ = G_s, b_ = bx_s, v_ = vcu_s; asm volatile("" : "+s"(g_), "+s"(b_), "+s"(v_)); F.G = g_; F.bx = b_; F.vcu = v_; \
        unsigned char* w_ = args.ws; asm volatile("" : "+s"(w_)); F.ws = w_; ws = w_; F.ctl = (gu32*)(w_ + WS_CTL); float* o_ = args.out; asm volatile("" : "+s"(o_)); F.out = o_; } while (0)
    unsigned char* ws = args.ws;
    if (HAS(13) && IN(0)) { FRESH(); phase_p0(F); SEAM(0); }
#pragma unroll 1
    for (int l = 0; l < NL; ++l) {
        const int pb = 1 + l * NPH_LAYER;
        if (HAS(0) && IN(pb + 0)) { FRESH(); small_gates_mfma(F, l);
            pg8::Gemm g{(const pg8::bf16_t*)(ws + WS_XB), (const pg8::bf16_t*)(ws + WS_WIN), 1024, 1024, 1024}; pg8::StaticOrder S; S.init(T, NIN, F.G, F.bx);
            LAS float* BIAS = (LAS float*)(F.lds + LDSX_OFF);
            { const float* bsrc = F.ka->in[I_b_in] + (size_t)l * INTOT; for (int i = F.tid; i < INTOT / 4; i += 512) *(LAS f32x4*)(BIAS + 4 * i) = *(const f32x4*)(bsrc + 4 * i); }
            __syncthreads();
            EpiInProj E{ws, BIAS};
            pg8::gemm_phase<EpiInProj, pg8::StaticOrder, true>(F.lds + RING_OFF, g, S, E, F.tid);
            SEAM(pb + 0);
        }
        if (HAS(1) && IN(pb + 1)) { FRESH(); phase_prep2(F, l); SEAM(pb + 1); }
        if (HAS(2) && IN(pb + 2)) { FRESH();
#ifndef P2_NO_A
            if (sub & 1) mlstm_pass1_all(F, l);
#endif
#ifndef P2_NO_B
            if (sub & 2) { pg8::Gemm g{(const pg8::bf16_t*)(ws + WS_S5A), (const pg8::bf16_t*)(ws + WS_S5ALL + (size_t)l * S5_LAYER_BYTES + 20 * MiB), 512, S5K, 512}; SchedS5E S{F.vcu}; EpiS5E E{(float*)(ws + WS_EBUF)};
              pg8::gemm_phase<EpiS5E, SchedS5E, true>(F.lds + RING_OFF, g, S, E, F.tid); }
            __syncthreads();
#endif
#ifndef P2_NO_C
            if (sub & 4) phase_attention(F, l);
#endif
            SEAM(pb + 2);
        }
        if (HAS(3) && IN(pb + 3)) { FRESH(); phase_scans(F, l, (sub & 0x10) != 0); SEAM(pb + 3); }
        if (HAS(4) && IN(pb + 4)) { FRESH();
            mlstm_pass3_all(F, l);
            { pg8::Gemm g{(const pg8::bf16_t*)(ws + WS_S5A), (const pg8::bf16_t*)(ws + WS_S5ALL + (size_t)l * S5_LAYER_BYTES), S5K, S5K, S5K}; SchedS5Y S{F.vcu}; EpiS5Y E{(bf16*)(ws + WS_YS1)};
              pg8::gemm_phase<EpiS5Y, SchedS5Y, true>(F.lds + RING_OFF, g, S, E, F.tid); }
            SEAM(pb + 4);
        }
        if (HAS(5) && IN(pb + 5)) { FRESH();            pg8::Gemm g{(const pg8::bf16_t*)(ws + WS_YS1), (const pg8::bf16_t*)(ws + WS_WGLU), 512, 512, 512}; pg8::StaticOrder S; S.init(T, 512, F.G, F.bx);
            EpiGlu E{(const bf16*)(ws + WS_YS1), (bf16*)(ws + WS_YTALL) + (size_t)T * 512, F.ka->in[I_s5_b_glu] + (size_t)l * 512};
            pg8::gemm_phase<EpiGlu, pg8::StaticOrder, true>(F.lds + RING_OFF, g, S, E, F.tid);
            SEAM(pb + 5);
        }
        if (HAS(6) && IN(pb + 6)) { FRESH();            pg8::Gemm g{(const pg8::bf16_t*)(ws + WS_YTALL), (const pg8::bf16_t*)(ws + WS_WBR), 512, 512, 512}; SchedMerge S{F.vcu, F.G};
            EpiMerge E{(const bf16*)(ws + WS_GATE), (bf16*)(ws + WS_MIXED)};
            pg8::gemm_phase<EpiMerge, SchedMerge, true>(F.lds + RING_OFF, g, S, E, F.tid);
            SEAM(pb + 6);
        }
        if (HAS(7) && IN(pb + 7)) { FRESH();
            pg8::Gemm g{(const pg8::bf16_t*)(ws + WS_MIXED), (const pg8::bf16_t*)(ws + WS_WOUT), 1024, 1024, 1024}; pg8::StaticOrder S; S.init(T, 1024, F.G, F.bx);
            EpiOutProj E{l == 0 ? F.ka->in[I_x] : (const float*)F.out, F.out};
            pg8::gemm_phase<EpiOutProj, pg8::StaticOrder, true>(F.lds + RING_OFF, g, S, E, F.tid);
            SEAM(pb + 7);
        }
        if (HAS(8) && IN(pb + 8)) { FRESH(); phase_ln1_route(F, l, (sub & 0x10) != 0); SEAM(pb + 8); }
        if (HAS(10) && IN(pb + 9)) { FRESH();moe_tables(F, l); moe_stage_rows(F);
            pg8::Gemm g{(const pg8::bf16_t*)(ws + WS_XB), (const pg8::bf16_t*)(ws + WS_WGU), 1024, 1024, 1024}; SchedMoeG S{(const LAS int*)(F.lds + LDSX_OFF + 20480), (const LAS int*)(F.lds + LDSX_OFF), F.vcu, F.G};
            EpiGateUp E{(bf16*)(ws + WS_HB)};
            pg8::gemm_phase<EpiGateUp, SchedMoeG, true>(F.lds + RING_OFF, g, S, E, F.tid);
            SEAM(pb + 9);
        }
        if (HAS(11) && IN(pb + 10)) { FRESH();            moe_tables(F, l);
            pg8::Gemm g{(const pg8::bf16_t*)(ws + WS_HB), (const pg8::bf16_t*)(ws + WS_WDN), 512, 512, 512}; SchedMoe S{(const LAS int*)(F.lds + LDSX_OFF + 20480), F.vcu, F.G};
            EpiDown E{(bf16*)(ws + WS_YB), (const int*)(ws + WS_TPF), (const float*)(ws + WS_WPF), (const LAS int*)(F.lds + LDSX_OFF + 20480)};
            pg8::gemm_phase<EpiDown, SchedMoe, true>(F.lds + RING_OFF, g, S, E, F.tid);
            SEAM(pb + 10);
        }
        if (HAS(12) && IN(pb + 11)) { FRESH(); phase_ln2(F, l, sub); SEAM(pb + 11); }
    }
#undef IN
#undef SEAM
}

extern "C" void kernel_launch(void* const* d_in, const int* in_sizes, int n_in, void* d_out, int out_size, void* d_ws, size_t ws_size, hipStream_t stream) {
    static int grid = 0;
    if (grid == 0) {
        if (n_in != 29 || in_sizes[0] != T * D || out_size != T * D || ws_size < WS_END) { fprintf(stderr, "kernel_launch: unexpected shapes / workspace (n_in %d, ws %zu < %zu)\n", n_in, ws_size, (size_t)WS_END); grid = -1; return; }
        int dev = 0, cus = 0;
        if (hipGetDevice(&dev) != hipSuccess || hipDeviceGetAttribute(&cus, hipDeviceAttributeMultiprocessorCount, dev) != hipSuccess) { grid = -1; return; }
        if (hipFuncSetAttribute((const void*)mega_fwd, hipFuncAttributeMaxDynamicSharedMemorySize, LDS_BYTES) != hipSuccess) { fprintf(stderr, "kernel_launch: hipFuncSetAttribute failed\n"); grid = -1; return; }
        int per_cu = 0;
        (void)hipOccupancyMaxActiveBlocksPerMultiprocessor(&per_cu, (const void*)mega_fwd, NWAVES * 64, LDS_BYTES);
        (void)hipGetLastError();
        if (cus != 256 || per_cu < 1) { fprintf(stderr, "kernel_launch: needs 256 CUs with one resident workgroup each (cus %d, per_cu %d)\n", cus, per_cu); grid = -1; return; }
        grid = cus;
    }
    if (grid < 0) return;
    (void)hipMemsetAsync((char*)d_ws + WS_CTL, 0, CTL_ZERO_BYTES, stream);
    Args a{};
    for (int i = 0; i < 29; ++i) a.in[i] = (const float*)d_in[i];
    a.out = (float*)d_out; a.ws = (unsigned char*)d_ws;
    a.sub = 0xF; a.pad = 0;
#if MK_ONE_LAUNCH
    a.ph_lo = 0; a.ph_hi = NPHASES;
    hipLaunchKernelGGL(mega_fwd, dim3(grid), dim3(NWAVES * 64), LDS_BYTES, stream, a);
#else
#ifndef PROBE_KIND
#define PROBE_KIND -1
#endif
#ifndef PROBE_REPS
#define PROBE_REPS 1
#endif
#ifndef PROBE_SUB
#define PROBE_SUB -1
#endif
    for (int p = 0; p < NPHASES; ++p) { a.ph_lo = p; a.ph_hi = p + 1; a.sub = 0xF;
        const int kind = (p == 0) ? 13 : (p - 1) % NPH_LAYER;
        if (kind == PROBE_KIND && PROBE_SUB != -1 && (PROBE_SUB & 0x100)) {   }
        hipLaunchKernelGGL(mega_fwd, dim3(grid), dim3(NWAVES * 64), LDS_BYTES, stream, a);
        if (kind == PROBE_KIND) { a.sub = PROBE_SUB; for (int r = 0; r < PROBE_REPS; ++r) hipLaunchKernelGGL(mega_fwd, dim3(grid), dim3(NWAVES * 64), LDS_BYTES, stream, a); }
    }
#endif
}
```
